# Optimizing an MI355X kernel written in HIP

```python
import math
import jax
import jax.numpy as jnp
from jax import lax
import numpy as np

D_MODEL = 1024
BATCH = 2
SEQ = 8192
DEPTH = 2

HEAD_DIM = 64
BRANCH_WIDTH = D_MODEL // 2
N_BRANCHES = 4
N_HEADS = BRANCH_WIDTH // HEAD_DIM
SSM_HEADS = N_HEADS
SSM_GROUPS = 2
SSM_STATE = 128
SSM_CONV = 4
SSM_CHUNK = 256
SSM_BC = SSM_GROUPS * SSM_STATE
SSM_CONV_DIM = BRANCH_WIDTH + 2 * SSM_BC
MOBA_BLOCK = 256
MOBA_TOPK = 3
MOBA_Q_CHUNK = 64
FOX_Q_BLOCK = 128
SWA_WINDOW = 128
SWA_KV_HEADS = 2
REL_BUCKETS = 32
REL_MAX_EXACT = REL_BUCKETS // 2
REL_MAX_DISTANCE = 1024
N_BIAS_HEADS = 2 * N_HEADS
D_FF = 256 * math.ceil(8 * D_MODEL / 3 / 256)
NORM_EPS = 1e-6
SPLIT_SIZES = (
    BRANCH_WIDTH,
    SSM_CONV_DIM,
    SSM_HEADS,
    3 * BRANCH_WIDTH,
    3 * BRANCH_WIDTH,
    N_HEADS,
    BRANCH_WIDTH,
    2 * SWA_KV_HEADS * HEAD_DIM,
    N_BRANCHES * D_MODEL,
)
D_IN_PROJ = sum(SPLIT_SIZES)
SPLIT_POINTS = [int(v) for v in np.cumsum(SPLIT_SIZES)[:-1]]

kernel_name = 'hybrid_ssd_moba_fox_swa_gated_block'


def rmsnorm(x, w):
    xf = x.astype(jnp.float32)
    y = xf * lax.rsqrt(jnp.mean(xf * xf, axis=-1, keepdims=True) + NORM_EPS)
    return (y * w.astype(jnp.float32)).astype(x.dtype)


def rel_bucket(dist):
    dist = jnp.maximum(dist, 0)
    d = jnp.maximum(dist, 1).astype(jnp.float32)
    large = REL_MAX_EXACT + (jnp.log(d / REL_MAX_EXACT) / math.log(REL_MAX_DISTANCE / REL_MAX_EXACT)
                             * (REL_BUCKETS - REL_MAX_EXACT)).astype(jnp.int32)
    large = jnp.minimum(large, REL_BUCKETS - 1)
    return jnp.where(dist < REL_MAX_EXACT, dist, large)


def causal_depthwise_conv(u, w, b):
    c = u.shape[-1]
    out = lax.conv_general_dilated(u, w.astype(u.dtype)[:, None, :], window_strides=(1,),
                                   padding=((w.shape[0] - 1, 0),),
                                   dimension_numbers=('NWC', 'WIO', 'NWC'),
                                   feature_group_count=c)
    return out + b.astype(u.dtype)


def ssd_chunked_scan(xs, bm, cm, dt_raw, dt_bias, a_log, d_skip):
    f32 = jnp.float32
    bsz, s_len, n_h, p_dim = xs.shape
    n_g, n_s = bm.shape[2], bm.shape[3]
    r = n_h // n_g
    lc = SSM_CHUNK
    nc = -(-s_len // lc)
    pad = nc * lc - s_len
    xs, bm, cm = xs.astype(f32), bm.astype(f32), cm.astype(f32)
    dt = jax.nn.softplus(dt_raw.astype(f32) + dt_bias.astype(f32))
    a = dt * (-jnp.exp(a_log.astype(f32)))

    def padseq(u):
        return jnp.pad(u, [(0, 0), (0, pad)] + [(0, 0)] * (u.ndim - 2))

    xc = padseq(xs * dt[..., None]).reshape(bsz, nc, lc, n_g, r, p_dim)
    bc = padseq(bm).reshape(bsz, nc, lc, n_g, n_s)
    cc = padseq(cm).reshape(bsz, nc, lc, n_g, n_s)
    acum_l = jnp.cumsum(padseq(a).reshape(bsz, nc, lc, n_g, r), axis=2)
    acum = jnp.moveaxis(acum_l, 2, -1)
    causal = jnp.tril(jnp.ones((lc, lc), dtype=bool))
    decay_in = jnp.exp(jnp.where(causal, acum[..., :, None] - acum[..., None, :], -jnp.inf))
    cb = jnp.einsum('bclgn,bcsgn->bcgls', cc, bc)
    y_diag = jnp.einsum('bcgrls,bcsgrp->bclgrp', cb[:, :, :, None] * decay_in, xc)
    decay_to_end = jnp.exp(acum_l[:, :, -1:] - acum_l)
    states = jnp.einsum('bclgn,bclgrp->bcgrpn', bc, xc * decay_to_end[..., None])
    chunk_decay = jnp.exp(acum[..., -1])

    def step(h, inp):
        st, dec = inp
        return h * dec[..., None, None] + st, h

    h0 = jnp.zeros((bsz, n_g, r, p_dim, n_s), f32)
    _, h_in = lax.scan(step, h0, (jnp.moveaxis(states, 1, 0), jnp.moveaxis(chunk_decay, 1, 0)))
    h_in = jnp.moveaxis(h_in, 0, 1)
    y_off = jnp.einsum('bclgn,bcgrpn->bclgrp', cc, h_in) * jnp.exp(acum_l)[..., None]
    y = (y_diag + y_off).reshape(bsz, nc * lc, n_h, p_dim)[:, :s_len]
    return y + d_skip.astype(f32)[:, None] * xs


def mamba2_branch(z, xbc, dt_raw, conv_w, conv_b, dt_bias, a_log, d_skip, norm_w):
    bsz, s_len, _ = z.shape
    xbc = jax.nn.silu(causal_depthwise_conv(xbc, conv_w, conv_b))
    xs, bm, cm = jnp.split(xbc, [BRANCH_WIDTH, BRANCH_WIDTH + SSM_BC], axis=-1)
    y = ssd_chunked_scan(xs.reshape(bsz, s_len, SSM_HEADS, HEAD_DIM),
                         bm.reshape(bsz, s_len, SSM_GROUPS, SSM_STATE),
                         cm.reshape(bsz, s_len, SSM_GROUPS, SSM_STATE),
                         dt_raw, dt_bias, a_log, d_skip)
    y = y.reshape(bsz, s_len, BRANCH_WIDTH).astype(z.dtype)
    return rmsnorm(y * jax.nn.silu(z), norm_w)


def moba_attention(q, k, v, bias_tab):
    f32 = jnp.float32
    bsz, s_len, n_h, hd = q.shape
    nblk = -(-s_len // MOBA_BLOCK)
    s_pad = nblk * MOBA_BLOCK
    topk = min(MOBA_TOPK, nblk)
    scale = hd ** -0.5
    qh = q.transpose(0, 2, 1, 3)

    def blocks(u):
        u = jnp.pad(u, ((0, 0), (0, s_pad - s_len), (0, 0), (0, 0)))
        return u.reshape(bsz, nblk, MOBA_BLOCK, n_h, hd).transpose(0, 3, 1, 2, 4)

    kb, vb = blocks(k), blocks(v)
    k_mean = jnp.mean(kb.astype(f32), axis=3)
    q_blk = jnp.arange(s_len) // MOBA_BLOCK
    gate = jnp.einsum('bhsd,bhnd->bhsn', qh.astype(f32), k_mean)
    fully_past = jnp.arange(nblk)[None, :] < q_blk[:, None]
    gate = jnp.where(fully_past, gate, -jnp.inf)
    _, sel = lax.top_k(gate, topk)
    sel_valid = jnp.arange(topk)[None, :] < q_blk[:, None]
    bias_ht = bias_tab.T.astype(f32)
    b_idx = jnp.arange(bsz)[:, None, None, None]
    h_idx = jnp.arange(n_h)[None, :, None, None]
    blk_off = jnp.arange(MOBA_BLOCK)

    def chunk(c):
        start = c * MOBA_Q_CHUNK
        qc = lax.dynamic_slice_in_dim(qh, start, MOBA_Q_CHUNK, axis=2)
        selc = lax.dynamic_slice_in_dim(sel, start, MOBA_Q_CHUNK, axis=2)
        validc = lax.dynamic_slice_in_dim(sel_valid, start, MOBA_Q_CHUNK, axis=0)
        qpos = start + jnp.arange(MOBA_Q_CHUNK)
        kg = kb[b_idx, h_idx, selc]
        vg = vb[b_idx, h_idx, selc]
        s_sel = jnp.einsum('bhqd,bhqkjd->bhqkj', qc, kg).astype(f32) * scale
        kpos = selc[..., None] * MOBA_BLOCK + blk_off
        s_sel = s_sel + bias_ht[h_idx[..., None], rel_bucket(qpos[:, None, None] - kpos)]
        s_sel = jnp.where(validc[None, None, :, :, None], s_sel, -jnp.inf)
        own = start // MOBA_BLOCK
        ko = lax.dynamic_index_in_dim(kb, own, axis=2, keepdims=False)
        vo = lax.dynamic_index_in_dim(vb, own, axis=2, keepdims=False)
        dist_own = qpos[:, None] - (own * MOBA_BLOCK + blk_off)[None, :]
        s_own = jnp.einsum('bhqd,bhjd->bhqj', qc, ko).astype(f32) * scale
        s_own = s_own + bias_ht[:, rel_bucket(dist_own)][None]
        s_own = jnp.where(dist_own >= 0, s_own, -jnp.inf)
        logits = jnp.concatenate([s_sel.reshape(bsz, n_h, MOBA_Q_CHUNK, topk * MOBA_BLOCK), s_own], axis=-1)
        p = jax.nn.softmax(logits, axis=-1)
        p_sel = p[..., :topk * MOBA_BLOCK].reshape(bsz, n_h, MOBA_Q_CHUNK, topk, MOBA_BLOCK).astype(v.dtype)
        p_own = p[..., topk * MOBA_BLOCK:].astype(v.dtype)
        return (jnp.einsum('bhqkj,bhqkjd->bhqd', p_sel, vg)
                + jnp.einsum('bhqj,bhjd->bhqd', p_own, vo))

    out = lax.map(chunk, jnp.arange(s_len // MOBA_Q_CHUNK))
    return out.transpose(1, 0, 3, 2, 4).reshape(bsz, s_len, n_h * hd)


def forgetting_attention(q, k, v, f_logit):
    f32 = jnp.float32
    bsz, s_len, n_h, hd = q.shape
    scale = hd ** -0.5
    cum = jnp.cumsum(jax.nn.log_sigmoid(f_logit.astype(f32)), axis=1).transpose(0, 2, 1)
    qh, kh, vh = (u.transpose(0, 2, 1, 3) for u in (q, k, v))
    kpos = jnp.arange(s_len)

    def block(i):
        start = i * FOX_Q_BLOCK
        qb = lax.dynamic_slice_in_dim(qh, start, FOX_Q_BLOCK, axis=2)
        cq = lax.dynamic_slice_in_dim(cum, start, FOX_Q_BLOCK, axis=2)
        s = (jnp.einsum('bhqd,bhkd->bhqk', qb, kh).astype(f32) * scale
             + (cq[..., :, None] - cum[..., None, :]))
        causal = (start + jnp.arange(FOX_Q_BLOCK))[:, None] >= kpos[None, :]
        p = jax.nn.softmax(jnp.where(causal, s, -jnp.inf), axis=-1)
        return jnp.einsum('bhqk,bhkd->bhqd', p.astype(v.dtype), vh)

    out = lax.map(block, jnp.arange(s_len // FOX_Q_BLOCK))
    return out.transpose(1, 0, 3, 2, 4).reshape(bsz, s_len, n_h * hd)


def sliding_window_attention(q, k, v, sinks, bias_tab):
    f32 = jnp.float32
    bsz, s_len, n_q, hd = q.shape
    n_kv = k.shape[2]
    grp = n_q // n_kv
    w = SWA_WINDOW
    nb = s_len // w
    scale = hd ** -0.5
    qb = q.reshape(bsz, nb, w, n_kv, grp, hd)

    def band(u):
        ub = u.reshape(bsz, nb, w, n_kv, hd)
        prev = jnp.pad(ub, ((0, 0), (1, 0), (0, 0), (0, 0), (0, 0)))[:, :-1]
        return jnp.concatenate([prev, ub], axis=2)

    kk, vv = band(k), band(v)
    s = jnp.einsum('bnqkgd,bnjkd->bnkgqj', qb, kk).astype(f32) * scale
    qi = jnp.arange(w)[:, None]
    kj = jnp.arange(2 * w)[None, :]
    dist = qi + w - kj
    in_window = (dist >= 0) & (dist < w)
    key_pos = jnp.arange(nb)[:, None, None] * w + kj[None] - w
    mask = in_window[None] & (key_pos >= 0)
    bias = bias_tab.astype(f32)[rel_bucket(dist)].transpose(2, 0, 1).reshape(n_kv, grp, w, 2 * w)
    s = jnp.where(mask[None, :, None, None], s + bias, -jnp.inf)
    sink = jnp.broadcast_to(sinks.astype(f32).reshape(n_kv, grp, 1, 1), s.shape[:-1] + (1,))
    p = jax.nn.softmax(jnp.concatenate([s, sink], axis=-1), axis=-1)[..., :-1]
    out = jnp.einsum('bnkgqj,bnjkd->bnqkgd', p.astype(v.dtype), vv)
    return out.reshape(bsz, s_len, n_q * hd)


def hybrid_mixer(h, w_in, conv_w, conv_b, dt_bias, a_log, d_skip, ssm_norm_w,
                 forget_bias, sinks, rel_bias, w_branch, w_out):
    bsz, s_len, _ = h.shape
    proj = h @ w_in
    (m_z, m_xbc, m_dt, b_qkv, c_qkv, c_f, d_q, d_kv, gate_logits) = jnp.split(proj, SPLIT_POINTS, axis=-1)

    def heads(u, n):
        return u.reshape(bsz, s_len, n, HEAD_DIM)

    y_a = mamba2_branch(m_z, m_xbc, m_dt, conv_w, conv_b, dt_bias, a_log, d_skip, ssm_norm_w)
    bq, bk, bv = jnp.split(b_qkv, 3, axis=-1)
    y_b = moba_attention(heads(bq, N_HEADS), heads(bk, N_HEADS), heads(bv, N_HEADS), rel_bias[:, :N_HEADS])
    cq, ck, cv = jnp.split(c_qkv, 3, axis=-1)
    y_c = forgetting_attention(heads(cq, N_HEADS), heads(ck, N_HEADS), heads(cv, N_HEADS), c_f + forget_bias)
    dk, dv = jnp.split(d_kv, 2, axis=-1)
    y_d = sliding_window_attention(heads(d_q, N_HEADS), heads(dk, SWA_KV_HEADS), heads(dv, SWA_KV_HEADS),
                                   sinks, rel_bias[:, N_HEADS:])
    branches = jnp.stack([y_a, y_b, y_c, y_d], axis=2)
    branch_out = jnp.einsum('bsiw,iwd->bsid', branches, w_branch)
    gates = jax.nn.sigmoid(gate_logits.reshape(bsz, s_len, N_BRANCHES, D_MODEL))
    return jnp.sum(gates * branch_out, axis=2) @ w_out


def swiglu(h, w_gate, w_up, w_down):
    return (jax.nn.silu(h @ w_gate) * (h @ w_up)) @ w_down


def setup_inputs(seed: int = 0) -> dict:
    key = jax.random.key(seed)
    ks = jax.random.split(key, 20)
    nrm = jax.random.normal
    x = nrm(ks[0], (BATCH, SEQ, D_MODEL), jnp.float32)
    w_in = nrm(ks[1], (DEPTH, D_MODEL, D_IN_PROJ), jnp.float32) * D_MODEL ** -0.5
    conv_w = nrm(ks[2], (DEPTH, SSM_CONV, SSM_CONV_DIM), jnp.float32) * SSM_CONV ** -0.5
    conv_b = 0.02 * nrm(ks[3], (DEPTH, SSM_CONV_DIM), jnp.float32)
    dt0 = jnp.exp(jax.random.uniform(ks[4], (DEPTH, SSM_HEADS), jnp.float32,
                                     minval=math.log(1e-3), maxval=math.log(1e-1)))
    dt_bias = dt0 + jnp.log(-jnp.expm1(-dt0))
    a_log = jnp.log(jax.random.uniform(ks[5], (DEPTH, SSM_HEADS), jnp.float32, minval=1.0, maxval=16.0))
    d_skip = 1.0 + 0.1 * nrm(ks[6], (DEPTH, SSM_HEADS), jnp.float32)
    ssm_norm_w = 1.0 + 0.05 * nrm(ks[7], (DEPTH, BRANCH_WIDTH), jnp.float32)
    forget_bias = jax.random.uniform(ks[8], (DEPTH, N_HEADS), jnp.float32, minval=1.0, maxval=6.0)
    sinks = nrm(ks[9], (DEPTH, N_HEADS), jnp.float32)
    rel_bias = 0.3 * nrm(ks[10], (REL_BUCKETS, N_BIAS_HEADS), jnp.float32)
    w_branch = nrm(ks[11], (DEPTH, N_BRANCHES, BRANCH_WIDTH, D_MODEL), jnp.float32) * BRANCH_WIDTH ** -0.5
    w_out = nrm(ks[12], (DEPTH, D_MODEL, D_MODEL), jnp.float32) * D_MODEL ** -0.5
    norm_mix = 1.0 + 0.05 * nrm(ks[13], (DEPTH, D_MODEL), jnp.float32)
    norm_ffn = 1.0 + 0.05 * nrm(ks[14], (DEPTH, D_MODEL), jnp.float32)
    w_ffn_gate = nrm(ks[15], (DEPTH, D_MODEL, D_FF), jnp.float32) * D_MODEL ** -0.5
    w_ffn_up = nrm(ks[16], (DEPTH, D_MODEL, D_FF), jnp.float32) * D_MODEL ** -0.5
    w_ffn_down = nrm(ks[17], (DEPTH, D_FF, D_MODEL), jnp.float32) * D_FF ** -0.5
    norm_final = 1.0 + 0.05 * nrm(ks[18], (D_MODEL,), jnp.float32)
    return {'x': x, 'w_in': w_in, 'conv_w': conv_w, 'conv_b': conv_b, 'dt_bias': dt_bias,
            'a_log': a_log, 'd_skip': d_skip, 'ssm_norm_w': ssm_norm_w, 'forget_bias': forget_bias,
            'sinks': sinks, 'rel_bias': rel_bias, 'w_branch': w_branch, 'w_out': w_out,
            'norm_mix': norm_mix, 'norm_ffn': norm_ffn, 'w_ffn_gate': w_ffn_gate,
            'w_ffn_up': w_ffn_up, 'w_ffn_down': w_ffn_down, 'norm_final': norm_final}


def reference(x, w_in, conv_w, conv_b, dt_bias, a_log, d_skip, ssm_norm_w, forget_bias,
              sinks, rel_bias, w_branch, w_out, norm_mix, norm_ffn, w_ffn_gate,
              w_ffn_up, w_ffn_down, norm_final):
    for l in range(DEPTH):
        h = rmsnorm(x, norm_mix[l])
        x = x + hybrid_mixer(h, w_in[l], conv_w[l], conv_b[l], dt_bias[l], a_log[l], d_skip[l],
                             ssm_norm_w[l], forget_bias[l], sinks[l], rel_bias, w_branch[l], w_out[l])
        h = rmsnorm(x, norm_ffn[l])
        x = x + swiglu(h, w_ffn_gate[l], w_ffn_up[l], w_ffn_down[l])
    return rmsnorm(x, norm_final)
```

```cpp
#include <hip/hip_runtime.h>
#include <hip/hip_cooperative_groups.h>
#include <cstdio>
#include <cstdint>
namespace cg = cooperative_groups;

#ifndef SINGLE_LAUNCH
#define SINGLE_LAUNCH 0
#endif

typedef unsigned short bf16_t;
constexpr int M = 16384, SEQ = 8192, D = 1024, DIN = 9488, NPROJ = 5376, DFF = 2816;
constexpr int NT = 512;
constexpr int PC_Z = 0, PC_XBC = 512, PC_MQ = 1536, PC_MK = 2048, PC_MV = 2560, PC_FQ = 3072, PC_FK = 3584, PC_FV = 4096, PC_SQ = 4608, PC_SK = 5120, PC_SV = 5248;
constexpr int WC_DT = 1536, WC_F = 4616, WC_GATE = 5392;
constexpr size_t MiB = 1u << 20;
constexpr size_t WS_XN = 0, WS_PROJ = 32 * MiB, WS_XC = 200 * MiB, WS_DT = 232 * MiB, WS_LF = WS_DT + MiB / 2, WS_CUM = 233 * MiB, WS_KMEAN = WS_CUM + MiB / 2, WS_END = 234 * MiB;

struct Args { const float* in[19]; float* out; unsigned char* ws; int ph_lo, ph_hi, coop, pad; };

__device__ __forceinline__ float bf2f(unsigned v) { return __uint_as_float(v << 16); }
__device__ __forceinline__ float bflo(unsigned v) { return __uint_as_float(v << 16); }
__device__ __forceinline__ float bfhi(unsigned v) { return __uint_as_float(v & 0xffff0000u); }
__device__ __forceinline__ unsigned f2bf(float f) { unsigned u = __float_as_uint(f); return (u + 0x7fffu + ((u >> 16) & 1u)) >> 16; }
__device__ __forceinline__ unsigned pk2(float lo, float hi) { return f2bf(lo) | (f2bf(hi) << 16); }
__device__ __forceinline__ float wave_sum(float v) {
#pragma unroll
    for (int o = 1; o < 64; o <<= 1) v += __shfl_xor(v, o);
    return v;
}
__device__ __forceinline__ float log1p_pos(float e) {
    const float small = e * (1.f + e * (-0.5f + e * (0.33333333f + e * (-0.25f + e * 0.2f))));
    return e < 0.02f ? small : logf(1.f + e);
}
__device__ __forceinline__ float softplus_f(float x) { return fmaxf(x, 0.f) + log1p_pos(expf(-fabsf(x))); }
__device__ __forceinline__ float silu_f(float x) { return x / (1.f + expf(-x)); }
__device__ __forceinline__ float sigmoid_f(float x) { return 1.f / (1.f + expf(-x)); }
__device__ __forceinline__ int rel_bucket(int d) {
    if (d < 16) return d;
    int b = 16;
    b += (d >= 21); b += (d >= 27); b += (d >= 35); b += (d >= 46); b += (d >= 59); b += (d >= 77); b += (d >= 99); b += (d >= 128);
    b += (d >= 166); b += (d >= 216); b += (d >= 280); b += (d >= 363); b += (d >= 470); b += (d >= 609); b += (d >= 790);
    return b;
}

__device__ __forceinline__ void ph_norm(float* hrow, const float* xin, const float* nw, bf16_t* XN, bool dots, const float* w_in, const float* dt_bias, const float* fbias, float* DT, float* LF) {
    const int lane = threadIdx.x & 63, wave = threadIdx.x >> 6;
    const int gw = blockIdx.x * 8 + wave, NGW = gridDim.x * 8;
    for (int row = gw; row < M; row += NGW) {
        const float4* xr = (const float4*)(xin + (size_t)row * D);
        float4 v[4]; float ss = 0.f;
#pragma unroll
        for (int j = 0; j < 4; ++j) { v[j] = xr[lane + 64 * j]; ss += v[j].x * v[j].x + v[j].y * v[j].y + v[j].z * v[j].z + v[j].w * v[j].w; }
        ss = wave_sum(ss);
        const float rstd = 1.0f / sqrtf(ss * (1.0f / D) + 1e-6f);
#pragma unroll
        for (int j = 0; j < 4; ++j) { const float4 w4 = ((const float4*)nw)[lane + 64 * j]; v[j].x *= rstd * w4.x; v[j].y *= rstd * w4.y; v[j].z *= rstd * w4.z; v[j].w *= rstd * w4.w; }
        uint2* o = (uint2*)(XN + (size_t)row * D);
#pragma unroll
        for (int j = 0; j < 4; ++j) o[lane + 64 * j] = make_uint2(pk2(v[j].x, v[j].y), pk2(v[j].z, v[j].w));
        if (dots) {
            float* hr = hrow + (threadIdx.x >> 6) * 1024;
#pragma unroll
            for (int j = 0; j < 4; ++j) *(float4*)(hr + (lane + 64 * j) * 4) = v[j];
            __builtin_amdgcn_s_waitcnt(0xc07f);
            float d[16];
#pragma unroll
            for (int c = 0; c < 16; ++c) d[c] = 0.f;
#pragma unroll 1
            for (int k = lane; k < D; k += 64) {
                const float* wr = w_in + (size_t)k * DIN;
                const float4 a0 = *(const float4*)(wr + WC_DT), a1 = *(const float4*)(wr + WC_DT + 4), b0 = *(const float4*)(wr + WC_F), b1 = *(const float4*)(wr + WC_F + 4);
                const float h = hr[k];
                d[0] += h * a0.x; d[1] += h * a0.y; d[2] += h * a0.z; d[3] += h * a0.w; d[4] += h * a1.x; d[5] += h * a1.y; d[6] += h * a1.z; d[7] += h * a1.w;
                d[8] += h * b0.x; d[9] += h * b0.y; d[10] += h * b0.z; d[11] += h * b0.w; d[12] += h * b1.x; d[13] += h * b1.y; d[14] += h * b1.z; d[15] += h * b1.w;
            }
            float mine = 0.f;
#pragma unroll
            for (int c = 0; c < 16; ++c) { const float s = wave_sum(d[c]); if (lane == c) mine = s; }
            if (lane < 8) DT[(size_t)row * 8 + lane] = softplus_f(mine + dt_bias[lane]);
            else if (lane < 16) LF[(size_t)row * 8 + (lane - 8)] = -softplus_f(-(mine + fbias[lane - 8]));
        }
    }
}

constexpr int LDT = 132;
__device__ __forceinline__ void tile_gemm(float (&acc)[4][8], const bf16_t* A, int lda, int row0, const float* B, int ldb, int bcol0, int K, float* As, float* Bs) {
    const int tid = threadIdx.x, ty = tid >> 4, tx = tid & 15;
    const int ar = tid >> 2, ak = (tid & 3) * 4;
    const int bk = tid >> 5, bn = (tid & 31) * 4;
    for (int k0 = 0; k0 < K; k0 += 16) {
        const uint2 av = *(const uint2*)(A + (size_t)(row0 + ar) * lda + k0 + ak);
        const float4 bv = *(const float4*)(B + (size_t)(k0 + bk) * ldb + bcol0 + bn);
        __syncthreads();
        As[(ak + 0) * LDT + ar] = bflo(av.x); As[(ak + 1) * LDT + ar] = bfhi(av.x); As[(ak + 2) * LDT + ar] = bflo(av.y); As[(ak + 3) * LDT + ar] = bfhi(av.y);
        *(float4*)(Bs + bk * LDT + bn) = bv;
        __syncthreads();
#pragma unroll 2
        for (int kk = 0; kk < 16; ++kk) {
            const float4 a4 = *(const float4*)(As + kk * LDT + ty * 4);
            const float4 b0 = *(const float4*)(Bs + kk * LDT + tx * 8), b1 = *(const float4*)(Bs + kk * LDT + tx * 8 + 4);
            const float a[4] = {a4.x, a4.y, a4.z, a4.w}; const float b[8] = {b0.x, b0.y, b0.z, b0.w, b1.x, b1.y, b1.z, b1.w};
#pragma unroll
            for (int i = 0; i < 4; ++i)
#pragma unroll
                for (int j = 0; j < 8; ++j) acc[i][j] += a[i] * b[j];
        }
    }
}
#define ZERO_ACC(acc) do { _Pragma("unroll") for (int i_ = 0; i_ < 4; ++i_) _Pragma("unroll") for (int j_ = 0; j_ < 8; ++j_) acc[i_][j_] = 0.f; } while (0)

__device__ __forceinline__ void ph_inproj(const bf16_t* XN, const float* w_in, bf16_t* PROJ, float* As, float* Bs) {
    const int ty = threadIdx.x >> 4, tx = threadIdx.x & 15;
    const int ntn = NPROJ / 128;
    for (int item = blockIdx.x; item < (M / 128) * ntn; item += gridDim.x) {
        const int pm = item / ntn, pn = item % ntn, col0 = pn * 128;
        const int src0 = col0 + (col0 >= 1536 ? 8 : 0) + (col0 >= 4608 ? 8 : 0);
        float acc[4][8]; ZERO_ACC(acc);
        tile_gemm(acc, XN, D, pm * 128, w_in, DIN, src0, D, As, Bs);
#pragma unroll
        for (int i = 0; i < 4; ++i) {
            uint4 o; o.x = pk2(acc[i][0], acc[i][1]); o.y = pk2(acc[i][2], acc[i][3]); o.z = pk2(acc[i][4], acc[i][5]); o.w = pk2(acc[i][6], acc[i][7]);
            *(uint4*)(PROJ + (size_t)(pm * 128 + ty * 4 + i) * NPROJ + col0 + tx * 8) = o;
        }
    }
}

__device__ __forceinline__ void ph_pre(const bf16_t* PROJ, const float* conv_w, const float* conv_b, bf16_t* XC, float* KMEAN, const float* LF, float* CUM) {
    const size_t gt = (size_t)blockIdx.x * NT + threadIdx.x, tot = (size_t)gridDim.x * NT;
    for (size_t e = gt; e < (size_t)M * 1024; e += tot) {
        const int row = (int)(e >> 10), c = (int)(e & 1023), t = row & (SEQ - 1);
        float acc = conv_b[c];
#pragma unroll
        for (int i = 0; i < 4; ++i) { const int tt = t - 3 + i; if (tt >= 0) acc += conv_w[i * 1024 + c] * bf2f(PROJ[(size_t)(row - 3 + i) * NPROJ + PC_XBC + c]); }
        XC[e] = (bf16_t)f2bf(silu_f(acc));
    }
    for (size_t e = gt; e < (size_t)2 * 32 * 512; e += tot) {
        const int c = (int)(e & 511), blk = (int)((e >> 9) & 31), b = (int)(e >> 14);
        float s = 0.f;
        for (int r = 0; r < 256; ++r) s += bf2f(PROJ[(size_t)(b * SEQ + blk * 256 + r) * NPROJ + PC_MK + c]);
        KMEAN[e] = s * (1.0f / 256.0f);
    }
    const int lane = threadIdx.x & 63, gw = blockIdx.x * 8 + (threadIdx.x >> 6);
    if (gw < 16) {
        const int b = gw >> 3, h = gw & 7;
        const float* lf = LF + ((size_t)b * SEQ + lane * 128) * 8 + h;
        float s = 0.f;
        for (int i = 0; i < 128; ++i) s += lf[(size_t)i * 8];
        float incl = s;
#pragma unroll
        for (int o = 1; o < 64; o <<= 1) { const float v = __shfl_up(incl, o); if (lane >= o) incl += v; }
        float run = incl - s;
        float* cu = CUM + ((size_t)b * SEQ + lane * 128) * 8 + h;
        for (int i = 0; i < 128; ++i) { run += lf[(size_t)i * 8]; cu[(size_t)i * 8] = run; }
    }
}

__device__ __forceinline__ void load_q(float (&qv)[64], const bf16_t* qp, float sc) {
#pragma unroll
    for (int c = 0; c < 8; ++c) { const uint4 u = *(const uint4*)(qp + c * 8);
        qv[c * 8 + 0] = bflo(u.x) * sc; qv[c * 8 + 1] = bfhi(u.x) * sc; qv[c * 8 + 2] = bflo(u.y) * sc; qv[c * 8 + 3] = bfhi(u.y) * sc;
        qv[c * 8 + 4] = bflo(u.z) * sc; qv[c * 8 + 5] = bfhi(u.z) * sc; qv[c * 8 + 6] = bflo(u.w) * sc; qv[c * 8 + 7] = bfhi(u.w) * sc; }
}
__device__ __forceinline__ float dot_q(const float (&qv)[64], const bf16_t* kp) {
    float s = 0.f;
#pragma unroll
    for (int c = 0; c < 8; ++c) { const uint4 u = *(const uint4*)(kp + c * 8);
        s += qv[c * 8 + 0] * bflo(u.x) + qv[c * 8 + 1] * bfhi(u.x) + qv[c * 8 + 2] * bflo(u.y) + qv[c * 8 + 3] * bfhi(u.y)
           + qv[c * 8 + 4] * bflo(u.z) + qv[c * 8 + 5] * bfhi(u.z) + qv[c * 8 + 6] * bflo(u.w) + qv[c * 8 + 7] * bfhi(u.w); }
    return s;
}
__device__ __forceinline__ void osm(float s, const bf16_t* vp, float& m, float& l, float (&o)[64]) {
    const float mn = fmaxf(m, s), al = __expf(m - mn), p = __expf(s - mn);
    l = l * al + p; m = mn;
#pragma unroll
    for (int c = 0; c < 8; ++c) { const uint4 u = *(const uint4*)(vp + c * 8);
        o[c * 8 + 0] = o[c * 8 + 0] * al + p * bflo(u.x); o[c * 8 + 1] = o[c * 8 + 1] * al + p * bfhi(u.x);
        o[c * 8 + 2] = o[c * 8 + 2] * al + p * bflo(u.y); o[c * 8 + 3] = o[c * 8 + 3] * al + p * bfhi(u.y);
        o[c * 8 + 4] = o[c * 8 + 4] * al + p * bflo(u.z); o[c * 8 + 5] = o[c * 8 + 5] * al + p * bfhi(u.z);
        o[c * 8 + 6] = o[c * 8 + 6] * al + p * bflo(u.w); o[c * 8 + 7] = o[c * 8 + 7] * al + p * bfhi(u.w); }
}
__device__ __forceinline__ void store_o(bf16_t* op, const float (&o)[64], float inv) {
#pragma unroll
    for (int c = 0; c < 8; ++c) { uint4 u; u.x = pk2(o[c * 8 + 0] * inv, o[c * 8 + 1] * inv); u.y = pk2(o[c * 8 + 2] * inv, o[c * 8 + 3] * inv);
        u.z = pk2(o[c * 8 + 4] * inv, o[c * 8 + 5] * inv); u.w = pk2(o[c * 8 + 6] * inv, o[c * 8 + 7] * inv); *(uint4*)(op + c * 8) = u; }
}

__device__ __forceinline__ void mamba_item(int item, bf16_t* XC, const float* DT, const float* a_log, const float* d_skip) {
    const int lane = threadIdx.x & 63;
    const int p = item & 63, h = (item >> 6) & 7, b = item >> 9, g = h >> 2;
    const float A = -expf(a_log[h]), Dh = d_skip[h];
    float h0 = 0.f, h1 = 0.f;
    for (int t = 0; t < SEQ; t += 4) {
        float xt[4], dt[4]; unsigned Bp[4], Cp[4];
#pragma unroll
        for (int u = 0; u < 4; ++u) { const size_t row = (size_t)b * SEQ + t + u; const bf16_t* xr = XC + row * 1024;
            xt[u] = bf2f(xr[h * 64 + p]); dt[u] = DT[row * 8 + h]; Bp[u] = *(const unsigned*)(xr + 512 + g * 128 + lane * 2); Cp[u] = *(const unsigned*)(xr + 768 + g * 128 + lane * 2); }
#pragma unroll
        for (int u = 0; u < 4; ++u) { const float dec = expf(dt[u] * A), dx = dt[u] * xt[u];
            h0 = h0 * dec + dx * bflo(Bp[u]); h1 = h1 * dec + dx * bfhi(Bp[u]);
            float y = bflo(Cp[u]) * h0 + bfhi(Cp[u]) * h1; y = wave_sum(y); y += Dh * xt[u];
            if (lane == 0) XC[((size_t)b * SEQ + t + u) * 1024 + h * 64 + p] = (bf16_t)f2bf(y); }
    }
}
__device__ __forceinline__ void fox_item(int item, bf16_t* PROJ, const float* CUM) {
    const int lane = threadIdx.x & 63;
    const int bh = item & 15, qg = 127 - (item >> 4), b = bh >> 3, h = bh & 7;
    const int q = qg * 64 + lane; const size_t row = (size_t)b * SEQ + q;
    float qv[64], o[64]; load_q(qv, PROJ + row * NPROJ + PC_FQ + h * 64, 0.125f);
#pragma unroll
    for (int d = 0; d < 64; ++d) o[d] = 0.f;
    const float cq = CUM[row * 8 + h]; float m = -INFINITY, l = 0.f;
    const int jmax = qg * 64 + 63;
    for (int j = 0; j <= jmax; ++j) {
        const size_t kr = (size_t)b * SEQ + j; const bf16_t* kp = PROJ + kr * NPROJ;
        const float s = dot_q(qv, kp + PC_FK + h * 64) + (cq - CUM[kr * 8 + h]);
        if (j <= q) osm(s, kp + PC_FV + h * 64, m, l, o);
    }
    store_o(PROJ + row * NPROJ + PC_FQ + h * 64, o, 1.0f / l);
}
__device__ __forceinline__ void moba_block(const float (&qv)[64], const bf16_t* PROJ, int b, int h, int blk, int q, const float* btab, float& m, float& l, float (&o)[64]) {
    for (int j = 0; j < 256; ++j) {
        const int kpos = blk * 256 + j; const bf16_t* kp = PROJ + ((size_t)b * SEQ + kpos) * NPROJ;
        const float s = dot_q(qv, kp + PC_MK + h * 64) + btab[rel_bucket(q - kpos) * 16 + h];
        osm(s, kp + PC_MV + h * 64, m, l, o);
    }
}
__device__ __forceinline__ void moba_item(int item, bf16_t* PROJ, const float* KMEAN, const float* btab) {
    const int lane = threadIdx.x & 63;
    const int bh = item & 15, qg = item >> 4, b = bh >> 3, h = bh & 7;
    const int q = qg * 64 + lane, qb = q >> 8; const size_t row = (size_t)b * SEQ + q;
    float qv[64], o[64]; load_q(qv, PROJ + row * NPROJ + PC_MQ + h * 64, 1.0f);
#pragma unroll
    for (int d = 0; d < 64; ++d) o[d] = 0.f;
    float g0 = -INFINITY, g1 = -INFINITY, g2 = -INFINITY; int i0 = -1, i1 = -1, i2 = -1;
    for (int n = 0; n < qb; ++n) {
        const float* km = KMEAN + ((size_t)(b * 32 + n)) * 512 + h * 64; float g = 0.f;
#pragma unroll
        for (int d = 0; d < 64; ++d) g += qv[d] * km[d];
        if (g > g0) { g2 = g1; i2 = i1; g1 = g0; i1 = i0; g0 = g; i0 = n; }
        else if (g > g1) { g2 = g1; i2 = i1; g1 = g; i1 = n; }
        else if (g > g2) { g2 = g; i2 = n; }
    }
#pragma unroll
    for (int d = 0; d < 64; ++d) qv[d] *= 0.125f;
    float m = -INFINITY, l = 0.f;
    if (i0 >= 0) moba_block(qv, PROJ, b, h, i0, q, btab, m, l, o);
    if (i1 >= 0) moba_block(qv, PROJ, b, h, i1, q, btab, m, l, o);
    if (i2 >= 0) moba_block(qv, PROJ, b, h, i2, q, btab, m, l, o);
    for (int j = 0; j <= (q & 255); ++j) {
        const int kpos = qb * 256 + j; const bf16_t* kp = PROJ + ((size_t)b * SEQ + kpos) * NPROJ;
        const float s = dot_q(qv, kp + PC_MK + h * 64) + btab[rel_bucket(q - kpos) * 16 + h];
        osm(s, kp + PC_MV + h * 64, m, l, o);
    }
    store_o(PROJ + row * NPROJ + PC_MQ + h * 64, o, 1.0f / l);
}
__device__ __forceinline__ void swa_item(int item, bf16_t* PROJ, const float* sinks, const float* btab) {
    const int lane = threadIdx.x & 63;
    const int bh = item & 15, qg = item >> 4, b = bh >> 3, hq = bh & 7, kv = hq >> 2;
    const int q = qg * 64 + lane; const size_t row = (size_t)b * SEQ + q;
    float qv[64], o[64]; load_q(qv, PROJ + row * NPROJ + PC_SQ + hq * 64, 0.125f);
#pragma unroll
    for (int d = 0; d < 64; ++d) o[d] = 0.f;
    float m = sinks[hq], l = 1.f;
    for (int jj = 0; jj < 128; ++jj) {
        const int kpos = q - 127 + jj;
        if (kpos >= 0) { const bf16_t* kp = PROJ + ((size_t)b * SEQ + kpos) * NPROJ;
            const float s = dot_q(qv, kp + PC_SK + kv * 64) + btab[rel_bucket(q - kpos) * 16 + 8 + hq];
            osm(s, kp + PC_SV + kv * 64, m, l, o); }
    }
    store_o(PROJ + row * NPROJ + PC_SQ + hq * 64, o, 1.0f / l);
}
__device__ __forceinline__ void ph_seq(bf16_t* PROJ, bf16_t* XC, const float* DT, const float* CUM, const float* KMEAN, const float* a_log, const float* d_skip, const float* sinks, const float* btab) {
    const int gw = blockIdx.x * 8 + (threadIdx.x >> 6), NGW = gridDim.x * 8;
    for (int it = gw; it < 1024 + 3 * 2048; it += NGW) {
        if (it < 1024) mamba_item(it, XC, DT, a_log, d_skip);
        else if (it < 1024 + 2048) fox_item(it - 1024, PROJ, CUM);
        else if (it < 1024 + 4096) moba_item(it - 1024 - 2048, PROJ, KMEAN, btab);
        else swa_item(it - 1024 - 4096, PROJ, sinks, btab);
    }
}
__device__ __forceinline__ void ph_mamba_norm(bf16_t* PROJ, const bf16_t* XC, const float* nw) {
    const int lane = threadIdx.x & 63, gw = blockIdx.x * 8 + (threadIdx.x >> 6), NGW = gridDim.x * 8;
    for (int row = gw; row < M; row += NGW) {
        const uint4 yv = *(const uint4*)(XC + (size_t)row * 1024 + lane * 8); const uint4 zv = *(const uint4*)(PROJ + (size_t)row * NPROJ + PC_Z + lane * 8);
        float y[8] = {bflo(yv.x), bfhi(yv.x), bflo(yv.y), bfhi(yv.y), bflo(yv.z), bfhi(yv.z), bflo(yv.w), bfhi(yv.w)};
        const float z[8] = {bflo(zv.x), bfhi(zv.x), bflo(zv.y), bfhi(zv.y), bflo(zv.z), bfhi(zv.z), bflo(zv.w), bfhi(zv.w)};
        float ss = 0.f;
#pragma unroll
        for (int i = 0; i < 8; ++i) { y[i] *= silu_f(z[i]); ss += y[i] * y[i]; }
        ss = wave_sum(ss); const float rstd = 1.0f / sqrtf(ss * (1.0f / 512.0f) + 1e-6f);
        const float4 w0 = *(const float4*)(nw + lane * 8), w1 = *(const float4*)(nw + lane * 8 + 4);
        uint4 o; o.x = pk2(y[0] * rstd * w0.x, y[1] * rstd * w0.y); o.y = pk2(y[2] * rstd * w0.z, y[3] * rstd * w0.w); o.z = pk2(y[4] * rstd * w1.x, y[5] * rstd * w1.y); o.w = pk2(y[6] * rstd * w1.z, y[7] * rstd * w1.w);
        *(uint4*)(PROJ + (size_t)row * NPROJ + PC_Z + lane * 8) = o;
    }
}
__device__ __forceinline__ void ph_mix(const bf16_t* XN, const bf16_t* PROJ, const float* w_in, const float* w_branch, bf16_t* MIXED, float* As, float* Bs) {
    const int ty = threadIdx.x >> 4, tx = threadIdx.x & 15;
    for (int item = blockIdx.x; item < (M / 128) * 8; item += gridDim.x) {
        const int pm = item >> 3, pn = item & 7, col0 = pn * 128;
        float mix[4][8]; ZERO_ACC(mix);
#pragma unroll 1
        for (int i = 0; i < 4; ++i) {
            const int ycol = (i == 0) ? PC_Z : (i == 1) ? PC_MQ : (i == 2) ? PC_FQ : PC_SQ;
            float ag[4][8], ab[4][8]; ZERO_ACC(ag); ZERO_ACC(ab);
            tile_gemm(ag, XN, D, pm * 128, w_in, DIN, WC_GATE + i * 1024 + col0, D, As, Bs);
            tile_gemm(ab, PROJ + ycol, NPROJ, pm * 128, w_branch + (size_t)i * 512 * 1024, D, col0, 512, As, Bs);
#pragma unroll
            for (int r = 0; r < 4; ++r)
#pragma unroll
                for (int c = 0; c < 8; ++c) mix[r][c] += sigmoid_f(ag[r][c]) * ab[r][c];
        }
#pragma unroll
        for (int r = 0; r < 4; ++r) { uint4 o; o.x = pk2(mix[r][0], mix[r][1]); o.y = pk2(mix[r][2], mix[r][3]); o.z = pk2(mix[r][4], mix[r][5]); o.w = pk2(mix[r][6], mix[r][7]);
            *(uint4*)(MIXED + (size_t)(pm * 128 + ty * 4 + r) * D + col0 + tx * 8) = o; }
    }
}
__device__ __forceinline__ void ph_resgemm(const bf16_t* A, int lda, int K, const float* W, const float* res, float* out, float* As, float* Bs) {
    const int ty = threadIdx.x >> 4, tx = threadIdx.x & 15;
    for (int item = blockIdx.x; item < (M / 128) * 8; item += gridDim.x) {
        const int pm = item >> 3, pn = item & 7, col0 = pn * 128;
        float acc[4][8]; ZERO_ACC(acc);
        tile_gemm(acc, A, lda, pm * 128, W, D, col0, K, As, Bs);
#pragma unroll
        for (int r = 0; r < 4; ++r) { const size_t off = (size_t)(pm * 128 + ty * 4 + r) * D + col0 + tx * 8;
            const float4 r0 = *(const float4*)(res + off), r1 = *(const float4*)(res + off + 4);
            *(float4*)(out + off) = make_float4(r0.x + acc[r][0], r0.y + acc[r][1], r0.z + acc[r][2], r0.w + acc[r][3]);
            *(float4*)(out + off + 4) = make_float4(r1.x + acc[r][4], r1.y + acc[r][5], r1.z + acc[r][6], r1.w + acc[r][7]); }
    }
}
__device__ __forceinline__ void ph_up(const bf16_t* XN, const float* wg, const float* wu, bf16_t* H, float* As, float* Bs) {
    const int ty = threadIdx.x >> 4, tx = threadIdx.x & 15;
    const int ntn = DFF / 128;
    for (int item = blockIdx.x; item < (M / 128) * ntn; item += gridDim.x) {
        const int pm = item / ntn, pn = item % ntn, col0 = pn * 128;
        float ag[4][8], au[4][8]; ZERO_ACC(ag); ZERO_ACC(au);
        tile_gemm(ag, XN, D, pm * 128, wg, DFF, col0, D, As, Bs);
        tile_gemm(au, XN, D, pm * 128, wu, DFF, col0, D, As, Bs);
#pragma unroll
        for (int r = 0; r < 4; ++r) { float v[8];
#pragma unroll
            for (int c = 0; c < 8; ++c) v[c] = silu_f(ag[r][c]) * au[r][c];
            uint4 o; o.x = pk2(v[0], v[1]); o.y = pk2(v[2], v[3]); o.z = pk2(v[4], v[5]); o.w = pk2(v[6], v[7]);
            *(uint4*)(H + (size_t)(pm * 128 + ty * 4 + r) * DFF + col0 + tx * 8) = o; }
    }
}
__device__ __forceinline__ void ph_final(float* out, const float* nw) {
    const int lane = threadIdx.x & 63, gw = blockIdx.x * 8 + (threadIdx.x >> 6), NGW = gridDim.x * 8;
    for (int row = gw; row < M; row += NGW) {
        float4* xr = (float4*)(out + (size_t)row * D);
        float4 v[4]; float ss = 0.f;
#pragma unroll
        for (int j = 0; j < 4; ++j) { v[j] = xr[lane + 64 * j]; ss += v[j].x * v[j].x + v[j].y * v[j].y + v[j].z * v[j].z + v[j].w * v[j].w; }
        ss = wave_sum(ss); const float rstd = 1.0f / sqrtf(ss * (1.0f / D) + 1e-6f);
#pragma unroll
        for (int j = 0; j < 4; ++j) { const float4 w4 = ((const float4*)nw)[lane + 64 * j]; xr[lane + 64 * j] = make_float4(v[j].x * rstd * w4.x, v[j].y * rstd * w4.y, v[j].z * rstd * w4.z, v[j].w * rstd * w4.w); }
    }
}

constexpr int PH_PER_LAYER = 10, NPH = 2 * PH_PER_LAYER + 1;
template <int P> __global__ void __launch_bounds__(NT) fwd(Args a) {
    __shared__ __attribute__((aligned(16))) float As[16 * LDT];
    __shared__ __attribute__((aligned(16))) float Bs[16 * LDT];
    __shared__ __attribute__((aligned(16))) float hrow[P == 0 ? 8 * 1024 : 4];
    unsigned char* ws = a.ws;
    bf16_t* XN = (bf16_t*)(ws + WS_XN); bf16_t* PROJ = (bf16_t*)(ws + WS_PROJ); bf16_t* XC = (bf16_t*)(ws + WS_XC);
    float* DT = (float*)(ws + WS_DT); float* LF = (float*)(ws + WS_LF); float* CUM = (float*)(ws + WS_CUM); float* KMEAN = (float*)(ws + WS_KMEAN);
    bf16_t* MIXED = XC; bf16_t* H = PROJ;
    const int l = a.ph_lo;
    const float* xin = (l == 0) ? a.in[0] : a.out;
    const float* w_in = a.in[1] + (size_t)l * D * DIN;
    if constexpr (P == 10) ph_final(a.out, a.in[18]);
    if constexpr (P == 0) ph_norm(hrow, xin, a.in[13] + l * D, XN, true, w_in, a.in[4] + l * 8, a.in[8] + l * 8, DT, LF);
    if constexpr (P == 1) ph_inproj(XN, w_in, PROJ, As, Bs);
    if constexpr (P == 2) ph_pre(PROJ, a.in[2] + (size_t)l * 4 * 1024, a.in[3] + l * 1024, XC, KMEAN, LF, CUM);
    if constexpr (P == 3) ph_seq(PROJ, XC, DT, CUM, KMEAN, a.in[5] + l * 8, a.in[6] + l * 8, a.in[9] + l * 8, a.in[10]);
    if constexpr (P == 4) ph_mamba_norm(PROJ, XC, a.in[7] + l * 512);
    if constexpr (P == 5) ph_mix(XN, PROJ, w_in, a.in[11] + (size_t)l * 4 * 512 * 1024, MIXED, As, Bs);
    if constexpr (P == 6) ph_resgemm(MIXED, D, D, a.in[12] + (size_t)l * D * D, xin, a.out, As, Bs);
    if constexpr (P == 7) ph_norm(nullptr, a.out, a.in[14] + l * D, XN, false, nullptr, nullptr, nullptr, nullptr, nullptr);
    if constexpr (P == 8) ph_up(XN, a.in[15] + (size_t)l * D * DFF, a.in[16] + (size_t)l * D * DFF, H, As, Bs);
    if constexpr (P == 9) ph_resgemm(H, DFF, DFF, a.in[17] + (size_t)l * DFF * D, a.out, a.out, As, Bs);
}

extern "C" void kernel_launch(void* const* d_in, const int* in_sizes, int n_in, void* d_out, int out_size, void* d_ws, size_t ws_size, hipStream_t stream) {
    if (n_in != 19 || out_size != M * D || ws_size < WS_END) { fprintf(stderr, "kernel_launch: unexpected shapes (n_in %d out %d ws %zu)\n", n_in, out_size, ws_size); return; }
    const int grid = 512;
    Args a{};
    for (int i = 0; i < 19; ++i) a.in[i] = (const float*)d_in[i];
    a.out = (float*)d_out; a.ws = (unsigned char*)d_ws;
    for (int l = 0; l < 2; ++l) {
        a.ph_lo = l;
        hipLaunchKernelGGL(fwd<0>, dim3(grid), dim3(NT), 0, stream, a);
        hipLaunchKernelGGL(fwd<1>, dim3(grid), dim3(NT), 0, stream, a);
        hipLaunchKernelGGL(fwd<2>, dim3(grid), dim3(NT), 0, stream, a);
        hipLaunchKernelGGL(fwd<3>, dim3(grid), dim3(NT), 0, stream, a);
        hipLaunchKernelGGL(fwd<4>, dim3(grid), dim3(NT), 0, stream, a);
        hipLaunchKernelGGL(fwd<5>, dim3(grid), dim3(NT), 0, stream, a);
        hipLaunchKernelGGL(fwd<6>, dim3(grid), dim3(NT), 0, stream, a);
        hipLaunchKernelGGL(fwd<7>, dim3(grid), dim3(NT), 0, stream, a);
        hipLaunchKernelGGL(fwd<8>, dim3(grid), dim3(NT), 0, stream, a);
        hipLaunchKernelGGL(fwd<9>, dim3(grid), dim3(NT), 0, stream, a);
    }
    a.ph_lo = 0;
    hipLaunchKernelGGL(fwd<10>, dim3(grid), dim3(NT), 0, stream, a);
}
```

```cpp
#include <hip/hip_runtime.h>
#include <hip/hip_cooperative_groups.h>
#include <cstdio>
#include <cstdint>
namespace cg = cooperative_groups;

#ifndef SINGLE_LAUNCH
#define SINGLE_LAUNCH 0
#endif

typedef unsigned short bf16_t;
constexpr int M = 16384, SEQ = 8192, D = 1024, DIN = 9488, NPROJ = 5376, DFF = 2816;
constexpr int NT = 512;
constexpr int PC_Z = 0, PC_XBC = 512, PC_MQ = 1536, PC_MK = 2048, PC_MV = 2560, PC_FQ = 3072, PC_FK = 3584, PC_FV = 4096, PC_SQ = 4608, PC_SK = 5120, PC_SV = 5248;
constexpr int WC_DT = 1536, WC_F = 4616, WC_GATE = 5392;
constexpr size_t MiB = 1u << 20;
constexpr size_t WS_XN = 0, WS_PROJ = 32 * MiB, WS_XC = 200 * MiB, WS_DT = 232 * MiB, WS_LF = WS_DT + MiB / 2, WS_CUM = 233 * MiB, WS_KMEAN = WS_CUM + MiB / 2;
constexpr size_t WS_WIN = 234 * MiB;
constexpr size_t WS_WG = WS_WIN + (size_t)NPROJ * D * 2;
constexpr size_t WS_WBR = WS_WG + (size_t)4096 * D * 2;
constexpr size_t WS_WOUT = WS_WBR + (size_t)4 * D * 512 * 2;
constexpr size_t WS_WGU = WS_WOUT + (size_t)D * D * 2;
constexpr size_t WS_WDN = WS_WGU + (size_t)2 * DFF * D * 2;
constexpr size_t WS_END = WS_WDN + (size_t)D * DFF * 2;
static_assert(WS_END <= 276 * MiB, "workspace map");

constexpr size_t WS_CTL = 276 * MiB, CTL_ZERO_BYTES = 65536, WS_CDEC = WS_CTL + 131072, WS_TOTAL = 294 * MiB;
constexpr size_t WS_STATES = 234 * MiB, WS_PL = WS_STATES + 8 * MiB;
constexpr size_t WS_PO2 = 277 * MiB, WS_SEL = 293 * MiB;
#define P_XN(w) ((bf16_t*)((w) + WS_XN))
#define P_PROJ(w) ((bf16_t*)((w) + WS_PROJ))
#define P_XC(w) ((bf16_t*)((w) + WS_XC))
struct Args { const float* in[19]; float* out; unsigned char* ws; int ph_lo, ph_hi, coop, pad; };

__device__ __forceinline__ float bf2f(unsigned v) { return __uint_as_float(v << 16); }
__device__ __forceinline__ float bflo(unsigned v) { return __uint_as_float(v << 16); }
__device__ __forceinline__ float bfhi(unsigned v) { return __uint_as_float(v & 0xffff0000u); }
__device__ __forceinline__ unsigned f2bf(float f) { unsigned u = __float_as_uint(f); return (u + 0x7fffu + ((u >> 16) & 1u)) >> 16; }
__device__ __forceinline__ unsigned pk2(float lo, float hi) { return f2bf(lo) | (f2bf(hi) << 16); }
__device__ __forceinline__ float wave_sum(float v) {
#pragma unroll
    for (int o = 1; o < 64; o <<= 1) v += __shfl_xor(v, o);
    return v;
}
__device__ __forceinline__ int ltid() { int t = threadIdx.x; asm volatile("" : "+v"(t)); return t; }
__device__ __forceinline__ float log1p_pos(float e) {
    const float small = e * (1.f + e * (-0.5f + e * (0.33333333f + e * (-0.25f + e * 0.2f))));
    return e < 0.02f ? small : logf(1.f + e);
}
__device__ __forceinline__ float softplus_f(float x) { return fmaxf(x, 0.f) + log1p_pos(expf(-fabsf(x))); }
__device__ __forceinline__ float silu_f(float x) { return x / (1.f + expf(-x)); }
__device__ __forceinline__ float sigmoid_f(float x) { return 1.f / (1.f + expf(-x)); }
__device__ __forceinline__ int rel_bucket(int d) {
    if (d < 16) return d;
    int b = 16;
    b += (d >= 21); b += (d >= 27); b += (d >= 35); b += (d >= 46); b += (d >= 59); b += (d >= 77); b += (d >= 99); b += (d >= 128);
    b += (d >= 166); b += (d >= 216); b += (d >= 280); b += (d >= 363); b += (d >= 470); b += (d >= 609); b += (d >= 790);
    return b;
}

__device__ __forceinline__ void ph_norm(float* wd, const float* xin, const float* nw, bf16_t* XN, bool dots, const float* w_in, const float* dt_bias, const float* fbias, float* DT, float* LF) {
    const int tx_ = ltid();
    const int lane = tx_ & 63, wave = tx_ >> 6;
    const int gw = blockIdx.x * 8 + wave, NGW = gridDim.x * 8;
    if (dots) {
        for (int i = tx_; i < 1024 * 4; i += NT) { const int k = i >> 2, part = i & 3;
            *(float4*)((char*)wd + (k >> 2) * 272 + (k & 3) * 64 + part * 16) = *(const float4*)(w_in + (size_t)k * DIN + (part < 2 ? WC_DT + part * 4 : WC_F + (part - 2) * 4)); }
        __syncthreads();
    }
    for (int row = gw; row < M; row += NGW) {
        const float4* xr = (const float4*)(xin + (size_t)row * D);
        float4 v[4]; float ss = 0.f;
#pragma unroll
        for (int j = 0; j < 4; ++j) { v[j] = xr[lane + 64 * j]; ss += v[j].x * v[j].x + v[j].y * v[j].y + v[j].z * v[j].z + v[j].w * v[j].w; }
        ss = wave_sum(ss);
        const float rstd = 1.0f / sqrtf(ss * (1.0f / D) + 1e-6f);
#pragma unroll
        for (int j = 0; j < 4; ++j) { const float4 w4 = ((const float4*)nw)[lane + 64 * j]; v[j].x *= rstd * w4.x; v[j].y *= rstd * w4.y; v[j].z *= rstd * w4.z; v[j].w *= rstd * w4.w; }
        uint2* o = (uint2*)(XN + (size_t)row * D);
#pragma unroll
        for (int j = 0; j < 4; ++j) o[lane + 64 * j] = make_uint2(pk2(v[j].x, v[j].y), pk2(v[j].z, v[j].w));
        if (dots) {
            float d[16];
#pragma unroll
            for (int c = 0; c < 16; ++c) d[c] = 0.f;
#pragma unroll
            for (int j = 0; j < 4; ++j) { const float hv[4] = {v[j].x, v[j].y, v[j].z, v[j].w};
#pragma unroll
                for (int e = 0; e < 4; ++e) { const float* wr = (const float*)((const char*)wd + (lane + 64 * j) * 272 + e * 64); const float h = hv[e];
                    const float4 a0 = *(const float4*)(wr), a1 = *(const float4*)(wr + 4), b0 = *(const float4*)(wr + 8), b1 = *(const float4*)(wr + 12);
                    d[0] += h * a0.x; d[1] += h * a0.y; d[2] += h * a0.z; d[3] += h * a0.w; d[4] += h * a1.x; d[5] += h * a1.y; d[6] += h * a1.z; d[7] += h * a1.w;
                    d[8] += h * b0.x; d[9] += h * b0.y; d[10] += h * b0.z; d[11] += h * b0.w; d[12] += h * b1.x; d[13] += h * b1.y; d[14] += h * b1.z; d[15] += h * b1.w; }
                asm volatile("" ::: "memory"); }
            float r8[8], r4[4], r2[2];
            { const bool up = (lane & 32) != 0;
#pragma unroll
              for (int i = 0; i < 8; ++i) { const float keep = up ? d[i + 8] : d[i], send = up ? d[i] : d[i + 8]; r8[i] = keep + __shfl_xor(send, 32); } }
            { const bool up = (lane & 16) != 0;
#pragma unroll
              for (int i = 0; i < 4; ++i) { const float keep = up ? r8[i + 4] : r8[i], send = up ? r8[i] : r8[i + 4]; r4[i] = keep + __shfl_xor(send, 16); } }
            { const bool up = (lane & 8) != 0;
#pragma unroll
              for (int i = 0; i < 2; ++i) { const float keep = up ? r4[i + 2] : r4[i], send = up ? r4[i] : r4[i + 2]; r2[i] = keep + __shfl_xor(send, 8); } }
            float mine; { const bool up = (lane & 4) != 0; const float keep = up ? r2[1] : r2[0], send = up ? r2[0] : r2[1]; mine = keep + __shfl_xor(send, 4); }
            mine += __shfl_xor(mine, 2); mine += __shfl_xor(mine, 1);
            const int col = ((lane >> 5) & 1) * 8 + ((lane >> 4) & 1) * 4 + ((lane >> 3) & 1) * 2 + ((lane >> 2) & 1);
            if ((lane & 3) == 0) { if (col < 8) DT[(size_t)row * 8 + col] = softplus_f(mine + dt_bias[col]); else LF[(size_t)row * 8 + (col - 8)] = -softplus_f(-(mine + fbias[col - 8])); }
        }
    }
}

namespace pg8 {
#define PG8_LAS __attribute__((address_space(3)))
typedef short bf16x8 __attribute__((ext_vector_type(8)));
typedef float f32x4 __attribute__((ext_vector_type(4)));
typedef unsigned u32x4 __attribute__((ext_vector_type(4)));
constexpr int BM = 256, BK = 64, HALF = 128, HTB = HALF * BK * 2, STAGE_BYTES = 8 * HTB, NXCD = 8, WGM = 8;
__host__ __device__ __forceinline__ int lds_byte(int r, int c) { const int st = (r >> 4) * 2 + (c >> 5), rr = r & 15, cc = c & 31, ob = rr * 64 + cc * 2; return st * 1024 + (ob ^ (((ob >> 9) & 1) << 5)); }
__host__ __device__ __forceinline__ void stage_rc(int b, int& R, int& C) { const int st = b / 1024, sb = b % 1024, swz = sb ^ (((sb >> 9) & 1) << 5); R = (st >> 1) * 16 + swz / 64; C = (st & 1) * 32 + (swz % 64) / 2; }
__host__ __device__ __forceinline__ int perm32(int rho) { const int n = rho >> 4, i = rho & 15; return 8 * (i >> 2) + 4 * n + (i & 3); }
struct Unit { const char* A; const char* B; unsigned lda2, ldb2; int nt, pm, pn, aux; };
struct TileOrder {
    int nM, nN, nwg, G, c;
    __device__ void init(int nM_, int nN_, int G_, int c_) { nM = nM_; nN = nN_; nwg = nM * nN; G = G_; c = c_; }
    __device__ bool tile(int i, int& pm, int& pn) const {
        const long L = (long)i * G + c; if (L >= nwg) return false;
        int wgid = (int)L; { const int q = nwg / NXCD, r = nwg % NXCD, xcd = wgid % NXCD, off = wgid / NXCD; wgid = (xcd < r ? xcd * (q + 1) : r * (q + 1) + (xcd - r) * q) + off; }
        const int nig = WGM * nN, gid = wgid / nig, fm = gid * WGM, gsz = (nM - fm) < WGM ? (nM - fm) : WGM;
        pm = fm + ((wgid % nig) % gsz); pn = (wgid % nig) / gsz; return true;
    }
};
typedef float f32x2_t __attribute__((ext_vector_type(2))); typedef __bf16 bf16x2_t __attribute__((ext_vector_type(2)));
__device__ __forceinline__ unsigned cvt_pk_bf16(float lo, float hi) { f32x2_t v = {lo, hi}; bf16x2_t b = __builtin_convertvector(v, bf16x2_t); return __builtin_bit_cast(unsigned, b); }

template <class Epi, class Sched, bool ALIGN_EPI>
__device__ __forceinline__ void gemm_phase(PG8_LAS unsigned char* lds, const Sched& S, const Epi& E) {
    int tid = threadIdx.x; asm volatile("" : "+v"(tid));
    const int wid = __builtin_amdgcn_readfirstlane(tid >> 6), lane = tid & 63, wr = wid >> 2, wc = wid & 3, fr = lane & 15, fq = lane >> 4;
    unsigned RA[2], RB[2], C2[2];
#pragma unroll
    for (int i = 0; i < 2; ++i) { int R, C; stage_rc(tid * 16 + i * 8192, R, C); RA[i] = (unsigned)R; RB[i] = (unsigned)(Epi::PERM ? ((R & ~31) + perm32(R & 31)) : R); C2[i] = (unsigned)(C * 2); }
    const unsigned ldsw = (unsigned)wid * 1024u;
    const int aoff = lds_byte(wr * 64 + fr, fq * 8), boff = lds_byte(wc * 32 + fr, fq * 8);
#define PG8_SA(b, h) (((b) * 2 + (h)) * HTB)
#define PG8_SB(b, h) ((4 + (b) * 2 + (h)) * HTB)
#define PG8_STAGE(bufoff, gbase, RR, pitch) do { _Pragma("unroll") for (int _i = 0; _i < 2; ++_i) \
        __builtin_amdgcn_global_load_lds((const unsigned*)((const char*)(gbase) + (RR[_i] * (pitch) + C2[_i])), (PG8_LAS unsigned*)(lds + (bufoff) + ldsw + _i * 8192), 16, 0, 0); } while (0)
#define PG8_LDA(dst, b, h) do { _Pragma("unroll") for (int m = 0; m < 4; ++m) _Pragma("unroll") for (int k = 0; k < 2; ++k) dst[m][k] = *(const PG8_LAS bf16x8*)(lds + PG8_SA(b, h) + aoff + m * 2048 + k * 1024); } while (0)
#define PG8_LDB(dst, b, h) do { _Pragma("unroll") for (int n = 0; n < 2; ++n) _Pragma("unroll") for (int k = 0; k < 2; ++k) dst[n][k] = *(const PG8_LAS bf16x8*)(lds + PG8_SB(b, h) + boff + n * 2048 + k * 1024); } while (0)
#define PG8_MMA(ai, bj, At, Bt) do { __builtin_amdgcn_s_setprio(1); _Pragma("unroll") for (int m = 0; m < 4; ++m) _Pragma("unroll") for (int n = 0; n < 2; ++n) _Pragma("unroll") for (int k = 0; k < 2; ++k) \
        acc[ai][bj][m][n] = __builtin_amdgcn_mfma_f32_16x16x32_bf16(Bt[n][k], At[m][k], acc[ai][bj][m][n], 0, 0, 0); __builtin_amdgcn_s_setprio(0); } while (0)
#define PG8_WAIT_V(n) asm volatile("s_waitcnt vmcnt(" #n ")" ::: "memory")
#define PG8_WAIT_L(n) asm volatile("s_waitcnt lgkmcnt(" #n ")" ::: "memory")
#define PG8_BAR __builtin_amdgcn_s_barrier()
#define PG8_SCHED __builtin_amdgcn_sched_barrier(0)
#define PG8_ZERO() do { _Pragma("unroll") for (int a_ = 0; a_ < 2; ++a_) _Pragma("unroll") for (int b_ = 0; b_ < 2; ++b_) _Pragma("unroll") for (int m_ = 0; m_ < 4; ++m_) _Pragma("unroll") for (int n_ = 0; n_ < 2; ++n_) acc[a_][b_][m_][n_] = (f32x4){0.f, 0.f, 0.f, 0.f}; } while (0)
    Unit cur, nxt; int ui = 0;
    if (!S.next(0, cur)) return;
    f32x4 acc[2][2][4][2];
    PG8_ZERO();
    bf16x8 At[4][2], B0[2][2], B1[2][2];
    const char* cA = cur.A; const char* cB = cur.B; unsigned pAc = cur.lda2, pBc = cur.ldb2; int ntc = cur.nt;
    const unsigned kstep = BK * 2;
    {
        const size_t hA = (size_t)HALF * pAc, hB = (size_t)HALF * pBc;
        PG8_STAGE(PG8_SB(0, 0), cB, RB, pBc); PG8_STAGE(PG8_SB(0, 1), cB + hB, RB, pBc); PG8_STAGE(PG8_SA(0, 0), cA, RA, pAc); PG8_STAGE(PG8_SA(0, 1), cA + hA, RA, pAc);
        if (wr == 1) PG8_BAR;
        PG8_WAIT_V(2); PG8_BAR;
        PG8_STAGE(PG8_SB(1, 0), cB + kstep, RB, pBc); PG8_STAGE(PG8_SA(1, 0), cA + kstep, RA, pAc); PG8_STAGE(PG8_SB(1, 1), cB + hB + kstep, RB, pBc);
        PG8_WAIT_V(6); PG8_BAR;
    }
    for (;;) {
        const bool has_next = S.next(ui + 1, nxt);
        const char* nA = has_next ? nxt.A : cA; const char* nB = has_next ? nxt.B : cB;
        const unsigned pAn = has_next ? nxt.lda2 : pAc, pBn = has_next ? nxt.ldb2 : pBc;
        const size_t hAc = (size_t)HALF * pAc;
        for (int t = 0; t < ntc; t += 2) {
            const bool last = (t == ntc - 2);
            const char* a1 = cA + (size_t)(t + 1) * kstep;
            const char* a2 = last ? nA : cA + (size_t)(t + 2) * kstep; const char* b2 = last ? nB : cB + (size_t)(t + 2) * kstep;
            const char* a3 = a2 + kstep; const char* b3 = b2 + kstep;
            const unsigned pA2 = last ? pAn : pAc, pB2 = last ? pBn : pBc;
            const size_t hA2 = (size_t)HALF * pA2, hB2 = (size_t)HALF * pB2;
            PG8_LDB(B0, 0, 0); PG8_LDB(B1, 0, 1); PG8_SCHED; PG8_LDA(At, 0, 0); PG8_STAGE(PG8_SA(1, 1), a1 + hAc, RA, pAc);
            PG8_WAIT_V(8); PG8_WAIT_L(0); PG8_BAR; PG8_MMA(0, 0, At, B0); PG8_MMA(0, 1, At, B1); PG8_BAR; PG8_SCHED;
            PG8_LDA(At, 0, 1); PG8_STAGE(PG8_SB(0, 0), b2, RB, pB2); PG8_STAGE(PG8_SB(0, 1), b2 + hB2, RB, pB2); PG8_STAGE(PG8_SA(0, 0), a2, RA, pA2);
            PG8_WAIT_V(8); PG8_WAIT_L(0); PG8_BAR; PG8_MMA(1, 0, At, B0); PG8_MMA(1, 1, At, B1); PG8_BAR; PG8_SCHED;
            PG8_LDB(B0, 1, 0); PG8_LDB(B1, 1, 1); PG8_SCHED; PG8_LDA(At, 1, 0); PG8_STAGE(PG8_SA(0, 1), a2 + hA2, RA, pA2);
            PG8_WAIT_V(8); PG8_WAIT_L(0); PG8_BAR; PG8_MMA(0, 0, At, B0); PG8_MMA(0, 1, At, B1); PG8_BAR; PG8_SCHED;
            PG8_LDA(At, 1, 1); PG8_STAGE(PG8_SB(1, 0), b3, RB, pB2); PG8_STAGE(PG8_SB(1, 1), b3 + hB2, RB, pB2); PG8_STAGE(PG8_SA(1, 0), a3, RA, pA2);
            PG8_WAIT_V(8); PG8_WAIT_L(0); PG8_BAR; PG8_MMA(1, 0, At, B0); PG8_MMA(1, 1, At, B1); PG8_BAR; PG8_SCHED;
        }
        if constexpr (ALIGN_EPI) { if (wr == 0) PG8_BAR; }
        { int fr_ = fr, fq_ = fq; asm volatile("" : "+v"(fr_), "+v"(fq_)); E(acc, cur, wr, wc, fr_, fq_); }
        if (!has_next) break;
        PG8_ZERO();
        cur = nxt; cA = nA; cB = nB; pAc = pAn; pBc = pBn; ntc = nxt.nt; ++ui;
        if constexpr (ALIGN_EPI) { if (wr == 1) PG8_BAR; }
    }
    PG8_WAIT_V(0);
    if constexpr (!ALIGN_EPI) { if (wr == 0) PG8_BAR; }
    PG8_BAR;
#undef PG8_SA
#undef PG8_SB
#undef PG8_STAGE
#undef PG8_LDA
#undef PG8_LDB
#undef PG8_MMA
#undef PG8_WAIT_V
#undef PG8_WAIT_L
#undef PG8_BAR
#undef PG8_SCHED
#undef PG8_ZERO
}

struct PlainSched {
    TileOrder T; const char* A; const char* B; unsigned lda2, ldb2; int nt;
    __device__ bool next(int i, Unit& u) const { int pm, pn; if (!T.tile(i, pm, pn)) return false;
        u.A = A + (size_t)pm * 256 * lda2; u.B = B + (size_t)pn * 256 * ldb2; u.lda2 = lda2; u.ldb2 = ldb2; u.nt = nt; u.pm = pm; u.pn = pn; u.aux = 0; return true; }
};
struct EpiStoreBf16 {
    static constexpr bool PERM = true;
    bf16_t* O; int ldc;
    __device__ __forceinline__ void operator()(const f32x4 (&acc)[2][2][4][2], const Unit& u, int wr, int wc, int fr, int fq) const {
        const int row0 = u.pm * BM + wr * 64 + fr, col0 = u.pn * BM + wc * 32 + 8 * fq;
#pragma unroll
        for (int ai = 0; ai < 2; ++ai)
#pragma unroll
            for (int m = 0; m < 4; ++m) { bf16_t* rowp = O + (size_t)(row0 + ai * HALF + m * 16) * ldc + col0;
#pragma unroll
                for (int bj = 0; bj < 2; ++bj) { const f32x4 v0 = acc[ai][bj][m][0], v1 = acc[ai][bj][m][1];
                    u32x4 w; w.x = cvt_pk_bf16(v0[0], v0[1]); w.y = cvt_pk_bf16(v0[2], v0[3]); w.z = cvt_pk_bf16(v1[0], v1[1]); w.w = cvt_pk_bf16(v1[2], v1[3]);
                    *(u32x4*)(rowp + bj * HALF) = w; } }
    }
};
__device__ __forceinline__ float fast_sigmoid(float x) { return __builtin_amdgcn_rcpf(1.f + __expf(-x)); }
struct EpiSwiglu {
    static constexpr bool PERM = true;
    bf16_t* H;
    __device__ __forceinline__ void operator()(const f32x4 (&acc)[2][2][4][2], const Unit& u, int wr, int wc, int fr, int fq) const {
        const int row0 = u.pm * BM + wr * 64 + fr, col0 = u.pn * HALF + wc * 32 + 8 * fq;
#pragma unroll
        for (int ai = 0; ai < 2; ++ai)
#pragma unroll
            for (int m = 0; m < 4; ++m) { float v[8];
#pragma unroll
                for (int n = 0; n < 2; ++n)
#pragma unroll
                    for (int e = 0; e < 4; ++e) { const float g = acc[ai][0][m][n][e], up = acc[ai][1][m][n][e]; v[n * 4 + e] = g * fast_sigmoid(g) * up; }
                u32x4 w; w.x = cvt_pk_bf16(v[0], v[1]); w.y = cvt_pk_bf16(v[2], v[3]); w.z = cvt_pk_bf16(v[4], v[5]); w.w = cvt_pk_bf16(v[6], v[7]);
                *(u32x4*)(H + (size_t)(row0 + ai * HALF + m * 16) * DFF + col0) = w; }
    }
};
struct EpiResidual {
    static constexpr bool PERM = false;
    const float* res; float* out;
    __device__ __forceinline__ void operator()(const f32x4 (&acc)[2][2][4][2], const Unit& u, int wr, int wc, int fr, int fq) const {
        const int row0 = u.pm * BM + wr * 64 + fr, col0 = u.pn * BM + wc * 32 + 4 * fq;
#pragma unroll
        for (int ai = 0; ai < 2; ++ai)
#pragma unroll
            for (int m = 0; m < 4; ++m) { const size_t off = (size_t)(row0 + ai * HALF + m * 16) * D + col0;
#pragma unroll
                for (int bj = 0; bj < 2; ++bj)
#pragma unroll
                    for (int n = 0; n < 2; ++n) { const f32x4 r = *(const f32x4*)(res + off + bj * HALF + n * 16); *(f32x4*)(out + off + bj * HALF + n * 16) = r + acc[ai][bj][m][n]; } }
    }
};
struct EpiGate {
    static constexpr bool PERM = true;
    bf16_t* PROJ; bf16_t* XC;
    __device__ __forceinline__ void operator()(const f32x4 (&acc)[2][2][4][2], const Unit& u, int wr, int wc, int fr, int fq) const {
        const int br = u.pn >> 2, row0 = u.pm * BM + wr * 64 + fr, col0 = (u.pn & 3) * BM + wc * 32 + 8 * fq;
        bf16_t* base = br < 3 ? PROJ + 512 + 1536 * br : XC;
        const int ld = br < 3 ? NPROJ : 1024;
#pragma unroll
        for (int ai = 0; ai < 2; ++ai)
#pragma unroll
            for (int m = 0; m < 4; ++m) { bf16_t* rowp = base + (size_t)(row0 + ai * HALF + m * 16) * ld + col0;
#pragma unroll
                for (int bj = 0; bj < 2; ++bj) { const f32x4 v0 = acc[ai][bj][m][0], v1 = acc[ai][bj][m][1];
                    u32x4 w; w.x = cvt_pk_bf16(fast_sigmoid(v0[0]), fast_sigmoid(v0[1])); w.y = cvt_pk_bf16(fast_sigmoid(v0[2]), fast_sigmoid(v0[3]));
                    w.z = cvt_pk_bf16(fast_sigmoid(v1[0]), fast_sigmoid(v1[1])); w.w = cvt_pk_bf16(fast_sigmoid(v1[2]), fast_sigmoid(v1[3]));
                    *(u32x4*)(rowp + bj * HALF) = w; } }
    }
};
struct BranchSched {
    TileOrder T; const char* PROJ; const char* WBR;
    __device__ bool next(int i, Unit& u) const { int pm, pn; if (!T.tile(i >> 2, pm, pn)) return false;
        const int br = i & 3; u.pm = pm; u.pn = pn; u.aux = br;
        u.A = PROJ + (size_t)pm * 256 * (NPROJ * 2) + 1536 * 2 * br; u.lda2 = NPROJ * 2; u.B = WBR + ((size_t)br * 1024 + pn * 256) * (512 * 2); u.ldb2 = 512 * 2; u.nt = 512 / 64; return true; }
};
struct EpiBranch {
    static constexpr bool PERM = true;
    const bf16_t* PROJ; const bf16_t* XC; bf16_t* MIX;
    __device__ __forceinline__ void operator()(const f32x4 (&acc)[2][2][4][2], const Unit& u, int wr, int wc, int fr, int fq) const {
        const int br = u.aux, row0 = u.pm * BM + wr * 64 + fr, col0 = u.pn * BM + wc * 32 + 8 * fq;
        const bf16_t* G = br < 3 ? PROJ + 512 + 1536 * br : XC; const int ldg = br < 3 ? NPROJ : 1024;
        if (br == 0) run<true>(acc, G, ldg, row0, col0); else run<false>(acc, G, ldg, row0, col0);
    }
    template <bool FIRST>
    __device__ __forceinline__ void run(const f32x4 (&acc)[2][2][4][2], const bf16_t* G, int ldg, int row0, int col0) const {
#pragma unroll
        for (int gb = 0; gb < 16; gb += 4) {
            u32x4 g[4], o[4];
#pragma unroll
            for (int k = 0; k < 4; ++k) { const int i = gb + k, ai = i >> 3, m = (i >> 1) & 3, bj = i & 1; const size_t row = (size_t)(row0 + ai * HALF + m * 16);
                g[k] = *(const u32x4*)(G + row * ldg + col0 + bj * HALF); if (!FIRST) o[k] = *(const u32x4*)(MIX + row * D + col0 + bj * HALF); }
#pragma unroll
            for (int k = 0; k < 4; ++k) { const int i = gb + k, ai = i >> 3, m = (i >> 1) & 3, bj = i & 1; const size_t row = (size_t)(row0 + ai * HALF + m * 16);
                f32x4 p0 = acc[ai][bj][m][0], p1 = acc[ai][bj][m][1];
                p0[0] *= bflo(g[k].x); p0[1] *= bfhi(g[k].x); p0[2] *= bflo(g[k].y); p0[3] *= bfhi(g[k].y); p1[0] *= bflo(g[k].z); p1[1] *= bfhi(g[k].z); p1[2] *= bflo(g[k].w); p1[3] *= bfhi(g[k].w);
                if (!FIRST) { p0[0] += bflo(o[k].x); p0[1] += bfhi(o[k].x); p0[2] += bflo(o[k].y); p0[3] += bfhi(o[k].y); p1[0] += bflo(o[k].z); p1[1] += bfhi(o[k].z); p1[2] += bflo(o[k].w); p1[3] += bfhi(o[k].w); }
                u32x4 w; w.x = cvt_pk_bf16(p0[0], p0[1]); w.y = cvt_pk_bf16(p0[2], p0[3]); w.z = cvt_pk_bf16(p1[0], p1[1]); w.w = cvt_pk_bf16(p1[2], p1[3]);
                *(u32x4*)(MIX + row * D + col0 + bj * HALF) = w; }
            asm volatile("" ::: "memory");
        }
    }
};
}

#define LAS __attribute__((address_space(3)))
__device__ __forceinline__ void wt_item(const float* W, int ldw, int src_col0, int k0, bf16_t* WT, int ldwt, int dst_row0, LAS float* scr, int lane) {
#pragma unroll
    for (int i = 0; i < 8; ++i) { const int k = 4 * i + (lane >> 4), n4 = (lane & 15) * 4;
        const float4 v = *(const float4*)(W + (size_t)(k0 + k) * ldw + src_col0 + n4);
        LAS float* d = scr + k * 65 + n4; d[0] = v.x; d[1] = v.y; d[2] = v.z; d[3] = v.w; }
    asm volatile("s_waitcnt lgkmcnt(0)" ::: "memory");
    unsigned w[16];
#pragma unroll
    for (int j = 0; j < 16; ++j) w[j] = pk2(scr[(2 * j) * 65 + lane], scr[(2 * j + 1) * 65 + lane]);
    uint4* o = (uint4*)(WT + (size_t)(dst_row0 + lane) * ldwt + k0);
#pragma unroll
    for (int j = 0; j < 4; ++j) o[j] = make_uint4(w[4 * j], w[4 * j + 1], w[4 * j + 2], w[4 * j + 3]);
    asm volatile("s_waitcnt lgkmcnt(0)" ::: "memory");
}
__device__ __forceinline__ void ph_wconv(unsigned char* ws, const float* w_in, const float* w_branch, const float* w_out, const float* w_gate, const float* w_up, const float* w_down, LAS float* scr_base) {
    const int tx_ = ltid();
    const int lane = tx_ & 63, wave = tx_ >> 6;
    LAS float* scr = scr_base + wave * (32 * 65);
    const int gw = blockIdx.x * 8 + wave, NGW = gridDim.x * 8;
    constexpr int I_IN = 32 * (NPROJ / 64), I_G = 32 * 64, I_BR = 4 * 16 * 16, I_OUT = 32 * 16, I_GU = 32 * (2 * DFF / 64), I_DN = (DFF / 32) * 16;
    for (int it = gw; it < I_IN + I_G + I_BR + I_OUT + I_GU + I_DN; it += NGW) {
        int r = it;
        if (r < I_IN) { const int nb = r % (NPROJ / 64), kb = r / (NPROJ / 64), c0 = nb * 64;
            wt_item(w_in, DIN, c0 + (c0 >= 1536 ? 8 : 0) + (c0 >= 4608 ? 8 : 0), kb * 32, (bf16_t*)(ws + WS_WIN), D, c0, scr, lane); continue; } r -= I_IN;
        if (r < I_G) { const int nb = r % 64, kb = r / 64; wt_item(w_in, DIN, WC_GATE + nb * 64, kb * 32, (bf16_t*)(ws + WS_WG), D, nb * 64, scr, lane); continue; } r -= I_G;
        if (r < I_BR) { const int br = r / 256, q = r % 256, nb = q % 16, kb = q / 16;
            wt_item(w_branch + (size_t)br * 512 * 1024, D, nb * 64, kb * 32, (bf16_t*)(ws + WS_WBR) + (size_t)br * 1024 * 512, 512, nb * 64, scr, lane); continue; } r -= I_BR;
        if (r < I_OUT) { const int nb = r % 16, kb = r / 16; wt_item(w_out, D, nb * 64, kb * 32, (bf16_t*)(ws + WS_WOUT), D, nb * 64, scr, lane); continue; } r -= I_OUT;
        if (r < I_GU) { const int nb = r % (2 * DFF / 64), kb = r / (2 * DFF / 64), r0 = nb * 64, t = r0 >> 8, j = r0 & 255;
            wt_item(j < 128 ? w_gate : w_up, DFF, t * 128 + (j & 127), kb * 32, (bf16_t*)(ws + WS_WGU), D, r0, scr, lane); continue; } r -= I_GU;
        { const int nb = r % 16, kb = r / 16; wt_item(w_down, D, nb * 64, kb * 32, (bf16_t*)(ws + WS_WDN), DFF, nb * 64, scr, lane); }
    }
}

__device__ __forceinline__ void ph_pre(unsigned char* lds, const bf16_t* PROJ, const float* conv_w, const float* conv_b, bf16_t* XC, float* KMEAN, float* KMAXP) {
    const int tx_ = ltid();
    const size_t gt = (size_t)blockIdx.x * NT + tx_, tot = (size_t)gridDim.x * NT;
    for (size_t e = gt; e < (size_t)M * 128; e += tot) {
        const int row = (int)(e >> 7), c8 = (int)(e & 127) * 8, t = row & (SEQ - 1);
        float acc[8];
        { const float4 b0 = *(const float4*)(conv_b + c8), b1 = *(const float4*)(conv_b + c8 + 4); acc[0] = b0.x; acc[1] = b0.y; acc[2] = b0.z; acc[3] = b0.w; acc[4] = b1.x; acc[5] = b1.y; acc[6] = b1.z; acc[7] = b1.w; }
#pragma unroll
        for (int i = 0; i < 4; ++i) { const int tt = t - 3 + i;
            if (tt >= 0) { const uint4 u = *(const uint4*)(PROJ + (size_t)(row - 3 + i) * NPROJ + PC_XBC + c8);
                const float4 w0 = *(const float4*)(conv_w + i * 1024 + c8), w1 = *(const float4*)(conv_w + i * 1024 + c8 + 4);
                acc[0] += w0.x * bflo(u.x); acc[1] += w0.y * bfhi(u.x); acc[2] += w0.z * bflo(u.y); acc[3] += w0.w * bfhi(u.y);
                acc[4] += w1.x * bflo(u.z); acc[5] += w1.y * bfhi(u.z); acc[6] += w1.z * bflo(u.w); acc[7] += w1.w * bfhi(u.w); } }
        uint4 o; o.x = pk2(silu_f(acc[0]), silu_f(acc[1])); o.y = pk2(silu_f(acc[2]), silu_f(acc[3])); o.z = pk2(silu_f(acc[4]), silu_f(acc[5])); o.w = pk2(silu_f(acc[6]), silu_f(acc[7]));
        *(uint4*)(XC + (size_t)row * 1024 + c8) = o;
    }
    {
        int* smax = (int*)lds;
        if (tx_ < 16) smax[tx_] = 0;
        __syncthreads();
        for (size_t e = gt; e < (size_t)M * 8; e += tot) { const int row = (int)(e >> 3), h = (int)(e & 7);
            const bf16_t* kp = PROJ + (size_t)row * NPROJ + PC_FK + h * 64; float n2 = 0.f;
#pragma unroll
            for (int c = 0; c < 8; ++c) { const uint4 u = *(const uint4*)(kp + c * 8);
                n2 += bflo(u.x) * bflo(u.x) + bfhi(u.x) * bfhi(u.x) + bflo(u.y) * bflo(u.y) + bfhi(u.y) * bfhi(u.y) + bflo(u.z) * bflo(u.z) + bfhi(u.z) * bfhi(u.z) + bflo(u.w) * bflo(u.w) + bfhi(u.w) * bfhi(u.w); }
            atomicMax(&smax[(row >> 13) * 8 + h], __float_as_int(n2)); }
        __syncthreads();
        if (tx_ < 16) KMAXP[blockIdx.x * 16 + tx_] = sqrtf(__int_as_float(smax[tx_]));
    }
    const int lane = tx_ & 63, gw = blockIdx.x * 8 + (tx_ >> 6), NGW = gridDim.x * 8;
    for (int it = gw; it < 64 * 64; it += NGW) {
        const int bb = it >> 6, c8 = (it & 63) * 8;
        float sm[8];
#pragma unroll
        for (int j = 0; j < 8; ++j) sm[j] = 0.f;
#pragma unroll
        for (int r = 0; r < 4; ++r) { const uint4 u = *(const uint4*)(PROJ + ((size_t)bb * 256 + lane * 4 + r) * NPROJ + PC_MK + c8);
            sm[0] += bflo(u.x); sm[1] += bfhi(u.x); sm[2] += bflo(u.y); sm[3] += bfhi(u.y); sm[4] += bflo(u.z); sm[5] += bfhi(u.z); sm[6] += bflo(u.w); sm[7] += bfhi(u.w); }
        float mine = 0.f;
#pragma unroll
        for (int j = 0; j < 8; ++j) { const float v = wave_sum(sm[j]); if (lane == j) mine = v; }
        if (lane < 8) KMEAN[(size_t)bb * 512 + c8 + lane] = mine * (1.0f / 256.0f);
    }
}

__device__ __forceinline__ void ph_mamba_norm(bf16_t* PROJ, const bf16_t* XC, const float* nw) {
    const int tx_ = ltid();
    const int lane = tx_ & 63, gw = blockIdx.x * 8 + (tx_ >> 6), NGW = gridDim.x * 8;
    for (int row = gw; row < M; row += NGW) {
        const uint4 yv = *(const uint4*)(XC + (size_t)row * 1024 + lane * 8); const uint4 zv = *(const uint4*)(PROJ + (size_t)row * NPROJ + PC_Z + lane * 8);
        float y[8] = {bflo(yv.x), bfhi(yv.x), bflo(yv.y), bfhi(yv.y), bflo(yv.z), bfhi(yv.z), bflo(yv.w), bfhi(yv.w)};
        const float z[8] = {bflo(zv.x), bfhi(zv.x), bflo(zv.y), bfhi(zv.y), bflo(zv.z), bfhi(zv.z), bflo(zv.w), bfhi(zv.w)};
        float ss = 0.f;
#pragma unroll
        for (int i = 0; i < 8; ++i) { y[i] *= silu_f(z[i]); ss += y[i] * y[i]; }
        ss = wave_sum(ss); const float rstd = 1.0f / sqrtf(ss * (1.0f / 512.0f) + 1e-6f);
        const float4 w0 = *(const float4*)(nw + lane * 8), w1 = *(const float4*)(nw + lane * 8 + 4);
        uint4 o; o.x = pk2(y[0] * rstd * w0.x, y[1] * rstd * w0.y); o.y = pk2(y[2] * rstd * w0.z, y[3] * rstd * w0.w); o.z = pk2(y[4] * rstd * w1.x, y[5] * rstd * w1.y); o.w = pk2(y[6] * rstd * w1.z, y[7] * rstd * w1.w);
        *(uint4*)(PROJ + (size_t)row * NPROJ + PC_Z + lane * 8) = o;
    }
}
__device__ __forceinline__ void ph_final(float* out, const float* nw) {
    const int tx_ = ltid();
    const int lane = tx_ & 63, gw = blockIdx.x * 8 + (tx_ >> 6), NGW = gridDim.x * 8;
    for (int row = gw; row < M; row += NGW) {
        float4* xr = (float4*)(out + (size_t)row * D);
        float4 v[4]; float ss = 0.f;
#pragma unroll
        for (int j = 0; j < 4; ++j) { v[j] = xr[lane + 64 * j]; ss += v[j].x * v[j].x + v[j].y * v[j].y + v[j].z * v[j].z + v[j].w * v[j].w; }
        ss = wave_sum(ss); const float rstd = 1.0f / sqrtf(ss * (1.0f / D) + 1e-6f);
#pragma unroll
        for (int j = 0; j < 4; ++j) { const float4 w4 = ((const float4*)nw)[lane + 64 * j]; xr[lane + 64 * j] = make_float4(v[j].x * rstd * w4.x, v[j].y * rstd * w4.y, v[j].z * rstd * w4.z, v[j].w * rstd * w4.w); }
    }
}


namespace att {
typedef short bf16x8 __attribute__((ext_vector_type(8)));
typedef short s16x4 __attribute__((ext_vector_type(4)));
typedef float f32x16 __attribute__((ext_vector_type(16)));
typedef float f32x2_t __attribute__((ext_vector_type(2))); typedef __bf16 bf16x2_t __attribute__((ext_vector_type(2)));
__device__ __forceinline__ unsigned cvtpk(float lo, float hi) { f32x2_t v = {lo, hi}; bf16x2_t b = __builtin_convertvector(v, bf16x2_t); return __builtin_bit_cast(unsigned, b); }
constexpr float LOG2E = 1.4426950408889634f, C2 = 0.125f * LOG2E;
constexpr int ST_BYTES = 16384, OFF_BIAS = 65536, OFF_EB = OFF_BIAS + 1024, OFF_KMAX = OFF_EB + 32, OFF_TAB = OFF_BIAS + 2048, TAB_N = 1280, OFF_END = OFF_TAB + TAB_N * 4;
constexpr float FOX_THR = 25.f;
enum { MODE_FOX = 0, MODE_SWA = 1, MODE_MOBA = 2, MODE_MOWN = 3 };
#define LASC __attribute__((address_space(3)))
typedef short v4i16_t __attribute__((ext_vector_type(4)));

template <int MODE>
__device__ __forceinline__ void attn_unit(unsigned char* lds, bf16_t* PROJ, const float* AUX, const float* btab, int bcol, float sink, int b, int hq, int hk, int qb, int qcol, int kcol, int vcol, bool dry = false, const void* ex0 = nullptr, const void* ex1 = nullptr) {
    const int tid = ltid(), lane = tid & 63, wave = __builtin_amdgcn_readfirstlane(tid >> 6), r32 = lane & 31, hi = lane >> 5;
    const int q0 = qb * 256, qw = q0 + wave * 32, q = qw + r32;
    const size_t rowbase = (size_t)b * SEQ;
    float* tab = (float*)(lds + OFF_TAB);
    if constexpr (MODE == MODE_SWA) {
        if (tid < 512) { const int d = tid - 128; tab[tid] = (d >= 0 && d < 128) ? btab[rel_bucket(d) * 16 + bcol] * LOG2E : 0.f; }
    }
    if constexpr (MODE == MODE_MOBA || MODE == MODE_MOWN) {
        for (int d = tid; d < 1024; d += NT) tab[d] = btab[rel_bucket(d) * 16 + bcol] * LOG2E;
    }
    bf16x8 qr[4]; float gq[32]; float qn2 = 0.f;
    { const bf16_t* qp = PROJ + (rowbase + q) * NPROJ + qcol + hq * 64 + 8 * hi;
#pragma unroll
      for (int d0 = 0; d0 < 4; ++d0) { const uint4 u = *(const uint4*)(qp + 16 * d0);
          const float f[8] = {bflo(u.x), bfhi(u.x), bflo(u.y), bfhi(u.y), bflo(u.z), bfhi(u.z), bflo(u.w), bfhi(u.w)};
          if constexpr (MODE == MODE_MOBA) {
#pragma unroll
              for (int e = 0; e < 8; ++e) gq[d0 * 8 + e] = f[e]; }
          if constexpr (MODE == MODE_FOX) {
#pragma unroll
              for (int e = 0; e < 8; ++e) qn2 += f[e] * f[e]; }
          uint4 w; w.x = cvtpk(f[0] * C2, f[1] * C2); w.y = cvtpk(f[2] * C2, f[3] * C2); w.z = cvtpk(f[4] * C2, f[5] * C2); w.w = cvtpk(f[6] * C2, f[7] * C2);
          qr[d0] = __builtin_bit_cast(bf16x8, w); } }
    unsigned selmask = 0u;
    if constexpr (MODE == MODE_MOBA) {
        float g0 = -INFINITY, g1 = -INFINITY, g2 = -INFINITY; int i0 = -1, i1 = -1, i2 = -1;
        for (int n = 0; n < qb; ++n) {
            const float* km = AUX + ((size_t)(b * 32 + n)) * 512 + hk * 64 + 8 * hi; float g = 0.f;
#pragma unroll
            for (int d0 = 0; d0 < 4; ++d0) { const float4 k0 = *(const float4*)(km + 16 * d0), k1 = *(const float4*)(km + 16 * d0 + 4);
                g += gq[d0 * 8] * k0.x + gq[d0 * 8 + 1] * k0.y + gq[d0 * 8 + 2] * k0.z + gq[d0 * 8 + 3] * k0.w + gq[d0 * 8 + 4] * k1.x + gq[d0 * 8 + 5] * k1.y + gq[d0 * 8 + 6] * k1.z + gq[d0 * 8 + 7] * k1.w; }
            g += __shfl_xor(g, 32);
            if (g > g0) { g2 = g1; i2 = i1; g1 = g0; i1 = i0; g0 = g; i0 = n; }
            else if (g > g1) { g2 = g1; i2 = i1; g1 = g; i1 = n; }
            else if (g > g2) { g2 = g; i2 = n; }
        }
        if (i0 >= 0) selmask |= 1u << i0; if (i1 >= 0) selmask |= 1u << i1; if (i2 >= 0) selmask |= 1u << i2;
    }
    float carry = 0.f;
    f32x16 o0, o1;
#pragma unroll
    for (int r = 0; r < 16; ++r) { o0[r] = 0.f; o1[r] = 0.f; }
    float m = -1e30f, l = 0.f;
    if constexpr (MODE == MODE_SWA) { m = sink * LOG2E; l = hi == 0 ? 1.f : 0.f; }
    const int t_beg = (MODE == MODE_SWA) ? (qb > 0 ? 4 * qb - 2 : 0) : (MODE == MODE_MOWN ? 4 * qb : 0), t_end = 4 * (qb + 1);
    const int skey = tid >> 3, sch = tid & 7;
    const bf16_t* kg = PROJ + (rowbase + skey) * NPROJ + kcol + hk * 64 + sch * 8;
    const bf16_t* vg = PROJ + (rowbase + skey) * NPROJ + vcol + hk * 64 + sch * 8;
    const int kdst = skey * 128 + ((sch ^ ((skey >> 1) & 7)) * 16);
    uint4 kreg0, kreg1, vreg0, vreg1; float breg0 = 0.f, breg1 = 0.f;
#define ATT_LOAD1(t_, KR, VR, BR) do { KR = *(const uint4*)(kg + (size_t)(t_) * 64 * NPROJ); VR = *(const uint4*)(vg + (size_t)(t_) * 64 * NPROJ); \
        if (MODE == MODE_FOX) { if (tid < 64) BR = AUX[(rowbase + (t_) * 64 + tid) * 8 + hq]; } } while (0)
#define ATT_LOAD(s_) do { ATT_LOAD1(ATT_TI(2 * (s_)), kreg0, vreg0, breg0); ATT_LOAD1(ATT_TI(2 * (s_) + 1), kreg1, vreg1, breg1); } while (0)
#define ATT_STORE1(ts_, KR, VR, BR) do { unsigned char* sb_ = lds + (ts_) * ST_BYTES; \
        *(uint4*)(sb_ + kdst) = KR; *(uint4*)(sb_ + 8192 + skey * 128 + ((sch ^ (((skey >> 1) & 1) << 2)) * 16)) = VR; \
        if (MODE == MODE_FOX) { if (tid < 64) { float inc_ = BR; \
            _Pragma("unroll") for (int o_ = 1; o_ < 64; o_ <<= 1) { const float v_ = __shfl_up(inc_, o_); if (lane >= o_) inc_ += v_; } \
            const float tot_ = __shfl(inc_, 63); \
            ((float*)(lds + OFF_BIAS))[(ts_) * 64 + tid] = (carry + tot_ - inc_) * LOG2E;        \
            carry += tot_; if (tid == 0) ((float*)(lds + OFF_EB))[(ts_)] = carry * LOG2E; } } } while (0)
#define ATT_STORE(st) do { ATT_STORE1((st) * 2, kreg0, vreg0, breg0); ATT_STORE1((st) * 2 + 1, kreg1, vreg1, breg1); } while (0)
    const int ntile = t_end - t_beg;
#define ATT_TI(i) ((MODE == MODE_FOX) ? (t_end - 1 - (i)) : (t_beg + (i)))
    float qkb = 0.f;
    if constexpr (MODE == MODE_FOX) {
        if (tid < 64) { float km = 0.f;
#pragma unroll
            for (int i = 0; i < 4; ++i) km = fmaxf(km, btab[(tid * 4 + i) * 16 + b * 8 + hq]);
#pragma unroll
            for (int o = 1; o < 64; o <<= 1) km = fmaxf(km, __shfl_xor(km, o));
            if (tid == 0) *(float*)(lds + OFF_KMAX) = km; }
    }
    const int nstep = ntile >> 1;
    ATT_LOAD(0); ATT_STORE(0);
    if (1 < nstep) ATT_LOAD(1);
    __syncthreads();
    if constexpr (MODE == MODE_FOX) { qn2 += __shfl_xor(qn2, 32); qkb = sqrtf(qn2) * C2 * 1.01f * *(const float*)(lds + OFF_KMAX); }
    const int vtr_off = ((lane & 15) >> 2) * 128 + (16 * ((lane >> 4) & 1) + 4 * (lane & 3)) * 2 + 4 * hi * 128;
    bool started = false;
    for (int i = 0; i < nstep; ++i) {
        const int st = i & 1;
        if (i + 1 < nstep) ATT_STORE(st ^ 1);
        if (i + 2 < nstep) ATT_LOAD(i + 2);
#pragma unroll 1
        for (int sub = 0; sub < 2; ++sub) {
        const int t = ATT_TI(2 * i + sub), ts = st * 2 + sub;
        bool act = (64 * t <= qw + 31);
        if constexpr (MODE == MODE_SWA) act = act && (64 * t + 63 >= qw - 127);
        if constexpr (MODE == MODE_MOBA) { if (t < 4 * qb) act = __builtin_amdgcn_ballot_w64(((selmask >> (t >> 2)) & 1u) != 0u) != 0ull; }
        if (act) {
            const unsigned char* Ks = lds + ts * ST_BYTES; const unsigned char* Vt = Ks + 8192;
            f32x16 p0, p1;
            if constexpr (MODE == MODE_FOX) { const float* bt = (const float*)(lds + OFF_BIAS) + ts * 64;
#pragma unroll
                for (int g = 0; g < 4; ++g) { const float4 b0 = *(const float4*)(bt + 8 * g + 4 * hi), b1 = *(const float4*)(bt + 32 + 8 * g + 4 * hi);
                    p0[4 * g] = b0.x; p0[4 * g + 1] = b0.y; p0[4 * g + 2] = b0.z; p0[4 * g + 3] = b0.w; p1[4 * g] = b1.x; p1[4 * g + 1] = b1.y; p1[4 * g + 2] = b1.z; p1[4 * g + 3] = b1.w; }
            } else if constexpr (MODE == MODE_SWA) { const float* tp = tab + 128 + (q - 64 * t - 4 * hi);
#pragma unroll
                for (int r = 0; r < 16; ++r) { const int kofs = (r & 3) + 8 * (r >> 2); p0[r] = tp[-kofs]; p1[r] = tp[-kofs - 32]; }
            } else { const int dq = q - 64 * t - 4 * hi;
                if (64 * t + 63 + 790 <= qw) { const float c31 = tab[1023];
#pragma unroll
                    for (int r = 0; r < 16; ++r) { p0[r] = c31; p1[r] = c31; } }
                else {
#pragma unroll
                    for (int r = 0; r < 16; ++r) { const int kofs = (r & 3) + 8 * (r >> 2); const int d0_ = dq - kofs, d1_ = dq - kofs - 32;
                        p0[r] = tab[d0_ < 0 ? 0 : (d0_ > 1023 ? 1023 : d0_)]; p1[r] = tab[d1_ < 0 ? 0 : (d1_ > 1023 ? 1023 : d1_)]; } }
            }
#pragma unroll
            for (int d0 = 0; d0 < 4; ++d0) {
                const bf16x8 a0 = *(const bf16x8*)(Ks + r32 * 128 + (((2 * d0 + hi) ^ ((r32 >> 1) & 7)) * 16));
                const bf16x8 a1 = *(const bf16x8*)(Ks + (32 + r32) * 128 + (((2 * d0 + hi) ^ ((r32 >> 1) & 7)) * 16));
                p0 = __builtin_amdgcn_mfma_f32_32x32x16_bf16(a0, qr[d0], p0, 0, 0, 0);
                p1 = __builtin_amdgcn_mfma_f32_32x32x16_bf16(a1, qr[d0], p1, 0, 0, 0);
            }
            const int kb = 64 * t + 4 * hi;
            if constexpr (MODE == MODE_SWA) {
#pragma unroll
                for (int r = 0; r < 16; ++r) { const int kv = kb + (r & 3) + 8 * (r >> 2); if (kv > q || kv < q - 127) p0[r] = -INFINITY; if (kv + 32 > q || kv + 32 < q - 127) p1[r] = -INFINITY; }
            } else {
                if (64 * t + 63 > qw) {
#pragma unroll
                    for (int r = 0; r < 16; ++r) { const int kv = kb + (r & 3) + 8 * (r >> 2); if (kv > q) p0[r] = -INFINITY; if (kv + 32 > q) p1[r] = -INFINITY; }
                }
                if constexpr (MODE == MODE_MOBA) { if (t < 4 * qb && ((selmask >> (t >> 2)) & 1u) == 0u) {
#pragma unroll
                    for (int r = 0; r < 16; ++r) { p0[r] = -INFINITY; p1[r] = -INFINITY; } } }
            }
            float mx = fmaxf(p0[0], p1[0]);
#pragma unroll
            for (int r = 1; r < 16; ++r) mx = fmaxf(mx, fmaxf(p0[r], p1[r]));
            mx = fmaxf(mx, __shfl_xor(mx, 32));
            const float mn = fmaxf(m, mx);
            if (__builtin_amdgcn_ballot_w64(mn > m) != 0ull) {
                const float alpha = __builtin_amdgcn_exp2f(m - mn); l *= alpha;
#pragma unroll
                for (int r = 0; r < 16; ++r) { o0[r] *= alpha; o1[r] *= alpha; }
            }
            m = mn;
            float sum = 0.f;
#pragma unroll
            for (int r = 0; r < 16; ++r) { p0[r] = __builtin_amdgcn_exp2f(p0[r] - mn); p1[r] = __builtin_amdgcn_exp2f(p1[r] - mn); sum += p0[r] + p1[r]; }
            l += sum;
            bf16x8 pa[4];
#pragma unroll
            for (int ks = 0; ks < 4; ++ks) { uint4 w;
                if (ks < 2) { w.x = cvtpk(p0[8 * ks], p0[8 * ks + 1]); w.y = cvtpk(p0[8 * ks + 2], p0[8 * ks + 3]); w.z = cvtpk(p0[8 * ks + 4], p0[8 * ks + 5]); w.w = cvtpk(p0[8 * ks + 6], p0[8 * ks + 7]); }
                else { const int k2 = ks - 2; w.x = cvtpk(p1[8 * k2], p1[8 * k2 + 1]); w.y = cvtpk(p1[8 * k2 + 2], p1[8 * k2 + 3]); w.z = cvtpk(p1[8 * k2 + 4], p1[8 * k2 + 5]); w.w = cvtpk(p1[8 * k2 + 6], p1[8 * k2 + 7]); }
                pa[ks] = __builtin_bit_cast(bf16x8, w); }
#pragma unroll
            for (int ks = 0; ks < 4; ++ks) {
#pragma unroll
                for (int db = 0; db < 2; ++db) {
                    const LASC unsigned char* vp = (const LASC unsigned char*)(Vt + vtr_off + ks * 16 * 128 + ((db ^ ((lane >> 3) & 1)) * 64));
                    const s16x4 lo = __builtin_bit_cast(s16x4, __builtin_amdgcn_ds_read_tr16_b64_v4i16((LASC v4i16_t*)vp));
                    const s16x4 hh = __builtin_bit_cast(s16x4, __builtin_amdgcn_ds_read_tr16_b64_v4i16((LASC v4i16_t*)(vp + 8 * 128)));
                    const bf16x8 vf = {lo[0], lo[1], lo[2], lo[3], hh[0], hh[1], hh[2], hh[3]};
                    if (db == 0) o0 = __builtin_amdgcn_mfma_f32_32x32x16_bf16(vf, pa[ks], o0, 0, 0, 0);
                    else o1 = __builtin_amdgcn_mfma_f32_32x32x16_bf16(vf, pa[ks], o1, 0, 0, 0); }
            }
            started = true;
        }
        }
        if constexpr (MODE == MODE_FOX) {
            const float eb = ((const float*)(lds + OFF_EB))[st * 2 + 1];
            if (__syncthreads_and((started && (qkb + eb - m < -FOX_THR)) ? 1 : 0)) break;
        } else __syncthreads();
    }
    if constexpr (MODE == MODE_FOX) __syncthreads();
#undef ATT_LOAD
#undef ATT_STORE
#undef ATT_LOAD1
#undef ATT_STORE1
#undef ATT_TI
    l += __shfl_xor(l, 32);
    float inv = 1.0f / l;
    bf16_t* op = PROJ + (rowbase + q) * NPROJ + qcol + hq * 64 + 4 * hi;
    if (dry && inv != 123.4567f) return;
    if constexpr (MODE == MODE_MOWN) {
        const unsigned sel = ((const unsigned*)AUX)[(size_t)(b * 8 + hq) * SEQ + q]; const int cnt = (int)((sel >> 15) & 3u);
        const float* pl = (const float*)ex1 + ((rowbase + q) * 8 + hq) * 4;
        float R = m + __builtin_amdgcn_logf(l), wsum = 1.f;
#pragma unroll
        for (int r = 0; r < 16; ++r) { o0[r] *= inv; o1[r] *= inv; }
#pragma unroll 1
        for (int sl = 0; sl < cnt; ++sl) {
            const float ls = pl[sl]; const float Rn = fmaxf(R, ls), sc = __builtin_amdgcn_exp2f(R - Rn), ws_ = __builtin_amdgcn_exp2f(ls - Rn);
            const bf16_t* pp = (sl < 2) ? PROJ + (rowbase + q) * NPROJ + PC_XBC + (hq * 2 + sl) * 64 + 4 * hi : (const bf16_t*)ex0 + ((rowbase + q) * 8 + hq) * 64 + 4 * hi;
#pragma unroll
            for (int g = 0; g < 4; ++g) { const uint2 a0 = *(const uint2*)(pp + 8 * g), a1 = *(const uint2*)(pp + 32 + 8 * g);
                o0[4 * g] = o0[4 * g] * sc + ws_ * bflo(a0.x); o0[4 * g + 1] = o0[4 * g + 1] * sc + ws_ * bfhi(a0.x); o0[4 * g + 2] = o0[4 * g + 2] * sc + ws_ * bflo(a0.y); o0[4 * g + 3] = o0[4 * g + 3] * sc + ws_ * bfhi(a0.y);
                o1[4 * g] = o1[4 * g] * sc + ws_ * bflo(a1.x); o1[4 * g + 1] = o1[4 * g + 1] * sc + ws_ * bfhi(a1.x); o1[4 * g + 2] = o1[4 * g + 2] * sc + ws_ * bflo(a1.y); o1[4 * g + 3] = o1[4 * g + 3] * sc + ws_ * bfhi(a1.y); }
            wsum = wsum * sc + ws_; R = Rn;
        }
        inv = 1.0f / wsum;
    }
#pragma unroll
    for (int g = 0; g < 4; ++g) {
        *(uint2*)(op + 8 * g) = make_uint2(cvtpk(o0[4 * g] * inv, o0[4 * g + 1] * inv), cvtpk(o0[4 * g + 2] * inv, o0[4 * g + 3] * inv));
        *(uint2*)(op + 32 + 8 * g) = make_uint2(cvtpk(o1[4 * g] * inv, o1[4 * g + 1] * inv), cvtpk(o1[4 * g + 2] * inv, o1[4 * g + 3] * inv));
    }
}
}
namespace ssd {
using att::bf16x8; using att::s16x4; using att::f32x16; using att::cvtpk; using att::LOG2E;
#define LASC __attribute__((address_space(3)))
constexpr int STB = 40960;
constexpr int OFF_AL2 = 2 * STB, OFF_DTV = OFF_AL2 + 1024, OFF_E = OFF_DTV + 1024, OFF_HIN = 0;
__device__ __forceinline__ float chunk_scan(unsigned char* lds, const float* DT, size_t row0, int h, float A, int tid) {
    float* al = (float*)(lds + OFF_AL2); float* dtv = (float*)(lds + OFF_DTV);
    if (tid < 256) { const float d = DT[(row0 + tid) * 8 + h]; dtv[tid] = d; al[tid] = d * A; }
    __syncthreads();
    if (tid < 64) { const float4 a4 = *(const float4*)(al + 4 * tid); const float s = (a4.x + a4.y) + (a4.z + a4.w); float incl = s;
#pragma unroll
        for (int o = 1; o < 64; o <<= 1) { const float v = __shfl_up(incl, o); if (tid >= o) incl += v; }
        const float base = incl - s; float4 c4; c4.x = base + a4.x; c4.y = c4.x + a4.y; c4.z = c4.y + a4.z; c4.w = c4.z + a4.w; *(float4*)(al + 4 * tid) = c4; }
    __syncthreads();
    return al[255];
}
__device__ __forceinline__ void m1_unit(unsigned char* lds, bf16_t* XC, const float* DT, const float* a_log, const float* d_skip, bf16_t* STATES, float* CDEC, int b, int c, int h) {
    const int tid = ltid(), lane = tid & 63, wave = __builtin_amdgcn_readfirstlane(tid >> 6), r32 = lane & 31, hi = lane >> 5, g = h >> 2;
    const size_t row0 = (size_t)b * SEQ + c * 256; const int l = wave * 32 + r32;
    const float A = -expf(a_log[h]);
    float* al = (float*)(lds + OFF_AL2); float* dtv = (float*)(lds + OFF_DTV); float* ev = (float*)(lds + OFF_E);
    const float alast = chunk_scan(lds, DT, row0, h, A, tid);
    float myac = 0.f; if (tid < 256) myac = al[tid];
    __syncthreads();
    if (tid < 256) { ev[tid] = expf(alast - myac); al[tid] = myac * LOG2E; }
    if (tid == 0) CDEC[(b * 32 + c) * 8 + h] = expf(alast);
    __syncthreads();
    const float al_l = al[l];
    bf16x8 cfr[8];
    { const bf16_t* cp = XC + (row0 + l) * 1024 + 768 + g * 128 + 8 * hi;
#pragma unroll
      for (int k0 = 0; k0 < 8; ++k0) cfr[k0] = *(const bf16x8*)(cp + 16 * k0); }
    f32x16 o0, o1, sacc;
#pragma unroll
    for (int r = 0; r < 16; ++r) { o0[r] = 0.f; o1[r] = 0.f; sacc[r] = 0.f; }
    const int ss = tid >> 3, pc = tid & 7;
    const bf16_t* bg = XC + (row0 + ss) * 1024 + 512 + g * 128 + 16 * pc;
    const bf16_t* xg = XC + (row0 + ss) * 1024 + h * 64 + 8 * pc;
    uint4 b0r, b1r, xr;
#define SSD_LOAD(t) do { b0r = *(const uint4*)(bg + (size_t)(t) * 64 * 1024); b1r = *(const uint4*)(bg + (size_t)(t) * 64 * 1024 + 8); xr = *(const uint4*)(xg + (size_t)(t) * 64 * 1024); } while (0)
#define SSD_SC2(w, f) cvtpk(bflo(w) * (f), bfhi(w) * (f))
#define SSD_STORE(st, t) do { unsigned char* sb_ = lds + (st) * STB; \
        *(uint4*)(sb_ + ss * 256 + (((2 * pc) ^ (ss & 15)) * 16)) = b0r; *(uint4*)(sb_ + ss * 256 + (((2 * pc + 1) ^ (ss & 15)) * 16)) = b1r; \
        const float es_ = ev[(t) * 64 + ss], ds_ = dtv[(t) * 64 + ss]; \
        *(uint4*)(sb_ + 16384 + ss * 256 + pc * 32) = make_uint4(SSD_SC2(b0r.x, es_), SSD_SC2(b0r.y, es_), SSD_SC2(b0r.z, es_), SSD_SC2(b0r.w, es_));         \
        *(uint4*)(sb_ + 16384 + ss * 256 + pc * 32 + 16) = make_uint4(SSD_SC2(b1r.x, es_), SSD_SC2(b1r.y, es_), SSD_SC2(b1r.z, es_), SSD_SC2(b1r.w, es_)); \
        *(uint4*)(sb_ + 32768 + ss * 128 + pc * 16) = make_uint4(SSD_SC2(xr.x, ds_), SSD_SC2(xr.y, ds_), SSD_SC2(xr.z, ds_), SSD_SC2(xr.w, ds_)); } while (0)
    SSD_LOAD(0); SSD_STORE(0, 0);
    __syncthreads();
    const int nb = wave >> 1, pb = wave & 1;
    const int trx = ((lane & 15) >> 2) * 128 + (16 * ((lane >> 4) & 1) + 4 * (lane & 3)) * 2, trb = ((lane & 15) >> 2) * 256 + (16 * ((lane >> 4) & 1) + 4 * (lane & 3)) * 2;
#pragma unroll 1
    for (int t = 0; t < 4; ++t) {
        const int st = t & 1;
        if (t + 1 < 4) SSD_LOAD(t + 1);
        const unsigned char* Bs = lds + st * STB; const unsigned char* Bt = Bs + 16384; const unsigned char* Xt = Bs + 32768;
        if (64 * t <= wave * 32 + 31) {
            f32x16 p0, p1;
#pragma unroll
            for (int r = 0; r < 16; ++r) { p0[r] = 0.f; p1[r] = 0.f; }
#pragma unroll
            for (int k0 = 0; k0 < 8; ++k0) {
                const bf16x8 a0 = *(const bf16x8*)(Bs + r32 * 256 + (((2 * k0 + hi) ^ (r32 & 15)) * 16));
                const bf16x8 a1 = *(const bf16x8*)(Bs + (32 + r32) * 256 + (((2 * k0 + hi) ^ (r32 & 15)) * 16));
                p0 = __builtin_amdgcn_mfma_f32_32x32x16_bf16(a0, cfr[k0], p0, 0, 0, 0);
                p1 = __builtin_amdgcn_mfma_f32_32x32x16_bf16(a1, cfr[k0], p1, 0, 0, 0);
            }
#pragma unroll
            for (int gq = 0; gq < 4; ++gq) { const int sb0 = 64 * t + 8 * gq + 4 * hi;
                const float4 s0 = *(const float4*)(al + sb0), s1 = *(const float4*)(al + sb0 + 32);
                const float a0[4] = {s0.x, s0.y, s0.z, s0.w}, a1[4] = {s1.x, s1.y, s1.z, s1.w};
#pragma unroll
                for (int e = 0; e < 4; ++e) { const int r = 4 * gq + e;
                    p0[r] = (sb0 + e <= l) ? p0[r] * __builtin_amdgcn_exp2f(al_l - a0[e]) : 0.f;
                    p1[r] = (sb0 + 32 + e <= l) ? p1[r] * __builtin_amdgcn_exp2f(al_l - a1[e]) : 0.f; } }
            bf16x8 pa[4];
#pragma unroll
            for (int ks = 0; ks < 4; ++ks) { uint4 w;
                if (ks < 2) { w.x = cvtpk(p0[8 * ks], p0[8 * ks + 1]); w.y = cvtpk(p0[8 * ks + 2], p0[8 * ks + 3]); w.z = cvtpk(p0[8 * ks + 4], p0[8 * ks + 5]); w.w = cvtpk(p0[8 * ks + 6], p0[8 * ks + 7]); }
                else { const int k2 = ks - 2; w.x = cvtpk(p1[8 * k2], p1[8 * k2 + 1]); w.y = cvtpk(p1[8 * k2 + 2], p1[8 * k2 + 3]); w.z = cvtpk(p1[8 * k2 + 4], p1[8 * k2 + 5]); w.w = cvtpk(p1[8 * k2 + 6], p1[8 * k2 + 7]); }
                pa[ks] = __builtin_bit_cast(bf16x8, w); }
#pragma unroll
            for (int ks = 0; ks < 4; ++ks) {
#pragma unroll
                for (int db = 0; db < 2; ++db) {
                    const LASC unsigned char* vp = (const LASC unsigned char*)(Xt + trx + 4 * hi * 128 + ks * 16 * 128 + db * 64);
                    const s16x4 lo = __builtin_bit_cast(s16x4, __builtin_amdgcn_ds_read_tr16_b64_v4i16((LASC att::v4i16_t*)vp));
                    const s16x4 hh = __builtin_bit_cast(s16x4, __builtin_amdgcn_ds_read_tr16_b64_v4i16((LASC att::v4i16_t*)(vp + 8 * 128)));
                    const bf16x8 vf = {lo[0], lo[1], lo[2], lo[3], hh[0], hh[1], hh[2], hh[3]};
                    if (db == 0) o0 = __builtin_amdgcn_mfma_f32_32x32x16_bf16(vf, pa[ks], o0, 0, 0, 0);
                    else o1 = __builtin_amdgcn_mfma_f32_32x32x16_bf16(vf, pa[ks], o1, 0, 0, 0); } }
        }
        {
#pragma unroll
            for (int ks = 0; ks < 4; ++ks) {
                const LASC unsigned char* bp = (const LASC unsigned char*)(Bt + trb + (16 * ks + 8 * hi) * 256 + nb * 64);
                const s16x4 a_lo = __builtin_bit_cast(s16x4, __builtin_amdgcn_ds_read_tr16_b64_v4i16((LASC att::v4i16_t*)bp));
                const s16x4 a_hi = __builtin_bit_cast(s16x4, __builtin_amdgcn_ds_read_tr16_b64_v4i16((LASC att::v4i16_t*)(bp + 4 * 256)));
                const LASC unsigned char* xp = (const LASC unsigned char*)(Xt + trx + (16 * ks + 8 * hi) * 128 + pb * 64);
                const s16x4 x_lo = __builtin_bit_cast(s16x4, __builtin_amdgcn_ds_read_tr16_b64_v4i16((LASC att::v4i16_t*)xp));
                const s16x4 x_hi = __builtin_bit_cast(s16x4, __builtin_amdgcn_ds_read_tr16_b64_v4i16((LASC att::v4i16_t*)(xp + 4 * 128)));
                const bf16x8 af = {a_lo[0], a_lo[1], a_lo[2], a_lo[3], a_hi[0], a_hi[1], a_hi[2], a_hi[3]};
                const bf16x8 xf = {x_lo[0], x_lo[1], x_lo[2], x_lo[3], x_hi[0], x_hi[1], x_hi[2], x_hi[3]};
                sacc = __builtin_amdgcn_mfma_f32_32x32x16_bf16(af, xf, sacc, 0, 0, 0);
            }
        }
        if (t + 1 < 4) SSD_STORE(st ^ 1, t + 1);
        __syncthreads();
    }
#undef SSD_LOAD
#undef SSD_STORE
    { const float Dh = d_skip[h]; bf16_t* yp = XC + (row0 + l) * 1024 + h * 64 + 4 * hi;
#pragma unroll
      for (int gq = 0; gq < 4; ++gq) {
          const uint2 x0 = *(const uint2*)(yp + 8 * gq), x1 = *(const uint2*)(yp + 32 + 8 * gq);
          *(uint2*)(yp + 8 * gq) = make_uint2(cvtpk(o0[4 * gq] + Dh * bflo(x0.x), o0[4 * gq + 1] + Dh * bfhi(x0.x)), cvtpk(o0[4 * gq + 2] + Dh * bflo(x0.y), o0[4 * gq + 3] + Dh * bfhi(x0.y)));
          *(uint2*)(yp + 32 + 8 * gq) = make_uint2(cvtpk(o1[4 * gq] + Dh * bflo(x1.x), o1[4 * gq + 1] + Dh * bfhi(x1.x)), cvtpk(o1[4 * gq + 2] + Dh * bflo(x1.y), o1[4 * gq + 3] + Dh * bfhi(x1.y))); } }
    { bf16_t* sp = STATES + ((size_t)((b * 32 + c) * 8 + h)) * 8192 + (size_t)(r32 + 32 * pb) * 128 + 32 * nb + 4 * hi;
#pragma unroll
      for (int gq = 0; gq < 4; ++gq) *(uint2*)(sp + 8 * gq) = make_uint2(cvtpk(sacc[4 * gq], sacc[4 * gq + 1]), cvtpk(sacc[4 * gq + 2], sacc[4 * gq + 3])); }
    __syncthreads();
}
__device__ __forceinline__ void m2_unit(unsigned char* lds, bf16_t* XC, const float* DT, const float* a_log, const bf16_t* STATES, const float* CDEC, int b, int c, int h) {
    if (c == 0) return;
    const int tid = ltid(), lane = tid & 63, wave = __builtin_amdgcn_readfirstlane(tid >> 6), r32 = lane & 31, hi = lane >> 5, g = h >> 2;
    const size_t row0 = (size_t)b * SEQ + c * 256; const int l = wave * 32 + r32;
    const float A = -expf(a_log[h]);
    float* al = (float*)(lds + OFF_AL2);
    (void)chunk_scan(lds, DT, row0, h, A, tid);
    const float ea = expf(al[l]);
    float4 hin[4];
#pragma unroll
    for (int j = 0; j < 4; ++j) hin[j] = make_float4(0.f, 0.f, 0.f, 0.f);
    const bf16_t* sbase = STATES + ((size_t)((b * 32) * 8 + h)) * 8192 + 4 * tid;
    for (int c0 = 0; c0 < c; c0 += 4) {
        uint2 sv[4][4]; float dec[4];
#pragma unroll
        for (int k = 0; k < 4; ++k) { const int cc = (c0 + k < c) ? c0 + k : c - 1; dec[k] = CDEC[(b * 32 + cc) * 8 + h];
#pragma unroll
            for (int j = 0; j < 4; ++j) sv[k][j] = *(const uint2*)(sbase + (size_t)cc * 8 * 8192 + 2048 * j); }
#pragma unroll
        for (int k = 0; k < 4; ++k) if (c0 + k < c) {
#pragma unroll
            for (int j = 0; j < 4; ++j) { hin[j].x = hin[j].x * dec[k] + bflo(sv[k][j].x); hin[j].y = hin[j].y * dec[k] + bfhi(sv[k][j].x); hin[j].z = hin[j].z * dec[k] + bflo(sv[k][j].y); hin[j].w = hin[j].w * dec[k] + bfhi(sv[k][j].y); } } }
#pragma unroll
    for (int j = 0; j < 4; ++j) { const int idx = 4 * tid + 2048 * j, p = idx >> 7, n = idx & 127;
        *(uint2*)(lds + OFF_HIN + p * 256 + (((n >> 3) ^ (p & 15)) * 16) + (n & 7) * 2) = make_uint2(cvtpk(hin[j].x, hin[j].y), cvtpk(hin[j].z, hin[j].w)); }
    __syncthreads();
    bf16x8 cfr[8];
    { const bf16_t* cp = XC + (row0 + l) * 1024 + 768 + g * 128 + 8 * hi;
#pragma unroll
      for (int k0 = 0; k0 < 8; ++k0) cfr[k0] = *(const bf16x8*)(cp + 16 * k0); }
    f32x16 o0, o1;
#pragma unroll
    for (int r = 0; r < 16; ++r) { o0[r] = 0.f; o1[r] = 0.f; }
#pragma unroll
    for (int k0 = 0; k0 < 8; ++k0) {
        const bf16x8 h0 = *(const bf16x8*)(lds + OFF_HIN + r32 * 256 + (((2 * k0 + hi) ^ (r32 & 15)) * 16));
        const bf16x8 h1 = *(const bf16x8*)(lds + OFF_HIN + (32 + r32) * 256 + (((2 * k0 + hi) ^ (r32 & 15)) * 16));
        o0 = __builtin_amdgcn_mfma_f32_32x32x16_bf16(h0, cfr[k0], o0, 0, 0, 0);
        o1 = __builtin_amdgcn_mfma_f32_32x32x16_bf16(h1, cfr[k0], o1, 0, 0, 0);
    }
    { bf16_t* yp = XC + (row0 + l) * 1024 + h * 64 + 4 * hi;
#pragma unroll
      for (int gq = 0; gq < 4; ++gq) {
          const uint2 y0 = *(const uint2*)(yp + 8 * gq), y1 = *(const uint2*)(yp + 32 + 8 * gq);
          *(uint2*)(yp + 8 * gq) = make_uint2(cvtpk(bflo(y0.x) + ea * o0[4 * gq], bfhi(y0.x) + ea * o0[4 * gq + 1]), cvtpk(bflo(y0.y) + ea * o0[4 * gq + 2], bfhi(y0.y) + ea * o0[4 * gq + 3]));
          *(uint2*)(yp + 32 + 8 * gq) = make_uint2(cvtpk(bflo(y1.x) + ea * o1[4 * gq], bfhi(y1.x) + ea * o1[4 * gq + 1]), cvtpk(bflo(y1.y) + ea * o1[4 * gq + 2], bfhi(y1.y) + ea * o1[4 * gq + 3])); } }
    __syncthreads();
}
}

__device__ __forceinline__ void moba_select_unit(unsigned char* lds, const bf16_t* PROJ, const float* KMEAN, unsigned* SEL, int b, int h, int qb) {
    const int tid = ltid(), lane = tid & 63, hf = lane & 1;
    const int q = qb * 256 + (tid >> 1);
    float* km_s = (float*)lds;
    { const int n = tid >> 4, c4 = (tid & 15) * 4; *(float4*)(km_s + n * 64 + c4) = *(const float4*)(KMEAN + ((size_t)(b * 32 + n)) * 512 + h * 64 + c4); }
    __syncthreads();
    const bf16_t* qp = PROJ + ((size_t)b * SEQ + q) * NPROJ + PC_MQ + h * 64 + hf * 32;
    float qv[32];
#pragma unroll
    for (int c = 0; c < 4; ++c) { const uint4 u = *(const uint4*)(qp + c * 8);
        qv[c * 8 + 0] = bflo(u.x); qv[c * 8 + 1] = bfhi(u.x); qv[c * 8 + 2] = bflo(u.y); qv[c * 8 + 3] = bfhi(u.y); qv[c * 8 + 4] = bflo(u.z); qv[c * 8 + 5] = bfhi(u.z); qv[c * 8 + 6] = bflo(u.w); qv[c * 8 + 7] = bfhi(u.w); }
    float g0 = -INFINITY, g1 = -INFINITY, g2 = -INFINITY; int i0 = 31, i1 = 31, i2 = 31;
    for (int n = 0; n < qb; ++n) {
        const float* km = km_s + n * 64 + hf * 32; float g = 0.f;
#pragma unroll
        for (int c = 0; c < 8; ++c) { const float4 k4 = *(const float4*)(km + 4 * c); g += qv[4 * c] * k4.x + qv[4 * c + 1] * k4.y + qv[4 * c + 2] * k4.z + qv[4 * c + 3] * k4.w; }
        g += __shfl_xor(g, 1);
        if (g > g0) { g2 = g1; i2 = i1; g1 = g0; i1 = i0; g0 = g; i0 = n; }
        else if (g > g1) { g2 = g1; i2 = i1; g1 = g; i1 = n; }
        else if (g > g2) { g2 = g; i2 = n; }
    }
    const int cnt = qb < 3 ? qb : 3;
    if (hf == 0) SEL[(size_t)(b * 8 + h) * SEQ + q] = (unsigned)i0 | ((unsigned)i1 << 5) | ((unsigned)i2 << 10) | ((unsigned)cnt << 15);
    __syncthreads();
}
namespace gat { constexpr int OFF_LIST = 65536, OFF_TABG = 98304, OFF_CNT = 102400; }
__device__ __forceinline__ void moba_gather_unit(unsigned char* lds, bf16_t* PROJ, const unsigned* SEL, const float* btab, bf16_t* PO2, float* PL, int b, int h, int j, int qc) {
    using namespace att;
    const int tid = ltid(), lane = tid & 63, wave = __builtin_amdgcn_readfirstlane(tid >> 6), r32 = lane & 31, hi = lane >> 5;
    const size_t rowbase = (size_t)b * SEQ;
    float* tab = (float*)(lds + gat::OFF_TABG); unsigned* list = (unsigned*)(lds + gat::OFF_LIST); unsigned* cntp = (unsigned*)(lds + gat::OFF_CNT);
    for (int d = tid; d < 1024; d += NT) tab[d] = btab[rel_bucket(d) * 16 + h] * LOG2E;
    if (tid == 0) *cntp = 0u;
    { const int skey = tid >> 3, sch = tid & 7;
#pragma unroll
      for (int t = 0; t < 4; ++t) { const bf16_t* kp = PROJ + (rowbase + j * 256 + t * 64 + skey) * NPROJ + h * 64 + sch * 8;
          *(uint4*)(lds + t * ST_BYTES + skey * 128 + ((sch ^ ((skey >> 1) & 7)) * 16)) = *(const uint4*)(kp + PC_MK);
          *(uint4*)(lds + t * ST_BYTES + 8192 + skey * 128 + ((sch ^ (((skey >> 1) & 1) << 2)) * 16)) = *(const uint4*)(kp + PC_MV); } }
    __syncthreads();
    for (int half = 0; half < 2; ++half) {
        const int qf = 4096 * qc + 2048 * half + 4 * tid, qmin = 256 * (j + 1);
        const uint4 sv4 = *(const uint4*)(SEL + (size_t)(b * 8 + h) * SEQ + qf); const unsigned sv[4] = {sv4.x, sv4.y, sv4.z, sv4.w};
#pragma unroll
        for (int e = 0; e < 4; ++e) { int slot = -1; const int cnt = (int)((sv[e] >> 15) & 3u);
            if (qf + e >= qmin) { if ((int)(sv[e] & 31u) == j && cnt > 0) slot = 0; else if ((int)((sv[e] >> 5) & 31u) == j && cnt > 1) slot = 1; else if ((int)((sv[e] >> 10) & 31u) == j && cnt > 2) slot = 2; }
            const unsigned long long bal = __builtin_amdgcn_ballot_w64(slot >= 0);
            unsigned pos = 0u;
            if (lane == 0 && bal) pos = atomicAdd(cntp, (unsigned)__builtin_popcountll(bal));
            pos = __shfl(pos, 0);
            if (slot >= 0) list[pos + __builtin_popcountll(bal & ((1ull << lane) - 1ull))] = (unsigned)(qf + e) | ((unsigned)slot << 13); }
    }
    __syncthreads();
    const int n = (int)*cntp, ngroups = (n + 31) >> 5;
    const int vtr_off = ((lane & 15) >> 2) * 128 + (16 * ((lane >> 4) & 1) + 4 * (lane & 3)) * 2 + 4 * hi * 128;
    for (int grp = wave; grp < ngroups; grp += 8) {
        const int ei = 32 * grp + r32; const bool valid = ei < n; const unsigned ent = list[valid ? ei : n - 1];
        const int q = (int)(ent & 8191u), slot = (int)(ent >> 13);
        bf16x8 qr[4];
        { const bf16_t* qp = PROJ + (rowbase + q) * NPROJ + PC_MQ + h * 64 + 8 * hi;
#pragma unroll
          for (int d0 = 0; d0 < 4; ++d0) { const uint4 u = *(const uint4*)(qp + 16 * d0);
              uint4 w; w.x = cvtpk(bflo(u.x) * C2, bfhi(u.x) * C2); w.y = cvtpk(bflo(u.y) * C2, bfhi(u.y) * C2); w.z = cvtpk(bflo(u.z) * C2, bfhi(u.z) * C2); w.w = cvtpk(bflo(u.w) * C2, bfhi(u.w) * C2);
              qr[d0] = __builtin_bit_cast(bf16x8, w); } }
        f32x16 o0, o1;
#pragma unroll
        for (int r = 0; r < 16; ++r) { o0[r] = 0.f; o1[r] = 0.f; }
        float m = -1e30f, l = 0.f;
#pragma unroll 1
        for (int t = 0; t < 4; ++t) {
            const unsigned char* Ks = lds + t * ST_BYTES; const unsigned char* Vt = Ks + 8192;
            const int key0 = j * 256 + t * 64; f32x16 p0, p1;
            { const int dq = q - key0 - 4 * hi;
              if (__builtin_amdgcn_ballot_w64(q - (key0 + 63) >= 790) == ~0ull) { const float c31 = tab[1023];
#pragma unroll
                  for (int r = 0; r < 16; ++r) { p0[r] = c31; p1[r] = c31; } }
              else {
#pragma unroll
                  for (int r = 0; r < 16; ++r) { const int kofs = (r & 3) + 8 * (r >> 2); const int d0_ = dq - kofs, d1_ = dq - kofs - 32;
                      p0[r] = tab[d0_ > 1023 ? 1023 : d0_]; p1[r] = tab[d1_ > 1023 ? 1023 : d1_]; } } }
#pragma unroll
            for (int d0 = 0; d0 < 4; ++d0) {
                const bf16x8 a0 = *(const bf16x8*)(Ks + r32 * 128 + (((2 * d0 + hi) ^ ((r32 >> 1) & 7)) * 16));
                const bf16x8 a1 = *(const bf16x8*)(Ks + (32 + r32) * 128 + (((2 * d0 + hi) ^ ((r32 >> 1) & 7)) * 16));
                p0 = __builtin_amdgcn_mfma_f32_32x32x16_bf16(a0, qr[d0], p0, 0, 0, 0);
                p1 = __builtin_amdgcn_mfma_f32_32x32x16_bf16(a1, qr[d0], p1, 0, 0, 0);
            }
            float mx = fmaxf(p0[0], p1[0]);
#pragma unroll
            for (int r = 1; r < 16; ++r) mx = fmaxf(mx, fmaxf(p0[r], p1[r]));
            mx = fmaxf(mx, __shfl_xor(mx, 32));
            const float mn = fmaxf(m, mx);
            if (__builtin_amdgcn_ballot_w64(mn > m) != 0ull) {
                const float alpha = __builtin_amdgcn_exp2f(m - mn); l *= alpha;
#pragma unroll
                for (int r = 0; r < 16; ++r) { o0[r] *= alpha; o1[r] *= alpha; }
            }
            m = mn;
            float sum = 0.f;
#pragma unroll
            for (int r = 0; r < 16; ++r) { p0[r] = __builtin_amdgcn_exp2f(p0[r] - mn); p1[r] = __builtin_amdgcn_exp2f(p1[r] - mn); sum += p0[r] + p1[r]; }
            l += sum;
            bf16x8 pa[4];
#pragma unroll
            for (int ks = 0; ks < 4; ++ks) { uint4 w;
                if (ks < 2) { w.x = cvtpk(p0[8 * ks], p0[8 * ks + 1]); w.y = cvtpk(p0[8 * ks + 2], p0[8 * ks + 3]); w.z = cvtpk(p0[8 * ks + 4], p0[8 * ks + 5]); w.w = cvtpk(p0[8 * ks + 6], p0[8 * ks + 7]); }
                else { const int k2 = ks - 2; w.x = cvtpk(p1[8 * k2], p1[8 * k2 + 1]); w.y = cvtpk(p1[8 * k2 + 2], p1[8 * k2 + 3]); w.z = cvtpk(p1[8 * k2 + 4], p1[8 * k2 + 5]); w.w = cvtpk(p1[8 * k2 + 6], p1[8 * k2 + 7]); }
                pa[ks] = __builtin_bit_cast(bf16x8, w); }
#pragma unroll
            for (int ks = 0; ks < 4; ++ks) {
#pragma unroll
                for (int db = 0; db < 2; ++db) {
                    const LASC unsigned char* vp = (const LASC unsigned char*)(Vt + vtr_off + ks * 16 * 128 + ((db ^ ((lane >> 3) & 1)) * 64));
                    const s16x4 lo = __builtin_bit_cast(s16x4, __builtin_amdgcn_ds_read_tr16_b64_v4i16((LASC v4i16_t*)vp));
                    const s16x4 hh = __builtin_bit_cast(s16x4, __builtin_amdgcn_ds_read_tr16_b64_v4i16((LASC v4i16_t*)(vp + 8 * 128)));
                    const bf16x8 vf = {lo[0], lo[1], lo[2], lo[3], hh[0], hh[1], hh[2], hh[3]};
                    if (db == 0) o0 = __builtin_amdgcn_mfma_f32_32x32x16_bf16(vf, pa[ks], o0, 0, 0, 0);
                    else o1 = __builtin_amdgcn_mfma_f32_32x32x16_bf16(vf, pa[ks], o1, 0, 0, 0); }
            }
        }
        l += __shfl_xor(l, 32);
        const float inv = 1.0f / l;
        if (valid) {
            bf16_t* pp = (slot < 2) ? PROJ + (rowbase + q) * NPROJ + PC_XBC + (h * 2 + slot) * 64 + 4 * hi : PO2 + ((rowbase + q) * 8 + h) * 64 + 4 * hi;
#pragma unroll
            for (int g = 0; g < 4; ++g) {
                *(uint2*)(pp + 8 * g) = make_uint2(cvtpk(o0[4 * g] * inv, o0[4 * g + 1] * inv), cvtpk(o0[4 * g + 2] * inv, o0[4 * g + 3] * inv));
                *(uint2*)(pp + 32 + 8 * g) = make_uint2(cvtpk(o1[4 * g] * inv, o1[4 * g + 1] * inv), cvtpk(o1[4 * g + 2] * inv, o1[4 * g + 3] * inv)); }
            if (hi == 0) PL[((rowbase + q) * 8 + h) * 4 + slot] = m + __builtin_amdgcn_logf(l);
        }
    }
    __syncthreads();
}
#define MIX_WS ({ unsigned char* p_ = ws0; asm volatile("" : "+s"(p_)); p_; })
#define QUEUE_NEXT(u, word) do { if (tid == 0) *(volatile unsigned*)(lds + 131072 + 64) = atomicAdd((unsigned*)(MIX_WS + WS_CTL + 32768) + 64 * (word), 1u); \
        __syncthreads(); u = *(volatile unsigned*)(lds + 131072 + 64); __syncthreads(); } while (0)
__device__ __forceinline__ void ph_mixers(unsigned char* lds, unsigned char* ws0, const float* a_log, const float* d_skip, const float* sinks, const float* btab, int l) {
    const int tid = ltid();
    for (;;) {
        unsigned u; QUEUE_NEXT(u, 3 * l);
        if (u >= 2048u) break;
        const int k = (int)(u & 511u);
        if (u < 512u) { const int qb = 31 - (k >> 4), bh = k & 15; unsigned char* ws = MIX_WS;
            att::attn_unit<att::MODE_FOX>(lds, P_PROJ(ws), (const float*)(ws + WS_LF), (const float*)(ws + WS_CUM), 0, 0.f, bh >> 3, bh & 7, bh & 7, qb, PC_FQ, PC_FK, PC_FV); }
        else if (u < 1024u) { unsigned char* ws = MIX_WS; ssd::m1_unit(lds, P_XC(ws), (const float*)(ws + WS_DT), a_log, d_skip, (bf16_t*)(ws + WS_STATES), (float*)(ws + WS_CDEC), k >> 8, (k >> 3) & 31, k & 7); }
        else if (u < 1536u) { const int bh = k >> 5, qb = k & 31, hq = bh & 7; unsigned char* ws = MIX_WS;
            att::attn_unit<att::MODE_SWA>(lds, P_PROJ(ws), nullptr, btab, 8 + hq, sinks[hq], bh >> 3, hq, hq >> 2, qb, PC_SQ, PC_SK, PC_SV); }
        else { const int qb = 31 - (k >> 4), bh = k & 15; unsigned char* ws = MIX_WS;
            moba_select_unit(lds, P_PROJ(ws), (const float*)(ws + WS_KMEAN), (unsigned*)(ws + WS_SEL), bh >> 3, bh & 7, qb); }
    }
}
__device__ __forceinline__ void ph_mixers_b(unsigned char* lds, unsigned char* ws0, const float* a_log, const float* btab, int l) {
    const int tid = ltid();
    for (;;) {
        unsigned u; QUEUE_NEXT(u, 3 * l + 1);
        if (u >= 736u + 512u) break;
        if (u < 736u) { const int bh = (int)u & 15, idx = (int)u >> 4;
            const int qc = idx < 15 ? 0 : 1, j = idx - (qc == 0 ? 0 : 15); unsigned char* ws = MIX_WS;
            moba_gather_unit(lds, P_PROJ(ws), (const unsigned*)(ws + WS_SEL), btab, (bf16_t*)(ws + WS_PO2), (float*)(ws + WS_PL), bh >> 3, bh & 7, j, qc); }
        else { const int k = (int)u - 736, c = 31 - (k >> 4), bh = k & 15; unsigned char* ws = MIX_WS;
            ssd::m2_unit(lds, P_XC(ws), (const float*)(ws + WS_DT), a_log, (const bf16_t*)(ws + WS_STATES), (const float*)(ws + WS_CDEC), bh >> 3, c, bh & 7); }
    }
}
__device__ __forceinline__ void ph_mixers_c(unsigned char* lds, unsigned char* ws0, const float* btab, const float* ssm_norm_w, int l) {
    const int tid = ltid();
    for (;;) {
        unsigned u; QUEUE_NEXT(u, 3 * l + 2);
        if (u >= 512u) break;
        const int qb = 31 - ((int)u >> 4), bh = (int)u & 15, h = bh & 7; unsigned char* ws = MIX_WS;
        att::attn_unit<att::MODE_MOWN>(lds, P_PROJ(ws), (const float*)(ws + WS_SEL), btab, h, 0.f, bh >> 3, h, h, qb, PC_MQ, PC_MK, PC_MV, false, (const void*)(ws + WS_PO2), (const void*)(ws + WS_PL));
    }
    { unsigned char* ws = MIX_WS; ph_mamba_norm(P_PROJ(ws), P_XC(ws), ssm_norm_w); }
}
#define XB_TMO      128
#define XB_XCNT(j)  (256  + 64 * (j))
#define XB_XSUB(j)  (1280 + 64 * (j))
#define XB_XGEN(j)  (2304 + 64 * (j))
#define XB_TOP      3328
#define XB_TOPGEN   3392
#define XCD_BAR_WORDS 3456
#define XB_SPIN_CAP (1u << 18)

__device__ __forceinline__ unsigned xb_ld(unsigned* p)              { return __hip_atomic_load(p, __ATOMIC_RELAXED, __HIP_MEMORY_SCOPE_AGENT); }
__device__ __forceinline__ unsigned xb_add(unsigned* p, unsigned v) { return __hip_atomic_fetch_add(p, v, __ATOMIC_RELAXED, __HIP_MEMORY_SCOPE_AGENT); }
__device__ __forceinline__ unsigned xb_xcc_id() { return (unsigned)__builtin_amdgcn_s_getreg((3 << 11) | 20) & 0xFu; }
#define XB_SPIN(cond, bar) do { unsigned _sp = 0; while (cond) { __builtin_amdgcn_s_sleep(1); \
    if ((++_sp & 255u) == 0u) { if (xb_ld(&(bar)[XB_TMO])) break; if (_sp > XB_SPIN_CAP) { atomicAdd(&(bar)[XB_TMO], 1u); break; } } } } while (0)

struct XcdBarrier {
    unsigned* bar; unsigned x;
    volatile LAS unsigned* st;
};

__device__ __forceinline__ XcdBarrier xcd_barrier_post(unsigned* bar, volatile LAS unsigned* st) {
    XcdBarrier b; b.bar = bar; b.x = xb_xcc_id(); b.st = st;
    if (threadIdx.x == 0) (void)xb_add(&bar[XB_XCNT(b.x)], 1u);
    return b;
}
__device__ __forceinline__ void xcd_barrier_complete(unsigned* bar, unsigned x, unsigned& nloc, unsigned& nx) {
    const unsigned G = gridDim.x * gridDim.y * gridDim.z;
    unsigned sum, cnt, mine, sp = 0u;
    for (;;) {
        sum = 0u; cnt = 0u; mine = 0u;
#pragma unroll
        for (unsigned j = 0; j < 16; ++j) { const unsigned c = xb_ld(&bar[XB_XCNT(j)]); sum += c; cnt += (c > 0u) ? 1u : 0u; mine = (j == x) ? c : mine; }
        if (sum == G) break;
        __builtin_amdgcn_s_sleep(1);
        if ((++sp & 255u) == 0u) { if (xb_ld(&bar[XB_TMO])) break; if (sp > XB_SPIN_CAP) { atomicAdd(&bar[XB_TMO], 1u); break; } }
    }
    nloc = mine > 0u ? mine : 1u; nx = cnt > 0u ? cnt : 1u;
}

__device__ __forceinline__ void xcd_barrier(const XcdBarrier& b) {
    asm volatile("s_waitcnt vmcnt(0)" ::: "memory");
    __syncthreads();
    if (threadIdx.x == 0) {
        unsigned* bar = b.bar;
        __builtin_amdgcn_s_waitcnt(0);
        unsigned nloc = b.st[0], nx = b.st[1];
        if (nloc == 0u) { xcd_barrier_complete(bar, b.x, nloc, nx); b.st[0] = nloc; b.st[1] = nx; }
        const unsigned old = xb_add(&bar[XB_XSUB(b.x)], 1u);
        const unsigned gen = old / nloc;
        if (old + 1u == (gen + 1u) * nloc) {
            __builtin_amdgcn_fence(__ATOMIC_RELEASE, "agent");
            asm volatile("s_waitcnt vmcnt(0)" ::: "memory");
            const unsigned og = xb_add(&bar[XB_TOP], 1u);
            const unsigned tg = og / nx;
            if (og + 1u == (tg + 1u) * nx) xb_add(&bar[XB_TOPGEN], 1u);
            else XB_SPIN(xb_ld(&bar[XB_TOPGEN]) == tg, bar);
            __builtin_amdgcn_fence(__ATOMIC_ACQUIRE, "agent");
            xb_add(&bar[XB_XGEN(b.x)], 1u);
            asm volatile("s_waitcnt vmcnt(0)" ::: "memory");
        } else {
            XB_SPIN(xb_ld(&bar[XB_XGEN(b.x)]) == gen, bar);
            __builtin_amdgcn_fence(__ATOMIC_ACQUIRE, "agent");
            asm volatile("s_waitcnt vmcnt(0)" ::: "memory");
        }
    }
    __syncthreads();
}

constexpr int MISC_OFF = 131072 + 320;
constexpr int LDS_BYTES = 147456;
constexpr int HROW_OFF = 69632;
#define GRID_SYNC() xcd_barrier(bar)
#define WSL ({ unsigned char* p_ = a.ws; asm volatile("" : "+s"(p_)); p_; })
__global__ void __launch_bounds__(NT, 2) fwd(Args a) {
    extern __shared__ __attribute__((aligned(16))) unsigned char lds[];
    LAS unsigned char* L = (LAS unsigned char*)lds;
    volatile LAS unsigned* MISC = (volatile LAS unsigned*)(L + MISC_OFF);
    if (threadIdx.x < 32) MISC[threadIdx.x] = 0u;
    __syncthreads();
    XcdBarrier bar = xcd_barrier_post((unsigned*)(a.ws + WS_CTL) + 4096, MISC + 8);
#pragma unroll 1
    for (int l = 0; l < 2; ++l) {
        {
            unsigned char* ws = WSL; const float* xin = (l == 0) ? a.in[0] : a.out; const float* w_in = a.in[1] + (size_t)l * D * DIN;
            ph_wconv(ws, w_in, a.in[11] + (size_t)l * 4 * 512 * 1024, a.in[12] + (size_t)l * D * D, a.in[15] + (size_t)l * D * DFF, a.in[16] + (size_t)l * D * DFF, a.in[17] + (size_t)l * DFF * D, (LAS float*)L);
            __syncthreads();
            ph_norm((float*)lds, xin, a.in[13] + l * D, P_XN(ws), true, w_in, a.in[4] + l * 8, a.in[8] + l * 8, (float*)(ws + WS_DT), (float*)(ws + WS_LF));
        }
        GRID_SYNC();
        {
            unsigned char* ws = WSL;
            pg8::PlainSched S; S.T.init(M / 256, NPROJ / 256, gridDim.x, blockIdx.x); S.A = (const char*)P_XN(ws); S.B = (const char*)(ws + WS_WIN); S.lda2 = D * 2; S.ldb2 = D * 2; S.nt = D / 64;
            pg8::EpiStoreBf16 E{P_PROJ(ws), NPROJ}; pg8::gemm_phase<pg8::EpiStoreBf16, pg8::PlainSched, true>(L, S, E);
        }
        GRID_SYNC();
        { unsigned char* ws = WSL; ph_pre(lds, P_PROJ(ws), a.in[2] + (size_t)l * 4 * 1024, a.in[3] + l * 1024, P_XC(ws), (float*)(ws + WS_KMEAN), (float*)(ws + WS_CUM)); }
        GRID_SYNC();
        ph_mixers(lds, a.ws, a.in[5] + l * 8, a.in[6] + l * 8, a.in[9] + l * 8, a.in[10], l);
        GRID_SYNC();
        ph_mixers_b(lds, a.ws, a.in[5] + l * 8, a.in[10], l);
        GRID_SYNC();
        ph_mixers_c(lds, a.ws, a.in[10], a.in[7] + l * 512, l);
        GRID_SYNC();
        {
            unsigned char* ws = WSL;
            pg8::PlainSched S; S.T.init(M / 256, 4096 / 256, gridDim.x, blockIdx.x); S.A = (const char*)P_XN(ws); S.B = (const char*)(ws + WS_WG); S.lda2 = D * 2; S.ldb2 = D * 2; S.nt = D / 64;
            pg8::EpiGate E{P_PROJ(ws), P_XC(ws)}; pg8::gemm_phase<pg8::EpiGate, pg8::PlainSched, true>(L, S, E);
        }
        GRID_SYNC();
        {
            unsigned char* ws = WSL;
            pg8::BranchSched S; S.T.init(M / 256, D / 256, gridDim.x, blockIdx.x); S.PROJ = (const char*)P_PROJ(ws); S.WBR = (const char*)(ws + WS_WBR);
            pg8::EpiBranch E{P_PROJ(ws), P_XC(ws), P_XN(ws)}; pg8::gemm_phase<pg8::EpiBranch, pg8::BranchSched, true>(L, S, E);
        }
        GRID_SYNC();
        {
            unsigned char* ws = WSL; const float* xin = (l == 0) ? a.in[0] : a.out;
            pg8::PlainSched S; S.T.init(M / 256, D / 256, gridDim.x, blockIdx.x); S.A = (const char*)P_XN(ws); S.B = (const char*)(ws + WS_WOUT); S.lda2 = D * 2; S.ldb2 = D * 2; S.nt = D / 64;
            pg8::EpiResidual E{xin, a.out}; pg8::gemm_phase<pg8::EpiResidual, pg8::PlainSched, false>(L, S, E);
        }
        GRID_SYNC();
        { unsigned char* ws = WSL; ph_norm(nullptr, a.out, a.in[14] + l * D, P_XN(ws), false, nullptr, nullptr, nullptr, nullptr, nullptr); }
        GRID_SYNC();
        {
            unsigned char* ws = WSL;
            pg8::PlainSched S; S.T.init(M / 256, 2 * DFF / 256, gridDim.x, blockIdx.x); S.A = (const char*)P_XN(ws); S.B = (const char*)(ws + WS_WGU); S.lda2 = D * 2; S.ldb2 = D * 2; S.nt = D / 64;
            pg8::EpiSwiglu E{P_PROJ(ws)}; pg8::gemm_phase<pg8::EpiSwiglu, pg8::PlainSched, true>(L, S, E);
        }
        GRID_SYNC();
        {
            unsigned char* ws = WSL;
            pg8::PlainSched S; S.T.init(M / 256, D / 256, gridDim.x, blockIdx.x); S.A = (const char*)P_PROJ(ws); S.B = (const char*)(ws + WS_WDN); S.lda2 = DFF * 2; S.ldb2 = DFF * 2; S.nt = DFF / 64;
            pg8::EpiResidual E{a.out, a.out}; pg8::gemm_phase<pg8::EpiResidual, pg8::PlainSched, false>(L, S, E);
        }
        GRID_SYNC();
    }
    ph_final(a.out, a.in[18]);
}

extern "C" void kernel_launch(void* const* d_in, const int* in_sizes, int n_in, void* d_out, int out_size, void* d_ws, size_t ws_size, hipStream_t stream) {
    static int grid = 0;
    if (grid == 0) {
        if (n_in != 19 || out_size != M * D || ws_size < WS_TOTAL) { fprintf(stderr, "kernel_launch: unexpected shapes (n_in %d out %d ws %zu)\n", n_in, out_size, ws_size); grid = -1; return; }
        int dev = 0, cus = 0, per_cu = 0;
        (void)hipGetDevice(&dev); (void)hipDeviceGetAttribute(&cus, hipDeviceAttributeMultiprocessorCount, dev);
        if (hipFuncSetAttribute((const void*)fwd, hipFuncAttributeMaxDynamicSharedMemorySize, LDS_BYTES) != hipSuccess) { fprintf(stderr, "kernel_launch: hipFuncSetAttribute failed\n"); grid = -1; return; }
        (void)hipOccupancyMaxActiveBlocksPerMultiprocessor(&per_cu, (const void*)fwd, NT, LDS_BYTES);
        if (per_cu < 1) { fprintf(stderr, "kernel_launch: occupancy query says 0 blocks per CU\n"); grid = -1; return; }
        grid = cus < 256 ? cus : 256;
    }
    if (grid < 0) return;
    if (hipMemsetAsync((char*)d_ws + WS_CTL, 0, CTL_ZERO_BYTES, stream) != hipSuccess) { fprintf(stderr, "kernel_launch: memset of the control words failed\n"); return; }
    Args a{};
    for (int i = 0; i < 19; ++i) a.in[i] = (const float*)d_in[i];
    a.out = (float*)d_out; a.ws = (unsigned char*)d_ws;
    hipLaunchKernelGGL(fwd, dim3(grid), dim3(NT), LDS_BYTES, stream, a);
}
```

```cpp
#include <hip/hip_runtime.h>
#include <hip/hip_cooperative_groups.h>
#include <cstdio>
#include <cstdint>
namespace cg = cooperative_groups;

#ifndef SINGLE_LAUNCH
#define SINGLE_LAUNCH 0
#endif

typedef unsigned short bf16_t;
constexpr int M = 16384, SEQ = 8192, D = 1024, DIN = 9488, NPROJ = 5376, DFF = 2816;
constexpr int NT = 512;
constexpr int INP_TILES = 20;
constexpr int PC_Z = 0, PC_XBC = 512, PC_MQ = 1536, PC_MK = 2048, PC_MV = 2560, PC_FQ = 3072, PC_FK = 3584, PC_FV = 4096, PC_SQ = 4608, PC_SK = 5120, PC_SV = 5248;
constexpr int WC_DT = 1536, WC_F = 4616, WC_GATE = 5392;
constexpr size_t MiB = 1u << 20;
constexpr size_t WS_XN = 0, WS_PROJ = 32 * MiB, WS_XC = 200 * MiB, WS_DT = 232 * MiB, WS_LF = WS_DT + MiB / 2, WS_CUM = 233 * MiB, WS_KMEAN = WS_CUM + MiB / 2;
constexpr size_t WS_WIN = 234 * MiB;
constexpr size_t WS_WG = WS_WIN + (size_t)NPROJ * D * 2;
constexpr size_t WS_WBR = WS_WG + (size_t)4096 * D * 2;
constexpr size_t WS_WOUT = WS_WBR + (size_t)4 * D * 512 * 2;
constexpr size_t WS_WGU = WS_WOUT + (size_t)D * D * 2;
constexpr size_t WS_WDN = WS_WGU + (size_t)2 * DFF * D * 2;
constexpr size_t WS_END = WS_WDN + (size_t)D * DFF * 2;
static_assert(WS_END <= 276 * MiB, "workspace map");

constexpr size_t WS_CTL = 276 * MiB, CTL_ZERO_BYTES = 65536, WS_CDEC = WS_CTL + 131072, WS_TOTAL = 294 * MiB;
constexpr size_t WS_STATES = 234 * MiB, WS_PL = WS_STATES + 8 * MiB;
constexpr size_t WS_PO2 = 277 * MiB, WS_SEL = 293 * MiB;
#define P_XN(w) ((bf16_t*)((w) + WS_XN))
#define P_PROJ(w) ((bf16_t*)((w) + WS_PROJ))
#define P_XC(w) ((bf16_t*)((w) + WS_XC))
struct Args { const float* in[19]; float* out; unsigned char* ws; int ph_lo, ph_hi, coop, pad; };

__device__ __forceinline__ float bf2f(unsigned v) { return __uint_as_float(v << 16); }
__device__ __forceinline__ float bflo(unsigned v) { return __uint_as_float(v << 16); }
__device__ __forceinline__ float bfhi(unsigned v) { return __uint_as_float(v & 0xffff0000u); }
__device__ __forceinline__ unsigned f2bf(float f) { unsigned u = __float_as_uint(f); return (u + 0x7fffu + ((u >> 16) & 1u)) >> 16; }
__device__ __forceinline__ unsigned pk2(float lo, float hi) { return f2bf(lo) | (f2bf(hi) << 16); }
__device__ __forceinline__ float wave_sum(float v) {
#pragma unroll
    for (int o = 1; o < 64; o <<= 1) v += __shfl_xor(v, o);
    return v;
}
__device__ __forceinline__ unsigned q_ld(unsigned* p)              { return __hip_atomic_load(p, __ATOMIC_RELAXED, __HIP_MEMORY_SCOPE_AGENT); }
__device__ __forceinline__ unsigned q_add(unsigned* p, unsigned v) { return __hip_atomic_fetch_add(p, v, __ATOMIC_RELAXED, __HIP_MEMORY_SCOPE_AGENT); }
__device__ __forceinline__ int ltid() { int t = threadIdx.x; asm volatile("" : "+v"(t)); return t; }
__device__ __forceinline__ float log1p_pos(float e) {
    const float small = e * (1.f + e * (-0.5f + e * (0.33333333f + e * (-0.25f + e * 0.2f))));
    return e < 0.02f ? small : logf(1.f + e);
}
__device__ __forceinline__ float softplus_f(float x) { return fmaxf(x, 0.f) + log1p_pos(expf(-fabsf(x))); }
__device__ __forceinline__ float silu_f(float x) { return x / (1.f + expf(-x)); }
__device__ __forceinline__ float sigmoid_f(float x) { return 1.f / (1.f + expf(-x)); }
__device__ __forceinline__ int rel_bucket(int d) {
    if (d < 16) return d;
    int b = 16;
    b += (d >= 21); b += (d >= 27); b += (d >= 35); b += (d >= 46); b += (d >= 59); b += (d >= 77); b += (d >= 99); b += (d >= 128);
    b += (d >= 166); b += (d >= 216); b += (d >= 280); b += (d >= 363); b += (d >= 470); b += (d >= 609); b += (d >= 790);
    return b;
}

__device__ __forceinline__ void ph_norm(float* wd, const float* xin, const float* nw, bf16_t* XN, bool dots, const float* w_in, const float* dt_bias, const float* fbias, float* DT, float* LF) {
    const int tx_ = ltid();
    const int lane = tx_ & 63, wave = tx_ >> 6;
    const int gw = blockIdx.x * 8 + wave, NGW = gridDim.x * 8;
    if (dots) {
        for (int i = tx_; i < 1024 * 4; i += NT) { const int k = i >> 2, part = i & 3;
            *(float4*)((char*)wd + (k >> 2) * 272 + (k & 3) * 64 + part * 16) = *(const float4*)(w_in + (size_t)k * DIN + (part < 2 ? WC_DT + part * 4 : WC_F + (part - 2) * 4)); }
        __syncthreads();
    }
    for (int row = gw; row < M; row += NGW) {
        const float4* xr = (const float4*)(xin + (size_t)row * D);
        float4 v[4]; float ss = 0.f;
#pragma unroll
        for (int j = 0; j < 4; ++j) { v[j] = xr[lane + 64 * j]; ss += v[j].x * v[j].x + v[j].y * v[j].y + v[j].z * v[j].z + v[j].w * v[j].w; }
        ss = wave_sum(ss);
        const float rstd = 1.0f / sqrtf(ss * (1.0f / D) + 1e-6f);
#pragma unroll
        for (int j = 0; j < 4; ++j) { const float4 w4 = ((const float4*)nw)[lane + 64 * j]; v[j].x *= rstd * w4.x; v[j].y *= rstd * w4.y; v[j].z *= rstd * w4.z; v[j].w *= rstd * w4.w; }
        uint2* o = (uint2*)(XN + (size_t)row * D);
#pragma unroll
        for (int j = 0; j < 4; ++j) o[lane + 64 * j] = make_uint2(pk2(v[j].x, v[j].y), pk2(v[j].z, v[j].w));
        if (dots) {
            float d[16];
#pragma unroll
            for (int c = 0; c < 16; ++c) d[c] = 0.f;
#pragma unroll
            for (int j = 0; j < 4; ++j) { const float hv[4] = {v[j].x, v[j].y, v[j].z, v[j].w};
#pragma unroll
                for (int e = 0; e < 4; ++e) { const float* wr = (const float*)((const char*)wd + (lane + 64 * j) * 272 + e * 64); const float h = hv[e];
                    const float4 a0 = *(const float4*)(wr), a1 = *(const float4*)(wr + 4), b0 = *(const float4*)(wr + 8), b1 = *(const float4*)(wr + 12);
                    d[0] += h * a0.x; d[1] += h * a0.y; d[2] += h * a0.z; d[3] += h * a0.w; d[4] += h * a1.x; d[5] += h * a1.y; d[6] += h * a1.z; d[7] += h * a1.w;
                    d[8] += h * b0.x; d[9] += h * b0.y; d[10] += h * b0.z; d[11] += h * b0.w; d[12] += h * b1.x; d[13] += h * b1.y; d[14] += h * b1.z; d[15] += h * b1.w; }
                asm volatile("" ::: "memory"); }
            float r8[8], r4[4], r2[2];
            { const bool up = (lane & 32) != 0;
#pragma unroll
              for (int i = 0; i < 8; ++i) { const float keep = up ? d[i + 8] : d[i], send = up ? d[i] : d[i + 8]; r8[i] = keep + __shfl_xor(send, 32); } }
            { const bool up = (lane & 16) != 0;
#pragma unroll
              for (int i = 0; i < 4; ++i) { const float keep = up ? r8[i + 4] : r8[i], send = up ? r8[i] : r8[i + 4]; r4[i] = keep + __shfl_xor(send, 16); } }
            { const bool up = (lane & 8) != 0;
#pragma unroll
              for (int i = 0; i < 2; ++i) { const float keep = up ? r4[i + 2] : r4[i], send = up ? r4[i] : r4[i + 2]; r2[i] = keep + __shfl_xor(send, 8); } }
            float mine; { const bool up = (lane & 4) != 0; const float keep = up ? r2[1] : r2[0], send = up ? r2[0] : r2[1]; mine = keep + __shfl_xor(send, 4); }
            mine += __shfl_xor(mine, 2); mine += __shfl_xor(mine, 1);
            const int col = ((lane >> 5) & 1) * 8 + ((lane >> 4) & 1) * 4 + ((lane >> 3) & 1) * 2 + ((lane >> 2) & 1);
            if ((lane & 3) == 0) { if (col < 8) DT[(size_t)row * 8 + col] = softplus_f(mine + dt_bias[col]); else LF[(size_t)row * 8 + (col - 8)] = -softplus_f(-(mine + fbias[col - 8])); }
        }
    }
}

namespace pg8 {
#define PG8_LAS __attribute__((address_space(3)))
typedef short bf16x8 __attribute__((ext_vector_type(8)));
typedef float f32x4 __attribute__((ext_vector_type(4)));
typedef unsigned u32x4 __attribute__((ext_vector_type(4)));
constexpr int BM = 256, BK = 64, HALF = 128, HTB = HALF * BK * 2, STAGE_BYTES = 8 * HTB, NXCD = 8, WGM = 8;
__host__ __device__ __forceinline__ int lds_byte(int r, int c) { const int st = (r >> 4) * 2 + (c >> 5), rr = r & 15, cc = c & 31, ob = rr * 64 + cc * 2; return st * 1024 + (ob ^ (((ob >> 9) & 1) << 5)); }
__host__ __device__ __forceinline__ void stage_rc(int b, int& R, int& C) { const int st = b / 1024, sb = b % 1024, swz = sb ^ (((sb >> 9) & 1) << 5); R = (st >> 1) * 16 + swz / 64; C = (st & 1) * 32 + (swz % 64) / 2; }
__host__ __device__ __forceinline__ int perm32(int rho) { const int n = rho >> 4, i = rho & 15; return 8 * (i >> 2) + 4 * n + (i & 3); }
struct Unit { const char* A; const char* B; unsigned lda2, ldb2; int nt, pm, pn, aux; };
struct TileOrder {
    int nM, nN, nwg, G, c;
    __device__ void init(int nM_, int nN_, int G_, int c_) { nM = nM_; nN = nN_; nwg = nM * nN; G = G_; c = c_; }
    __device__ bool tile(int i, int& pm, int& pn) const {
        const long L = (long)i * G + c; if (L >= nwg) return false;
        int wgid = (int)L; { const int q = nwg / NXCD, r = nwg % NXCD, xcd = wgid % NXCD, off = wgid / NXCD; wgid = (xcd < r ? xcd * (q + 1) : r * (q + 1) + (xcd - r) * q) + off; }
        const int nig = WGM * nN, gid = wgid / nig, fm = gid * WGM, gsz = (nM - fm) < WGM ? (nM - fm) : WGM;
        pm = fm + ((wgid % nig) % gsz); pn = (wgid % nig) / gsz; return true;
    }
};
typedef float f32x2_t __attribute__((ext_vector_type(2))); typedef __bf16 bf16x2_t __attribute__((ext_vector_type(2)));
__device__ __forceinline__ unsigned cvt_pk_bf16(float lo, float hi) { f32x2_t v = {lo, hi}; bf16x2_t b = __builtin_convertvector(v, bf16x2_t); return __builtin_bit_cast(unsigned, b); }

template <class Epi, class Sched, bool ALIGN_EPI>
__device__ __forceinline__ void gemm_phase(PG8_LAS unsigned char* lds, const Sched& S, const Epi& E) {
    int tid = threadIdx.x; asm volatile("" : "+v"(tid));
    const int wid = __builtin_amdgcn_readfirstlane(tid >> 6), lane = tid & 63, wr = wid >> 2, wc = wid & 3, fr = lane & 15, fq = lane >> 4;
    unsigned RA[2], RB[2], C2[2];
#pragma unroll
    for (int i = 0; i < 2; ++i) { int R, C; stage_rc(tid * 16 + i * 8192, R, C); RA[i] = (unsigned)R; RB[i] = (unsigned)(Epi::PERM ? ((R & ~31) + perm32(R & 31)) : R); C2[i] = (unsigned)(C * 2); }
    const unsigned ldsw = (unsigned)wid * 1024u;
    const int aoff = lds_byte(wr * 64 + fr, fq * 8), boff = lds_byte(wc * 32 + fr, fq * 8);
#define PG8_SA(b, h) (((b) * 2 + (h)) * HTB)
#define PG8_SB(b, h) ((4 + (b) * 2 + (h)) * HTB)
#define PG8_STAGE(bufoff, gbase, RR, pitch) do { _Pragma("unroll") for (int _i = 0; _i < 2; ++_i) \
        __builtin_amdgcn_global_load_lds((const unsigned*)((const char*)(gbase) + (RR[_i] * (pitch) + C2[_i])), (PG8_LAS unsigned*)(lds + (bufoff) + ldsw + _i * 8192), 16, 0, 0); } while (0)
#define PG8_LDA(dst, b, h) do { _Pragma("unroll") for (int m = 0; m < 4; ++m) _Pragma("unroll") for (int k = 0; k < 2; ++k) dst[m][k] = *(const PG8_LAS bf16x8*)(lds + PG8_SA(b, h) + aoff + m * 2048 + k * 1024); } while (0)
#define PG8_LDB(dst, b, h) do { _Pragma("unroll") for (int n = 0; n < 2; ++n) _Pragma("unroll") for (int k = 0; k < 2; ++k) dst[n][k] = *(const PG8_LAS bf16x8*)(lds + PG8_SB(b, h) + boff + n * 2048 + k * 1024); } while (0)
#define PG8_MMA(ai, bj, At, Bt) do { __builtin_amdgcn_s_setprio(1); _Pragma("unroll") for (int m = 0; m < 4; ++m) _Pragma("unroll") for (int n = 0; n < 2; ++n) _Pragma("unroll") for (int k = 0; k < 2; ++k) \
        acc[ai][bj][m][n] = __builtin_amdgcn_mfma_f32_16x16x32_bf16(Bt[n][k], At[m][k], acc[ai][bj][m][n], 0, 0, 0); __builtin_amdgcn_s_setprio(0); } while (0)
#define PG8_WAIT_V(n) asm volatile("s_waitcnt vmcnt(" #n ")" ::: "memory")
#define PG8_WAIT_L(n) asm volatile("s_waitcnt lgkmcnt(" #n ")" ::: "memory")
#define PG8_BAR __builtin_amdgcn_s_barrier()
#define PG8_SCHED __builtin_amdgcn_sched_barrier(0)
#define PG8_ZERO() do { _Pragma("unroll") for (int a_ = 0; a_ < 2; ++a_) _Pragma("unroll") for (int b_ = 0; b_ < 2; ++b_) _Pragma("unroll") for (int m_ = 0; m_ < 4; ++m_) _Pragma("unroll") for (int n_ = 0; n_ < 2; ++n_) acc[a_][b_][m_][n_] = (f32x4){0.f, 0.f, 0.f, 0.f}; } while (0)
    Unit cur, nxt; int ui = 0;
    if (!S.next(0, cur)) return;
    f32x4 acc[2][2][4][2];
    PG8_ZERO();
    bf16x8 At[4][2], B0[2][2], B1[2][2];
    const char* cA = cur.A; const char* cB = cur.B; unsigned pAc = cur.lda2, pBc = cur.ldb2; int ntc = cur.nt;
    const unsigned kstep = BK * 2;
    {
        const size_t hA = (size_t)HALF * pAc, hB = (size_t)HALF * pBc;
        PG8_STAGE(PG8_SB(0, 0), cB, RB, pBc); PG8_STAGE(PG8_SB(0, 1), cB + hB, RB, pBc); PG8_STAGE(PG8_SA(0, 0), cA, RA, pAc); PG8_STAGE(PG8_SA(0, 1), cA + hA, RA, pAc);
        if (wr == 1) PG8_BAR;
        PG8_WAIT_V(2); PG8_BAR;
        PG8_STAGE(PG8_SB(1, 0), cB + kstep, RB, pBc); PG8_STAGE(PG8_SA(1, 0), cA + kstep, RA, pAc); PG8_STAGE(PG8_SB(1, 1), cB + hB + kstep, RB, pBc);
        PG8_WAIT_V(6); PG8_BAR;
    }
    for (;;) {
        const bool has_next = S.next(ui + 1, nxt);
        const char* nA = has_next ? nxt.A : cA; const char* nB = has_next ? nxt.B : cB;
        const unsigned pAn = has_next ? nxt.lda2 : pAc, pBn = has_next ? nxt.ldb2 : pBc;
        const size_t hAc = (size_t)HALF * pAc;
        for (int t = 0; t < ntc; t += 2) {
            const bool last = (t == ntc - 2);
            const char* a1 = cA + (size_t)(t + 1) * kstep;
            const char* a2 = last ? nA : cA + (size_t)(t + 2) * kstep; const char* b2 = last ? nB : cB + (size_t)(t + 2) * kstep;
            const char* a3 = a2 + kstep; const char* b3 = b2 + kstep;
            const unsigned pA2 = last ? pAn : pAc, pB2 = last ? pBn : pBc;
            const size_t hA2 = (size_t)HALF * pA2, hB2 = (size_t)HALF * pB2;
            PG8_LDB(B0, 0, 0); PG8_LDB(B1, 0, 1); PG8_SCHED; PG8_LDA(At, 0, 0); PG8_STAGE(PG8_SA(1, 1), a1 + hAc, RA, pAc);
            PG8_WAIT_V(8); PG8_WAIT_L(0); PG8_BAR; PG8_MMA(0, 0, At, B0); PG8_MMA(0, 1, At, B1); PG8_BAR; PG8_SCHED;
            PG8_LDA(At, 0, 1); PG8_STAGE(PG8_SB(0, 0), b2, RB, pB2); PG8_STAGE(PG8_SB(0, 1), b2 + hB2, RB, pB2); PG8_STAGE(PG8_SA(0, 0), a2, RA, pA2);
            PG8_WAIT_V(8); PG8_WAIT_L(0); PG8_BAR; PG8_MMA(1, 0, At, B0); PG8_MMA(1, 1, At, B1); PG8_BAR; PG8_SCHED;
            PG8_LDB(B0, 1, 0); PG8_LDB(B1, 1, 1); PG8_SCHED; PG8_LDA(At, 1, 0); PG8_STAGE(PG8_SA(0, 1), a2 + hA2, RA, pA2);
            PG8_WAIT_V(8); PG8_WAIT_L(0); PG8_BAR; PG8_MMA(0, 0, At, B0); PG8_MMA(0, 1, At, B1); PG8_BAR; PG8_SCHED;
            PG8_LDA(At, 1, 1); PG8_STAGE(PG8_SB(1, 0), b3, RB, pB2); PG8_STAGE(PG8_SB(1, 1), b3 + hB2, RB, pB2); PG8_STAGE(PG8_SA(1, 0), a3, RA, pA2);
            PG8_WAIT_V(8); PG8_WAIT_L(0); PG8_BAR; PG8_MMA(1, 0, At, B0); PG8_MMA(1, 1, At, B1); PG8_BAR; PG8_SCHED;
        }
        if constexpr (ALIGN_EPI) { if (wr == 0) PG8_BAR; }
        { int fr_ = fr, fq_ = fq; asm volatile("" : "+v"(fr_), "+v"(fq_)); E(acc, cur, wr, wc, fr_, fq_); }
        if (!has_next) break;
        PG8_ZERO();
        cur = nxt; cA = nA; cB = nB; pAc = pAn; pBc = pBn; ntc = nxt.nt; ++ui;
        if constexpr (ALIGN_EPI) { if (wr == 1) PG8_BAR; }
    }
    PG8_WAIT_V(0);
    if constexpr (!ALIGN_EPI) { if (wr == 0) PG8_BAR; }
    PG8_BAR;
#undef PG8_SA
#undef PG8_SB
#undef PG8_STAGE
#undef PG8_LDA
#undef PG8_LDB
#undef PG8_MMA
#undef PG8_WAIT_V
#undef PG8_WAIT_L
#undef PG8_BAR
#undef PG8_SCHED
#undef PG8_ZERO
}

struct PlainSched {
    TileOrder T; const char* A; const char* B; unsigned lda2, ldb2; int nt;
    __device__ bool next(int i, Unit& u) const { int pm, pn; if (!T.tile(i, pm, pn)) return false;
        u.A = A + (size_t)pm * 256 * lda2; u.B = B + (size_t)pn * 256 * ldb2; u.lda2 = lda2; u.ldb2 = ldb2; u.nt = nt; u.pm = pm; u.pn = pn; u.aux = 0; return true; }
};
struct OneSched { Unit u0; __device__ bool next(int i, Unit& u) const { if (i != 0) return false; u = u0; return true; } };
struct EpiStoreBf16 {
    static constexpr bool PERM = true;
    bf16_t* O; int ldc;
    __device__ __forceinline__ void operator()(const f32x4 (&acc)[2][2][4][2], const Unit& u, int wr, int wc, int fr, int fq) const {
        const int row0 = u.pm * BM + wr * 64 + fr, col0 = u.pn * BM + wc * 32 + 8 * fq;
#pragma unroll
        for (int ai = 0; ai < 2; ++ai)
#pragma unroll
            for (int m = 0; m < 4; ++m) { bf16_t* rowp = O + (size_t)(row0 + ai * HALF + m * 16) * ldc + col0;
#pragma unroll
                for (int bj = 0; bj < 2; ++bj) { const f32x4 v0 = acc[ai][bj][m][0], v1 = acc[ai][bj][m][1];
                    u32x4 w; w.x = cvt_pk_bf16(v0[0], v0[1]); w.y = cvt_pk_bf16(v0[2], v0[3]); w.z = cvt_pk_bf16(v1[0], v1[1]); w.w = cvt_pk_bf16(v1[2], v1[3]);
                    *(u32x4*)(rowp + bj * HALF) = w; } }
    }
};
__device__ __forceinline__ float fast_sigmoid(float x) { return __builtin_amdgcn_rcpf(1.f + __expf(-x)); }
struct EpiSwiglu {
    static constexpr bool PERM = true;
    bf16_t* H;
    __device__ __forceinline__ void operator()(const f32x4 (&acc)[2][2][4][2], const Unit& u, int wr, int wc, int fr, int fq) const {
        const int row0 = u.pm * BM + wr * 64 + fr, col0 = u.pn * HALF + wc * 32 + 8 * fq;
#pragma unroll
        for (int ai = 0; ai < 2; ++ai)
#pragma unroll
            for (int m = 0; m < 4; ++m) { float v[8];
#pragma unroll
                for (int n = 0; n < 2; ++n)
#pragma unroll
                    for (int e = 0; e < 4; ++e) { const float g = acc[ai][0][m][n][e], up = acc[ai][1][m][n][e]; v[n * 4 + e] = g * fast_sigmoid(g) * up; }
                u32x4 w; w.x = cvt_pk_bf16(v[0], v[1]); w.y = cvt_pk_bf16(v[2], v[3]); w.z = cvt_pk_bf16(v[4], v[5]); w.w = cvt_pk_bf16(v[6], v[7]);
                *(u32x4*)(H + (size_t)(row0 + ai * HALF + m * 16) * DFF + col0) = w; }
    }
};
struct EpiResidual {
    static constexpr bool PERM = false;
    const float* res; float* out;
    __device__ __forceinline__ void operator()(const f32x4 (&acc)[2][2][4][2], const Unit& u, int wr, int wc, int fr, int fq) const {
        const int row0 = u.pm * BM + wr * 64 + fr, col0 = u.pn * BM + wc * 32 + 4 * fq;
#pragma unroll
        for (int ai = 0; ai < 2; ++ai)
#pragma unroll
            for (int m = 0; m < 4; ++m) { const size_t off = (size_t)(row0 + ai * HALF + m * 16) * D + col0;
#pragma unroll
                for (int bj = 0; bj < 2; ++bj)
#pragma unroll
                    for (int n = 0; n < 2; ++n) { const f32x4 r = *(const f32x4*)(res + off + bj * HALF + n * 16); *(f32x4*)(out + off + bj * HALF + n * 16) = r + acc[ai][bj][m][n]; } }
    }
};
struct EpiGate {
    static constexpr bool PERM = true;
    bf16_t* PROJ; bf16_t* XC;
    __device__ __forceinline__ void operator()(const f32x4 (&acc)[2][2][4][2], const Unit& u, int wr, int wc, int fr, int fq) const {
        const int br = u.pn >> 2, row0 = u.pm * BM + wr * 64 + fr, col0 = (u.pn & 3) * BM + wc * 32 + 8 * fq;
        bf16_t* base = br < 3 ? PROJ + 512 + 1536 * br : XC;
        const int ld = br < 3 ? NPROJ : 1024;
#pragma unroll
        for (int ai = 0; ai < 2; ++ai)
#pragma unroll
            for (int m = 0; m < 4; ++m) { bf16_t* rowp = base + (size_t)(row0 + ai * HALF + m * 16) * ld + col0;
#pragma unroll
                for (int bj = 0; bj < 2; ++bj) { const f32x4 v0 = acc[ai][bj][m][0], v1 = acc[ai][bj][m][1];
                    u32x4 w; w.x = cvt_pk_bf16(fast_sigmoid(v0[0]), fast_sigmoid(v0[1])); w.y = cvt_pk_bf16(fast_sigmoid(v0[2]), fast_sigmoid(v0[3]));
                    w.z = cvt_pk_bf16(fast_sigmoid(v1[0]), fast_sigmoid(v1[1])); w.w = cvt_pk_bf16(fast_sigmoid(v1[2]), fast_sigmoid(v1[3]));
                    *(u32x4*)(rowp + bj * HALF) = w; } }
    }
};
struct BranchSched {
    TileOrder T; const char* PROJ; const char* WBR;
    __device__ bool next(int i, Unit& u) const { int pm, pn; if (!T.tile(i >> 2, pm, pn)) return false;
        const int br = i & 3; u.pm = pm; u.pn = pn; u.aux = br;
        u.A = PROJ + (size_t)pm * 256 * (NPROJ * 2) + 1536 * 2 * br; u.lda2 = NPROJ * 2; u.B = WBR + ((size_t)br * 1024 + pn * 256) * (512 * 2); u.ldb2 = 512 * 2; u.nt = 512 / 64; return true; }
};
struct EpiBranch {
    static constexpr bool PERM = true;
    const bf16_t* PROJ; const bf16_t* XC; bf16_t* MIX;
    __device__ __forceinline__ void operator()(const f32x4 (&acc)[2][2][4][2], const Unit& u, int wr, int wc, int fr, int fq) const {
        const int br = u.aux, row0 = u.pm * BM + wr * 64 + fr, col0 = u.pn * BM + wc * 32 + 8 * fq;
        const bf16_t* G = br < 3 ? PROJ + 512 + 1536 * br : XC; const int ldg = br < 3 ? NPROJ : 1024;
        if (br == 0) run<true>(acc, G, ldg, row0, col0); else run<false>(acc, G, ldg, row0, col0);
    }
    template <bool FIRST>
    __device__ __forceinline__ void run(const f32x4 (&acc)[2][2][4][2], const bf16_t* G, int ldg, int row0, int col0) const {
#pragma unroll
        for (int gb = 0; gb < 16; gb += 4) {
            u32x4 g[4], o[4];
#pragma unroll
            for (int k = 0; k < 4; ++k) { const int i = gb + k, ai = i >> 3, m = (i >> 1) & 3, bj = i & 1; const size_t row = (size_t)(row0 + ai * HALF + m * 16);
                g[k] = *(const u32x4*)(G + row * ldg + col0 + bj * HALF); if (!FIRST) o[k] = *(const u32x4*)(MIX + row * D + col0 + bj * HALF); }
#pragma unroll
            for (int k = 0; k < 4; ++k) { const int i = gb + k, ai = i >> 3, m = (i >> 1) & 3, bj = i & 1; const size_t row = (size_t)(row0 + ai * HALF + m * 16);
                f32x4 p0 = acc[ai][bj][m][0], p1 = acc[ai][bj][m][1];
                p0[0] *= bflo(g[k].x); p0[1] *= bfhi(g[k].x); p0[2] *= bflo(g[k].y); p0[3] *= bfhi(g[k].y); p1[0] *= bflo(g[k].z); p1[1] *= bfhi(g[k].z); p1[2] *= bflo(g[k].w); p1[3] *= bfhi(g[k].w);
                if (!FIRST) { p0[0] += bflo(o[k].x); p0[1] += bfhi(o[k].x); p0[2] += bflo(o[k].y); p0[3] += bfhi(o[k].y); p1[0] += bflo(o[k].z); p1[1] += bfhi(o[k].z); p1[2] += bflo(o[k].w); p1[3] += bfhi(o[k].w); }
                u32x4 w; w.x = cvt_pk_bf16(p0[0], p0[1]); w.y = cvt_pk_bf16(p0[2], p0[3]); w.z = cvt_pk_bf16(p1[0], p1[1]); w.w = cvt_pk_bf16(p1[2], p1[3]);
                *(u32x4*)(MIX + row * D + col0 + bj * HALF) = w; }
            asm volatile("" ::: "memory");
        }
    }
};
}

#define LAS __attribute__((address_space(3)))
__device__ __forceinline__ void wt_item(const float* W, int ldw, int src_col0, int k0, bf16_t* WT, int ldwt, int dst_row0, LAS float* scr, int lane) {
#pragma unroll
    for (int i = 0; i < 8; ++i) { const int k = 4 * i + (lane >> 4), n4 = (lane & 15) * 4;
        const float4 v = *(const float4*)(W + (size_t)(k0 + k) * ldw + src_col0 + n4);
        LAS float* d = scr + k * 65 + n4; d[0] = v.x; d[1] = v.y; d[2] = v.z; d[3] = v.w; }
    asm volatile("s_waitcnt lgkmcnt(0)" ::: "memory");
    unsigned w[16];
#pragma unroll
    for (int j = 0; j < 16; ++j) w[j] = pk2(scr[(2 * j) * 65 + lane], scr[(2 * j + 1) * 65 + lane]);
    uint4* o = (uint4*)(WT + (size_t)(dst_row0 + lane) * ldwt + k0);
#pragma unroll
    for (int j = 0; j < 4; ++j) o[j] = make_uint4(w[4 * j], w[4 * j + 1], w[4 * j + 2], w[4 * j + 3]);
    asm volatile("s_waitcnt lgkmcnt(0)" ::: "memory");
}
__device__ __forceinline__ void ph_wconv(unsigned char* ws, const float* w_in, const float* w_branch, const float* w_out, const float* w_gate, const float* w_up, const float* w_down, LAS float* scr_base) {
    const int tx_ = ltid();
    const int lane = tx_ & 63, wave = tx_ >> 6;
    LAS float* scr = scr_base + wave * (32 * 65);
    const int gw = blockIdx.x * 8 + wave, NGW = gridDim.x * 8;
    constexpr int I_IN = 32 * (NPROJ / 64), I_G = 32 * 64, I_BR = 4 * 16 * 16, I_OUT = 32 * 16, I_GU = 32 * (2 * DFF / 64), I_DN = (DFF / 32) * 16;
    for (int it = gw; it < I_IN + I_G + I_BR + I_OUT + I_GU + I_DN; it += NGW) {
        int r = it;
        if (r < I_IN) { const int nb = r % (NPROJ / 64), kb = r / (NPROJ / 64), c0 = nb * 64;
            wt_item(w_in, DIN, c0 + (c0 >= 1536 ? 8 : 0) + (c0 >= 4608 ? 8 : 0), kb * 32, (bf16_t*)(ws + WS_WIN), D, c0, scr, lane); continue; } r -= I_IN;
        if (r < I_G) { const int nb = r % 64, kb = r / 64; wt_item(w_in, DIN, WC_GATE + nb * 64, kb * 32, (bf16_t*)(ws + WS_WG), D, nb * 64, scr, lane); continue; } r -= I_G;
        if (r < I_BR) { const int br = r / 256, q = r % 256, nb = q % 16, kb = q / 16;
            wt_item(w_branch + (size_t)br * 512 * 1024, D, nb * 64, kb * 32, (bf16_t*)(ws + WS_WBR) + (size_t)br * 1024 * 512, 512, nb * 64, scr, lane); continue; } r -= I_BR;
        if (r < I_OUT) { const int nb = r % 16, kb = r / 16; wt_item(w_out, D, nb * 64, kb * 32, (bf16_t*)(ws + WS_WOUT), D, nb * 64, scr, lane); continue; } r -= I_OUT;
        if (r < I_GU) { const int nb = r % (2 * DFF / 64), kb = r / (2 * DFF / 64), r0 = nb * 64, t = r0 >> 8, j = r0 & 255;
            wt_item(j < 128 ? w_gate : w_up, DFF, t * 128 + (j & 127), kb * 32, (bf16_t*)(ws + WS_WGU), D, r0, scr, lane); continue; } r -= I_GU;
        { const int nb = r % 16, kb = r / 16; wt_item(w_down, D, nb * 64, kb * 32, (bf16_t*)(ws + WS_WDN), DFF, nb * 64, scr, lane); }
    }
}

__device__ __forceinline__ void ph_pre(unsigned char* lds, const bf16_t* PROJ, const float* conv_w, const float* conv_b, bf16_t* XC, float* KMEAN, float* KMAXP) {
    const int tx_ = ltid();
    const size_t gt = (size_t)blockIdx.x * NT + tx_, tot = (size_t)gridDim.x * NT;
    for (size_t e = gt; e < (size_t)M * 128; e += tot) {
        const int row = (int)(e >> 7), c8 = (int)(e & 127) * 8, t = row & (SEQ - 1);
        float acc[8];
        { const float4 b0 = *(const float4*)(conv_b + c8), b1 = *(const float4*)(conv_b + c8 + 4); acc[0] = b0.x; acc[1] = b0.y; acc[2] = b0.z; acc[3] = b0.w; acc[4] = b1.x; acc[5] = b1.y; acc[6] = b1.z; acc[7] = b1.w; }
#pragma unroll
        for (int i = 0; i < 4; ++i) { const int tt = t - 3 + i;
            if (tt >= 0) { const uint4 u = *(const uint4*)(PROJ + (size_t)(row - 3 + i) * NPROJ + PC_XBC + c8);
                const float4 w0 = *(const float4*)(conv_w + i * 1024 + c8), w1 = *(const float4*)(conv_w + i * 1024 + c8 + 4);
                acc[0] += w0.x * bflo(u.x); acc[1] += w0.y * bfhi(u.x); acc[2] += w0.z * bflo(u.y); acc[3] += w0.w * bfhi(u.y);
                acc[4] += w1.x * bflo(u.z); acc[5] += w1.y * bfhi(u.z); acc[6] += w1.z * bflo(u.w); acc[7] += w1.w * bfhi(u.w); } }
        uint4 o; o.x = pk2(silu_f(acc[0]), silu_f(acc[1])); o.y = pk2(silu_f(acc[2]), silu_f(acc[3])); o.z = pk2(silu_f(acc[4]), silu_f(acc[5])); o.w = pk2(silu_f(acc[6]), silu_f(acc[7]));
        *(uint4*)(XC + (size_t)row * 1024 + c8) = o;
    }
    {
        int* smax = (int*)lds;
        if (tx_ < 16) smax[tx_] = 0;
        __syncthreads();
        for (size_t e = gt; e < (size_t)M * 8; e += tot) { const int row = (int)(e >> 3), h = (int)(e & 7);
            const bf16_t* kp = PROJ + (size_t)row * NPROJ + PC_FK + h * 64; float n2 = 0.f;
#pragma unroll
            for (int c = 0; c < 8; ++c) { const uint4 u = *(const uint4*)(kp + c * 8);
                n2 += bflo(u.x) * bflo(u.x) + bfhi(u.x) * bfhi(u.x) + bflo(u.y) * bflo(u.y) + bfhi(u.y) * bfhi(u.y) + bflo(u.z) * bflo(u.z) + bfhi(u.z) * bfhi(u.z) + bflo(u.w) * bflo(u.w) + bfhi(u.w) * bfhi(u.w); }
            atomicMax(&smax[(row >> 13) * 8 + h], __float_as_int(n2)); }
        __syncthreads();
        if (tx_ < 16) KMAXP[blockIdx.x * 16 + tx_] = sqrtf(__int_as_float(smax[tx_]));
    }
    const int lane = tx_ & 63, gw = blockIdx.x * 8 + (tx_ >> 6), NGW = gridDim.x * 8;
    for (int it = gw; it < 64 * 64; it += NGW) {
        const int bb = it >> 6, c8 = (it & 63) * 8;
        float sm[8];
#pragma unroll
        for (int j = 0; j < 8; ++j) sm[j] = 0.f;
#pragma unroll
        for (int r = 0; r < 4; ++r) { const uint4 u = *(const uint4*)(PROJ + ((size_t)bb * 256 + lane * 4 + r) * NPROJ + PC_MK + c8);
            sm[0] += bflo(u.x); sm[1] += bfhi(u.x); sm[2] += bflo(u.y); sm[3] += bfhi(u.y); sm[4] += bflo(u.z); sm[5] += bfhi(u.z); sm[6] += bflo(u.w); sm[7] += bfhi(u.w); }
        float mine = 0.f;
#pragma unroll
        for (int j = 0; j < 8; ++j) { const float v = wave_sum(sm[j]); if (lane == j) mine = v; }
        if (lane < 8) KMEAN[(size_t)bb * 512 + c8 + lane] = mine * (1.0f / 256.0f);
    }
}

__device__ __forceinline__ void ph_mamba_norm(bf16_t* PROJ, const bf16_t* XC, const float* nw) {
    const int tx_ = ltid();
    const int lane = tx_ & 63, gw = blockIdx.x * 8 + (tx_ >> 6), NGW = gridDim.x * 8;
    for (int row = gw; row < M; row += NGW) {
        const uint4 yv = *(const uint4*)(XC + (size_t)row * 1024 + lane * 8); const uint4 zv = *(const uint4*)(PROJ + (size_t)row * NPROJ + PC_Z + lane * 8);
        float y[8] = {bflo(yv.x), bfhi(yv.x), bflo(yv.y), bfhi(yv.y), bflo(yv.z), bfhi(yv.z), bflo(yv.w), bfhi(yv.w)};
        const float z[8] = {bflo(zv.x), bfhi(zv.x), bflo(zv.y), bfhi(zv.y), bflo(zv.z), bfhi(zv.z), bflo(zv.w), bfhi(zv.w)};
        float ss = 0.f;
#pragma unroll
        for (int i = 0; i < 8; ++i) { y[i] *= silu_f(z[i]); ss += y[i] * y[i]; }
        ss = wave_sum(ss); const float rstd = 1.0f / sqrtf(ss * (1.0f / 512.0f) + 1e-6f);
        const float4 w0 = *(const float4*)(nw + lane * 8), w1 = *(const float4*)(nw + lane * 8 + 4);
        uint4 o; o.x = pk2(y[0] * rstd * w0.x, y[1] * rstd * w0.y); o.y = pk2(y[2] * rstd * w0.z, y[3] * rstd * w0.w); o.z = pk2(y[4] * rstd * w1.x, y[5] * rstd * w1.y); o.w = pk2(y[6] * rstd * w1.z, y[7] * rstd * w1.w);
        *(uint4*)(PROJ + (size_t)row * NPROJ + PC_Z + lane * 8) = o;
    }
}
__device__ __forceinline__ void ph_final(float* out, const float* nw) {
    const int tx_ = ltid();
    const int lane = tx_ & 63, gw = blockIdx.x * 8 + (tx_ >> 6), NGW = gridDim.x * 8;
    for (int row = gw; row < M; row += NGW) {
        float4* xr = (float4*)(out + (size_t)row * D);
        float4 v[4]; float ss = 0.f;
#pragma unroll
        for (int j = 0; j < 4; ++j) { v[j] = xr[lane + 64 * j]; ss += v[j].x * v[j].x + v[j].y * v[j].y + v[j].z * v[j].z + v[j].w * v[j].w; }
        ss = wave_sum(ss); const float rstd = 1.0f / sqrtf(ss * (1.0f / D) + 1e-6f);
#pragma unroll
        for (int j = 0; j < 4; ++j) { const float4 w4 = ((const float4*)nw)[lane + 64 * j]; xr[lane + 64 * j] = make_float4(v[j].x * rstd * w4.x, v[j].y * rstd * w4.y, v[j].z * rstd * w4.z, v[j].w * rstd * w4.w); }
    }
}


namespace att {
typedef short bf16x8 __attribute__((ext_vector_type(8)));
typedef short s16x4 __attribute__((ext_vector_type(4)));
typedef float f32x16 __attribute__((ext_vector_type(16)));
typedef float f32x2_t __attribute__((ext_vector_type(2))); typedef __bf16 bf16x2_t __attribute__((ext_vector_type(2)));
__device__ __forceinline__ unsigned cvtpk(float lo, float hi) { f32x2_t v = {lo, hi}; bf16x2_t b = __builtin_convertvector(v, bf16x2_t); return __builtin_bit_cast(unsigned, b); }
constexpr float LOG2E = 1.4426950408889634f, C2 = 0.125f * LOG2E;
constexpr int ST_BYTES = 16384, OFF_BIAS = 65536, OFF_EB = OFF_BIAS + 1024, OFF_KMAX = OFF_EB + 32, OFF_TAB = OFF_BIAS + 2048, TAB_N = 1280, OFF_END = OFF_TAB + TAB_N * 4;
constexpr float FOX_THR = 25.f;
enum { MODE_FOX = 0, MODE_SWA = 1, MODE_MOBA = 2, MODE_MOWN = 3 };
#define LASC __attribute__((address_space(3)))
typedef short v4i16_t __attribute__((ext_vector_type(4)));

template <int MODE>
__device__ __forceinline__ void attn_unit(unsigned char* lds, bf16_t* PROJ, const float* AUX, const float* btab, int bcol, float sink, int b, int hq, int hk, int qb, int qcol, int kcol, int vcol, bool dry = false, const void* ex0 = nullptr, const void* ex1 = nullptr) {
    const int tid = ltid(), lane = tid & 63, wave = __builtin_amdgcn_readfirstlane(tid >> 6), r32 = lane & 31, hi = lane >> 5;
    const int q0 = qb * 256, qw = q0 + wave * 32, q = qw + r32;
    const size_t rowbase = (size_t)b * SEQ;
    float* tab = (float*)(lds + OFF_TAB);
    if constexpr (MODE == MODE_SWA) {
        if (tid < 512) { const int d = tid - 128; tab[tid] = (d >= 0 && d < 128) ? btab[rel_bucket(d) * 16 + bcol] * LOG2E : 0.f; }
    }
    if constexpr (MODE == MODE_MOBA || MODE == MODE_MOWN) {
        for (int d = tid; d < 1024; d += NT) tab[d] = btab[rel_bucket(d) * 16 + bcol] * LOG2E;
    }
    bf16x8 qr[4]; float gq[32]; float qn2 = 0.f;
    { const bf16_t* qp = PROJ + (rowbase + q) * NPROJ + qcol + hq * 64 + 8 * hi;
#pragma unroll
      for (int d0 = 0; d0 < 4; ++d0) { const uint4 u = *(const uint4*)(qp + 16 * d0);
          const float f[8] = {bflo(u.x), bfhi(u.x), bflo(u.y), bfhi(u.y), bflo(u.z), bfhi(u.z), bflo(u.w), bfhi(u.w)};
          if constexpr (MODE == MODE_MOBA) {
#pragma unroll
              for (int e = 0; e < 8; ++e) gq[d0 * 8 + e] = f[e]; }
          if constexpr (MODE == MODE_FOX) {
#pragma unroll
              for (int e = 0; e < 8; ++e) qn2 += f[e] * f[e]; }
          uint4 w; w.x = cvtpk(f[0] * C2, f[1] * C2); w.y = cvtpk(f[2] * C2, f[3] * C2); w.z = cvtpk(f[4] * C2, f[5] * C2); w.w = cvtpk(f[6] * C2, f[7] * C2);
          qr[d0] = __builtin_bit_cast(bf16x8, w); } }
    unsigned selmask = 0u;
    if constexpr (MODE == MODE_MOBA) {
        float g0 = -INFINITY, g1 = -INFINITY, g2 = -INFINITY; int i0 = -1, i1 = -1, i2 = -1;
        for (int n = 0; n < qb; ++n) {
            const float* km = AUX + ((size_t)(b * 32 + n)) * 512 + hk * 64 + 8 * hi; float g = 0.f;
#pragma unroll
            for (int d0 = 0; d0 < 4; ++d0) { const float4 k0 = *(const float4*)(km + 16 * d0), k1 = *(const float4*)(km + 16 * d0 + 4);
                g += gq[d0 * 8] * k0.x + gq[d0 * 8 + 1] * k0.y + gq[d0 * 8 + 2] * k0.z + gq[d0 * 8 + 3] * k0.w + gq[d0 * 8 + 4] * k1.x + gq[d0 * 8 + 5] * k1.y + gq[d0 * 8 + 6] * k1.z + gq[d0 * 8 + 7] * k1.w; }
            g += __shfl_xor(g, 32);
            if (g > g0) { g2 = g1; i2 = i1; g1 = g0; i1 = i0; g0 = g; i0 = n; }
            else if (g > g1) { g2 = g1; i2 = i1; g1 = g; i1 = n; }
            else if (g > g2) { g2 = g; i2 = n; }
        }
        if (i0 >= 0) selmask |= 1u << i0; if (i1 >= 0) selmask |= 1u << i1; if (i2 >= 0) selmask |= 1u << i2;
    }
    float carry = 0.f;
    f32x16 o0, o1;
#pragma unroll
    for (int r = 0; r < 16; ++r) { o0[r] = 0.f; o1[r] = 0.f; }
    float m = -1e30f, l = 0.f;
    if constexpr (MODE == MODE_SWA) { m = sink * LOG2E; l = hi == 0 ? 1.f : 0.f; }
    const int t_beg = (MODE == MODE_SWA) ? (qb > 0 ? 4 * qb - 2 : 0) : (MODE == MODE_MOWN ? 4 * qb : 0), t_end = 4 * (qb + 1);
    const int skey = tid >> 3, sch = tid & 7;
    const bf16_t* kg = PROJ + (rowbase + skey) * NPROJ + kcol + hk * 64 + sch * 8;
    const bf16_t* vg = PROJ + (rowbase + skey) * NPROJ + vcol + hk * 64 + sch * 8;
    const int kdst = skey * 128 + ((sch ^ ((skey >> 1) & 7)) * 16);
    uint4 kreg0, kreg1, vreg0, vreg1; float breg0 = 0.f, breg1 = 0.f;
#define ATT_LOAD1(t_, KR, VR, BR) do { KR = *(const uint4*)(kg + (size_t)(t_) * 64 * NPROJ); VR = *(const uint4*)(vg + (size_t)(t_) * 64 * NPROJ); \
        if (MODE == MODE_FOX) { if (tid < 64) BR = AUX[(rowbase + (t_) * 64 + tid) * 8 + hq]; } } while (0)
#define ATT_LOAD(s_) do { ATT_LOAD1(ATT_TI(2 * (s_)), kreg0, vreg0, breg0); ATT_LOAD1(ATT_TI(2 * (s_) + 1), kreg1, vreg1, breg1); } while (0)
#define ATT_STORE1(ts_, KR, VR, BR) do { unsigned char* sb_ = lds + (ts_) * ST_BYTES; \
        *(uint4*)(sb_ + kdst) = KR; *(uint4*)(sb_ + 8192 + skey * 128 + ((sch ^ (((skey >> 1) & 1) << 2)) * 16)) = VR; \
        if (MODE == MODE_FOX) { if (tid < 64) { float inc_ = BR; \
            _Pragma("unroll") for (int o_ = 1; o_ < 64; o_ <<= 1) { const float v_ = __shfl_up(inc_, o_); if (lane >= o_) inc_ += v_; } \
            const float tot_ = __shfl(inc_, 63); \
            ((float*)(lds + OFF_BIAS))[(ts_) * 64 + tid] = (carry + tot_ - inc_) * LOG2E;        \
            carry += tot_; if (tid == 0) ((float*)(lds + OFF_EB))[(ts_)] = carry * LOG2E; } } } while (0)
#define ATT_STORE(st) do { ATT_STORE1((st) * 2, kreg0, vreg0, breg0); ATT_STORE1((st) * 2 + 1, kreg1, vreg1, breg1); } while (0)
    const int ntile = t_end - t_beg;
#define ATT_TI(i) ((MODE == MODE_FOX) ? (t_end - 1 - (i)) : (t_beg + (i)))
    float qkb = 0.f;
    if constexpr (MODE == MODE_FOX) {
        if (tid < 64) { float km = 0.f;
#pragma unroll
            for (int i = 0; i < 4; ++i) km = fmaxf(km, btab[(tid * 4 + i) * 16 + b * 8 + hq]);
#pragma unroll
            for (int o = 1; o < 64; o <<= 1) km = fmaxf(km, __shfl_xor(km, o));
            if (tid == 0) *(float*)(lds + OFF_KMAX) = km; }
    }
    const int nstep = ntile >> 1;
    ATT_LOAD(0); ATT_STORE(0);
    if (1 < nstep) ATT_LOAD(1);
    __syncthreads();
    if constexpr (MODE == MODE_FOX) { qn2 += __shfl_xor(qn2, 32); qkb = sqrtf(qn2) * C2 * 1.01f * *(const float*)(lds + OFF_KMAX); }
    const int vtr_off = ((lane & 15) >> 2) * 128 + (16 * ((lane >> 4) & 1) + 4 * (lane & 3)) * 2 + 4 * hi * 128;
    bool started = false;
    for (int i = 0; i < nstep; ++i) {
        const int st = i & 1;
        if (i + 1 < nstep) ATT_STORE(st ^ 1);
        if (i + 2 < nstep) ATT_LOAD(i + 2);
#pragma unroll 1
        for (int sub = 0; sub < 2; ++sub) {
        const int t = ATT_TI(2 * i + sub), ts = st * 2 + sub;
        bool act = (64 * t <= qw + 31);
        if constexpr (MODE == MODE_SWA) act = act && (64 * t + 63 >= qw - 127);
        if constexpr (MODE == MODE_MOBA) { if (t < 4 * qb) act = __builtin_amdgcn_ballot_w64(((selmask >> (t >> 2)) & 1u) != 0u) != 0ull; }
        if (act) {
            const unsigned char* Ks = lds + ts * ST_BYTES; const unsigned char* Vt = Ks + 8192;
            f32x16 p0, p1;
            if constexpr (MODE == MODE_FOX) { const float* bt = (const float*)(lds + OFF_BIAS) + ts * 64;
#pragma unroll
                for (int g = 0; g < 4; ++g) { const float4 b0 = *(const float4*)(bt + 8 * g + 4 * hi), b1 = *(const float4*)(bt + 32 + 8 * g + 4 * hi);
                    p0[4 * g] = b0.x; p0[4 * g + 1] = b0.y; p0[4 * g + 2] = b0.z; p0[4 * g + 3] = b0.w; p1[4 * g] = b1.x; p1[4 * g + 1] = b1.y; p1[4 * g + 2] = b1.z; p1[4 * g + 3] = b1.w; }
            } else if constexpr (MODE == MODE_SWA) { const float* tp = tab + 128 + (q - 64 * t - 4 * hi);
#pragma unroll
                for (int r = 0; r < 16; ++r) { const int kofs = (r & 3) + 8 * (r >> 2); p0[r] = tp[-kofs]; p1[r] = tp[-kofs - 32]; }
            } else { const int dq = q - 64 * t - 4 * hi;
                if (64 * t + 63 + 790 <= qw) { const float c31 = tab[1023];
#pragma unroll
                    for (int r = 0; r < 16; ++r) { p0[r] = c31; p1[r] = c31; } }
                else {
#pragma unroll
                    for (int r = 0; r < 16; ++r) { const int kofs = (r & 3) + 8 * (r >> 2); const int d0_ = dq - kofs, d1_ = dq - kofs - 32;
                        p0[r] = tab[d0_ < 0 ? 0 : (d0_ > 1023 ? 1023 : d0_)]; p1[r] = tab[d1_ < 0 ? 0 : (d1_ > 1023 ? 1023 : d1_)]; } }
            }
#pragma unroll
            for (int d0 = 0; d0 < 4; ++d0) {
                const bf16x8 a0 = *(const bf16x8*)(Ks + r32 * 128 + (((2 * d0 + hi) ^ ((r32 >> 1) & 7)) * 16));
                const bf16x8 a1 = *(const bf16x8*)(Ks + (32 + r32) * 128 + (((2 * d0 + hi) ^ ((r32 >> 1) & 7)) * 16));
                p0 = __builtin_amdgcn_mfma_f32_32x32x16_bf16(a0, qr[d0], p0, 0, 0, 0);
                p1 = __builtin_amdgcn_mfma_f32_32x32x16_bf16(a1, qr[d0], p1, 0, 0, 0);
            }
            const int kb = 64 * t + 4 * hi;
            if constexpr (MODE == MODE_SWA) {
#pragma unroll
                for (int r = 0; r < 16; ++r) { const int kv = kb + (r & 3) + 8 * (r >> 2); if (kv > q || kv < q - 127) p0[r] = -INFINITY; if (kv + 32 > q || kv + 32 < q - 127) p1[r] = -INFINITY; }
            } else {
                if (64 * t + 63 > qw) {
#pragma unroll
                    for (int r = 0; r < 16; ++r) { const int kv = kb + (r & 3) + 8 * (r >> 2); if (kv > q) p0[r] = -INFINITY; if (kv + 32 > q) p1[r] = -INFINITY; }
                }
                if constexpr (MODE == MODE_MOBA) { if (t < 4 * qb && ((selmask >> (t >> 2)) & 1u) == 0u) {
#pragma unroll
                    for (int r = 0; r < 16; ++r) { p0[r] = -INFINITY; p1[r] = -INFINITY; } } }
            }
            float mx = fmaxf(p0[0], p1[0]);
#pragma unroll
            for (int r = 1; r < 16; ++r) mx = fmaxf(mx, fmaxf(p0[r], p1[r]));
            mx = fmaxf(mx, __shfl_xor(mx, 32));
            const float mn = fmaxf(m, mx);
            if (__builtin_amdgcn_ballot_w64(mn > m) != 0ull) {
                const float alpha = __builtin_amdgcn_exp2f(m - mn); l *= alpha;
#pragma unroll
                for (int r = 0; r < 16; ++r) { o0[r] *= alpha; o1[r] *= alpha; }
            }
            m = mn;
            float sum = 0.f;
#pragma unroll
            for (int r = 0; r < 16; ++r) { p0[r] = __builtin_amdgcn_exp2f(p0[r] - mn); p1[r] = __builtin_amdgcn_exp2f(p1[r] - mn); sum += p0[r] + p1[r]; }
            l += sum;
            bf16x8 pa[4];
#pragma unroll
            for (int ks = 0; ks < 4; ++ks) { uint4 w;
                if (ks < 2) { w.x = cvtpk(p0[8 * ks], p0[8 * ks + 1]); w.y = cvtpk(p0[8 * ks + 2], p0[8 * ks + 3]); w.z = cvtpk(p0[8 * ks + 4], p0[8 * ks + 5]); w.w = cvtpk(p0[8 * ks + 6], p0[8 * ks + 7]); }
                else { const int k2 = ks - 2; w.x = cvtpk(p1[8 * k2], p1[8 * k2 + 1]); w.y = cvtpk(p1[8 * k2 + 2], p1[8 * k2 + 3]); w.z = cvtpk(p1[8 * k2 + 4], p1[8 * k2 + 5]); w.w = cvtpk(p1[8 * k2 + 6], p1[8 * k2 + 7]); }
                pa[ks] = __builtin_bit_cast(bf16x8, w); }
#pragma unroll
            for (int ks = 0; ks < 4; ++ks) {
#pragma unroll
                for (int db = 0; db < 2; ++db) {
                    const LASC unsigned char* vp = (const LASC unsigned char*)(Vt + vtr_off + ks * 16 * 128 + ((db ^ ((lane >> 3) & 1)) * 64));
                    const s16x4 lo = __builtin_bit_cast(s16x4, __builtin_amdgcn_ds_read_tr16_b64_v4i16((LASC v4i16_t*)vp));
                    const s16x4 hh = __builtin_bit_cast(s16x4, __builtin_amdgcn_ds_read_tr16_b64_v4i16((LASC v4i16_t*)(vp + 8 * 128)));
                    const bf16x8 vf = {lo[0], lo[1], lo[2], lo[3], hh[0], hh[1], hh[2], hh[3]};
                    if (db == 0) o0 = __builtin_amdgcn_mfma_f32_32x32x16_bf16(vf, pa[ks], o0, 0, 0, 0);
                    else o1 = __builtin_amdgcn_mfma_f32_32x32x16_bf16(vf, pa[ks], o1, 0, 0, 0); }
            }
            started = true;
        }
        }
        if constexpr (MODE == MODE_FOX) {
            const float eb = ((const float*)(lds + OFF_EB))[st * 2 + 1];
            if (__syncthreads_and((started && (qkb + eb - m < -FOX_THR)) ? 1 : 0)) break;
        } else __syncthreads();
    }
    if constexpr (MODE == MODE_FOX) __syncthreads();
#undef ATT_LOAD
#undef ATT_STORE
#undef ATT_LOAD1
#undef ATT_STORE1
#undef ATT_TI
    l += __shfl_xor(l, 32);
    float inv = 1.0f / l;
    bf16_t* op = PROJ + (rowbase + q) * NPROJ + qcol + hq * 64 + 4 * hi;
    if (dry && inv != 123.4567f) return;
    if constexpr (MODE == MODE_MOWN) {
        const unsigned sel = ((const unsigned*)AUX)[(size_t)(b * 8 + hq) * SEQ + q]; const int cnt = (int)((sel >> 15) & 3u);
        const float* pl = (const float*)ex1 + ((rowbase + q) * 8 + hq) * 4;
        float R = m + __builtin_amdgcn_logf(l), wsum = 1.f;
#pragma unroll
        for (int r = 0; r < 16; ++r) { o0[r] *= inv; o1[r] *= inv; }
#pragma unroll 1
        for (int sl = 0; sl < cnt; ++sl) {
            const float ls = pl[sl]; const float Rn = fmaxf(R, ls), sc = __builtin_amdgcn_exp2f(R - Rn), ws_ = __builtin_amdgcn_exp2f(ls - Rn);
            const bf16_t* pp = (sl < 2) ? PROJ + (rowbase + q) * NPROJ + PC_XBC + (hq * 2 + sl) * 64 + 4 * hi : (const bf16_t*)ex0 + ((rowbase + q) * 8 + hq) * 64 + 4 * hi;
#pragma unroll
            for (int g = 0; g < 4; ++g) { const uint2 a0 = *(const uint2*)(pp + 8 * g), a1 = *(const uint2*)(pp + 32 + 8 * g);
                o0[4 * g] = o0[4 * g] * sc + ws_ * bflo(a0.x); o0[4 * g + 1] = o0[4 * g + 1] * sc + ws_ * bfhi(a0.x); o0[4 * g + 2] = o0[4 * g + 2] * sc + ws_ * bflo(a0.y); o0[4 * g + 3] = o0[4 * g + 3] * sc + ws_ * bfhi(a0.y);
                o1[4 * g] = o1[4 * g] * sc + ws_ * bflo(a1.x); o1[4 * g + 1] = o1[4 * g + 1] * sc + ws_ * bfhi(a1.x); o1[4 * g + 2] = o1[4 * g + 2] * sc + ws_ * bflo(a1.y); o1[4 * g + 3] = o1[4 * g + 3] * sc + ws_ * bfhi(a1.y); }
            wsum = wsum * sc + ws_; R = Rn;
        }
        inv = 1.0f / wsum;
    }
#pragma unroll
    for (int g = 0; g < 4; ++g) {
        *(uint2*)(op + 8 * g) = make_uint2(cvtpk(o0[4 * g] * inv, o0[4 * g + 1] * inv), cvtpk(o0[4 * g + 2] * inv, o0[4 * g + 3] * inv));
        *(uint2*)(op + 32 + 8 * g) = make_uint2(cvtpk(o1[4 * g] * inv, o1[4 * g + 1] * inv), cvtpk(o1[4 * g + 2] * inv, o1[4 * g + 3] * inv));
    }
}
}
namespace ssd {
using att::bf16x8; using att::s16x4; using att::f32x16; using att::cvtpk; using att::LOG2E;
#define LASC __attribute__((address_space(3)))
constexpr int STB = 40960;
constexpr int OFF_AL2 = 2 * STB, OFF_DTV = OFF_AL2 + 1024, OFF_E = OFF_DTV + 1024, OFF_HIN = 0;
__device__ __forceinline__ float chunk_scan(unsigned char* lds, const float* DT, size_t row0, int h, float A, int tid) {
    float* al = (float*)(lds + OFF_AL2); float* dtv = (float*)(lds + OFF_DTV);
    if (tid < 256) { const float d = DT[(row0 + tid) * 8 + h]; dtv[tid] = d; al[tid] = d * A; }
    __syncthreads();
    if (tid < 64) { const float4 a4 = *(const float4*)(al + 4 * tid); const float s = (a4.x + a4.y) + (a4.z + a4.w); float incl = s;
#pragma unroll
        for (int o = 1; o < 64; o <<= 1) { const float v = __shfl_up(incl, o); if (tid >= o) incl += v; }
        const float base = incl - s; float4 c4; c4.x = base + a4.x; c4.y = c4.x + a4.y; c4.z = c4.y + a4.z; c4.w = c4.z + a4.w; *(float4*)(al + 4 * tid) = c4; }
    __syncthreads();
    return al[255];
}
__device__ __forceinline__ void m1_unit(unsigned char* lds, bf16_t* XC, const float* DT, const float* a_log, const float* d_skip, bf16_t* STATES, float* CDEC, int b, int c, int h) {
    const int tid = ltid(), lane = tid & 63, wave = __builtin_amdgcn_readfirstlane(tid >> 6), r32 = lane & 31, hi = lane >> 5, g = h >> 2;
    const size_t row0 = (size_t)b * SEQ + c * 256; const int l = wave * 32 + r32;
    const float A = -expf(a_log[h]);
    float* al = (float*)(lds + OFF_AL2); float* dtv = (float*)(lds + OFF_DTV); float* ev = (float*)(lds + OFF_E);
    const float alast = chunk_scan(lds, DT, row0, h, A, tid);
    float myac = 0.f; if (tid < 256) myac = al[tid];
    __syncthreads();
    if (tid < 256) { ev[tid] = expf(alast - myac); al[tid] = myac * LOG2E; }
    if (tid == 0) CDEC[(b * 32 + c) * 8 + h] = expf(alast);
    __syncthreads();
    const float al_l = al[l];
    bf16x8 cfr[8];
    { const bf16_t* cp = XC + (row0 + l) * 1024 + 768 + g * 128 + 8 * hi;
#pragma unroll
      for (int k0 = 0; k0 < 8; ++k0) cfr[k0] = *(const bf16x8*)(cp + 16 * k0); }
    f32x16 o0, o1, sacc;
#pragma unroll
    for (int r = 0; r < 16; ++r) { o0[r] = 0.f; o1[r] = 0.f; sacc[r] = 0.f; }
    const int ss = tid >> 3, pc = tid & 7;
    const bf16_t* bg = XC + (row0 + ss) * 1024 + 512 + g * 128 + 16 * pc;
    const bf16_t* xg = XC + (row0 + ss) * 1024 + h * 64 + 8 * pc;
    uint4 b0r, b1r, xr;
#define SSD_LOAD(t) do { b0r = *(const uint4*)(bg + (size_t)(t) * 64 * 1024); b1r = *(const uint4*)(bg + (size_t)(t) * 64 * 1024 + 8); xr = *(const uint4*)(xg + (size_t)(t) * 64 * 1024); } while (0)
#define SSD_SC2(w, f) cvtpk(bflo(w) * (f), bfhi(w) * (f))
#define SSD_STORE(st, t) do { unsigned char* sb_ = lds + (st) * STB; \
        *(uint4*)(sb_ + ss * 256 + (((2 * pc) ^ (ss & 15)) * 16)) = b0r; *(uint4*)(sb_ + ss * 256 + (((2 * pc + 1) ^ (ss & 15)) * 16)) = b1r; \
        const float es_ = ev[(t) * 64 + ss], ds_ = dtv[(t) * 64 + ss]; \
        *(uint4*)(sb_ + 16384 + ss * 256 + pc * 32) = make_uint4(SSD_SC2(b0r.x, es_), SSD_SC2(b0r.y, es_), SSD_SC2(b0r.z, es_), SSD_SC2(b0r.w, es_));         \
        *(uint4*)(sb_ + 16384 + ss * 256 + pc * 32 + 16) = make_uint4(SSD_SC2(b1r.x, es_), SSD_SC2(b1r.y, es_), SSD_SC2(b1r.z, es_), SSD_SC2(b1r.w, es_)); \
        *(uint4*)(sb_ + 32768 + ss * 128 + pc * 16) = make_uint4(SSD_SC2(xr.x, ds_), SSD_SC2(xr.y, ds_), SSD_SC2(xr.z, ds_), SSD_SC2(xr.w, ds_)); } while (0)
    SSD_LOAD(0); SSD_STORE(0, 0);
    __syncthreads();
    const int nb = wave >> 1, pb = wave & 1;
    const int trx = ((lane & 15) >> 2) * 128 + (16 * ((lane >> 4) & 1) + 4 * (lane & 3)) * 2, trb = ((lane & 15) >> 2) * 256 + (16 * ((lane >> 4) & 1) + 4 * (lane & 3)) * 2;
#pragma unroll 1
    for (int t = 0; t < 4; ++t) {
        const int st = t & 1;
        if (t + 1 < 4) SSD_LOAD(t + 1);
        const unsigned char* Bs = lds + st * STB; const unsigned char* Bt = Bs + 16384; const unsigned char* Xt = Bs + 32768;
        if (64 * t <= wave * 32 + 31) {
            f32x16 p0, p1;
#pragma unroll
            for (int r = 0; r < 16; ++r) { p0[r] = 0.f; p1[r] = 0.f; }
#pragma unroll
            for (int k0 = 0; k0 < 8; ++k0) {
                const bf16x8 a0 = *(const bf16x8*)(Bs + r32 * 256 + (((2 * k0 + hi) ^ (r32 & 15)) * 16));
                const bf16x8 a1 = *(const bf16x8*)(Bs + (32 + r32) * 256 + (((2 * k0 + hi) ^ (r32 & 15)) * 16));
                p0 = __builtin_amdgcn_mfma_f32_32x32x16_bf16(a0, cfr[k0], p0, 0, 0, 0);
                p1 = __builtin_amdgcn_mfma_f32_32x32x16_bf16(a1, cfr[k0], p1, 0, 0, 0);
            }
#pragma unroll
            for (int gq = 0; gq < 4; ++gq) { const int sb0 = 64 * t + 8 * gq + 4 * hi;
                const float4 s0 = *(const float4*)(al + sb0), s1 = *(const float4*)(al + sb0 + 32);
                const float a0[4] = {s0.x, s0.y, s0.z, s0.w}, a1[4] = {s1.x, s1.y, s1.z, s1.w};
#pragma unroll
                for (int e = 0; e < 4; ++e) { const int r = 4 * gq + e;
                    p0[r] = (sb0 + e <= l) ? p0[r] * __builtin_amdgcn_exp2f(al_l - a0[e]) : 0.f;
                    p1[r] = (sb0 + 32 + e <= l) ? p1[r] * __builtin_amdgcn_exp2f(al_l - a1[e]) : 0.f; } }
            bf16x8 pa[4];
#pragma unroll
            for (int ks = 0; ks < 4; ++ks) { uint4 w;
                if (ks < 2) { w.x = cvtpk(p0[8 * ks], p0[8 * ks + 1]); w.y = cvtpk(p0[8 * ks + 2], p0[8 * ks + 3]); w.z = cvtpk(p0[8 * ks + 4], p0[8 * ks + 5]); w.w = cvtpk(p0[8 * ks + 6], p0[8 * ks + 7]); }
                else { const int k2 = ks - 2; w.x = cvtpk(p1[8 * k2], p1[8 * k2 + 1]); w.y = cvtpk(p1[8 * k2 + 2], p1[8 * k2 + 3]); w.z = cvtpk(p1[8 * k2 + 4], p1[8 * k2 + 5]); w.w = cvtpk(p1[8 * k2 + 6], p1[8 * k2 + 7]); }
                pa[ks] = __builtin_bit_cast(bf16x8, w); }
#pragma unroll
            for (int ks = 0; ks < 4; ++ks) {
#pragma unroll
                for (int db = 0; db < 2; ++db) {
                    const LASC unsigned char* vp = (const LASC unsigned char*)(Xt + trx + 4 * hi * 128 + ks * 16 * 128 + db * 64);
                    const s16x4 lo = __builtin_bit_cast(s16x4, __builtin_amdgcn_ds_read_tr16_b64_v4i16((LASC att::v4i16_t*)vp));
                    const s16x4 hh = __builtin_bit_cast(s16x4, __builtin_amdgcn_ds_read_tr16_b64_v4i16((LASC att::v4i16_t*)(vp + 8 * 128)));
                    const bf16x8 vf = {lo[0], lo[1], lo[2], lo[3], hh[0], hh[1], hh[2], hh[3]};
                    if (db == 0) o0 = __builtin_amdgcn_mfma_f32_32x32x16_bf16(vf, pa[ks], o0, 0, 0, 0);
                    else o1 = __builtin_amdgcn_mfma_f32_32x32x16_bf16(vf, pa[ks], o1, 0, 0, 0); } }
        }
        {
#pragma unroll
            for (int ks = 0; ks < 4; ++ks) {
                const LASC unsigned char* bp = (const LASC unsigned char*)(Bt + trb + (16 * ks + 8 * hi) * 256 + nb * 64);
                const s16x4 a_lo = __builtin_bit_cast(s16x4, __builtin_amdgcn_ds_read_tr16_b64_v4i16((LASC att::v4i16_t*)bp));
                const s16x4 a_hi = __builtin_bit_cast(s16x4, __builtin_amdgcn_ds_read_tr16_b64_v4i16((LASC att::v4i16_t*)(bp + 4 * 256)));
                const LASC unsigned char* xp = (const LASC unsigned char*)(Xt + trx + (16 * ks + 8 * hi) * 128 + pb * 64);
                const s16x4 x_lo = __builtin_bit_cast(s16x4, __builtin_amdgcn_ds_read_tr16_b64_v4i16((LASC att::v4i16_t*)xp));
                const s16x4 x_hi = __builtin_bit_cast(s16x4, __builtin_amdgcn_ds_read_tr16_b64_v4i16((LASC att::v4i16_t*)(xp + 4 * 128)));
                const bf16x8 af = {a_lo[0], a_lo[1], a_lo[2], a_lo[3], a_hi[0], a_hi[1], a_hi[2], a_hi[3]};
                const bf16x8 xf = {x_lo[0], x_lo[1], x_lo[2], x_lo[3], x_hi[0], x_hi[1], x_hi[2], x_hi[3]};
                sacc = __builtin_amdgcn_mfma_f32_32x32x16_bf16(af, xf, sacc, 0, 0, 0);
            }
        }
        if (t + 1 < 4) SSD_STORE(st ^ 1, t + 1);
        __syncthreads();
    }
#undef SSD_LOAD
#undef SSD_STORE
    { const float Dh = d_skip[h]; bf16_t* yp = XC + (row0 + l) * 1024 + h * 64 + 4 * hi;
#pragma unroll
      for (int gq = 0; gq < 4; ++gq) {
          const uint2 x0 = *(const uint2*)(yp + 8 * gq), x1 = *(const uint2*)(yp + 32 + 8 * gq);
          *(uint2*)(yp + 8 * gq) = make_uint2(cvtpk(o0[4 * gq] + Dh * bflo(x0.x), o0[4 * gq + 1] + Dh * bfhi(x0.x)), cvtpk(o0[4 * gq + 2] + Dh * bflo(x0.y), o0[4 * gq + 3] + Dh * bfhi(x0.y)));
          *(uint2*)(yp + 32 + 8 * gq) = make_uint2(cvtpk(o1[4 * gq] + Dh * bflo(x1.x), o1[4 * gq + 1] + Dh * bfhi(x1.x)), cvtpk(o1[4 * gq + 2] + Dh * bflo(x1.y), o1[4 * gq + 3] + Dh * bfhi(x1.y))); } }
    { bf16_t* sp = STATES + ((size_t)((b * 32 + c) * 8 + h)) * 8192 + (size_t)(r32 + 32 * pb) * 128 + 32 * nb + 4 * hi;
#pragma unroll
      for (int gq = 0; gq < 4; ++gq) *(uint2*)(sp + 8 * gq) = make_uint2(cvtpk(sacc[4 * gq], sacc[4 * gq + 1]), cvtpk(sacc[4 * gq + 2], sacc[4 * gq + 3])); }
    __syncthreads();
}
__device__ __forceinline__ void m2_unit(unsigned char* lds, bf16_t* XC, const float* DT, const float* a_log, const bf16_t* STATES, const float* CDEC, int b, int c, int h) {
    if (c == 0) return;
    const int tid = ltid(), lane = tid & 63, wave = __builtin_amdgcn_readfirstlane(tid >> 6), r32 = lane & 31, hi = lane >> 5, g = h >> 2;
    const size_t row0 = (size_t)b * SEQ + c * 256; const int l = wave * 32 + r32;
    const float A = -expf(a_log[h]);
    float* al = (float*)(lds + OFF_AL2);
    (void)chunk_scan(lds, DT, row0, h, A, tid);
    const float ea = expf(al[l]);
    float4 hin[4];
#pragma unroll
    for (int j = 0; j < 4; ++j) hin[j] = make_float4(0.f, 0.f, 0.f, 0.f);
    const bf16_t* sbase = STATES + ((size_t)((b * 32) * 8 + h)) * 8192 + 4 * tid;
    for (int c0 = 0; c0 < c; c0 += 4) {
        uint2 sv[4][4]; float dec[4];
#pragma unroll
        for (int k = 0; k < 4; ++k) { const int cc = (c0 + k < c) ? c0 + k : c - 1; dec[k] = CDEC[(b * 32 + cc) * 8 + h];
#pragma unroll
            for (int j = 0; j < 4; ++j) sv[k][j] = *(const uint2*)(sbase + (size_t)cc * 8 * 8192 + 2048 * j); }
#pragma unroll
        for (int k = 0; k < 4; ++k) if (c0 + k < c) {
#pragma unroll
            for (int j = 0; j < 4; ++j) { hin[j].x = hin[j].x * dec[k] + bflo(sv[k][j].x); hin[j].y = hin[j].y * dec[k] + bfhi(sv[k][j].x); hin[j].z = hin[j].z * dec[k] + bflo(sv[k][j].y); hin[j].w = hin[j].w * dec[k] + bfhi(sv[k][j].y); } } }
#pragma unroll
    for (int j = 0; j < 4; ++j) { const int idx = 4 * tid + 2048 * j, p = idx >> 7, n = idx & 127;
        *(uint2*)(lds + OFF_HIN + p * 256 + (((n >> 3) ^ (p & 15)) * 16) + (n & 7) * 2) = make_uint2(cvtpk(hin[j].x, hin[j].y), cvtpk(hin[j].z, hin[j].w)); }
    __syncthreads();
    bf16x8 cfr[8];
    { const bf16_t* cp = XC + (row0 + l) * 1024 + 768 + g * 128 + 8 * hi;
#pragma unroll
      for (int k0 = 0; k0 < 8; ++k0) cfr[k0] = *(const bf16x8*)(cp + 16 * k0); }
    f32x16 o0, o1;
#pragma unroll
    for (int r = 0; r < 16; ++r) { o0[r] = 0.f; o1[r] = 0.f; }
#pragma unroll
    for (int k0 = 0; k0 < 8; ++k0) {
        const bf16x8 h0 = *(const bf16x8*)(lds + OFF_HIN + r32 * 256 + (((2 * k0 + hi) ^ (r32 & 15)) * 16));
        const bf16x8 h1 = *(const bf16x8*)(lds + OFF_HIN + (32 + r32) * 256 + (((2 * k0 + hi) ^ (r32 & 15)) * 16));
        o0 = __builtin_amdgcn_mfma_f32_32x32x16_bf16(h0, cfr[k0], o0, 0, 0, 0);
        o1 = __builtin_amdgcn_mfma_f32_32x32x16_bf16(h1, cfr[k0], o1, 0, 0, 0);
    }
    { bf16_t* yp = XC + (row0 + l) * 1024 + h * 64 + 4 * hi;
#pragma unroll
      for (int gq = 0; gq < 4; ++gq) {
          const uint2 y0 = *(const uint2*)(yp + 8 * gq), y1 = *(const uint2*)(yp + 32 + 8 * gq);
          *(uint2*)(yp + 8 * gq) = make_uint2(cvtpk(bflo(y0.x) + ea * o0[4 * gq], bfhi(y0.x) + ea * o0[4 * gq + 1]), cvtpk(bflo(y0.y) + ea * o0[4 * gq + 2], bfhi(y0.y) + ea * o0[4 * gq + 3]));
          *(uint2*)(yp + 32 + 8 * gq) = make_uint2(cvtpk(bflo(y1.x) + ea * o1[4 * gq], bfhi(y1.x) + ea * o1[4 * gq + 1]), cvtpk(bflo(y1.y) + ea * o1[4 * gq + 2], bfhi(y1.y) + ea * o1[4 * gq + 3])); } }
    __syncthreads();
}
}

__device__ __forceinline__ void moba_select_unit(unsigned char* lds, const bf16_t* PROJ, const float* KMEAN, unsigned* SEL, int b, int h, int qb) {
    const int tid = ltid(), lane = tid & 63, hf = lane & 1;
    const int q = qb * 256 + (tid >> 1);
    float* km_s = (float*)lds;
    { const int n = tid >> 4, c4 = (tid & 15) * 4; *(float4*)(km_s + n * 64 + c4) = *(const float4*)(KMEAN + ((size_t)(b * 32 + n)) * 512 + h * 64 + c4); }
    __syncthreads();
    const bf16_t* qp = PROJ + ((size_t)b * SEQ + q) * NPROJ + PC_MQ + h * 64 + hf * 32;
    float qv[32];
#pragma unroll
    for (int c = 0; c < 4; ++c) { const uint4 u = *(const uint4*)(qp + c * 8);
        qv[c * 8 + 0] = bflo(u.x); qv[c * 8 + 1] = bfhi(u.x); qv[c * 8 + 2] = bflo(u.y); qv[c * 8 + 3] = bfhi(u.y); qv[c * 8 + 4] = bflo(u.z); qv[c * 8 + 5] = bfhi(u.z); qv[c * 8 + 6] = bflo(u.w); qv[c * 8 + 7] = bfhi(u.w); }
    float g0 = -INFINITY, g1 = -INFINITY, g2 = -INFINITY; int i0 = 31, i1 = 31, i2 = 31;
    for (int n = 0; n < qb; ++n) {
        const float* km = km_s + n * 64 + hf * 32; float g = 0.f;
#pragma unroll
        for (int c = 0; c < 8; ++c) { const float4 k4 = *(const float4*)(km + 4 * c); g += qv[4 * c] * k4.x + qv[4 * c + 1] * k4.y + qv[4 * c + 2] * k4.z + qv[4 * c + 3] * k4.w; }
        g += __shfl_xor(g, 1);
        if (g > g0) { g2 = g1; i2 = i1; g1 = g0; i1 = i0; g0 = g; i0 = n; }
        else if (g > g1) { g2 = g1; i2 = i1; g1 = g; i1 = n; }
        else if (g > g2) { g2 = g; i2 = n; }
    }
    const int cnt = qb < 3 ? qb : 3;
    if (hf == 0) SEL[(size_t)(b * 8 + h) * SEQ + q] = (unsigned)i0 | ((unsigned)i1 << 5) | ((unsigned)i2 << 10) | ((unsigned)cnt << 15);
    __syncthreads();
}
namespace gat { constexpr int OFF_LIST = 65536, OFF_TABG = 98304, OFF_CNT = 102400; }
__device__ __forceinline__ void moba_gather_unit(unsigned char* lds, bf16_t* PROJ, const unsigned* SEL, const float* btab, bf16_t* PO2, float* PL, int b, int h, int j, int qc) {
    using namespace att;
    const int tid = ltid(), lane = tid & 63, wave = __builtin_amdgcn_readfirstlane(tid >> 6), r32 = lane & 31, hi = lane >> 5;
    const size_t rowbase = (size_t)b * SEQ;
    float* tab = (float*)(lds + gat::OFF_TABG); unsigned* list = (unsigned*)(lds + gat::OFF_LIST); unsigned* cntp = (unsigned*)(lds + gat::OFF_CNT);
    for (int d = tid; d < 1024; d += NT) tab[d] = btab[rel_bucket(d) * 16 + h] * LOG2E;
    if (tid == 0) *cntp = 0u;
    { const int skey = tid >> 3, sch = tid & 7;
#pragma unroll
      for (int t = 0; t < 4; ++t) { const bf16_t* kp = PROJ + (rowbase + j * 256 + t * 64 + skey) * NPROJ + h * 64 + sch * 8;
          *(uint4*)(lds + t * ST_BYTES + skey * 128 + ((sch ^ ((skey >> 1) & 7)) * 16)) = *(const uint4*)(kp + PC_MK);
          *(uint4*)(lds + t * ST_BYTES + 8192 + skey * 128 + ((sch ^ (((skey >> 1) & 1) << 2)) * 16)) = *(const uint4*)(kp + PC_MV); } }
    __syncthreads();
    for (int half = 0; half < 2; ++half) {
        const int qf = 4096 * qc + 2048 * half + 4 * tid, qmin = 256 * (j + 1);
        const uint4 sv4 = *(const uint4*)(SEL + (size_t)(b * 8 + h) * SEQ + qf); const unsigned sv[4] = {sv4.x, sv4.y, sv4.z, sv4.w};
#pragma unroll
        for (int e = 0; e < 4; ++e) { int slot = -1; const int cnt = (int)((sv[e] >> 15) & 3u);
            if (qf + e >= qmin) { if ((int)(sv[e] & 31u) == j && cnt > 0) slot = 0; else if ((int)((sv[e] >> 5) & 31u) == j && cnt > 1) slot = 1; else if ((int)((sv[e] >> 10) & 31u) == j && cnt > 2) slot = 2; }
            const unsigned long long bal = __builtin_amdgcn_ballot_w64(slot >= 0);
            unsigned pos = 0u;
            if (lane == 0 && bal) pos = atomicAdd(cntp, (unsigned)__builtin_popcountll(bal));
            pos = __shfl(pos, 0);
            if (slot >= 0) list[pos + __builtin_popcountll(bal & ((1ull << lane) - 1ull))] = (unsigned)(qf + e) | ((unsigned)slot << 13); }
    }
    __syncthreads();
    const int n = (int)*cntp, ngroups = (n + 31) >> 5;
    const int vtr_off = ((lane & 15) >> 2) * 128 + (16 * ((lane >> 4) & 1) + 4 * (lane & 3)) * 2 + 4 * hi * 128;
    for (int grp = wave; grp < ngroups; grp += 8) {
        const int ei = 32 * grp + r32; const bool valid = ei < n; const unsigned ent = list[valid ? ei : n - 1];
        const int q = (int)(ent & 8191u), slot = (int)(ent >> 13);
        bf16x8 qr[4];
        { const bf16_t* qp = PROJ + (rowbase + q) * NPROJ + PC_MQ + h * 64 + 8 * hi;
#pragma unroll
          for (int d0 = 0; d0 < 4; ++d0) { const uint4 u = *(const uint4*)(qp + 16 * d0);
              uint4 w; w.x = cvtpk(bflo(u.x) * C2, bfhi(u.x) * C2); w.y = cvtpk(bflo(u.y) * C2, bfhi(u.y) * C2); w.z = cvtpk(bflo(u.z) * C2, bfhi(u.z) * C2); w.w = cvtpk(bflo(u.w) * C2, bfhi(u.w) * C2);
              qr[d0] = __builtin_bit_cast(bf16x8, w); } }
        f32x16 o0, o1;
#pragma unroll
        for (int r = 0; r < 16; ++r) { o0[r] = 0.f; o1[r] = 0.f; }
        float m = -1e30f, l = 0.f;
#pragma unroll 1
        for (int t = 0; t < 4; ++t) {
            const unsigned char* Ks = lds + t * ST_BYTES; const unsigned char* Vt = Ks + 8192;
            const int key0 = j * 256 + t * 64; f32x16 p0, p1;
            { const int dq = q - key0 - 4 * hi;
              if (__builtin_amdgcn_ballot_w64(q - (key0 + 63) >= 790) == ~0ull) { const float c31 = tab[1023];
#pragma unroll
                  for (int r = 0; r < 16; ++r) { p0[r] = c31; p1[r] = c31; } }
              else {
#pragma unroll
                  for (int r = 0; r < 16; ++r) { const int kofs = (r & 3) + 8 * (r >> 2); const int d0_ = dq - kofs, d1_ = dq - kofs - 32;
                      p0[r] = tab[d0_ > 1023 ? 1023 : d0_]; p1[r] = tab[d1_ > 1023 ? 1023 : d1_]; } } }
#pragma unroll
            for (int d0 = 0; d0 < 4; ++d0) {
                const bf16x8 a0 = *(const bf16x8*)(Ks + r32 * 128 + (((2 * d0 + hi) ^ ((r32 >> 1) & 7)) * 16));
                const bf16x8 a1 = *(const bf16x8*)(Ks + (32 + r32) * 128 + (((2 * d0 + hi) ^ ((r32 >> 1) & 7)) * 16));
                p0 = __builtin_amdgcn_mfma_f32_32x32x16_bf16(a0, qr[d0], p0, 0, 0, 0);
                p1 = __builtin_amdgcn_mfma_f32_32x32x16_bf16(a1, qr[d0], p1, 0, 0, 0);
            }
            float mx = fmaxf(p0[0], p1[0]);
#pragma unroll
            for (int r = 1; r < 16; ++r) mx = fmaxf(mx, fmaxf(p0[r], p1[r]));
            mx = fmaxf(mx, __shfl_xor(mx, 32));
            const float mn = fmaxf(m, mx);
            if (__builtin_amdgcn_ballot_w64(mn > m) != 0ull) {
                const float alpha = __builtin_amdgcn_exp2f(m - mn); l *= alpha;
#pragma unroll
                for (int r = 0; r < 16; ++r) { o0[r] *= alpha; o1[r] *= alpha; }
            }
            m = mn;
            float sum = 0.f;
#pragma unroll
            for (int r = 0; r < 16; ++r) { p0[r] = __builtin_amdgcn_exp2f(p0[r] - mn); p1[r] = __builtin_amdgcn_exp2f(p1[r] - mn); sum += p0[r] + p1[r]; }
            l += sum;
            bf16x8 pa[4];
#pragma unroll
            for (int ks = 0; ks < 4; ++ks) { uint4 w;
                if (ks < 2) { w.x = cvtpk(p0[8 * ks], p0[8 * ks + 1]); w.y = cvtpk(p0[8 * ks + 2], p0[8 * ks + 3]); w.z = cvtpk(p0[8 * ks + 4], p0[8 * ks + 5]); w.w = cvtpk(p0[8 * ks + 6], p0[8 * ks + 7]); }
                else { const int k2 = ks - 2; w.x = cvtpk(p1[8 * k2], p1[8 * k2 + 1]); w.y = cvtpk(p1[8 * k2 + 2], p1[8 * k2 + 3]); w.z = cvtpk(p1[8 * k2 + 4], p1[8 * k2 + 5]); w.w = cvtpk(p1[8 * k2 + 6], p1[8 * k2 + 7]); }
                pa[ks] = __builtin_bit_cast(bf16x8, w); }
#pragma unroll
            for (int ks = 0; ks < 4; ++ks) {
#pragma unroll
                for (int db = 0; db < 2; ++db) {
                    const LASC unsigned char* vp = (const LASC unsigned char*)(Vt + vtr_off + ks * 16 * 128 + ((db ^ ((lane >> 3) & 1)) * 64));
                    const s16x4 lo = __builtin_bit_cast(s16x4, __builtin_amdgcn_ds_read_tr16_b64_v4i16((LASC v4i16_t*)vp));
                    const s16x4 hh = __builtin_bit_cast(s16x4, __builtin_amdgcn_ds_read_tr16_b64_v4i16((LASC v4i16_t*)(vp + 8 * 128)));
                    const bf16x8 vf = {lo[0], lo[1], lo[2], lo[3], hh[0], hh[1], hh[2], hh[3]};
                    if (db == 0) o0 = __builtin_amdgcn_mfma_f32_32x32x16_bf16(vf, pa[ks], o0, 0, 0, 0);
                    else o1 = __builtin_amdgcn_mfma_f32_32x32x16_bf16(vf, pa[ks], o1, 0, 0, 0); }
            }
        }
        l += __shfl_xor(l, 32);
        const float inv = 1.0f / l;
        if (valid) {
            bf16_t* pp = (slot < 2) ? PROJ + (rowbase + q) * NPROJ + PC_XBC + (h * 2 + slot) * 64 + 4 * hi : PO2 + ((rowbase + q) * 8 + h) * 64 + 4 * hi;
#pragma unroll
            for (int g = 0; g < 4; ++g) {
                *(uint2*)(pp + 8 * g) = make_uint2(cvtpk(o0[4 * g] * inv, o0[4 * g + 1] * inv), cvtpk(o0[4 * g + 2] * inv, o0[4 * g + 3] * inv));
                *(uint2*)(pp + 32 + 8 * g) = make_uint2(cvtpk(o1[4 * g] * inv, o1[4 * g + 1] * inv), cvtpk(o1[4 * g + 2] * inv, o1[4 * g + 3] * inv)); }
            if (hi == 0) PL[((rowbase + q) * 8 + h) * 4 + slot] = m + __builtin_amdgcn_logf(l);
        }
    }
    __syncthreads();
}
#define MIX_WS ({ unsigned char* p_ = ws0; asm volatile("" : "+s"(p_)); p_; })
#define QUEUE_NEXT(u, word) do { if (tid == 0) *(volatile unsigned*)(lds + 131072 + 64) = atomicAdd((unsigned*)(MIX_WS + WS_CTL + 32768) + 64 * (word), 1u); \
        __syncthreads(); u = *(volatile unsigned*)(lds + 131072 + 64); __syncthreads(); } while (0)
__device__ __forceinline__ void ph_mixers(unsigned char* lds, unsigned char* ws0, const float* a_log, const float* d_skip, const float* sinks, const float* btab, int l) {
    const int tid = ltid();
    bool swa_ok = false;
    for (;;) {
        unsigned u; QUEUE_NEXT(u, 3 * l);
        if (u >= 2048u + 64u) break;
        if (u < 64u) {
            unsigned char* ws = MIX_WS;
            pg8::OneSched S; S.u0.A = (const char*)P_XN(ws) + (size_t)u * 256 * (D * 2); S.u0.B = (const char*)(ws + WS_WIN) + (size_t)INP_TILES * 256 * (D * 2);
            S.u0.lda2 = D * 2; S.u0.ldb2 = D * 2; S.u0.nt = D / 64; S.u0.pm = (int)u; S.u0.pn = INP_TILES; S.u0.aux = 0;
            pg8::EpiStoreBf16 E{P_PROJ(ws), NPROJ}; pg8::gemm_phase<pg8::EpiStoreBf16, pg8::OneSched, true>((LAS unsigned char*)lds, S, E);
            if (tid == 0) { __builtin_amdgcn_fence(__ATOMIC_RELEASE, "agent"); asm volatile("s_waitcnt vmcnt(0)" ::: "memory"); (void)q_add((unsigned*)(ws + WS_CTL + 32768) + 64 * (6 + l), 1u); }
            continue;
        }
        u -= 64u;
        const int k = (int)(u & 511u);
        if (u < 512u) { const int qb = 31 - (k >> 4), bh = k & 15; unsigned char* ws = MIX_WS;
            att::attn_unit<att::MODE_FOX>(lds, P_PROJ(ws), (const float*)(ws + WS_LF), (const float*)(ws + WS_CUM), 0, 0.f, bh >> 3, bh & 7, bh & 7, qb, PC_FQ, PC_FK, PC_FV); }
        else if (u < 1024u) { unsigned char* ws = MIX_WS; ssd::m1_unit(lds, P_XC(ws), (const float*)(ws + WS_DT), a_log, d_skip, (bf16_t*)(ws + WS_STATES), (float*)(ws + WS_CDEC), k >> 8, (k >> 3) & 31, k & 7); }
        else if (u < 1536u) { const int bh = k >> 5, qb = k & 31, hq = bh & 7; unsigned char* ws = MIX_WS;
            if (!swa_ok) {
                if (tid == 0) { unsigned sp = 0; while (q_ld((unsigned*)(ws + WS_CTL + 32768) + 64 * (6 + l)) < 64u) { __builtin_amdgcn_s_sleep(2); if (++sp > (1u << 22)) break; } }
                __syncthreads();
                __builtin_amdgcn_fence(__ATOMIC_ACQUIRE, "agent"); asm volatile("s_waitcnt vmcnt(0)" ::: "memory");
                __syncthreads();
                swa_ok = true; }
            att::attn_unit<att::MODE_SWA>(lds, P_PROJ(ws), nullptr, btab, 8 + hq, sinks[hq], bh >> 3, hq, hq >> 2, qb, PC_SQ, PC_SK, PC_SV); }
        else { const int qb = 31 - (k >> 4), bh = k & 15; unsigned char* ws = MIX_WS;
            moba_select_unit(lds, P_PROJ(ws), (const float*)(ws + WS_KMEAN), (unsigned*)(ws + WS_SEL), bh >> 3, bh & 7, qb); }
    }
}
__device__ __forceinline__ void ph_mixers_b(unsigned char* lds, unsigned char* ws0, const float* a_log, const float* btab, int l) {
    const int tid = ltid();
    for (;;) {
        unsigned u; QUEUE_NEXT(u, 3 * l + 1);
        if (u >= 736u + 512u) break;
        if (u < 736u) { const int bh = (int)u & 15, idx = (int)u >> 4;
            const int qc = idx < 15 ? 0 : 1, j = idx - (qc == 0 ? 0 : 15); unsigned char* ws = MIX_WS;
            moba_gather_unit(lds, P_PROJ(ws), (const unsigned*)(ws + WS_SEL), btab, (bf16_t*)(ws + WS_PO2), (float*)(ws + WS_PL), bh >> 3, bh & 7, j, qc); }
        else { const int k = (int)u - 736, c = 31 - (k >> 4), bh = k & 15; unsigned char* ws = MIX_WS;
            ssd::m2_unit(lds, P_XC(ws), (const float*)(ws + WS_DT), a_log, (const bf16_t*)(ws + WS_STATES), (const float*)(ws + WS_CDEC), bh >> 3, c, bh & 7); }
    }
}
__device__ __forceinline__ void ph_mixers_c(unsigned char* lds, unsigned char* ws0, const float* btab, const float* ssm_norm_w, int l) {
    const int tid = ltid();
    for (;;) {
        unsigned u; QUEUE_NEXT(u, 3 * l + 2);
        if (u >= 512u) break;
        const int qb = 31 - ((int)u >> 4), bh = (int)u & 15, h = bh & 7; unsigned char* ws = MIX_WS;
        att::attn_unit<att::MODE_MOWN>(lds, P_PROJ(ws), (const float*)(ws + WS_SEL), btab, h, 0.f, bh >> 3, h, h, qb, PC_MQ, PC_MK, PC_MV, false, (const void*)(ws + WS_PO2), (const void*)(ws + WS_PL));
    }
    { unsigned char* ws = MIX_WS; ph_mamba_norm(P_PROJ(ws), P_XC(ws), ssm_norm_w); }
}
#define XB_TMO      128
#define XB_XCNT(j)  (256  + 64 * (j))
#define XB_XSUB(j)  (1280 + 64 * (j))
#define XB_XGEN(j)  (2304 + 64 * (j))
#define XB_TOP      3328
#define XB_TOPGEN   3392
#define XCD_BAR_WORDS 3456
#define XB_SPIN_CAP (1u << 18)

__device__ __forceinline__ unsigned xb_ld(unsigned* p)              { return __hip_atomic_load(p, __ATOMIC_RELAXED, __HIP_MEMORY_SCOPE_AGENT); }
__device__ __forceinline__ unsigned xb_add(unsigned* p, unsigned v) { return __hip_atomic_fetch_add(p, v, __ATOMIC_RELAXED, __HIP_MEMORY_SCOPE_AGENT); }
__device__ __forceinline__ unsigned xb_xcc_id() { return (unsigned)__builtin_amdgcn_s_getreg((3 << 11) | 20) & 0xFu; }
#define XB_SPIN(cond, bar) do { unsigned _sp = 0; while (cond) { __builtin_amdgcn_s_sleep(1); \
    if ((++_sp & 255u) == 0u) { if (xb_ld(&(bar)[XB_TMO])) break; if (_sp > XB_SPIN_CAP) { atomicAdd(&(bar)[XB_TMO], 1u); break; } } } } while (0)

struct XcdBarrier {
    unsigned* bar; unsigned x;
    volatile LAS unsigned* st;
};

__device__ __forceinline__ XcdBarrier xcd_barrier_post(unsigned* bar, volatile LAS unsigned* st) {
    XcdBarrier b; b.bar = bar; b.x = xb_xcc_id(); b.st = st;
    if (threadIdx.x == 0) (void)xb_add(&bar[XB_XCNT(b.x)], 1u);
    return b;
}
__device__ __forceinline__ void xcd_barrier_complete(unsigned* bar, unsigned x, unsigned& nloc, unsigned& nx) {
    const unsigned G = gridDim.x * gridDim.y * gridDim.z;
    unsigned sum, cnt, mine, sp = 0u;
    for (;;) {
        sum = 0u; cnt = 0u; mine = 0u;
#pragma unroll
        for (unsigned j = 0; j < 16; ++j) { const unsigned c = xb_ld(&bar[XB_XCNT(j)]); sum += c; cnt += (c > 0u) ? 1u : 0u; mine = (j == x) ? c : mine; }
        if (sum == G) break;
        __builtin_amdgcn_s_sleep(1);
        if ((++sp & 255u) == 0u) { if (xb_ld(&bar[XB_TMO])) break; if (sp > XB_SPIN_CAP) { atomicAdd(&bar[XB_TMO], 1u); break; } }
    }
    nloc = mine > 0u ? mine : 1u; nx = cnt > 0u ? cnt : 1u;
}

__device__ __forceinline__ void xcd_barrier(const XcdBarrier& b) {
    asm volatile("s_waitcnt vmcnt(0)" ::: "memory");
    __syncthreads();
    if (threadIdx.x == 0) {
        unsigned* bar = b.bar;
        __builtin_amdgcn_s_waitcnt(0);
        unsigned nloc = b.st[0], nx = b.st[1];
        if (nloc == 0u) { xcd_barrier_complete(bar, b.x, nloc, nx); b.st[0] = nloc; b.st[1] = nx; }
        const unsigned old = xb_add(&bar[XB_XSUB(b.x)], 1u);
        const unsigned gen = old / nloc;
        if (old + 1u == (gen + 1u) * nloc) {
            __builtin_amdgcn_fence(__ATOMIC_RELEASE, "agent");
            asm volatile("s_waitcnt vmcnt(0)" ::: "memory");
            const unsigned og = xb_add(&bar[XB_TOP], 1u);
            const unsigned tg = og / nx;
            if (og + 1u == (tg + 1u) * nx) xb_add(&bar[XB_TOPGEN], 1u);
            else XB_SPIN(xb_ld(&bar[XB_TOPGEN]) == tg, bar);
            __builtin_amdgcn_fence(__ATOMIC_ACQUIRE, "agent");
            xb_add(&bar[XB_XGEN(b.x)], 1u);
            asm volatile("s_waitcnt vmcnt(0)" ::: "memory");
        } else {
            XB_SPIN(xb_ld(&bar[XB_XGEN(b.x)]) == gen, bar);
            __builtin_amdgcn_fence(__ATOMIC_ACQUIRE, "agent");
            asm volatile("s_waitcnt vmcnt(0)" ::: "memory");
        }
    }
    __syncthreads();
}

constexpr int MISC_OFF = 131072 + 320;
constexpr int LDS_BYTES = 147456;
constexpr int HROW_OFF = 69632;
#define GRID_SYNC() xcd_barrier(bar)
#define WSL ({ unsigned char* p_ = a.ws; asm volatile("" : "+s"(p_)); p_; })
__global__ void __launch_bounds__(NT, 2) fwd(Args a) {
    extern __shared__ __attribute__((aligned(16))) unsigned char lds[];
    LAS unsigned char* L = (LAS unsigned char*)lds;
    volatile LAS unsigned* MISC = (volatile LAS unsigned*)(L + MISC_OFF);
    if (threadIdx.x < 32) MISC[threadIdx.x] = 0u;
    __syncthreads();
    XcdBarrier bar = xcd_barrier_post((unsigned*)(a.ws + WS_CTL) + 4096, MISC + 8);
#pragma unroll 1
    for (int l = 0; l < 2; ++l) {
        {
            unsigned char* ws = WSL; const float* xin = (l == 0) ? a.in[0] : a.out; const float* w_in = a.in[1] + (size_t)l * D * DIN;
            ph_wconv(ws, w_in, a.in[11] + (size_t)l * 4 * 512 * 1024, a.in[12] + (size_t)l * D * D, a.in[15] + (size_t)l * D * DFF, a.in[16] + (size_t)l * D * DFF, a.in[17] + (size_t)l * DFF * D, (LAS float*)L);
            __syncthreads();
            ph_norm((float*)lds, xin, a.in[13] + l * D, P_XN(ws), true, w_in, a.in[4] + l * 8, a.in[8] + l * 8, (float*)(ws + WS_DT), (float*)(ws + WS_LF));
        }
        GRID_SYNC();
        {
            unsigned char* ws = WSL;
            pg8::PlainSched S; S.T.init(M / 256, INP_TILES, gridDim.x, blockIdx.x); S.A = (const char*)P_XN(ws); S.B = (const char*)(ws + WS_WIN); S.lda2 = D * 2; S.ldb2 = D * 2; S.nt = D / 64;
            pg8::EpiStoreBf16 E{P_PROJ(ws), NPROJ}; pg8::gemm_phase<pg8::EpiStoreBf16, pg8::PlainSched, true>(L, S, E);
        }
        GRID_SYNC();
        { unsigned char* ws = WSL; ph_pre(lds, P_PROJ(ws), a.in[2] + (size_t)l * 4 * 1024, a.in[3] + l * 1024, P_XC(ws), (float*)(ws + WS_KMEAN), (float*)(ws + WS_CUM)); }
        GRID_SYNC();
        ph_mixers(lds, a.ws, a.in[5] + l * 8, a.in[6] + l * 8, a.in[9] + l * 8, a.in[10], l);
        GRID_SYNC();
        ph_mixers_b(lds, a.ws, a.in[5] + l * 8, a.in[10], l);
        GRID_SYNC();
        ph_mixers_c(lds, a.ws, a.in[10], a.in[7] + l * 512, l);
        GRID_SYNC();
        {
            unsigned char* ws = WSL;
            pg8::PlainSched S; S.T.init(M / 256, 4096 / 256, gridDim.x, blockIdx.x); S.A = (const char*)P_XN(ws); S.B = (const char*)(ws + WS_WG); S.lda2 = D * 2; S.ldb2 = D * 2; S.nt = D / 64;
            pg8::EpiGate E{P_PROJ(ws), P_XC(ws)}; pg8::gemm_phase<pg8::EpiGate, pg8::PlainSched, true>(L, S, E);
        }
        GRID_SYNC();
        {
            unsigned char* ws = WSL;
            pg8::BranchSched S; S.T.init(M / 256, D / 256, gridDim.x, blockIdx.x); S.PROJ = (const char*)P_PROJ(ws); S.WBR = (const char*)(ws + WS_WBR);
            pg8::EpiBranch E{P_PROJ(ws), P_XC(ws), P_XN(ws)}; pg8::gemm_phase<pg8::EpiBranch, pg8::BranchSched, true>(L, S, E);
        }
        GRID_SYNC();
        {
            unsigned char* ws = WSL; const float* xin = (l == 0) ? a.in[0] : a.out;
            pg8::PlainSched S; S.T.init(M / 256, D / 256, gridDim.x, blockIdx.x); S.A = (const char*)P_XN(ws); S.B = (const char*)(ws + WS_WOUT); S.lda2 = D * 2; S.ldb2 = D * 2; S.nt = D / 64;
            pg8::EpiResidual E{xin, a.out}; pg8::gemm_phase<pg8::EpiResidual, pg8::PlainSched, false>(L, S, E);
        }
        GRID_SYNC();
        { unsigned char* ws = WSL; ph_norm(nullptr, a.out, a.in[14] + l * D, P_XN(ws), false, nullptr, nullptr, nullptr, nullptr, nullptr); }
        GRID_SYNC();
        {
            unsigned char* ws = WSL;
            pg8::PlainSched S; S.T.init(M / 256, 2 * DFF / 256, gridDim.x, blockIdx.x); S.A = (const char*)P_XN(ws); S.B = (const char*)(ws + WS_WGU); S.lda2 = D * 2; S.ldb2 = D * 2; S.nt = D / 64;
            pg8::EpiSwiglu E{P_PROJ(ws)}; pg8::gemm_phase<pg8::EpiSwiglu, pg8::PlainSched, true>(L, S, E);
        }
        GRID_SYNC();
        {
            unsigned char* ws = WSL;
            pg8::PlainSched S; S.T.init(M / 256, D / 256, gridDim.x, blockIdx.x); S.A = (const char*)P_PROJ(ws); S.B = (const char*)(ws + WS_WDN); S.lda2 = DFF * 2; S.ldb2 = DFF * 2; S.nt = DFF / 64;
            pg8::EpiResidual E{a.out, a.out}; pg8::gemm_phase<pg8::EpiResidual, pg8::PlainSched, false>(L, S, E);
        }
        GRID_SYNC();
    }
    ph_final(a.out, a.in[18]);
}

extern "C" void kernel_launch(void* const* d_in, const int* in_sizes, int n_in, void* d_out, int out_size, void* d_ws, size_t ws_size, hipStream_t stream) {
    static int grid = 0;
    if (grid == 0) {
        if (n_in != 19 || out_size != M * D || ws_size < WS_TOTAL) { fprintf(stderr, "kernel_launch: unexpected shapes (n_in %d out %d ws %zu)\n", n_in, out_size, ws_size); grid = -1; return; }
        int dev = 0, cus = 0, per_cu = 0;
        (void)hipGetDevice(&dev); (void)hipDeviceGetAttribute(&cus, hipDeviceAttributeMultiprocessorCount, dev);
        if (hipFuncSetAttribute((const void*)fwd, hipFuncAttributeMaxDynamicSharedMemorySize, LDS_BYTES) != hipSuccess) { fprintf(stderr, "kernel_launch: hipFuncSetAttribute failed\n"); grid = -1; return; }
        (void)hipOccupancyMaxActiveBlocksPerMultiprocessor(&per_cu, (const void*)fwd, NT, LDS_BYTES);
        if (per_cu < 1) { fprintf(stderr, "kernel_launch: occupancy query says 0 blocks per CU\n"); grid = -1; return; }
        grid = cus < 256 ? cus : 256;
    }
    if (grid < 0) return;
    if (hipMemsetAsync((char*)d_ws + WS_CTL, 0, CTL_ZERO_BYTES, stream) != hipSuccess) { fprintf(stderr, "kernel_launch: memset of the control words failed\n"); return; }
    Args a{};
    for (int i = 0; i < 19; ++i) a.in[i] = (const float*)d_in[i];
    a.out = (float*)d_out; a.ws = (unsigned char*)d_ws;
    hipLaunchKernelGGL(fwd, dim3(grid), dim3(NT), LDS_BYTES, stream, a);
}
```

```cpp
#include <hip/hip_runtime.h>
#include <hip/hip_cooperative_groups.h>
#include <cstdio>
#include <cstdint>
namespace cg = cooperative_groups;

#ifndef SINGLE_LAUNCH
#define SINGLE_LAUNCH 0
#endif

typedef unsigned short bf16_t;
constexpr int M = 16384, SEQ = 8192, D = 1024, DIN = 9488, NPROJ = 5376, DFF = 2816;
constexpr int NT = 512;
constexpr int INP_TILES = 20;
constexpr int PC_Z = 0, PC_XBC = 512, PC_MQ = 1536, PC_MK = 2048, PC_MV = 2560, PC_FQ = 3072, PC_FK = 3584, PC_FV = 4096, PC_SQ = 4608, PC_SK = 5120, PC_SV = 5248;
constexpr int WC_DT = 1536, WC_F = 4616, WC_GATE = 5392;
constexpr size_t MiB = 1u << 20;
constexpr size_t WS_XN = 0, WS_PROJ = 32 * MiB, WS_XC = 200 * MiB, WS_DT = 232 * MiB, WS_LF = WS_DT + MiB / 2, WS_CUM = 233 * MiB, WS_KMEAN = WS_CUM + MiB / 2;
constexpr size_t WS_WIN = 234 * MiB;
constexpr size_t WS_WG = WS_WIN + (size_t)NPROJ * D * 2;
constexpr size_t WS_WBR = WS_WG + (size_t)4096 * D * 2;
constexpr size_t WS_WOUT = WS_WBR + (size_t)4 * D * 512 * 2;
constexpr size_t WS_WGU = WS_WOUT + (size_t)D * D * 2;
constexpr size_t WS_WDN = WS_WGU + (size_t)2 * DFF * D * 2;
constexpr size_t WS_END = WS_WDN + (size_t)D * DFF * 2;
static_assert(WS_END <= 276 * MiB, "workspace map");

constexpr size_t WS_CTL = 276 * MiB, CTL_ZERO_BYTES = 65536, WS_CDEC = WS_CTL + 131072, WS_TOTAL = 294 * MiB;
constexpr size_t WS_STATES = 234 * MiB, WS_PL = WS_STATES + 8 * MiB;
constexpr size_t WS_PO2 = 277 * MiB, WS_SEL = 293 * MiB;
#define P_XN(w) ((bf16_t*)((w) + WS_XN))
#define P_PROJ(w) ((bf16_t*)((w) + WS_PROJ))
#define P_XC(w) ((bf16_t*)((w) + WS_XC))
struct Args { const float* in[19]; float* out; unsigned char* ws; int ph_lo, ph_hi, coop, pad; };

__device__ __forceinline__ float bf2f(unsigned v) { return __uint_as_float(v << 16); }
__device__ __forceinline__ float bflo(unsigned v) { return __uint_as_float(v << 16); }
__device__ __forceinline__ float bfhi(unsigned v) { return __uint_as_float(v & 0xffff0000u); }
__device__ __forceinline__ unsigned f2bf(float f) { unsigned u = __float_as_uint(f); return (u + 0x7fffu + ((u >> 16) & 1u)) >> 16; }
__device__ __forceinline__ unsigned pk2(float lo, float hi) { return f2bf(lo) | (f2bf(hi) << 16); }
__device__ __forceinline__ float wave_sum(float v) {
#pragma unroll
    for (int o = 1; o < 64; o <<= 1) v += __shfl_xor(v, o);
    return v;
}
__device__ __forceinline__ unsigned q_ld(unsigned* p)              { return __hip_atomic_load(p, __ATOMIC_RELAXED, __HIP_MEMORY_SCOPE_AGENT); }
__device__ __forceinline__ unsigned q_add(unsigned* p, unsigned v) { return __hip_atomic_fetch_add(p, v, __ATOMIC_RELAXED, __HIP_MEMORY_SCOPE_AGENT); }
__device__ __forceinline__ int ltid() { int t = threadIdx.x; asm volatile("" : "+v"(t)); return t; }
__device__ __forceinline__ float log1p_pos(float e) {
    const float small = e * (1.f + e * (-0.5f + e * (0.33333333f + e * (-0.25f + e * 0.2f))));
    return e < 0.02f ? small : logf(1.f + e);
}
__device__ __forceinline__ float softplus_f(float x) { return fmaxf(x, 0.f) + log1p_pos(expf(-fabsf(x))); }
__device__ __forceinline__ float silu_f(float x) { return x / (1.f + expf(-x)); }
__device__ __forceinline__ float sigmoid_f(float x) { return 1.f / (1.f + expf(-x)); }
__device__ __forceinline__ int rel_bucket(int d) {
    if (d < 16) return d;
    int b = 16;
    b += (d >= 21); b += (d >= 27); b += (d >= 35); b += (d >= 46); b += (d >= 59); b += (d >= 77); b += (d >= 99); b += (d >= 128);
    b += (d >= 166); b += (d >= 216); b += (d >= 280); b += (d >= 363); b += (d >= 470); b += (d >= 609); b += (d >= 790);
    return b;
}

__device__ __forceinline__ void ph_norm(float* wd, const float* xin, const float* nw, bf16_t* XN, bool dots, const float* w_in, const float* dt_bias, const float* fbias, float* DT, float* LF) {
    const int tx_ = ltid();
    const int lane = tx_ & 63, wave = tx_ >> 6;
    const int gw = blockIdx.x * 8 + wave, NGW = gridDim.x * 8;
    if (dots) {
        for (int i = tx_; i < 1024 * 4; i += NT) { const int k = i >> 2, part = i & 3;
            *(float4*)((char*)wd + (k >> 2) * 272 + (k & 3) * 64 + part * 16) = *(const float4*)(w_in + (size_t)k * DIN + (part < 2 ? WC_DT + part * 4 : WC_F + (part - 2) * 4)); }
        __syncthreads();
    }
    for (int row = gw; row < M; row += NGW) {
        const float4* xr = (const float4*)(xin + (size_t)row * D);
        float4 v[4]; float ss = 0.f;
#pragma unroll
        for (int j = 0; j < 4; ++j) { v[j] = xr[lane + 64 * j]; ss += v[j].x * v[j].x + v[j].y * v[j].y + v[j].z * v[j].z + v[j].w * v[j].w; }
        ss = wave_sum(ss);
        const float rstd = 1.0f / sqrtf(ss * (1.0f / D) + 1e-6f);
#pragma unroll
        for (int j = 0; j < 4; ++j) { const float4 w4 = ((const float4*)nw)[lane + 64 * j]; v[j].x *= rstd * w4.x; v[j].y *= rstd * w4.y; v[j].z *= rstd * w4.z; v[j].w *= rstd * w4.w; }
        uint2* o = (uint2*)(XN + (size_t)row * D);
#pragma unroll
        for (int j = 0; j < 4; ++j) o[lane + 64 * j] = make_uint2(pk2(v[j].x, v[j].y), pk2(v[j].z, v[j].w));
        if (dots) {
            float d[16];
#pragma unroll
            for (int c = 0; c < 16; ++c) d[c] = 0.f;
#pragma unroll
            for (int j = 0; j < 4; ++j) { const float hv[4] = {v[j].x, v[j].y, v[j].z, v[j].w};
#pragma unroll
                for (int e = 0; e < 4; ++e) { const float* wr = (const float*)((const char*)wd + (lane + 64 * j) * 272 + e * 64); const float h = hv[e];
                    const float4 a0 = *(const float4*)(wr), a1 = *(const float4*)(wr + 4), b0 = *(const float4*)(wr + 8), b1 = *(const float4*)(wr + 12);
                    d[0] += h * a0.x; d[1] += h * a0.y; d[2] += h * a0.z; d[3] += h * a0.w; d[4] += h * a1.x; d[5] += h * a1.y; d[6] += h * a1.z; d[7] += h * a1.w;
                    d[8] += h * b0.x; d[9] += h * b0.y; d[10] += h * b0.z; d[11] += h * b0.w; d[12] += h * b1.x; d[13] += h * b1.y; d[14] += h * b1.z; d[15] += h * b1.w; }
                asm volatile("" ::: "memory"); }
            float r8[8], r4[4], r2[2];
            { const bool up = (lane & 32) != 0;
#pragma unroll
              for (int i = 0; i < 8; ++i) { const float keep = up ? d[i + 8] : d[i], send = up ? d[i] : d[i + 8]; r8[i] = keep + __shfl_xor(send, 32); } }
            { const bool up = (lane & 16) != 0;
#pragma unroll
              for (int i = 0; i < 4; ++i) { const float keep = up ? r8[i + 4] : r8[i], send = up ? r8[i] : r8[i + 4]; r4[i] = keep + __shfl_xor(send, 16); } }
            { const bool up = (lane & 8) != 0;
#pragma unroll
              for (int i = 0; i < 2; ++i) { const float keep = up ? r4[i + 2] : r4[i], send = up ? r4[i] : r4[i + 2]; r2[i] = keep + __shfl_xor(send, 8); } }
            float mine; { const bool up = (lane & 4) != 0; const float keep = up ? r2[1] : r2[0], send = up ? r2[0] : r2[1]; mine = keep + __shfl_xor(send, 4); }
            mine += __shfl_xor(mine, 2); mine += __shfl_xor(mine, 1);
            const int col = ((lane >> 5) & 1) * 8 + ((lane >> 4) & 1) * 4 + ((lane >> 3) & 1) * 2 + ((lane >> 2) & 1);
            if ((lane & 3) == 0) { if (col < 8) DT[(size_t)row * 8 + col] = softplus_f(mine + dt_bias[col]); else LF[(size_t)row * 8 + (col - 8)] = -softplus_f(-(mine + fbias[col - 8])); }
        }
    }
}

namespace pg8 {
#define PG8_LAS __attribute__((address_space(3)))
typedef short bf16x8 __attribute__((ext_vector_type(8)));
typedef float f32x4 __attribute__((ext_vector_type(4)));
typedef unsigned u32x4 __attribute__((ext_vector_type(4)));
constexpr int BM = 256, BK = 64, HALF = 128, HTB = HALF * BK * 2, STAGE_BYTES = 8 * HTB, NXCD = 8, WGM = 8;
__host__ __device__ __forceinline__ int lds_byte(int r, int c) { const int st = (r >> 4) * 2 + (c >> 5), rr = r & 15, cc = c & 31, ob = rr * 64 + cc * 2; return st * 1024 + (ob ^ (((ob >> 9) & 1) << 5)); }
__host__ __device__ __forceinline__ void stage_rc(int b, int& R, int& C) { const int st = b / 1024, sb = b % 1024, swz = sb ^ (((sb >> 9) & 1) << 5); R = (st >> 1) * 16 + swz / 64; C = (st & 1) * 32 + (swz % 64) / 2; }
__host__ __device__ __forceinline__ int perm32(int rho) { const int n = rho >> 4, i = rho & 15; return 8 * (i >> 2) + 4 * n + (i & 3); }
struct Unit { const char* A; const char* B; unsigned lda2, ldb2; int nt, pm, pn, aux; };
struct TileOrder {
    int nM, nN, nwg, G, c;
    __device__ void init(int nM_, int nN_, int G_, int c_) { nM = nM_; nN = nN_; nwg = nM * nN; G = G_; c = c_; }
    __device__ bool tile(int i, int& pm, int& pn) const {
        const long L = (long)i * G + c; if (L >= nwg) return false;
        int wgid = (int)L; { const int q = nwg / NXCD, r = nwg % NXCD, xcd = wgid % NXCD, off = wgid / NXCD; wgid = (xcd < r ? xcd * (q + 1) : r * (q + 1) + (xcd - r) * q) + off; }
        const int nig = WGM * nN, gid = wgid / nig, fm = gid * WGM, gsz = (nM - fm) < WGM ? (nM - fm) : WGM;
        pm = fm + ((wgid % nig) % gsz); pn = (wgid % nig) / gsz; return true;
    }
};
typedef float f32x2_t __attribute__((ext_vector_type(2))); typedef __bf16 bf16x2_t __attribute__((ext_vector_type(2)));
__device__ __forceinline__ unsigned cvt_pk_bf16(float lo, float hi) { f32x2_t v = {lo, hi}; bf16x2_t b = __builtin_convertvector(v, bf16x2_t); return __builtin_bit_cast(unsigned, b); }

template <class Epi, class Sched, bool ALIGN_EPI>
__device__ __forceinline__ void gemm_phase(PG8_LAS unsigned char* lds, const Sched& S, const Epi& E) {
    int tid = threadIdx.x; asm volatile("" : "+v"(tid));
    const int wid = __builtin_amdgcn_readfirstlane(tid >> 6), lane = tid & 63, wr = wid >> 2, wc = wid & 3, fr = lane & 15, fq = lane >> 4;
    unsigned RA[2], RB[2], C2[2];
#pragma unroll
    for (int i = 0; i < 2; ++i) { int R, C; stage_rc(tid * 16 + i * 8192, R, C); RA[i] = (unsigned)R; RB[i] = (unsigned)(Epi::PERM ? ((R & ~31) + perm32(R & 31)) : R); C2[i] = (unsigned)(C * 2); }
    const unsigned ldsw = (unsigned)wid * 1024u;
    const int aoff = lds_byte(wr * 64 + fr, fq * 8), boff = lds_byte(wc * 32 + fr, fq * 8);
#define PG8_SA(b, h) (((b) * 2 + (h)) * HTB)
#define PG8_SB(b, h) ((4 + (b) * 2 + (h)) * HTB)
#define PG8_STAGE(bufoff, gbase, RR, pitch) do { _Pragma("unroll") for (int _i = 0; _i < 2; ++_i) \
        __builtin_amdgcn_global_load_lds((const unsigned*)((const char*)(gbase) + (RR[_i] * (pitch) + C2[_i])), (PG8_LAS unsigned*)(lds + (bufoff) + ldsw + _i * 8192), 16, 0, 0); } while (0)
#define PG8_LDA(dst, b, h) do { _Pragma("unroll") for (int m = 0; m < 4; ++m) _Pragma("unroll") for (int k = 0; k < 2; ++k) dst[m][k] = *(const PG8_LAS bf16x8*)(lds + PG8_SA(b, h) + aoff + m * 2048 + k * 1024); } while (0)
#define PG8_LDB(dst, b, h) do { _Pragma("unroll") for (int n = 0; n < 2; ++n) _Pragma("unroll") for (int k = 0; k < 2; ++k) dst[n][k] = *(const PG8_LAS bf16x8*)(lds + PG8_SB(b, h) + boff + n * 2048 + k * 1024); } while (0)
#define PG8_MMA(ai, bj, At, Bt) do { __builtin_amdgcn_s_setprio(1); _Pragma("unroll") for (int m = 0; m < 4; ++m) _Pragma("unroll") for (int n = 0; n < 2; ++n) _Pragma("unroll") for (int k = 0; k < 2; ++k) \
        acc[ai][bj][m][n] = __builtin_amdgcn_mfma_f32_16x16x32_bf16(Bt[n][k], At[m][k], acc[ai][bj][m][n], 0, 0, 0); __builtin_amdgcn_s_setprio(0); } while (0)
#define PG8_WAIT_V(n) asm volatile("s_waitcnt vmcnt(" #n ")" ::: "memory")
#define PG8_WAIT_L(n) asm volatile("s_waitcnt lgkmcnt(" #n ")" ::: "memory")
#define PG8_BAR __builtin_amdgcn_s_barrier()
#define PG8_SCHED __builtin_amdgcn_sched_barrier(0)
#define PG8_ZERO() do { _Pragma("unroll") for (int a_ = 0; a_ < 2; ++a_) _Pragma("unroll") for (int b_ = 0; b_ < 2; ++b_) _Pragma("unroll") for (int m_ = 0; m_ < 4; ++m_) _Pragma("unroll") for (int n_ = 0; n_ < 2; ++n_) acc[a_][b_][m_][n_] = (f32x4){0.f, 0.f, 0.f, 0.f}; } while (0)
    Unit cur, nxt; int ui = 0;
    if (!S.next(0, cur)) return;
    f32x4 acc[2][2][4][2];
    PG8_ZERO();
    bf16x8 At[4][2], B0[2][2], B1[2][2];
    const char* cA = cur.A; const char* cB = cur.B; unsigned pAc = cur.lda2, pBc = cur.ldb2; int ntc = cur.nt;
    const unsigned kstep = BK * 2;
    {
        const size_t hA = (size_t)HALF * pAc, hB = (size_t)HALF * pBc;
        PG8_STAGE(PG8_SB(0, 0), cB, RB, pBc); PG8_STAGE(PG8_SB(0, 1), cB + hB, RB, pBc); PG8_STAGE(PG8_SA(0, 0), cA, RA, pAc); PG8_STAGE(PG8_SA(0, 1), cA + hA, RA, pAc);
        if (wr == 1) PG8_BAR;
        PG8_WAIT_V(2); PG8_BAR;
        PG8_STAGE(PG8_SB(1, 0), cB + kstep, RB, pBc); PG8_STAGE(PG8_SA(1, 0), cA + kstep, RA, pAc); PG8_STAGE(PG8_SB(1, 1), cB + hB + kstep, RB, pBc);
        PG8_WAIT_V(6); PG8_BAR;
    }
    for (;;) {
        const bool has_next = S.next(ui + 1, nxt);
        const char* nA = has_next ? nxt.A : cA; const char* nB = has_next ? nxt.B : cB;
        const unsigned pAn = has_next ? nxt.lda2 : pAc, pBn = has_next ? nxt.ldb2 : pBc;
        const size_t hAc = (size_t)HALF * pAc;
        for (int t = 0; t < ntc; t += 2) {
            const bool last = (t == ntc - 2);
            const char* a1 = cA + (size_t)(t + 1) * kstep;
            const char* a2 = last ? nA : cA + (size_t)(t + 2) * kstep; const char* b2 = last ? nB : cB + (size_t)(t + 2) * kstep;
            const char* a3 = a2 + kstep; const char* b3 = b2 + kstep;
            const unsigned pA2 = last ? pAn : pAc, pB2 = last ? pBn : pBc;
            const size_t hA2 = (size_t)HALF * pA2, hB2 = (size_t)HALF * pB2;
            PG8_LDB(B0, 0, 0); PG8_LDB(B1, 0, 1); PG8_SCHED; PG8_LDA(At, 0, 0); PG8_STAGE(PG8_SA(1, 1), a1 + hAc, RA, pAc);
            PG8_WAIT_V(8); PG8_WAIT_L(0); PG8_BAR; PG8_MMA(0, 0, At, B0); PG8_MMA(0, 1, At, B1); PG8_BAR; PG8_SCHED;
            PG8_LDA(At, 0, 1); PG8_STAGE(PG8_SB(0, 0), b2, RB, pB2); PG8_STAGE(PG8_SB(0, 1), b2 + hB2, RB, pB2); PG8_STAGE(PG8_SA(0, 0), a2, RA, pA2);
            PG8_WAIT_V(8); PG8_WAIT_L(0); PG8_BAR; PG8_MMA(1, 0, At, B0); PG8_MMA(1, 1, At, B1); PG8_BAR; PG8_SCHED;
            PG8_LDB(B0, 1, 0); PG8_LDB(B1, 1, 1); PG8_SCHED; PG8_LDA(At, 1, 0); PG8_STAGE(PG8_SA(0, 1), a2 + hA2, RA, pA2);
            PG8_WAIT_V(8); PG8_WAIT_L(0); PG8_BAR; PG8_MMA(0, 0, At, B0); PG8_MMA(0, 1, At, B1); PG8_BAR; PG8_SCHED;
            PG8_LDA(At, 1, 1); PG8_STAGE(PG8_SB(1, 0), b3, RB, pB2); PG8_STAGE(PG8_SB(1, 1), b3 + hB2, RB, pB2); PG8_STAGE(PG8_SA(1, 0), a3, RA, pA2);
            PG8_WAIT_V(8); PG8_WAIT_L(0); PG8_BAR; PG8_MMA(1, 0, At, B0); PG8_MMA(1, 1, At, B1); PG8_BAR; PG8_SCHED;
        }
        if constexpr (ALIGN_EPI) { if (wr == 0) PG8_BAR; }
        { int fr_ = fr, fq_ = fq; asm volatile("" : "+v"(fr_), "+v"(fq_)); E(acc, cur, wr, wc, fr_, fq_); }
        if (!has_next) break;
        PG8_ZERO();
        cur = nxt; cA = nA; cB = nB; pAc = pAn; pBc = pBn; ntc = nxt.nt; ++ui;
        if constexpr (ALIGN_EPI) { if (wr == 1) PG8_BAR; }
    }
    PG8_WAIT_V(0);
    if constexpr (!ALIGN_EPI) { if (wr == 0) PG8_BAR; }
    PG8_BAR;
#undef PG8_SA
#undef PG8_SB
#undef PG8_STAGE
#undef PG8_LDA
#undef PG8_LDB
#undef PG8_MMA
#undef PG8_WAIT_V
#undef PG8_WAIT_L
#undef PG8_BAR
#undef PG8_SCHED
#undef PG8_ZERO
}

struct PlainSched {
    TileOrder T; const char* A; const char* B; unsigned lda2, ldb2; int nt;
    __device__ bool next(int i, Unit& u) const { int pm, pn; if (!T.tile(i, pm, pn)) return false;
        u.A = A + (size_t)pm * 256 * lda2; u.B = B + (size_t)pn * 256 * ldb2; u.lda2 = lda2; u.ldb2 = ldb2; u.nt = nt; u.pm = pm; u.pn = pn; u.aux = 0; return true; }
};
struct OneSched { Unit u0; __device__ bool next(int i, Unit& u) const { if (i != 0) return false; u = u0; return true; } };
struct EpiStoreBf16 {
    static constexpr bool PERM = true;
    bf16_t* O; int ldc;
    __device__ __forceinline__ void operator()(const f32x4 (&acc)[2][2][4][2], const Unit& u, int wr, int wc, int fr, int fq) const {
        const int row0 = u.pm * BM + wr * 64 + fr, col0 = u.pn * BM + wc * 32 + 8 * fq;
#pragma unroll
        for (int ai = 0; ai < 2; ++ai)
#pragma unroll
            for (int m = 0; m < 4; ++m) { bf16_t* rowp = O + (size_t)(row0 + ai * HALF + m * 16) * ldc + col0;
#pragma unroll
                for (int bj = 0; bj < 2; ++bj) { const f32x4 v0 = acc[ai][bj][m][0], v1 = acc[ai][bj][m][1];
                    u32x4 w; w.x = cvt_pk_bf16(v0[0], v0[1]); w.y = cvt_pk_bf16(v0[2], v0[3]); w.z = cvt_pk_bf16(v1[0], v1[1]); w.w = cvt_pk_bf16(v1[2], v1[3]);
                    *(u32x4*)(rowp + bj * HALF) = w; } }
    }
};
__device__ __forceinline__ float fast_sigmoid(float x) { return __builtin_amdgcn_rcpf(1.f + __expf(-x)); }
struct EpiSwiglu {
    static constexpr bool PERM = true;
    bf16_t* H;
    __device__ __forceinline__ void operator()(const f32x4 (&acc)[2][2][4][2], const Unit& u, int wr, int wc, int fr, int fq) const {
        const int row0 = u.pm * BM + wr * 64 + fr, col0 = u.pn * HALF + wc * 32 + 8 * fq;
#pragma unroll
        for (int ai = 0; ai < 2; ++ai)
#pragma unroll
            for (int m = 0; m < 4; ++m) { float v[8];
#pragma unroll
                for (int n = 0; n < 2; ++n)
#pragma unroll
                    for (int e = 0; e < 4; ++e) { const float g = acc[ai][0][m][n][e], up = acc[ai][1][m][n][e]; v[n * 4 + e] = g * fast_sigmoid(g) * up; }
                u32x4 w; w.x = cvt_pk_bf16(v[0], v[1]); w.y = cvt_pk_bf16(v[2], v[3]); w.z = cvt_pk_bf16(v[4], v[5]); w.w = cvt_pk_bf16(v[6], v[7]);
                *(u32x4*)(H + (size_t)(row0 + ai * HALF + m * 16) * DFF + col0) = w; }
    }
};
struct EpiResidual {
    static constexpr bool PERM = false;
    const float* res; float* out;
    __device__ __forceinline__ void operator()(const f32x4 (&acc)[2][2][4][2], const Unit& u, int wr, int wc, int fr, int fq) const {
        const int row0 = u.pm * BM + wr * 64 + fr, col0 = u.pn * BM + wc * 32 + 4 * fq;
#pragma unroll
        for (int ai = 0; ai < 2; ++ai)
#pragma unroll
            for (int m = 0; m < 4; ++m) { const size_t off = (size_t)(row0 + ai * HALF + m * 16) * D + col0;
#pragma unroll
                for (int bj = 0; bj < 2; ++bj)
#pragma unroll
                    for (int n = 0; n < 2; ++n) { const f32x4 r = *(const f32x4*)(res + off + bj * HALF + n * 16); *(f32x4*)(out + off + bj * HALF + n * 16) = r + acc[ai][bj][m][n]; } }
    }
};
struct EpiGate {
    static constexpr bool PERM = true;
    bf16_t* PROJ; bf16_t* XC;
    __device__ __forceinline__ void operator()(const f32x4 (&acc)[2][2][4][2], const Unit& u, int wr, int wc, int fr, int fq) const {
        const int br = u.pn >> 2, row0 = u.pm * BM + wr * 64 + fr, col0 = (u.pn & 3) * BM + wc * 32 + 8 * fq;
        bf16_t* base = br < 3 ? PROJ + 512 + 1536 * br : XC;
        const int ld = br < 3 ? NPROJ : 1024;
#pragma unroll
        for (int ai = 0; ai < 2; ++ai)
#pragma unroll
            for (int m = 0; m < 4; ++m) { bf16_t* rowp = base + (size_t)(row0 + ai * HALF + m * 16) * ld + col0;
#pragma unroll
                for (int bj = 0; bj < 2; ++bj) { const f32x4 v0 = acc[ai][bj][m][0], v1 = acc[ai][bj][m][1];
                    u32x4 w; w.x = cvt_pk_bf16(fast_sigmoid(v0[0]), fast_sigmoid(v0[1])); w.y = cvt_pk_bf16(fast_sigmoid(v0[2]), fast_sigmoid(v0[3]));
                    w.z = cvt_pk_bf16(fast_sigmoid(v1[0]), fast_sigmoid(v1[1])); w.w = cvt_pk_bf16(fast_sigmoid(v1[2]), fast_sigmoid(v1[3]));
                    *(u32x4*)(rowp + bj * HALF) = w; } }
    }
};
struct BranchSched {
    TileOrder T; const char* PROJ; const char* WBR;
    __device__ bool next(int i, Unit& u) const { int pm, pn; if (!T.tile(i >> 2, pm, pn)) return false;
        const int br = i & 3; u.pm = pm; u.pn = pn; u.aux = br;
        u.A = PROJ + (size_t)pm * 256 * (NPROJ * 2) + 1536 * 2 * br; u.lda2 = NPROJ * 2; u.B = WBR + ((size_t)br * 1024 + pn * 256) * (512 * 2); u.ldb2 = 512 * 2; u.nt = 512 / 64; return true; }
};
struct EpiBranch {
    static constexpr bool PERM = true;
    const bf16_t* PROJ; const bf16_t* XC; bf16_t* MIX;
    __device__ __forceinline__ void operator()(const f32x4 (&acc)[2][2][4][2], const Unit& u, int wr, int wc, int fr, int fq) const {
        const int br = u.aux, row0 = u.pm * BM + wr * 64 + fr, col0 = u.pn * BM + wc * 32 + 8 * fq;
        const bf16_t* G = br < 3 ? PROJ + 512 + 1536 * br : XC; const int ldg = br < 3 ? NPROJ : 1024;
        if (br == 0) run<true>(acc, G, ldg, row0, col0); else run<false>(acc, G, ldg, row0, col0);
    }
    template <bool FIRST>
    __device__ __forceinline__ void run(const f32x4 (&acc)[2][2][4][2], const bf16_t* G, int ldg, int row0, int col0) const {
#pragma unroll
        for (int gb = 0; gb < 16; gb += 4) {
            u32x4 g[4], o[4];
#pragma unroll
            for (int k = 0; k < 4; ++k) { const int i = gb + k, ai = i >> 3, m = (i >> 1) & 3, bj = i & 1; const size_t row = (size_t)(row0 + ai * HALF + m * 16);
                g[k] = *(const u32x4*)(G + row * ldg + col0 + bj * HALF); if (!FIRST) o[k] = *(const u32x4*)(MIX + row * D + col0 + bj * HALF); }
#pragma unroll
            for (int k = 0; k < 4; ++k) { const int i = gb + k, ai = i >> 3, m = (i >> 1) & 3, bj = i & 1; const size_t row = (size_t)(row0 + ai * HALF + m * 16);
                f32x4 p0 = acc[ai][bj][m][0], p1 = acc[ai][bj][m][1];
                p0[0] *= bflo(g[k].x); p0[1] *= bfhi(g[k].x); p0[2] *= bflo(g[k].y); p0[3] *= bfhi(g[k].y); p1[0] *= bflo(g[k].z); p1[1] *= bfhi(g[k].z); p1[2] *= bflo(g[k].w); p1[3] *= bfhi(g[k].w);
                if (!FIRST) { p0[0] += bflo(o[k].x); p0[1] += bfhi(o[k].x); p0[2] += bflo(o[k].y); p0[3] += bfhi(o[k].y); p1[0] += bflo(o[k].z); p1[1] += bfhi(o[k].z); p1[2] += bflo(o[k].w); p1[3] += bfhi(o[k].w); }
                u32x4 w; w.x = cvt_pk_bf16(p0[0], p0[1]); w.y = cvt_pk_bf16(p0[2], p0[3]); w.z = cvt_pk_bf16(p1[0], p1[1]); w.w = cvt_pk_bf16(p1[2], p1[3]);
                *(u32x4*)(MIX + row * D + col0 + bj * HALF) = w; }
            asm volatile("" ::: "memory");
        }
    }
};
}

#define LAS __attribute__((address_space(3)))
__device__ __forceinline__ void wt_item(const float* W, int ldw, int src_col0, int k0, bf16_t* WT, int ldwt, int dst_row0, LAS float* scr, int lane) {
#pragma unroll
    for (int i = 0; i < 8; ++i) { const int k = 4 * i + (lane >> 4), n4 = (lane & 15) * 4;
        const float4 v = *(const float4*)(W + (size_t)(k0 + k) * ldw + src_col0 + n4);
        LAS float* d = scr + k * 65 + n4; d[0] = v.x; d[1] = v.y; d[2] = v.z; d[3] = v.w; }
    asm volatile("s_waitcnt lgkmcnt(0)" ::: "memory");
    unsigned w[16];
#pragma unroll
    for (int j = 0; j < 16; ++j) w[j] = pk2(scr[(2 * j) * 65 + lane], scr[(2 * j + 1) * 65 + lane]);
    uint4* o = (uint4*)(WT + (size_t)(dst_row0 + lane) * ldwt + k0);
#pragma unroll
    for (int j = 0; j < 4; ++j) o[j] = make_uint4(w[4 * j], w[4 * j + 1], w[4 * j + 2], w[4 * j + 3]);
    asm volatile("s_waitcnt lgkmcnt(0)" ::: "memory");
}
constexpr int WCV_IN = 32 * (NPROJ / 64), WCV_ALL = WCV_IN + 32 * 64 + 4 * 16 * 16 + 32 * 16 + 32 * (2 * DFF / 64) + (DFF / 32) * 16, WCV_CHUNK = 16;
__device__ __forceinline__ void ph_wconv(unsigned char* ws, const float* w_in, const float* w_branch, const float* w_out, const float* w_gate, const float* w_up, const float* w_down, LAS float* scr_base,
                                         int lo, int hi, int first, int stride) {
    const int tx_ = ltid();
    const int lane = tx_ & 63, wave = tx_ >> 6;
    LAS float* scr = scr_base + wave * (32 * 65);
    constexpr int I_IN = 32 * (NPROJ / 64), I_G = 32 * 64, I_BR = 4 * 16 * 16, I_OUT = 32 * 16, I_GU = 32 * (2 * DFF / 64), I_DN = (DFF / 32) * 16;
    static_assert(I_IN + I_G + I_BR + I_OUT + I_GU + I_DN == WCV_ALL && (WCV_ALL - WCV_IN) % WCV_CHUNK == 0, "conversion list");
    for (int it = lo + first * 8 + wave; it < hi; it += stride * 8) {
        int r = it;
        if (r < I_IN) { const int nb = r % (NPROJ / 64), kb = r / (NPROJ / 64), c0 = nb * 64;
            wt_item(w_in, DIN, c0 + (c0 >= 1536 ? 8 : 0) + (c0 >= 4608 ? 8 : 0), kb * 32, (bf16_t*)(ws + WS_WIN), D, c0, scr, lane); continue; } r -= I_IN;
        if (r < I_G) { const int nb = r % 64, kb = r / 64; wt_item(w_in, DIN, WC_GATE + nb * 64, kb * 32, (bf16_t*)(ws + WS_WG), D, nb * 64, scr, lane); continue; } r -= I_G;
        if (r < I_BR) { const int br = r / 256, q = r % 256, nb = q % 16, kb = q / 16;
            wt_item(w_branch + (size_t)br * 512 * 1024, D, nb * 64, kb * 32, (bf16_t*)(ws + WS_WBR) + (size_t)br * 1024 * 512, 512, nb * 64, scr, lane); continue; } r -= I_BR;
        if (r < I_OUT) { const int nb = r % 16, kb = r / 16; wt_item(w_out, D, nb * 64, kb * 32, (bf16_t*)(ws + WS_WOUT), D, nb * 64, scr, lane); continue; } r -= I_OUT;
        if (r < I_GU) { const int nb = r % (2 * DFF / 64), kb = r / (2 * DFF / 64), r0 = nb * 64, t = r0 >> 8, j = r0 & 255;
            wt_item(j < 128 ? w_gate : w_up, DFF, t * 128 + (j & 127), kb * 32, (bf16_t*)(ws + WS_WGU), D, r0, scr, lane); continue; } r -= I_GU;
        { const int nb = r % 16, kb = r / 16; wt_item(w_down, D, nb * 64, kb * 32, (bf16_t*)(ws + WS_WDN), DFF, nb * 64, scr, lane); }
    }
}

__device__ __forceinline__ void ph_pre(unsigned char* lds, const bf16_t* PROJ, const float* conv_w, const float* conv_b, bf16_t* XC, float* KMEAN, float* KMAXP) {
    const int tx_ = ltid();
    const size_t gt = (size_t)blockIdx.x * NT + tx_, tot = (size_t)gridDim.x * NT;
    for (size_t e = gt; e < (size_t)M * 128; e += tot) {
        const int row = (int)(e >> 7), c8 = (int)(e & 127) * 8, t = row & (SEQ - 1);
        float acc[8];
        { const float4 b0 = *(const float4*)(conv_b + c8), b1 = *(const float4*)(conv_b + c8 + 4); acc[0] = b0.x; acc[1] = b0.y; acc[2] = b0.z; acc[3] = b0.w; acc[4] = b1.x; acc[5] = b1.y; acc[6] = b1.z; acc[7] = b1.w; }
#pragma unroll
        for (int i = 0; i < 4; ++i) { const int tt = t - 3 + i;
            if (tt >= 0) { const uint4 u = *(const uint4*)(PROJ + (size_t)(row - 3 + i) * NPROJ + PC_XBC + c8);
                const float4 w0 = *(const float4*)(conv_w + i * 1024 + c8), w1 = *(const float4*)(conv_w + i * 1024 + c8 + 4);
                acc[0] += w0.x * bflo(u.x); acc[1] += w0.y * bfhi(u.x); acc[2] += w0.z * bflo(u.y); acc[3] += w0.w * bfhi(u.y);
                acc[4] += w1.x * bflo(u.z); acc[5] += w1.y * bfhi(u.z); acc[6] += w1.z * bflo(u.w); acc[7] += w1.w * bfhi(u.w); } }
        uint4 o; o.x = pk2(silu_f(acc[0]), silu_f(acc[1])); o.y = pk2(silu_f(acc[2]), silu_f(acc[3])); o.z = pk2(silu_f(acc[4]), silu_f(acc[5])); o.w = pk2(silu_f(acc[6]), silu_f(acc[7]));
        *(uint4*)(XC + (size_t)row * 1024 + c8) = o;
    }
    {
        int* smax = (int*)lds;
        if (tx_ < 16) smax[tx_] = 0;
        __syncthreads();
        for (size_t e = gt; e < (size_t)M * 8; e += tot) { const int row = (int)(e >> 3), h = (int)(e & 7);
            const bf16_t* kp = PROJ + (size_t)row * NPROJ + PC_FK + h * 64; float n2 = 0.f;
#pragma unroll
            for (int c = 0; c < 8; ++c) { const uint4 u = *(const uint4*)(kp + c * 8);
                n2 += bflo(u.x) * bflo(u.x) + bfhi(u.x) * bfhi(u.x) + bflo(u.y) * bflo(u.y) + bfhi(u.y) * bfhi(u.y) + bflo(u.z) * bflo(u.z) + bfhi(u.z) * bfhi(u.z) + bflo(u.w) * bflo(u.w) + bfhi(u.w) * bfhi(u.w); }
            atomicMax(&smax[(row >> 13) * 8 + h], __float_as_int(n2)); }
        __syncthreads();
        if (tx_ < 16) KMAXP[blockIdx.x * 16 + tx_] = sqrtf(__int_as_float(smax[tx_]));
    }
    const int lane = tx_ & 63, gw = blockIdx.x * 8 + (tx_ >> 6), NGW = gridDim.x * 8;
    for (int it = gw; it < 64 * 64; it += NGW) {
        const int bb = it >> 6, c8 = (it & 63) * 8;
        float sm[8];
#pragma unroll
        for (int j = 0; j < 8; ++j) sm[j] = 0.f;
#pragma unroll
        for (int r = 0; r < 4; ++r) { const uint4 u = *(const uint4*)(PROJ + ((size_t)bb * 256 + lane * 4 + r) * NPROJ + PC_MK + c8);
            sm[0] += bflo(u.x); sm[1] += bfhi(u.x); sm[2] += bflo(u.y); sm[3] += bfhi(u.y); sm[4] += bflo(u.z); sm[5] += bfhi(u.z); sm[6] += bflo(u.w); sm[7] += bfhi(u.w); }
        float mine = 0.f;
#pragma unroll
        for (int j = 0; j < 8; ++j) { const float v = wave_sum(sm[j]); if (lane == j) mine = v; }
        if (lane < 8) KMEAN[(size_t)bb * 512 + c8 + lane] = mine * (1.0f / 256.0f);
    }
}

__device__ __forceinline__ void ph_mamba_norm(bf16_t* PROJ, const bf16_t* XC, const float* nw) {
    const int tx_ = ltid();
    const int lane = tx_ & 63, gw = blockIdx.x * 8 + (tx_ >> 6), NGW = gridDim.x * 8;
    for (int row = gw; row < M; row += NGW) {
        const uint4 yv = *(const uint4*)(XC + (size_t)row * 1024 + lane * 8); const uint4 zv = *(const uint4*)(PROJ + (size_t)row * NPROJ + PC_Z + lane * 8);
        float y[8] = {bflo(yv.x), bfhi(yv.x), bflo(yv.y), bfhi(yv.y), bflo(yv.z), bfhi(yv.z), bflo(yv.w), bfhi(yv.w)};
        const float z[8] = {bflo(zv.x), bfhi(zv.x), bflo(zv.y), bfhi(zv.y), bflo(zv.z), bfhi(zv.z), bflo(zv.w), bfhi(zv.w)};
        float ss = 0.f;
#pragma unroll
        for (int i = 0; i < 8; ++i) { y[i] *= silu_f(z[i]); ss += y[i] * y[i]; }
        ss = wave_sum(ss); const float rstd = 1.0f / sqrtf(ss * (1.0f / 512.0f) + 1e-6f);
        const float4 w0 = *(const float4*)(nw + lane * 8), w1 = *(const float4*)(nw + lane * 8 + 4);
        uint4 o; o.x = pk2(y[0] * rstd * w0.x, y[1] * rstd * w0.y); o.y = pk2(y[2] * rstd * w0.z, y[3] * rstd * w0.w); o.z = pk2(y[4] * rstd * w1.x, y[5] * rstd * w1.y); o.w = pk2(y[6] * rstd * w1.z, y[7] * rstd * w1.w);
        *(uint4*)(PROJ + (size_t)row * NPROJ + PC_Z + lane * 8) = o;
    }
}
__device__ __forceinline__ void ph_final(float* out, const float* nw) {
    const int tx_ = ltid();
    const int lane = tx_ & 63, gw = blockIdx.x * 8 + (tx_ >> 6), NGW = gridDim.x * 8;
    for (int row = gw; row < M; row += NGW) {
        float4* xr = (float4*)(out + (size_t)row * D);
        float4 v[4]; float ss = 0.f;
#pragma unroll
        for (int j = 0; j < 4; ++j) { v[j] = xr[lane + 64 * j]; ss += v[j].x * v[j].x + v[j].y * v[j].y + v[j].z * v[j].z + v[j].w * v[j].w; }
        ss = wave_sum(ss); const float rstd = 1.0f / sqrtf(ss * (1.0f / D) + 1e-6f);
#pragma unroll
        for (int j = 0; j < 4; ++j) { const float4 w4 = ((const float4*)nw)[lane + 64 * j]; xr[lane + 64 * j] = make_float4(v[j].x * rstd * w4.x, v[j].y * rstd * w4.y, v[j].z * rstd * w4.z, v[j].w * rstd * w4.w); }
    }
}


namespace att {
typedef short bf16x8 __attribute__((ext_vector_type(8)));
typedef short s16x4 __attribute__((ext_vector_type(4)));
typedef float f32x16 __attribute__((ext_vector_type(16)));
typedef float f32x2_t __attribute__((ext_vector_type(2))); typedef __bf16 bf16x2_t __attribute__((ext_vector_type(2)));
__device__ __forceinline__ unsigned cvtpk(float lo, float hi) { f32x2_t v = {lo, hi}; bf16x2_t b = __builtin_convertvector(v, bf16x2_t); return __builtin_bit_cast(unsigned, b); }
constexpr float LOG2E = 1.4426950408889634f, C2 = 0.125f * LOG2E;
constexpr int ST_BYTES = 16384, OFF_BIAS = 65536, OFF_EB = OFF_BIAS + 1024, OFF_KMAX = OFF_EB + 32, OFF_TAB = OFF_BIAS + 2048, TAB_N = 1280, OFF_END = OFF_TAB + TAB_N * 4;
constexpr float FOX_THR = 25.f;
enum { MODE_FOX = 0, MODE_SWA = 1, MODE_MOBA = 2, MODE_MOWN = 3 };
#define LASC __attribute__((address_space(3)))
typedef short v4i16_t __attribute__((ext_vector_type(4)));

template <int MODE>
__device__ __forceinline__ void attn_unit(unsigned char* lds, bf16_t* PROJ, const float* AUX, const float* btab, int bcol, float sink, int b, int hq, int hk, int qb, int qcol, int kcol, int vcol, bool dry = false, const void* ex0 = nullptr, const void* ex1 = nullptr) {
    const int tid = ltid(), lane = tid & 63, wave = __builtin_amdgcn_readfirstlane(tid >> 6), r32 = lane & 31, hi = lane >> 5;
    const int q0 = qb * 256, qw = q0 + wave * 32, q = qw + r32;
    const size_t rowbase = (size_t)b * SEQ;
    float* tab = (float*)(lds + OFF_TAB);
    if constexpr (MODE == MODE_SWA) {
        if (tid < 512) { const int d = tid - 128; tab[tid] = (d >= 0 && d < 128) ? btab[rel_bucket(d) * 16 + bcol] * LOG2E : 0.f; }
    }
    if constexpr (MODE == MODE_MOBA || MODE == MODE_MOWN) {
        for (int d = tid; d < 1024; d += NT) tab[d] = btab[rel_bucket(d) * 16 + bcol] * LOG2E;
    }
    bf16x8 qr[4]; float gq[32]; float qn2 = 0.f;
    { const bf16_t* qp = PROJ + (rowbase + q) * NPROJ + qcol + hq * 64 + 8 * hi;
#pragma unroll
      for (int d0 = 0; d0 < 4; ++d0) { const uint4 u = *(const uint4*)(qp + 16 * d0);
          const float f[8] = {bflo(u.x), bfhi(u.x), bflo(u.y), bfhi(u.y), bflo(u.z), bfhi(u.z), bflo(u.w), bfhi(u.w)};
          if constexpr (MODE == MODE_MOBA) {
#pragma unroll
              for (int e = 0; e < 8; ++e) gq[d0 * 8 + e] = f[e]; }
          if constexpr (MODE == MODE_FOX) {
#pragma unroll
              for (int e = 0; e < 8; ++e) qn2 += f[e] * f[e]; }
          uint4 w; w.x = cvtpk(f[0] * C2, f[1] * C2); w.y = cvtpk(f[2] * C2, f[3] * C2); w.z = cvtpk(f[4] * C2, f[5] * C2); w.w = cvtpk(f[6] * C2, f[7] * C2);
          qr[d0] = __builtin_bit_cast(bf16x8, w); } }
    unsigned selmask = 0u;
    if constexpr (MODE == MODE_MOBA) {
        float g0 = -INFINITY, g1 = -INFINITY, g2 = -INFINITY; int i0 = -1, i1 = -1, i2 = -1;
        for (int n = 0; n < qb; ++n) {
            const float* km = AUX + ((size_t)(b * 32 + n)) * 512 + hk * 64 + 8 * hi; float g = 0.f;
#pragma unroll
            for (int d0 = 0; d0 < 4; ++d0) { const float4 k0 = *(const float4*)(km + 16 * d0), k1 = *(const float4*)(km + 16 * d0 + 4);
                g += gq[d0 * 8] * k0.x + gq[d0 * 8 + 1] * k0.y + gq[d0 * 8 + 2] * k0.z + gq[d0 * 8 + 3] * k0.w + gq[d0 * 8 + 4] * k1.x + gq[d0 * 8 + 5] * k1.y + gq[d0 * 8 + 6] * k1.z + gq[d0 * 8 + 7] * k1.w; }
            g += __shfl_xor(g, 32);
            if (g > g0) { g2 = g1; i2 = i1; g1 = g0; i1 = i0; g0 = g; i0 = n; }
            else if (g > g1) { g2 = g1; i2 = i1; g1 = g; i1 = n; }
            else if (g > g2) { g2 = g; i2 = n; }
        }
        if (i0 >= 0) selmask |= 1u << i0; if (i1 >= 0) selmask |= 1u << i1; if (i2 >= 0) selmask |= 1u << i2;
    }
    float carry = 0.f;
    f32x16 o0, o1;
#pragma unroll
    for (int r = 0; r < 16; ++r) { o0[r] = 0.f; o1[r] = 0.f; }
    float m = -1e30f, l = 0.f;
    if constexpr (MODE == MODE_SWA) { m = sink * LOG2E; l = hi == 0 ? 1.f : 0.f; }
    const int t_beg = (MODE == MODE_SWA) ? (qb > 0 ? 4 * qb - 2 : 0) : (MODE == MODE_MOWN ? 4 * qb : 0), t_end = 4 * (qb + 1);
    const int skey = tid >> 3, sch = tid & 7;
    const bf16_t* kg = PROJ + (rowbase + skey) * NPROJ + kcol + hk * 64 + sch * 8;
    const bf16_t* vg = PROJ + (rowbase + skey) * NPROJ + vcol + hk * 64 + sch * 8;
    const int kdst = skey * 128 + ((sch ^ ((skey >> 1) & 7)) * 16);
    uint4 kreg0, kreg1, vreg0, vreg1; float breg0 = 0.f, breg1 = 0.f;
#define ATT_LOAD1(t_, KR, VR, BR) do { KR = *(const uint4*)(kg + (size_t)(t_) * 64 * NPROJ); VR = *(const uint4*)(vg + (size_t)(t_) * 64 * NPROJ); \
        if (MODE == MODE_FOX) { if (tid < 64) BR = AUX[(rowbase + (t_) * 64 + tid) * 8 + hq]; } } while (0)
#define ATT_LOAD(s_) do { ATT_LOAD1(ATT_TI(2 * (s_)), kreg0, vreg0, breg0); ATT_LOAD1(ATT_TI(2 * (s_) + 1), kreg1, vreg1, breg1); } while (0)
#define ATT_STORE1(ts_, KR, VR, BR) do { unsigned char* sb_ = lds + (ts_) * ST_BYTES; \
        *(uint4*)(sb_ + kdst) = KR; *(uint4*)(sb_ + 8192 + skey * 128 + ((sch ^ (((skey >> 1) & 1) << 2)) * 16)) = VR; \
        if (MODE == MODE_FOX) { if (tid < 64) { float inc_ = BR; \
            _Pragma("unroll") for (int o_ = 1; o_ < 64; o_ <<= 1) { const float v_ = __shfl_up(inc_, o_); if (lane >= o_) inc_ += v_; } \
            const float tot_ = __shfl(inc_, 63); \
            ((float*)(lds + OFF_BIAS))[(ts_) * 64 + tid] = (carry + tot_ - inc_) * LOG2E;        \
            carry += tot_; if (tid == 0) ((float*)(lds + OFF_EB))[(ts_)] = carry * LOG2E; } } } while (0)
#define ATT_STORE(st) do { ATT_STORE1((st) * 2, kreg0, vreg0, breg0); ATT_STORE1((st) * 2 + 1, kreg1, vreg1, breg1); } while (0)
    const int ntile = t_end - t_beg;
#define ATT_TI(i) ((MODE == MODE_FOX) ? (t_end - 1 - (i)) : (t_beg + (i)))
    float qkb = 0.f;
    if constexpr (MODE == MODE_FOX) {
        if (tid < 64) { float km = 0.f;
#pragma unroll
            for (int i = 0; i < 4; ++i) km = fmaxf(km, btab[(tid * 4 + i) * 16 + b * 8 + hq]);
#pragma unroll
            for (int o = 1; o < 64; o <<= 1) km = fmaxf(km, __shfl_xor(km, o));
            if (tid == 0) *(float*)(lds + OFF_KMAX) = km; }
    }
    const int nstep = ntile >> 1;
    ATT_LOAD(0); ATT_STORE(0);
    if (1 < nstep) ATT_LOAD(1);
    __syncthreads();
    if constexpr (MODE == MODE_FOX) { qn2 += __shfl_xor(qn2, 32); qkb = sqrtf(qn2) * C2 * 1.01f * *(const float*)(lds + OFF_KMAX); }
    const int vtr_off = ((lane & 15) >> 2) * 128 + (16 * ((lane >> 4) & 1) + 4 * (lane & 3)) * 2 + 4 * hi * 128;
    bool started = false;
    for (int i = 0; i < nstep; ++i) {
        const int st = i & 1;
        if (i + 1 < nstep) ATT_STORE(st ^ 1);
        if (i + 2 < nstep) ATT_LOAD(i + 2);
#pragma unroll 1
        for (int sub = 0; sub < 2; ++sub) {
        const int t = ATT_TI(2 * i + sub), ts = st * 2 + sub;
        bool act = (64 * t <= qw + 31);
        if constexpr (MODE == MODE_SWA) act = act && (64 * t + 63 >= qw - 127);
        if constexpr (MODE == MODE_MOBA) { if (t < 4 * qb) act = __builtin_amdgcn_ballot_w64(((selmask >> (t >> 2)) & 1u) != 0u) != 0ull; }
        if (act) {
            const unsigned char* Ks = lds + ts * ST_BYTES; const unsigned char* Vt = Ks + 8192;
            f32x16 p0, p1;
            if constexpr (MODE == MODE_FOX) { const float* bt = (const float*)(lds + OFF_BIAS) + ts * 64;
#pragma unroll
                for (int g = 0; g < 4; ++g) { const float4 b0 = *(const float4*)(bt + 8 * g + 4 * hi), b1 = *(const float4*)(bt + 32 + 8 * g + 4 * hi);
                    p0[4 * g] = b0.x; p0[4 * g + 1] = b0.y; p0[4 * g + 2] = b0.z; p0[4 * g + 3] = b0.w; p1[4 * g] = b1.x; p1[4 * g + 1] = b1.y; p1[4 * g + 2] = b1.z; p1[4 * g + 3] = b1.w; }
            } else if constexpr (MODE == MODE_SWA) { const float* tp = tab + 128 + (q - 64 * t - 4 * hi);
#pragma unroll
                for (int r = 0; r < 16; ++r) { const int kofs = (r & 3) + 8 * (r >> 2); p0[r] = tp[-kofs]; p1[r] = tp[-kofs - 32]; }
            } else { const int dq = q - 64 * t - 4 * hi;
                if (64 * t + 63 + 790 <= qw) { const float c31 = tab[1023];
#pragma unroll
                    for (int r = 0; r < 16; ++r) { p0[r] = c31; p1[r] = c31; } }
                else {
#pragma unroll
                    for (int r = 0; r < 16; ++r) { const int kofs = (r & 3) + 8 * (r >> 2); const int d0_ = dq - kofs, d1_ = dq - kofs - 32;
                        p0[r] = tab[d0_ < 0 ? 0 : (d0_ > 1023 ? 1023 : d0_)]; p1[r] = tab[d1_ < 0 ? 0 : (d1_ > 1023 ? 1023 : d1_)]; } }
            }
#pragma unroll
            for (int d0 = 0; d0 < 4; ++d0) {
                const bf16x8 a0 = *(const bf16x8*)(Ks + r32 * 128 + (((2 * d0 + hi) ^ ((r32 >> 1) & 7)) * 16));
                const bf16x8 a1 = *(const bf16x8*)(Ks + (32 + r32) * 128 + (((2 * d0 + hi) ^ ((r32 >> 1) & 7)) * 16));
                p0 = __builtin_amdgcn_mfma_f32_32x32x16_bf16(a0, qr[d0], p0, 0, 0, 0);
                p1 = __builtin_amdgcn_mfma_f32_32x32x16_bf16(a1, qr[d0], p1, 0, 0, 0);
            }
            const int kb = 64 * t + 4 * hi;
            if constexpr (MODE == MODE_SWA) {
#pragma unroll
                for (int r = 0; r < 16; ++r) { const int kv = kb + (r & 3) + 8 * (r >> 2); if (kv > q || kv < q - 127) p0[r] = -INFINITY; if (kv + 32 > q || kv + 32 < q - 127) p1[r] = -INFINITY; }
            } else {
                if (64 * t + 63 > qw) {
#pragma unroll
                    for (int r = 0; r < 16; ++r) { const int kv = kb + (r & 3) + 8 * (r >> 2); if (kv > q) p0[r] = -INFINITY; if (kv + 32 > q) p1[r] = -INFINITY; }
                }
                if constexpr (MODE == MODE_MOBA) { if (t < 4 * qb && ((selmask >> (t >> 2)) & 1u) == 0u) {
#pragma unroll
                    for (int r = 0; r < 16; ++r) { p0[r] = -INFINITY; p1[r] = -INFINITY; } } }
            }
            float mx = fmaxf(p0[0], p1[0]);
#pragma unroll
            for (int r = 1; r < 16; ++r) mx = fmaxf(mx, fmaxf(p0[r], p1[r]));
            mx = fmaxf(mx, __shfl_xor(mx, 32));
            const float mn = fmaxf(m, mx);
            if (__builtin_amdgcn_ballot_w64(mn > m) != 0ull) {
                const float alpha = __builtin_amdgcn_exp2f(m - mn); l *= alpha;
#pragma unroll
                for (int r = 0; r < 16; ++r) { o0[r] *= alpha; o1[r] *= alpha; }
            }
            m = mn;
            float sum = 0.f;
#pragma unroll
            for (int r = 0; r < 16; ++r) { p0[r] = __builtin_amdgcn_exp2f(p0[r] - mn); p1[r] = __builtin_amdgcn_exp2f(p1[r] - mn); sum += p0[r] + p1[r]; }
            l += sum;
            bf16x8 pa[4];
#pragma unroll
            for (int ks = 0; ks < 4; ++ks) { uint4 w;
                if (ks < 2) { w.x = cvtpk(p0[8 * ks], p0[8 * ks + 1]); w.y = cvtpk(p0[8 * ks + 2], p0[8 * ks + 3]); w.z = cvtpk(p0[8 * ks + 4], p0[8 * ks + 5]); w.w = cvtpk(p0[8 * ks + 6], p0[8 * ks + 7]); }
                else { const int k2 = ks - 2; w.x = cvtpk(p1[8 * k2], p1[8 * k2 + 1]); w.y = cvtpk(p1[8 * k2 + 2], p1[8 * k2 + 3]); w.z = cvtpk(p1[8 * k2 + 4], p1[8 * k2 + 5]); w.w = cvtpk(p1[8 * k2 + 6], p1[8 * k2 + 7]); }
                pa[ks] = __builtin_bit_cast(bf16x8, w); }
#pragma unroll
            for (int ks = 0; ks < 4; ++ks) {
#pragma unroll
                for (int db = 0; db < 2; ++db) {
                    const LASC unsigned char* vp = (const LASC unsigned char*)(Vt + vtr_off + ks * 16 * 128 + ((db ^ ((lane >> 3) & 1)) * 64));
                    const s16x4 lo = __builtin_bit_cast(s16x4, __builtin_amdgcn_ds_read_tr16_b64_v4i16((LASC v4i16_t*)vp));
                    const s16x4 hh = __builtin_bit_cast(s16x4, __builtin_amdgcn_ds_read_tr16_b64_v4i16((LASC v4i16_t*)(vp + 8 * 128)));
                    const bf16x8 vf = {lo[0], lo[1], lo[2], lo[3], hh[0], hh[1], hh[2], hh[3]};
                    if (db == 0) o0 = __builtin_amdgcn_mfma_f32_32x32x16_bf16(vf, pa[ks], o0, 0, 0, 0);
                    else o1 = __builtin_amdgcn_mfma_f32_32x32x16_bf16(vf, pa[ks], o1, 0, 0, 0); }
            }
            started = true;
        }
        }
        if constexpr (MODE == MODE_FOX) {
            const float eb = ((const float*)(lds + OFF_EB))[st * 2 + 1];
            if (__syncthreads_and((started && (qkb + eb - m < -FOX_THR)) ? 1 : 0)) break;
        } else __syncthreads();
    }
    if constexpr (MODE == MODE_FOX) __syncthreads();
#undef ATT_LOAD
#undef ATT_STORE
#undef ATT_LOAD1
#undef ATT_STORE1
#undef ATT_TI
    l += __shfl_xor(l, 32);
    float inv = 1.0f / l;
    bf16_t* op = PROJ + (rowbase + q) * NPROJ + qcol + hq * 64 + 4 * hi;
    if (dry && inv != 123.4567f) return;
    if constexpr (MODE == MODE_MOWN) {
        const unsigned sel = ((const unsigned*)AUX)[(size_t)(b * 8 + hq) * SEQ + q]; const int cnt = (int)((sel >> 15) & 3u);
        const float* pl = (const float*)ex1 + ((rowbase + q) * 8 + hq) * 4;
        float R = m + __builtin_amdgcn_logf(l), wsum = 1.f;
#pragma unroll
        for (int r = 0; r < 16; ++r) { o0[r] *= inv; o1[r] *= inv; }
#pragma unroll 1
        for (int sl = 0; sl < cnt; ++sl) {
            const float ls = pl[sl]; const float Rn = fmaxf(R, ls), sc = __builtin_amdgcn_exp2f(R - Rn), ws_ = __builtin_amdgcn_exp2f(ls - Rn);
            const bf16_t* pp = (sl < 2) ? PROJ + (rowbase + q) * NPROJ + PC_XBC + (hq * 2 + sl) * 64 + 4 * hi : (const bf16_t*)ex0 + ((rowbase + q) * 8 + hq) * 64 + 4 * hi;
#pragma unroll
            for (int g = 0; g < 4; ++g) { const uint2 a0 = *(const uint2*)(pp + 8 * g), a1 = *(const uint2*)(pp + 32 + 8 * g);
                o0[4 * g] = o0[4 * g] * sc + ws_ * bflo(a0.x); o0[4 * g + 1] = o0[4 * g + 1] * sc + ws_ * bfhi(a0.x); o0[4 * g + 2] = o0[4 * g + 2] * sc + ws_ * bflo(a0.y); o0[4 * g + 3] = o0[4 * g + 3] * sc + ws_ * bfhi(a0.y);
                o1[4 * g] = o1[4 * g] * sc + ws_ * bflo(a1.x); o1[4 * g + 1] = o1[4 * g + 1] * sc + ws_ * bfhi(a1.x); o1[4 * g + 2] = o1[4 * g + 2] * sc + ws_ * bflo(a1.y); o1[4 * g + 3] = o1[4 * g + 3] * sc + ws_ * bfhi(a1.y); }
            wsum = wsum * sc + ws_; R = Rn;
        }
        inv = 1.0f / wsum;
    }
#pragma unroll
    for (int g = 0; g < 4; ++g) {
        *(uint2*)(op + 8 * g) = make_uint2(cvtpk(o0[4 * g] * inv, o0[4 * g + 1] * inv), cvtpk(o0[4 * g + 2] * inv, o0[4 * g + 3] * inv));
        *(uint2*)(op + 32 + 8 * g) = make_uint2(cvtpk(o1[4 * g] * inv, o1[4 * g + 1] * inv), cvtpk(o1[4 * g + 2] * inv, o1[4 * g + 3] * inv));
    }
}
}
namespace ssd {
using att::bf16x8; using att::s16x4; using att::f32x16; using att::cvtpk; using att::LOG2E;
#define LASC __attribute__((address_space(3)))
constexpr int STB = 40960;
constexpr int OFF_AL2 = 2 * STB, OFF_DTV = OFF_AL2 + 1024, OFF_E = OFF_DTV + 1024, OFF_HIN = 0;
__device__ __forceinline__ float chunk_scan(unsigned char* lds, const float* DT, size_t row0, int h, float A, int tid) {
    float* al = (float*)(lds + OFF_AL2); float* dtv = (float*)(lds + OFF_DTV);
    if (tid < 256) { const float d = DT[(row0 + tid) * 8 + h]; dtv[tid] = d; al[tid] = d * A; }
    __syncthreads();
    if (tid < 64) { const float4 a4 = *(const float4*)(al + 4 * tid); const float s = (a4.x + a4.y) + (a4.z + a4.w); float incl = s;
#pragma unroll
        for (int o = 1; o < 64; o <<= 1) { const float v = __shfl_up(incl, o); if (tid >= o) incl += v; }
        const float base = incl - s; float4 c4; c4.x = base + a4.x; c4.y = c4.x + a4.y; c4.z = c4.y + a4.z; c4.w = c4.z + a4.w; *(float4*)(al + 4 * tid) = c4; }
    __syncthreads();
    return al[255];
}
__device__ __forceinline__ void m1_unit(unsigned char* lds, bf16_t* XC, const float* DT, const float* a_log, const float* d_skip, bf16_t* STATES, float* CDEC, int b, int c, int h) {
    const int tid = ltid(), lane = tid & 63, wave = __builtin_amdgcn_readfirstlane(tid >> 6), r32 = lane & 31, hi = lane >> 5, g = h >> 2;
    const size_t row0 = (size_t)b * SEQ + c * 256; const int l = wave * 32 + r32;
    const float A = -expf(a_log[h]);
    float* al = (float*)(lds + OFF_AL2); float* dtv = (float*)(lds + OFF_DTV); float* ev = (float*)(lds + OFF_E);
    const float alast = chunk_scan(lds, DT, row0, h, A, tid);
    float myac = 0.f; if (tid < 256) myac = al[tid];
    __syncthreads();
    if (tid < 256) { ev[tid] = expf(alast - myac); al[tid] = myac * LOG2E; }
    if (tid == 0) CDEC[(b * 32 + c) * 8 + h] = expf(alast);
    __syncthreads();
    const float al_l = al[l];
    bf16x8 cfr[8];
    { const bf16_t* cp = XC + (row0 + l) * 1024 + 768 + g * 128 + 8 * hi;
#pragma unroll
      for (int k0 = 0; k0 < 8; ++k0) cfr[k0] = *(const bf16x8*)(cp + 16 * k0); }
    f32x16 o0, o1, sacc;
#pragma unroll
    for (int r = 0; r < 16; ++r) { o0[r] = 0.f; o1[r] = 0.f; sacc[r] = 0.f; }
    const int ss = tid >> 3, pc = tid & 7;
    const bf16_t* bg = XC + (row0 + ss) * 1024 + 512 + g * 128 + 16 * pc;
    const bf16_t* xg = XC + (row0 + ss) * 1024 + h * 64 + 8 * pc;
    uint4 b0r, b1r, xr;
#define SSD_LOAD(t) do { b0r = *(const uint4*)(bg + (size_t)(t) * 64 * 1024); b1r = *(const uint4*)(bg + (size_t)(t) * 64 * 1024 + 8); xr = *(const uint4*)(xg + (size_t)(t) * 64 * 1024); } while (0)
#define SSD_SC2(w, f) cvtpk(bflo(w) * (f), bfhi(w) * (f))
#define SSD_STORE(st, t) do { unsigned char* sb_ = lds + (st) * STB; \
        *(uint4*)(sb_ + ss * 256 + (((2 * pc) ^ (ss & 15)) * 16)) = b0r; *(uint4*)(sb_ + ss * 256 + (((2 * pc + 1) ^ (ss & 15)) * 16)) = b1r; \
        const float es_ = ev[(t) * 64 + ss], ds_ = dtv[(t) * 64 + ss]; \
        *(uint4*)(sb_ + 16384 + ss * 256 + pc * 32) = make_uint4(SSD_SC2(b0r.x, es_), SSD_SC2(b0r.y, es_), SSD_SC2(b0r.z, es_), SSD_SC2(b0r.w, es_));         \
        *(uint4*)(sb_ + 16384 + ss * 256 + pc * 32 + 16) = make_uint4(SSD_SC2(b1r.x, es_), SSD_SC2(b1r.y, es_), SSD_SC2(b1r.z, es_), SSD_SC2(b1r.w, es_)); \
        *(uint4*)(sb_ + 32768 + ss * 128 + pc * 16) = make_uint4(SSD_SC2(xr.x, ds_), SSD_SC2(xr.y, ds_), SSD_SC2(xr.z, ds_), SSD_SC2(xr.w, ds_)); } while (0)
    SSD_LOAD(0); SSD_STORE(0, 0);
    __syncthreads();
    const int nb = wave >> 1, pb = wave & 1;
    const int trx = ((lane & 15) >> 2) * 128 + (16 * ((lane >> 4) & 1) + 4 * (lane & 3)) * 2, trb = ((lane & 15) >> 2) * 256 + (16 * ((lane >> 4) & 1) + 4 * (lane & 3)) * 2;
#pragma unroll 1
    for (int t = 0; t < 4; ++t) {
        const int st = t & 1;
        if (t + 1 < 4) SSD_LOAD(t + 1);
        const unsigned char* Bs = lds + st * STB; const unsigned char* Bt = Bs + 16384; const unsigned char* Xt = Bs + 32768;
        if (64 * t <= wave * 32 + 31) {
            f32x16 p0, p1;
#pragma unroll
            for (int r = 0; r < 16; ++r) { p0[r] = 0.f; p1[r] = 0.f; }
#pragma unroll
            for (int k0 = 0; k0 < 8; ++k0) {
                const bf16x8 a0 = *(const bf16x8*)(Bs + r32 * 256 + (((2 * k0 + hi) ^ (r32 & 15)) * 16));
                const bf16x8 a1 = *(const bf16x8*)(Bs + (32 + r32) * 256 + (((2 * k0 + hi) ^ (r32 & 15)) * 16));
                p0 = __builtin_amdgcn_mfma_f32_32x32x16_bf16(a0, cfr[k0], p0, 0, 0, 0);
                p1 = __builtin_amdgcn_mfma_f32_32x32x16_bf16(a1, cfr[k0], p1, 0, 0, 0);
            }
#pragma unroll
            for (int gq = 0; gq < 4; ++gq) { const int sb0 = 64 * t + 8 * gq + 4 * hi;
                const float4 s0 = *(const float4*)(al + sb0), s1 = *(const float4*)(al + sb0 + 32);
                const float a0[4] = {s0.x, s0.y, s0.z, s0.w}, a1[4] = {s1.x, s1.y, s1.z, s1.w};
#pragma unroll
                for (int e = 0; e < 4; ++e) { const int r = 4 * gq + e;
                    p0[r] = (sb0 + e <= l) ? p0[r] * __builtin_amdgcn_exp2f(al_l - a0[e]) : 0.f;
                    p1[r] = (sb0 + 32 + e <= l) ? p1[r] * __builtin_amdgcn_exp2f(al_l - a1[e]) : 0.f; } }
            bf16x8 pa[4];
#pragma unroll
            for (int ks = 0; ks < 4; ++ks) { uint4 w;
                if (ks < 2) { w.x = cvtpk(p0[8 * ks], p0[8 * ks + 1]); w.y = cvtpk(p0[8 * ks + 2], p0[8 * ks + 3]); w.z = cvtpk(p0[8 * ks + 4], p0[8 * ks + 5]); w.w = cvtpk(p0[8 * ks + 6], p0[8 * ks + 7]); }
                else { const int k2 = ks - 2; w.x = cvtpk(p1[8 * k2], p1[8 * k2 + 1]); w.y = cvtpk(p1[8 * k2 + 2], p1[8 * k2 + 3]); w.z = cvtpk(p1[8 * k2 + 4], p1[8 * k2 + 5]); w.w = cvtpk(p1[8 * k2 + 6], p1[8 * k2 + 7]); }
                pa[ks] = __builtin_bit_cast(bf16x8, w); }
#pragma unroll
            for (int ks = 0; ks < 4; ++ks) {
#pragma unroll
                for (int db = 0; db < 2; ++db) {
                    const LASC unsigned char* vp = (const LASC unsigned char*)(Xt + trx + 4 * hi * 128 + ks * 16 * 128 + db * 64);
                    const s16x4 lo = __builtin_bit_cast(s16x4, __builtin_amdgcn_ds_read_tr16_b64_v4i16((LASC att::v4i16_t*)vp));
                    const s16x4 hh = __builtin_bit_cast(s16x4, __builtin_amdgcn_ds_read_tr16_b64_v4i16((LASC att::v4i16_t*)(vp + 8 * 128)));
                    const bf16x8 vf = {lo[0], lo[1], lo[2], lo[3], hh[0], hh[1], hh[2], hh[3]};
                    if (db == 0) o0 = __builtin_amdgcn_mfma_f32_32x32x16_bf16(vf, pa[ks], o0, 0, 0, 0);
                    else o1 = __builtin_amdgcn_mfma_f32_32x32x16_bf16(vf, pa[ks], o1, 0, 0, 0); } }
        }
        {
#pragma unroll
            for (int ks = 0; ks < 4; ++ks) {
                const LASC unsigned char* bp = (const LASC unsigned char*)(Bt + trb + (16 * ks + 8 * hi) * 256 + nb * 64);
                const s16x4 a_lo = __builtin_bit_cast(s16x4, __builtin_amdgcn_ds_read_tr16_b64_v4i16((LASC att::v4i16_t*)bp));
                const s16x4 a_hi = __builtin_bit_cast(s16x4, __builtin_amdgcn_ds_read_tr16_b64_v4i16((LASC att::v4i16_t*)(bp + 4 * 256)));
                const LASC unsigned char* xp = (const LASC unsigned char*)(Xt + trx + (16 * ks + 8 * hi) * 128 + pb * 64);
                const s16x4 x_lo = __builtin_bit_cast(s16x4, __builtin_amdgcn_ds_read_tr16_b64_v4i16((LASC att::v4i16_t*)xp));
                const s16x4 x_hi = __builtin_bit_cast(s16x4, __builtin_amdgcn_ds_read_tr16_b64_v4i16((LASC att::v4i16_t*)(xp + 4 * 128)));
                const bf16x8 af = {a_lo[0], a_lo[1], a_lo[2], a_lo[3], a_hi[0], a_hi[1], a_hi[2], a_hi[3]};
                const bf16x8 xf = {x_lo[0], x_lo[1], x_lo[2], x_lo[3], x_hi[0], x_hi[1], x_hi[2], x_hi[3]};
                sacc = __builtin_amdgcn_mfma_f32_32x32x16_bf16(af, xf, sacc, 0, 0, 0);
            }
        }
        if (t + 1 < 4) SSD_STORE(st ^ 1, t + 1);
        __syncthreads();
    }
#undef SSD_LOAD
#undef SSD_STORE
    { const float Dh = d_skip[h]; bf16_t* yp = XC + (row0 + l) * 1024 + h * 64 + 4 * hi;
#pragma unroll
      for (int gq = 0; gq < 4; ++gq) {
          const uint2 x0 = *(const uint2*)(yp + 8 * gq), x1 = *(const uint2*)(yp + 32 + 8 * gq);
          *(uint2*)(yp + 8 * gq) = make_uint2(cvtpk(o0[4 * gq] + Dh * bflo(x0.x), o0[4 * gq + 1] + Dh * bfhi(x0.x)), cvtpk(o0[4 * gq + 2] + Dh * bflo(x0.y), o0[4 * gq + 3] + Dh * bfhi(x0.y)));
          *(uint2*)(yp + 32 + 8 * gq) = make_uint2(cvtpk(o1[4 * gq] + Dh * bflo(x1.x), o1[4 * gq + 1] + Dh * bfhi(x1.x)), cvtpk(o1[4 * gq + 2] + Dh * bflo(x1.y), o1[4 * gq + 3] + Dh * bfhi(x1.y))); } }
    { bf16_t* sp = STATES + ((size_t)((b * 32 + c) * 8 + h)) * 8192 + (size_t)(r32 + 32 * pb) * 128 + 32 * nb + 4 * hi;
#pragma unroll
      for (int gq = 0; gq < 4; ++gq) *(uint2*)(sp + 8 * gq) = make_uint2(cvtpk(sacc[4 * gq], sacc[4 * gq + 1]), cvtpk(sacc[4 * gq + 2], sacc[4 * gq + 3])); }
    __syncthreads();
}
__device__ __forceinline__ void m2_unit(unsigned char* lds, bf16_t* XC, const float* DT, const float* a_log, const bf16_t* STATES, const float* CDEC, int b, int c, int h) {
    if (c == 0) return;
    const int tid = ltid(), lane = tid & 63, wave = __builtin_amdgcn_readfirstlane(tid >> 6), r32 = lane & 31, hi = lane >> 5, g = h >> 2;
    const size_t row0 = (size_t)b * SEQ + c * 256; const int l = wave * 32 + r32;
    const float A = -expf(a_log[h]);
    float* al = (float*)(lds + OFF_AL2);
    (void)chunk_scan(lds, DT, row0, h, A, tid);
    const float ea = expf(al[l]);
    float4 hin[4];
#pragma unroll
    for (int j = 0; j < 4; ++j) hin[j] = make_float4(0.f, 0.f, 0.f, 0.f);
    const bf16_t* sbase = STATES + ((size_t)((b * 32) * 8 + h)) * 8192 + 4 * tid;
    for (int c0 = 0; c0 < c; c0 += 4) {
        uint2 sv[4][4]; float dec[4];
#pragma unroll
        for (int k = 0; k < 4; ++k) { const int cc = (c0 + k < c) ? c0 + k : c - 1; dec[k] = CDEC[(b * 32 + cc) * 8 + h];
#pragma unroll
            for (int j = 0; j < 4; ++j) sv[k][j] = *(const uint2*)(sbase + (size_t)cc * 8 * 8192 + 2048 * j); }
#pragma unroll
        for (int k = 0; k < 4; ++k) if (c0 + k < c) {
#pragma unroll
            for (int j = 0; j < 4; ++j) { hin[j].x = hin[j].x * dec[k] + bflo(sv[k][j].x); hin[j].y = hin[j].y * dec[k] + bfhi(sv[k][j].x); hin[j].z = hin[j].z * dec[k] + bflo(sv[k][j].y); hin[j].w = hin[j].w * dec[k] + bfhi(sv[k][j].y); } } }
#pragma unroll
    for (int j = 0; j < 4; ++j) { const int idx = 4 * tid + 2048 * j, p = idx >> 7, n = idx & 127;
        *(uint2*)(lds + OFF_HIN + p * 256 + (((n >> 3) ^ (p & 15)) * 16) + (n & 7) * 2) = make_uint2(cvtpk(hin[j].x, hin[j].y), cvtpk(hin[j].z, hin[j].w)); }
    __syncthreads();
    bf16x8 cfr[8];
    { const bf16_t* cp = XC + (row0 + l) * 1024 + 768 + g * 128 + 8 * hi;
#pragma unroll
      for (int k0 = 0; k0 < 8; ++k0) cfr[k0] = *(const bf16x8*)(cp + 16 * k0); }
    f32x16 o0, o1;
#pragma unroll
    for (int r = 0; r < 16; ++r) { o0[r] = 0.f; o1[r] = 0.f; }
#pragma unroll
    for (int k0 = 0; k0 < 8; ++k0) {
        const bf16x8 h0 = *(const bf16x8*)(lds + OFF_HIN + r32 * 256 + (((2 * k0 + hi) ^ (r32 & 15)) * 16));
        const bf16x8 h1 = *(const bf16x8*)(lds + OFF_HIN + (32 + r32) * 256 + (((2 * k0 + hi) ^ (r32 & 15)) * 16));
        o0 = __builtin_amdgcn_mfma_f32_32x32x16_bf16(h0, cfr[k0], o0, 0, 0, 0);
        o1 = __builtin_amdgcn_mfma_f32_32x32x16_bf16(h1, cfr[k0], o1, 0, 0, 0);
    }
    { bf16_t* yp = XC + (row0 + l) * 1024 + h * 64 + 4 * hi;
#pragma unroll
      for (int gq = 0; gq < 4; ++gq) {
          const uint2 y0 = *(const uint2*)(yp + 8 * gq), y1 = *(const uint2*)(yp + 32 + 8 * gq);
          *(uint2*)(yp + 8 * gq) = make_uint2(cvtpk(bflo(y0.x) + ea * o0[4 * gq], bfhi(y0.x) + ea * o0[4 * gq + 1]), cvtpk(bflo(y0.y) + ea * o0[4 * gq + 2], bfhi(y0.y) + ea * o0[4 * gq + 3]));
          *(uint2*)(yp + 32 + 8 * gq) = make_uint2(cvtpk(bflo(y1.x) + ea * o1[4 * gq], bfhi(y1.x) + ea * o1[4 * gq + 1]), cvtpk(bflo(y1.y) + ea * o1[4 * gq + 2], bfhi(y1.y) + ea * o1[4 * gq + 3])); } }
    __syncthreads();
}
}

__device__ __forceinline__ void moba_select_unit(unsigned char* lds, const bf16_t* PROJ, const float* KMEAN, unsigned* SEL, int b, int h, int qb) {
    const int tid = ltid(), lane = tid & 63, hf = lane & 1;
    const int q = qb * 256 + (tid >> 1);
    float* km_s = (float*)lds;
    { const int n = tid >> 4, c4 = (tid & 15) * 4; *(float4*)(km_s + n * 64 + c4) = *(const float4*)(KMEAN + ((size_t)(b * 32 + n)) * 512 + h * 64 + c4); }
    __syncthreads();
    const bf16_t* qp = PROJ + ((size_t)b * SEQ + q) * NPROJ + PC_MQ + h * 64 + hf * 32;
    float qv[32];
#pragma unroll
    for (int c = 0; c < 4; ++c) { const uint4 u = *(const uint4*)(qp + c * 8);
        qv[c * 8 + 0] = bflo(u.x); qv[c * 8 + 1] = bfhi(u.x); qv[c * 8 + 2] = bflo(u.y); qv[c * 8 + 3] = bfhi(u.y); qv[c * 8 + 4] = bflo(u.z); qv[c * 8 + 5] = bfhi(u.z); qv[c * 8 + 6] = bflo(u.w); qv[c * 8 + 7] = bfhi(u.w); }
    float g0 = -INFINITY, g1 = -INFINITY, g2 = -INFINITY; int i0 = 31, i1 = 31, i2 = 31;
    for (int n = 0; n < qb; ++n) {
        const float* km = km_s + n * 64 + hf * 32; float g = 0.f;
#pragma unroll
        for (int c = 0; c < 8; ++c) { const float4 k4 = *(const float4*)(km + 4 * c); g += qv[4 * c] * k4.x + qv[4 * c + 1] * k4.y + qv[4 * c + 2] * k4.z + qv[4 * c + 3] * k4.w; }
        g += __shfl_xor(g, 1);
        if (g > g0) { g2 = g1; i2 = i1; g1 = g0; i1 = i0; g0 = g; i0 = n; }
        else if (g > g1) { g2 = g1; i2 = i1; g1 = g; i1 = n; }
        else if (g > g2) { g2 = g; i2 = n; }
    }
    const int cnt = qb < 3 ? qb : 3;
    if (hf == 0) SEL[(size_t)(b * 8 + h) * SEQ + q] = (unsigned)i0 | ((unsigned)i1 << 5) | ((unsigned)i2 << 10) | ((unsigned)cnt << 15);
    __syncthreads();
}
namespace gat { constexpr int OFF_LIST = 65536, OFF_TABG = 98304, OFF_CNT = 102400; }
__device__ __forceinline__ void moba_gather_unit(unsigned char* lds, bf16_t* PROJ, const unsigned* SEL, const float* btab, bf16_t* PO2, float* PL, int b, int h, int j, int qc) {
    using namespace att;
    const int tid = ltid(), lane = tid & 63, wave = __builtin_amdgcn_readfirstlane(tid >> 6), r32 = lane & 31, hi = lane >> 5;
    const size_t rowbase = (size_t)b * SEQ;
    float* tab = (float*)(lds + gat::OFF_TABG); unsigned* list = (unsigned*)(lds + gat::OFF_LIST); unsigned* cntp = (unsigned*)(lds + gat::OFF_CNT);
    for (int d = tid; d < 1024; d += NT) tab[d] = btab[rel_bucket(d) * 16 + h] * LOG2E;
    if (tid == 0) *cntp = 0u;
    { const int skey = tid >> 3, sch = tid & 7;
#pragma unroll
      for (int t = 0; t < 4; ++t) { const bf16_t* kp = PROJ + (rowbase + j * 256 + t * 64 + skey) * NPROJ + h * 64 + sch * 8;
          *(uint4*)(lds + t * ST_BYTES + skey * 128 + ((sch ^ ((skey >> 1) & 7)) * 16)) = *(const uint4*)(kp + PC_MK);
          *(uint4*)(lds + t * ST_BYTES + 8192 + skey * 128 + ((sch ^ (((skey >> 1) & 1) << 2)) * 16)) = *(const uint4*)(kp + PC_MV); } }
    __syncthreads();
    for (int half = 0; half < 2; ++half) {
        const int qf = 4096 * qc + 2048 * half + 4 * tid, qmin = 256 * (j + 1);
        const uint4 sv4 = *(const uint4*)(SEL + (size_t)(b * 8 + h) * SEQ + qf); const unsigned sv[4] = {sv4.x, sv4.y, sv4.z, sv4.w};
#pragma unroll
        for (int e = 0; e < 4; ++e) { int slot = -1; const int cnt = (int)((sv[e] >> 15) & 3u);
            if (qf + e >= qmin) { if ((int)(sv[e] & 31u) == j && cnt > 0) slot = 0; else if ((int)((sv[e] >> 5) & 31u) == j && cnt > 1) slot = 1; else if ((int)((sv[e] >> 10) & 31u) == j && cnt > 2) slot = 2; }
            const unsigned long long bal = __builtin_amdgcn_ballot_w64(slot >= 0);
            unsigned pos = 0u;
            if (lane == 0 && bal) pos = atomicAdd(cntp, (unsigned)__builtin_popcountll(bal));
            pos = __shfl(pos, 0);
            if (slot >= 0) list[pos + __builtin_popcountll(bal & ((1ull << lane) - 1ull))] = (unsigned)(qf + e) | ((unsigned)slot << 13); }
    }
    __syncthreads();
    const int n = (int)*cntp, ngroups = (n + 31) >> 5;
    const int vtr_off = ((lane & 15) >> 2) * 128 + (16 * ((lane >> 4) & 1) + 4 * (lane & 3)) * 2 + 4 * hi * 128;
    for (int grp = wave; grp < ngroups; grp += 8) {
        const int ei = 32 * grp + r32; const bool valid = ei < n; const unsigned ent = list[valid ? ei : n - 1];
        const int q = (int)(ent & 8191u), slot = (int)(ent >> 13);
        bf16x8 qr[4];
        { const bf16_t* qp = PROJ + (rowbase + q) * NPROJ + PC_MQ + h * 64 + 8 * hi;
#pragma unroll
          for (int d0 = 0; d0 < 4; ++d0) { const uint4 u = *(const uint4*)(qp + 16 * d0);
              uint4 w; w.x = cvtpk(bflo(u.x) * C2, bfhi(u.x) * C2); w.y = cvtpk(bflo(u.y) * C2, bfhi(u.y) * C2); w.z = cvtpk(bflo(u.z) * C2, bfhi(u.z) * C2); w.w = cvtpk(bflo(u.w) * C2, bfhi(u.w) * C2);
              qr[d0] = __builtin_bit_cast(bf16x8, w); } }
        f32x16 o0, o1;
#pragma unroll
        for (int r = 0; r < 16; ++r) { o0[r] = 0.f; o1[r] = 0.f; }
        float m = -1e30f, l = 0.f;
#pragma unroll 1
        for (int t = 0; t < 4; ++t) {
            const unsigned char* Ks = lds + t * ST_BYTES; const unsigned char* Vt = Ks + 8192;
            const int key0 = j * 256 + t * 64; f32x16 p0, p1;
            { const int dq = q - key0 - 4 * hi;
              if (__builtin_amdgcn_ballot_w64(q - (key0 + 63) >= 790) == ~0ull) { const float c31 = tab[1023];
#pragma unroll
                  for (int r = 0; r < 16; ++r) { p0[r] = c31; p1[r] = c31; } }
              else {
#pragma unroll
                  for (int r = 0; r < 16; ++r) { const int kofs = (r & 3) + 8 * (r >> 2); const int d0_ = dq - kofs, d1_ = dq - kofs - 32;
                      p0[r] = tab[d0_ > 1023 ? 1023 : d0_]; p1[r] = tab[d1_ > 1023 ? 1023 : d1_]; } } }
#pragma unroll
            for (int d0 = 0; d0 < 4; ++d0) {
                const bf16x8 a0 = *(const bf16x8*)(Ks + r32 * 128 + (((2 * d0 + hi) ^ ((r32 >> 1) & 7)) * 16));
                const bf16x8 a1 = *(const bf16x8*)(Ks + (32 + r32) * 128 + (((2 * d0 + hi) ^ ((r32 >> 1) & 7)) * 16));
                p0 = __builtin_amdgcn_mfma_f32_32x32x16_bf16(a0, qr[d0], p0, 0, 0, 0);
                p1 = __builtin_amdgcn_mfma_f32_32x32x16_bf16(a1, qr[d0], p1, 0, 0, 0);
            }
            float mx = fmaxf(p0[0], p1[0]);
#pragma unroll
            for (int r = 1; r < 16; ++r) mx = fmaxf(mx, fmaxf(p0[r], p1[r]));
            mx = fmaxf(mx, __shfl_xor(mx, 32));
            const float mn = fmaxf(m, mx);
            if (__builtin_amdgcn_ballot_w64(mn > m) != 0ull) {
                const float alpha = __builtin_amdgcn_exp2f(m - mn); l *= alpha;
#pragma unroll
                for (int r = 0; r < 16; ++r) { o0[r] *= alpha; o1[r] *= alpha; }
            }
            m = mn;
            float sum = 0.f;
#pragma unroll
            for (int r = 0; r < 16; ++r) { p0[r] = __builtin_amdgcn_exp2f(p0[r] - mn); p1[r] = __builtin_amdgcn_exp2f(p1[r] - mn); sum += p0[r] + p1[r]; }
            l += sum;
            bf16x8 pa[4];
#pragma unroll
            for (int ks = 0; ks < 4; ++ks) { uint4 w;
                if (ks < 2) { w.x = cvtpk(p0[8 * ks], p0[8 * ks + 1]); w.y = cvtpk(p0[8 * ks + 2], p0[8 * ks + 3]); w.z = cvtpk(p0[8 * ks + 4], p0[8 * ks + 5]); w.w = cvtpk(p0[8 * ks + 6], p0[8 * ks + 7]); }
                else { const int k2 = ks - 2; w.x = cvtpk(p1[8 * k2], p1[8 * k2 + 1]); w.y = cvtpk(p1[8 * k2 + 2], p1[8 * k2 + 3]); w.z = cvtpk(p1[8 * k2 + 4], p1[8 * k2 + 5]); w.w = cvtpk(p1[8 * k2 + 6], p1[8 * k2 + 7]); }
                pa[ks] = __builtin_bit_cast(bf16x8, w); }
#pragma unroll
            for (int ks = 0; ks < 4; ++ks) {
#pragma unroll
                for (int db = 0; db < 2; ++db) {
                    const LASC unsigned char* vp = (const LASC unsigned char*)(Vt + vtr_off + ks * 16 * 128 + ((db ^ ((lane >> 3) & 1)) * 64));
                    const s16x4 lo = __builtin_bit_cast(s16x4, __builtin_amdgcn_ds_read_tr16_b64_v4i16((LASC v4i16_t*)vp));
                    const s16x4 hh = __builtin_bit_cast(s16x4, __builtin_amdgcn_ds_read_tr16_b64_v4i16((LASC v4i16_t*)(vp + 8 * 128)));
                    const bf16x8 vf = {lo[0], lo[1], lo[2], lo[3], hh[0], hh[1], hh[2], hh[3]};
                    if (db == 0) o0 = __builtin_amdgcn_mfma_f32_32x32x16_bf16(vf, pa[ks], o0, 0, 0, 0);
                    else o1 = __builtin_amdgcn_mfma_f32_32x32x16_bf16(vf, pa[ks], o1, 0, 0, 0); }
            }
        }
        l += __shfl_xor(l, 32);
        const float inv = 1.0f / l;
        if (valid) {
            bf16_t* pp = (slot < 2) ? PROJ + (rowbase + q) * NPROJ + PC_XBC + (h * 2 + slot) * 64 + 4 * hi : PO2 + ((rowbase + q) * 8 + h) * 64 + 4 * hi;
#pragma unroll
            for (int g = 0; g < 4; ++g) {
                *(uint2*)(pp + 8 * g) = make_uint2(cvtpk(o0[4 * g] * inv, o0[4 * g + 1] * inv), cvtpk(o0[4 * g + 2] * inv, o0[4 * g + 3] * inv));
                *(uint2*)(pp + 32 + 8 * g) = make_uint2(cvtpk(o1[4 * g] * inv, o1[4 * g + 1] * inv), cvtpk(o1[4 * g + 2] * inv, o1[4 * g + 3] * inv)); }
            if (hi == 0) PL[((rowbase + q) * 8 + h) * 4 + slot] = m + __builtin_amdgcn_logf(l);
        }
    }
    __syncthreads();
}
#define MIX_WS ({ unsigned char* p_ = ws0; asm volatile("" : "+s"(p_)); p_; })
#define QUEUE_NEXT(u, word) do { if (tid == 0) *(volatile unsigned*)(lds + 131072 + 64) = atomicAdd((unsigned*)(MIX_WS + WS_CTL + 32768) + 64 * (word), 1u); \
        __syncthreads(); u = *(volatile unsigned*)(lds + 131072 + 64); __syncthreads(); } while (0)
__device__ __forceinline__ void ph_mixers(unsigned char* lds, unsigned char* ws0, const float* a_log, const float* d_skip, const float* sinks, const float* btab, int l) {
    const int tid = ltid();
    bool swa_ok = false;
    for (;;) {
        unsigned u; QUEUE_NEXT(u, 3 * l);
        if (u >= 2048u + 64u) break;
        if (u < 64u) {
            unsigned char* ws = MIX_WS;
            pg8::OneSched S; S.u0.A = (const char*)P_XN(ws) + (size_t)u * 256 * (D * 2); S.u0.B = (const char*)(ws + WS_WIN) + (size_t)INP_TILES * 256 * (D * 2);
            S.u0.lda2 = D * 2; S.u0.ldb2 = D * 2; S.u0.nt = D / 64; S.u0.pm = (int)u; S.u0.pn = INP_TILES; S.u0.aux = 0;
            pg8::EpiStoreBf16 E{P_PROJ(ws), NPROJ}; pg8::gemm_phase<pg8::EpiStoreBf16, pg8::OneSched, true>((LAS unsigned char*)lds, S, E);
            if (tid == 0) { __builtin_amdgcn_fence(__ATOMIC_RELEASE, "agent"); asm volatile("s_waitcnt vmcnt(0)" ::: "memory"); (void)q_add((unsigned*)(ws + WS_CTL + 32768) + 64 * (6 + l), 1u); }
            continue;
        }
        u -= 64u;
        const int k = (int)(u & 511u);
        if (u < 512u) { const int qb = 31 - (k >> 4), bh = k & 15; unsigned char* ws = MIX_WS;
            att::attn_unit<att::MODE_FOX>(lds, P_PROJ(ws), (const float*)(ws + WS_LF), (const float*)(ws + WS_CUM), 0, 0.f, bh >> 3, bh & 7, bh & 7, qb, PC_FQ, PC_FK, PC_FV); }
        else if (u < 1024u) { unsigned char* ws = MIX_WS; ssd::m1_unit(lds, P_XC(ws), (const float*)(ws + WS_DT), a_log, d_skip, (bf16_t*)(ws + WS_STATES), (float*)(ws + WS_CDEC), k >> 8, (k >> 3) & 31, k & 7); }
        else if (u < 1536u) { const int bh = k >> 5, qb = k & 31, hq = bh & 7; unsigned char* ws = MIX_WS;
            if (!swa_ok) {
                if (tid == 0) { unsigned sp = 0; while (q_ld((unsigned*)(ws + WS_CTL + 32768) + 64 * (6 + l)) < 64u) { __builtin_amdgcn_s_sleep(2); if (++sp > (1u << 22)) break; } }
                __syncthreads();
                __builtin_amdgcn_fence(__ATOMIC_ACQUIRE, "agent"); asm volatile("s_waitcnt vmcnt(0)" ::: "memory");
                __syncthreads();
                swa_ok = true; }
            att::attn_unit<att::MODE_SWA>(lds, P_PROJ(ws), nullptr, btab, 8 + hq, sinks[hq], bh >> 3, hq, hq >> 2, qb, PC_SQ, PC_SK, PC_SV); }
        else { const int qb = 31 - (k >> 4), bh = k & 15; unsigned char* ws = MIX_WS;
            moba_select_unit(lds, P_PROJ(ws), (const float*)(ws + WS_KMEAN), (unsigned*)(ws + WS_SEL), bh >> 3, bh & 7, qb); }
    }
}
__device__ __forceinline__ void ph_mixers_b(unsigned char* lds, unsigned char* ws0, const float* a_log, const float* btab, int l, const float* const* in) {
    const int tid = ltid();
    for (;;) {
        unsigned u; QUEUE_NEXT(u, 3 * l + 1);
        if (u >= 736u + 512u + (unsigned)((WCV_ALL - WCV_IN) / WCV_CHUNK)) break;
        if (u >= 736u + 512u) {
            const int lo = WCV_IN + (int)(u - (736u + 512u)) * WCV_CHUNK; unsigned char* ws = MIX_WS;
            ph_wconv(ws, in[1] + (size_t)l * D * DIN, in[11] + (size_t)l * 4 * 512 * 1024, in[12] + (size_t)l * D * D, in[15] + (size_t)l * D * DFF, in[16] + (size_t)l * D * DFF, in[17] + (size_t)l * DFF * D,
                     (LAS float*)lds, lo, lo + WCV_CHUNK, 0, 1);
            continue; }
        if (u < 736u) { const int bh = (int)u & 15, idx = (int)u >> 4;
            const int qc = idx < 15 ? 0 : 1, j = idx - (qc == 0 ? 0 : 15); unsigned char* ws = MIX_WS;
            moba_gather_unit(lds, P_PROJ(ws), (const unsigned*)(ws + WS_SEL), btab, (bf16_t*)(ws + WS_PO2), (float*)(ws + WS_PL), bh >> 3, bh & 7, j, qc); }
        else { const int k = (int)u - 736, c = 31 - (k >> 4), bh = k & 15; unsigned char* ws = MIX_WS;
            ssd::m2_unit(lds, P_XC(ws), (const float*)(ws + WS_DT), a_log, (const bf16_t*)(ws + WS_STATES), (const float*)(ws + WS_CDEC), bh >> 3, c, bh & 7); }
    }
}
__device__ __forceinline__ void ph_mixers_c(unsigned char* lds, unsigned char* ws0, const float* btab, const float* ssm_norm_w, int l) {
    const int tid = ltid();
    for (;;) {
        unsigned u; QUEUE_NEXT(u, 3 * l + 2);
        if (u >= 512u) break;
        const int qb = 31 - ((int)u >> 4), bh = (int)u & 15, h = bh & 7; unsigned char* ws = MIX_WS;
        att::attn_unit<att::MODE_MOWN>(lds, P_PROJ(ws), (const float*)(ws + WS_SEL), btab, h, 0.f, bh >> 3, h, h, qb, PC_MQ, PC_MK, PC_MV, false, (const void*)(ws + WS_PO2), (const void*)(ws + WS_PL));
    }
    { unsigned char* ws = MIX_WS; ph_mamba_norm(P_PROJ(ws), P_XC(ws), ssm_norm_w); }
}
#define XB_TMO      128
#define XB_XCNT(j)  (256  + 64 * (j))
#define XB_XSUB(j)  (1280 + 64 * (j))
#define XB_XGEN(j)  (2304 + 64 * (j))
#define XB_TOP      3328
#define XB_TOPGEN   3392
#define XCD_BAR_WORDS 3456
#define XB_SPIN_CAP (1u << 18)

__device__ __forceinline__ unsigned xb_ld(unsigned* p)              { return __hip_atomic_load(p, __ATOMIC_RELAXED, __HIP_MEMORY_SCOPE_AGENT); }
__device__ __forceinline__ unsigned xb_add(unsigned* p, unsigned v) { return __hip_atomic_fetch_add(p, v, __ATOMIC_RELAXED, __HIP_MEMORY_SCOPE_AGENT); }
__device__ __forceinline__ unsigned xb_xcc_id() { return (unsigned)__builtin_amdgcn_s_getreg((3 << 11) | 20) & 0xFu; }
#define XB_SPIN(cond, bar) do { unsigned _sp = 0; while (cond) { __builtin_amdgcn_s_sleep(1); \
    if ((++_sp & 255u) == 0u) { if (xb_ld(&(bar)[XB_TMO])) break; if (_sp > XB_SPIN_CAP) { atomicAdd(&(bar)[XB_TMO], 1u); break; } } } } while (0)

struct XcdBarrier {
    unsigned* bar; unsigned x;
    volatile LAS unsigned* st;
};

__device__ __forceinline__ XcdBarrier xcd_barrier_post(unsigned* bar, volatile LAS unsigned* st) {
    XcdBarrier b; b.bar = bar; b.x = xb_xcc_id(); b.st = st;
    if (threadIdx.x == 0) (void)xb_add(&bar[XB_XCNT(b.x)], 1u);
    return b;
}
__device__ __forceinline__ void xcd_barrier_complete(unsigned* bar, unsigned x, unsigned& nloc, unsigned& nx) {
    const unsigned G = gridDim.x * gridDim.y * gridDim.z;
    unsigned sum, cnt, mine, sp = 0u;
    for (;;) {
        sum = 0u; cnt = 0u; mine = 0u;
#pragma unroll
        for (unsigned j = 0; j < 16; ++j) { const unsigned c = xb_ld(&bar[XB_XCNT(j)]); sum += c; cnt += (c > 0u) ? 1u : 0u; mine = (j == x) ? c : mine; }
        if (sum == G) break;
        __builtin_amdgcn_s_sleep(1);
        if ((++sp & 255u) == 0u) { if (xb_ld(&bar[XB_TMO])) break; if (sp > XB_SPIN_CAP) { atomicAdd(&bar[XB_TMO], 1u); break; } }
    }
    nloc = mine > 0u ? mine : 1u; nx = cnt > 0u ? cnt : 1u;
}

__device__ __forceinline__ void xcd_barrier(const XcdBarrier& b) {
    asm volatile("s_waitcnt vmcnt(0)" ::: "memory");
    __syncthreads();
    if (threadIdx.x == 0) {
        unsigned* bar = b.bar;
        __builtin_amdgcn_s_waitcnt(0);
        unsigned nloc = b.st[0], nx = b.st[1];
        if (nloc == 0u) { xcd_barrier_complete(bar, b.x, nloc, nx); b.st[0] = nloc; b.st[1] = nx; }
        const unsigned old = xb_add(&bar[XB_XSUB(b.x)], 1u);
        const unsigned gen = old / nloc;
        if (old + 1u == (gen + 1u) * nloc) {
            __builtin_amdgcn_fence(__ATOMIC_RELEASE, "agent");
            asm volatile("s_waitcnt vmcnt(0)" ::: "memory");
            const unsigned og = xb_add(&bar[XB_TOP], 1u);
            const unsigned tg = og / nx;
            if (og + 1u == (tg + 1u) * nx) xb_add(&bar[XB_TOPGEN], 1u);
            else XB_SPIN(xb_ld(&bar[XB_TOPGEN]) == tg, bar);
            __builtin_amdgcn_fence(__ATOMIC_ACQUIRE, "agent");
            xb_add(&bar[XB_XGEN(b.x)], 1u);
            asm volatile("s_waitcnt vmcnt(0)" ::: "memory");
        } else {
            XB_SPIN(xb_ld(&bar[XB_XGEN(b.x)]) == gen, bar);
            __builtin_amdgcn_fence(__ATOMIC_ACQUIRE, "agent");
            asm volatile("s_waitcnt vmcnt(0)" ::: "memory");
        }
    }
    __syncthreads();
}

constexpr int MISC_OFF = 131072 + 320;
constexpr int LDS_BYTES = 147456;
constexpr int HROW_OFF = 69632;
#define GRID_SYNC() xcd_barrier(bar)
#define WSL ({ unsigned char* p_ = a.ws; asm volatile("" : "+s"(p_)); p_; })
__global__ void __launch_bounds__(NT, 2) fwd(Args a) {
    extern __shared__ __attribute__((aligned(16))) unsigned char lds[];
    LAS unsigned char* L = (LAS unsigned char*)lds;
    volatile LAS unsigned* MISC = (volatile LAS unsigned*)(L + MISC_OFF);
    if (threadIdx.x < 32) MISC[threadIdx.x] = 0u;
    __syncthreads();
    XcdBarrier bar = xcd_barrier_post((unsigned*)(a.ws + WS_CTL) + 4096, MISC + 8);
#pragma unroll 1
    for (int l = 0; l < 2; ++l) {
        {
            unsigned char* ws = WSL; const float* xin = (l == 0) ? a.in[0] : a.out; const float* w_in = a.in[1] + (size_t)l * D * DIN;
            ph_wconv(ws, w_in, a.in[11] + (size_t)l * 4 * 512 * 1024, a.in[12] + (size_t)l * D * D, a.in[15] + (size_t)l * D * DFF, a.in[16] + (size_t)l * D * DFF, a.in[17] + (size_t)l * DFF * D, (LAS float*)L, 0, WCV_IN, blockIdx.x, gridDim.x);
            __syncthreads();
            ph_norm((float*)lds, xin, a.in[13] + l * D, P_XN(ws), true, w_in, a.in[4] + l * 8, a.in[8] + l * 8, (float*)(ws + WS_DT), (float*)(ws + WS_LF));
        }
        GRID_SYNC();
        {
            unsigned char* ws = WSL;
            pg8::PlainSched S; S.T.init(M / 256, INP_TILES, gridDim.x, blockIdx.x); S.A = (const char*)P_XN(ws); S.B = (const char*)(ws + WS_WIN); S.lda2 = D * 2; S.ldb2 = D * 2; S.nt = D / 64;
            pg8::EpiStoreBf16 E{P_PROJ(ws), NPROJ}; pg8::gemm_phase<pg8::EpiStoreBf16, pg8::PlainSched, true>(L, S, E);
        }
        GRID_SYNC();
        { unsigned char* ws = WSL; ph_pre(lds, P_PROJ(ws), a.in[2] + (size_t)l * 4 * 1024, a.in[3] + l * 1024, P_XC(ws), (float*)(ws + WS_KMEAN), (float*)(ws + WS_CUM)); }
        GRID_SYNC();
        ph_mixers(lds, a.ws, a.in[5] + l * 8, a.in[6] + l * 8, a.in[9] + l * 8, a.in[10], l);
        GRID_SYNC();
        ph_mixers_b(lds, a.ws, a.in[5] + l * 8, a.in[10], l, a.in);
        GRID_SYNC();
        ph_mixers_c(lds, a.ws, a.in[10], a.in[7] + l * 512, l);
        GRID_SYNC();
        {
            unsigned char* ws = WSL;
            pg8::PlainSched S; S.T.init(M / 256, 4096 / 256, gridDim.x, blockIdx.x); S.A = (const char*)P_XN(ws); S.B = (const char*)(ws + WS_WG); S.lda2 = D * 2; S.ldb2 = D * 2; S.nt = D / 64;
            pg8::EpiGate E{P_PROJ(ws), P_XC(ws)}; pg8::gemm_phase<pg8::EpiGate, pg8::PlainSched, true>(L, S, E);
        }
        GRID_SYNC();
        {
            unsigned char* ws = WSL;
            pg8::BranchSched S; S.T.init(M / 256, D / 256, gridDim.x, blockIdx.x); S.PROJ = (const char*)P_PROJ(ws); S.WBR = (const char*)(ws + WS_WBR);
            pg8::EpiBranch E{P_PROJ(ws), P_XC(ws), P_XN(ws)}; pg8::gemm_phase<pg8::EpiBranch, pg8::BranchSched, true>(L, S, E);
        }
        GRID_SYNC();
        {
            unsigned char* ws = WSL; const float* xin = (l == 0) ? a.in[0] : a.out;
            pg8::PlainSched S; S.T.init(M / 256, D / 256, gridDim.x, blockIdx.x); S.A = (const char*)P_XN(ws); S.B = (const char*)(ws + WS_WOUT); S.lda2 = D * 2; S.ldb2 = D * 2; S.nt = D / 64;
            pg8::EpiResidual E{xin, a.out}; pg8::gemm_phase<pg8::EpiResidual, pg8::PlainSched, false>(L, S, E);
        }
        GRID_SYNC();
        { unsigned char* ws = WSL; ph_norm(nullptr, a.out, a.in[14] + l * D, P_XN(ws), false, nullptr, nullptr, nullptr, nullptr, nullptr); }
        GRID_SYNC();
        {
            unsigned char* ws = WSL;
            pg8::PlainSched S; S.T.init(M / 256, 2 * DFF / 256, gridDim.x, blockIdx.x); S.A = (const char*)P_XN(ws); S.B = (const char*)(ws + WS_WGU); S.lda2 = D * 2; S.ldb2 = D * 2; S.nt = D / 64;
            pg8::EpiSwiglu E{P_PROJ(ws)}; pg8::gemm_phase<pg8::EpiSwiglu, pg8::PlainSched, true>(L, S, E);
        }
        GRID_SYNC();
        {
            unsigned char* ws = WSL;
            pg8::PlainSched S; S.T.init(M / 256, D / 256, gridDim.x, blockIdx.x); S.A = (const char*)P_PROJ(ws); S.B = (const char*)(ws + WS_WDN); S.lda2 = DFF * 2; S.ldb2 = DFF * 2; S.nt = DFF / 64;
            pg8::EpiResidual E{a.out, a.out}; pg8::gemm_phase<pg8::EpiResidual, pg8::PlainSched, false>(L, S, E);
        }
        GRID_SYNC();
    }
    ph_final(a.out, a.in[18]);
}

extern "C" void kernel_launch(void* const* d_in, const int* in_sizes, int n_in, void* d_out, int out_size, void* d_ws, size_t ws_size, hipStream_t stream) {
    static int grid = 0;
    if (grid == 0) {
        if (n_in != 19 || out_size != M * D || ws_size < WS_TOTAL) { fprintf(stderr, "kernel_launch: unexpected shapes (n_in %d out %d ws %zu)\n", n_in, out_size, ws_size); grid = -1; return; }
        int dev = 0, cus = 0, per_cu = 0;
        (void)hipGetDevice(&dev); (void)hipDeviceGetAttribute(&cus, hipDeviceAttributeMultiprocessorCount, dev);
        if (hipFuncSetAttribute((const void*)fwd, hipFuncAttributeMaxDynamicSharedMemorySize, LDS_BYTES) != hipSuccess) { fprintf(stderr, "kernel_launch: hipFuncSetAttribute failed\n"); grid = -1; return; }
        (void)hipOccupancyMaxActiveBlocksPerMultiprocessor(&per_cu, (const void*)fwd, NT, LDS_BYTES);
        if (per_cu < 1) { fprintf(stderr, "kernel_launch: occupancy query says 0 blocks per CU\n"); grid = -1; return; }
        grid = cus < 256 ? cus : 256;
    }
    if (grid < 0) return;
    if (hipMemsetAsync((char*)d_ws + WS_CTL, 0, CTL_ZERO_BYTES, stream) != hipSuccess) { fprintf(stderr, "kernel_launch: memset of the control words failed\n"); return; }
    Args a{};
    for (int i = 0; i < 19; ++i) a.in[i] = (const float*)d_in[i];
    a.out = (float*)d_out; a.ws = (unsigned char*)d_ws;
    hipLaunchKernelGGL(fwd, dim3(grid), dim3(NT), LDS_BYTES, stream, a);
}
```

```cpp
#include <hip/hip_runtime.h>
#include <hip/hip_cooperative_groups.h>
#include <cstdio>
#include <cstdint>
namespace cg = cooperative_groups;

#ifndef SINGLE_LAUNCH
#define SINGLE_LAUNCH 0
#endif

typedef unsigned short bf16_t;
constexpr int M = 16384, SEQ = 8192, D = 1024, DIN = 9488, NPROJ = 5376, DFF = 2816;
constexpr int NT = 512;
constexpr int INP_TILES = 20;
constexpr int PC_Z = 0, PC_XBC = 512, PC_MQ = 1536, PC_MK = 2048, PC_MV = 2560, PC_FQ = 3072, PC_FK = 3584, PC_FV = 4096, PC_SQ = 4608, PC_SK = 5120, PC_SV = 5248;
constexpr int WC_DT = 1536, WC_F = 4616, WC_GATE = 5392;
constexpr size_t MiB = 1u << 20;
constexpr size_t WS_XN = 0, WS_PROJ = 32 * MiB, WS_XC = 200 * MiB, WS_DT = 232 * MiB, WS_LF = WS_DT + MiB / 2, WS_CUM = 233 * MiB, WS_KMEAN = WS_CUM + MiB / 2;
constexpr size_t WS_WIN = 234 * MiB;
constexpr size_t WS_WG = WS_WIN + (size_t)NPROJ * D * 2;
constexpr size_t WS_WBR = WS_WG + (size_t)4096 * D * 2;
constexpr size_t WS_WOUT = WS_WBR + (size_t)4 * D * 512 * 2;
constexpr size_t WS_WGU = WS_WOUT + (size_t)D * D * 2;
constexpr size_t WS_WDN = WS_WGU + (size_t)2 * DFF * D * 2;
constexpr size_t WS_END = WS_WDN + (size_t)D * DFF * 2;
static_assert(WS_END <= 276 * MiB, "workspace map");

constexpr size_t WS_CTL = 276 * MiB, CTL_ZERO_BYTES = 65536, WS_CDEC = WS_CTL + 131072, WS_TOTAL = 294 * MiB;
constexpr size_t WS_STATES = 234 * MiB, WS_PL = WS_STATES + 8 * MiB;
constexpr size_t WS_PO2 = 277 * MiB, WS_SEL = 293 * MiB;
#define P_XN(w) ((bf16_t*)((w) + WS_XN))
#define P_PROJ(w) ((bf16_t*)((w) + WS_PROJ))
#define P_XC(w) ((bf16_t*)((w) + WS_XC))
struct Args { const float* in[19]; float* out; unsigned char* ws; int ph_lo, ph_hi, coop, pad; };

__device__ __forceinline__ float bf2f(unsigned v) { return __uint_as_float(v << 16); }
__device__ __forceinline__ float bflo(unsigned v) { return __uint_as_float(v << 16); }
__device__ __forceinline__ float bfhi(unsigned v) { return __uint_as_float(v & 0xffff0000u); }
__device__ __forceinline__ unsigned f2bf(float f) { unsigned u = __float_as_uint(f); return (u + 0x7fffu + ((u >> 16) & 1u)) >> 16; }
__device__ __forceinline__ unsigned pk2(float lo, float hi) { return f2bf(lo) | (f2bf(hi) << 16); }
__device__ __forceinline__ float wave_sum(float v) {
#pragma unroll
    for (int o = 1; o < 64; o <<= 1) v += __shfl_xor(v, o);
    return v;
}
__device__ __forceinline__ unsigned q_ld(unsigned* p)              { return __hip_atomic_load(p, __ATOMIC_RELAXED, __HIP_MEMORY_SCOPE_AGENT); }
__device__ __forceinline__ unsigned q_add(unsigned* p, unsigned v) { return __hip_atomic_fetch_add(p, v, __ATOMIC_RELAXED, __HIP_MEMORY_SCOPE_AGENT); }
__device__ __forceinline__ int ltid() { int t = threadIdx.x; asm volatile("" : "+v"(t)); return t; }
__device__ __forceinline__ float log1p_pos(float e) {
    const float small = e * (1.f + e * (-0.5f + e * (0.33333333f + e * (-0.25f + e * 0.2f))));
    return e < 0.02f ? small : logf(1.f + e);
}
__device__ __forceinline__ float softplus_f(float x) { return fmaxf(x, 0.f) + log1p_pos(expf(-fabsf(x))); }
__device__ __forceinline__ float silu_f(float x) { return x / (1.f + expf(-x)); }
__device__ __forceinline__ float sigmoid_f(float x) { return 1.f / (1.f + expf(-x)); }
__device__ __forceinline__ int rel_bucket(int d) {
    if (d < 16) return d;
    int b = 16;
    b += (d >= 21); b += (d >= 27); b += (d >= 35); b += (d >= 46); b += (d >= 59); b += (d >= 77); b += (d >= 99); b += (d >= 128);
    b += (d >= 166); b += (d >= 216); b += (d >= 280); b += (d >= 363); b += (d >= 470); b += (d >= 609); b += (d >= 790);
    return b;
}

__device__ __forceinline__ void ph_norm(float* wd, const float* xin, const float* nw, bf16_t* XN, bool dots, const float* w_in, const float* dt_bias, const float* fbias, float* DT, float* LF) {
    const int tx_ = ltid();
    const int lane = tx_ & 63, wave = tx_ >> 6;
    const int gw = blockIdx.x * 8 + wave, NGW = gridDim.x * 8;
    if (dots) {
        for (int i = tx_; i < 1024 * 4; i += NT) { const int k = i >> 2, part = i & 3;
            *(float4*)((char*)wd + (k >> 2) * 272 + (k & 3) * 64 + part * 16) = *(const float4*)(w_in + (size_t)k * DIN + (part < 2 ? WC_DT + part * 4 : WC_F + (part - 2) * 4)); }
        __syncthreads();
    }
    for (int row = gw; row < M; row += NGW) {
        const float4* xr = (const float4*)(xin + (size_t)row * D);
        float4 v[4]; float ss = 0.f;
#pragma unroll
        for (int j = 0; j < 4; ++j) { v[j] = xr[lane + 64 * j]; ss += v[j].x * v[j].x + v[j].y * v[j].y + v[j].z * v[j].z + v[j].w * v[j].w; }
        ss = wave_sum(ss);
        const float rstd = 1.0f / sqrtf(ss * (1.0f / D) + 1e-6f);
#pragma unroll
        for (int j = 0; j < 4; ++j) { const float4 w4 = ((const float4*)nw)[lane + 64 * j]; v[j].x *= rstd * w4.x; v[j].y *= rstd * w4.y; v[j].z *= rstd * w4.z; v[j].w *= rstd * w4.w; }
        uint2* o = (uint2*)(XN + (size_t)row * D);
#pragma unroll
        for (int j = 0; j < 4; ++j) o[lane + 64 * j] = make_uint2(pk2(v[j].x, v[j].y), pk2(v[j].z, v[j].w));
        if (dots) {
            float d[16];
#pragma unroll
            for (int c = 0; c < 16; ++c) d[c] = 0.f;
#pragma unroll
            for (int j = 0; j < 4; ++j) { const float hv[4] = {v[j].x, v[j].y, v[j].z, v[j].w};
#pragma unroll
                for (int e = 0; e < 4; ++e) { const float* wr = (const float*)((const char*)wd + (lane + 64 * j) * 272 + e * 64); const float h = hv[e];
                    const float4 a0 = *(const float4*)(wr), a1 = *(const float4*)(wr + 4), b0 = *(const float4*)(wr + 8), b1 = *(const float4*)(wr + 12);
                    d[0] += h * a0.x; d[1] += h * a0.y; d[2] += h * a0.z; d[3] += h * a0.w; d[4] += h * a1.x; d[5] += h * a1.y; d[6] += h * a1.z; d[7] += h * a1.w;
                    d[8] += h * b0.x; d[9] += h * b0.y; d[10] += h * b0.z; d[11] += h * b0.w; d[12] += h * b1.x; d[13] += h * b1.y; d[14] += h * b1.z; d[15] += h * b1.w; }
                asm volatile("" ::: "memory"); }
            float r8[8], r4[4], r2[2];
            { const bool up = (lane & 32) != 0;
#pragma unroll
              for (int i = 0; i < 8; ++i) { const float keep = up ? d[i + 8] : d[i], send = up ? d[i] : d[i + 8]; r8[i] = keep + __shfl_xor(send, 32); } }
            { const bool up = (lane & 16) != 0;
#pragma unroll
              for (int i = 0; i < 4; ++i) { const float keep = up ? r8[i + 4] : r8[i], send = up ? r8[i] : r8[i + 4]; r4[i] = keep + __shfl_xor(send, 16); } }
            { const bool up = (lane & 8) != 0;
#pragma unroll
              for (int i = 0; i < 2; ++i) { const float keep = up ? r4[i + 2] : r4[i], send = up ? r4[i] : r4[i + 2]; r2[i] = keep + __shfl_xor(send, 8); } }
            float mine; { const bool up = (lane & 4) != 0; const float keep = up ? r2[1] : r2[0], send = up ? r2[0] : r2[1]; mine = keep + __shfl_xor(send, 4); }
            mine += __shfl_xor(mine, 2); mine += __shfl_xor(mine, 1);
            const int col = ((lane >> 5) & 1) * 8 + ((lane >> 4) & 1) * 4 + ((lane >> 3) & 1) * 2 + ((lane >> 2) & 1);
            if ((lane & 3) == 0) { if (col < 8) DT[(size_t)row * 8 + col] = softplus_f(mine + dt_bias[col]); else LF[(size_t)row * 8 + (col - 8)] = -softplus_f(-(mine + fbias[col - 8])); }
        }
    }
}

namespace pg8 {
#define PG8_LAS __attribute__((address_space(3)))
typedef short bf16x8 __attribute__((ext_vector_type(8)));
typedef float f32x4 __attribute__((ext_vector_type(4)));
typedef unsigned u32x4 __attribute__((ext_vector_type(4)));
constexpr int BM = 256, BK = 64, HALF = 128, HTB = HALF * BK * 2, STAGE_BYTES = 8 * HTB, NXCD = 8, WGM = 8;
__host__ __device__ __forceinline__ int lds_byte(int r, int c) { const int st = (r >> 4) * 2 + (c >> 5), rr = r & 15, cc = c & 31, ob = rr * 64 + cc * 2; return st * 1024 + (ob ^ (((ob >> 9) & 1) << 5)); }
__host__ __device__ __forceinline__ void stage_rc(int b, int& R, int& C) { const int st = b / 1024, sb = b % 1024, swz = sb ^ (((sb >> 9) & 1) << 5); R = (st >> 1) * 16 + swz / 64; C = (st & 1) * 32 + (swz % 64) / 2; }
__host__ __device__ __forceinline__ int perm32(int rho) { const int n = rho >> 4, i = rho & 15; return 8 * (i >> 2) + 4 * n + (i & 3); }
struct Unit { const char* A; const char* B; unsigned lda2, ldb2; int nt, pm, pn, aux; };
struct TileOrder {
    int nM, nN, nwg, G, c;
    __device__ void init(int nM_, int nN_, int G_, int c_) { nM = nM_; nN = nN_; nwg = nM * nN; G = G_; c = c_; }
    __device__ bool tile(int i, int& pm, int& pn) const {
        const long L = (long)i * G + c; if (L >= nwg) return false;
        int wgid = (int)L; { const int q = nwg / NXCD, r = nwg % NXCD, xcd = wgid % NXCD, off = wgid / NXCD; wgid = (xcd < r ? xcd * (q + 1) : r * (q + 1) + (xcd - r) * q) + off; }
        const int nig = WGM * nN, gid = wgid / nig, fm = gid * WGM, gsz = (nM - fm) < WGM ? (nM - fm) : WGM;
        pm = fm + ((wgid % nig) % gsz); pn = (wgid % nig) / gsz; return true;
    }
};
typedef float f32x2_t __attribute__((ext_vector_type(2))); typedef __bf16 bf16x2_t __attribute__((ext_vector_type(2)));
__device__ __forceinline__ unsigned cvt_pk_bf16(float lo, float hi) { f32x2_t v = {lo, hi}; bf16x2_t b = __builtin_convertvector(v, bf16x2_t); return __builtin_bit_cast(unsigned, b); }

template <class Epi, class Sched, bool ALIGN_EPI>
__device__ __forceinline__ void gemm_phase(PG8_LAS unsigned char* lds, const Sched& S, const Epi& E) {
    int tid = threadIdx.x; asm volatile("" : "+v"(tid));
    const int wid = __builtin_amdgcn_readfirstlane(tid >> 6), lane = tid & 63, wr = wid >> 2, wc = wid & 3, fr = lane & 15, fq = lane >> 4;
    unsigned RA[2], RB[2], C2[2];
#pragma unroll
    for (int i = 0; i < 2; ++i) { int R, C; stage_rc(tid * 16 + i * 8192, R, C); RA[i] = (unsigned)R; RB[i] = (unsigned)(Epi::PERM ? ((R & ~31) + perm32(R & 31)) : R); C2[i] = (unsigned)(C * 2); }
    const unsigned ldsw = (unsigned)wid * 1024u;
    const int aoff = lds_byte(wr * 64 + fr, fq * 8), boff = lds_byte(wc * 32 + fr, fq * 8);
#define PG8_SA(b, h) (((b) * 2 + (h)) * HTB)
#define PG8_SB(b, h) ((4 + (b) * 2 + (h)) * HTB)
#define PG8_STAGE(bufoff, gbase, RR, pitch) do { _Pragma("unroll") for (int _i = 0; _i < 2; ++_i) \
        __builtin_amdgcn_global_load_lds((const unsigned*)((const char*)(gbase) + (RR[_i] * (pitch) + C2[_i])), (PG8_LAS unsigned*)(lds + (bufoff) + ldsw + _i * 8192), 16, 0, 0); } while (0)
#define PG8_LDA(dst, b, h) do { _Pragma("unroll") for (int m = 0; m < 4; ++m) _Pragma("unroll") for (int k = 0; k < 2; ++k) dst[m][k] = *(const PG8_LAS bf16x8*)(lds + PG8_SA(b, h) + aoff + m * 2048 + k * 1024); } while (0)
#define PG8_LDB(dst, b, h) do { _Pragma("unroll") for (int n = 0; n < 2; ++n) _Pragma("unroll") for (int k = 0; k < 2; ++k) dst[n][k] = *(const PG8_LAS bf16x8*)(lds + PG8_SB(b, h) + boff + n * 2048 + k * 1024); } while (0)
#define PG8_MMA(ai, bj, At, Bt) do { __builtin_amdgcn_s_setprio(1); _Pragma("unroll") for (int m = 0; m < 4; ++m) _Pragma("unroll") for (int n = 0; n < 2; ++n) _Pragma("unroll") for (int k = 0; k < 2; ++k) \
        acc[ai][bj][m][n] = __builtin_amdgcn_mfma_f32_16x16x32_bf16(Bt[n][k], At[m][k], acc[ai][bj][m][n], 0, 0, 0); __builtin_amdgcn_s_setprio(0); } while (0)
#define PG8_WAIT_V(n) asm volatile("s_waitcnt vmcnt(" #n ")" ::: "memory")
#define PG8_WAIT_L(n) asm volatile("s_waitcnt lgkmcnt(" #n ")" ::: "memory")
#define PG8_BAR __builtin_amdgcn_s_barrier()
#define PG8_SCHED __builtin_amdgcn_sched_barrier(0)
#define PG8_ZERO() do { _Pragma("unroll") for (int a_ = 0; a_ < 2; ++a_) _Pragma("unroll") for (int b_ = 0; b_ < 2; ++b_) _Pragma("unroll") for (int m_ = 0; m_ < 4; ++m_) _Pragma("unroll") for (int n_ = 0; n_ < 2; ++n_) acc[a_][b_][m_][n_] = (f32x4){0.f, 0.f, 0.f, 0.f}; } while (0)
    Unit cur, nxt; int ui = 0;
    if (!S.next(0, cur)) return;
    f32x4 acc[2][2][4][2];
    PG8_ZERO();
    bf16x8 At[4][2], B0[2][2], B1[2][2];
    const char* cA = cur.A; const char* cB = cur.B; unsigned pAc = cur.lda2, pBc = cur.ldb2; int ntc = cur.nt;
    const unsigned kstep = BK * 2;
    {
        const size_t hA = (size_t)HALF * pAc, hB = (size_t)HALF * pBc;
        PG8_STAGE(PG8_SB(0, 0), cB, RB, pBc); PG8_STAGE(PG8_SB(0, 1), cB + hB, RB, pBc); PG8_STAGE(PG8_SA(0, 0), cA, RA, pAc); PG8_STAGE(PG8_SA(0, 1), cA + hA, RA, pAc);
        if (wr == 1) PG8_BAR;
        PG8_WAIT_V(2); PG8_BAR;
        PG8_STAGE(PG8_SB(1, 0), cB + kstep, RB, pBc); PG8_STAGE(PG8_SA(1, 0), cA + kstep, RA, pAc); PG8_STAGE(PG8_SB(1, 1), cB + hB + kstep, RB, pBc);
        PG8_WAIT_V(6); PG8_BAR;
    }
    for (;;) {
        const bool has_next = S.next(ui + 1, nxt);
        const char* nA = has_next ? nxt.A : cA; const char* nB = has_next ? nxt.B : cB;
        const unsigned pAn = has_next ? nxt.lda2 : pAc, pBn = has_next ? nxt.ldb2 : pBc;
        const size_t hAc = (size_t)HALF * pAc;
        for (int t = 0; t < ntc; t += 2) {
            const bool last = (t == ntc - 2);
            const char* a1 = cA + (size_t)(t + 1) * kstep;
            const char* a2 = last ? nA : cA + (size_t)(t + 2) * kstep; const char* b2 = last ? nB : cB + (size_t)(t + 2) * kstep;
            const char* a3 = a2 + kstep; const char* b3 = b2 + kstep;
            const unsigned pA2 = last ? pAn : pAc, pB2 = last ? pBn : pBc;
            const size_t hA2 = (size_t)HALF * pA2, hB2 = (size_t)HALF * pB2;
            PG8_LDB(B0, 0, 0); PG8_LDB(B1, 0, 1); PG8_SCHED; PG8_LDA(At, 0, 0); PG8_STAGE(PG8_SA(1, 1), a1 + hAc, RA, pAc);
            PG8_WAIT_V(8); PG8_WAIT_L(0); PG8_BAR; PG8_MMA(0, 0, At, B0); PG8_MMA(0, 1, At, B1); PG8_BAR; PG8_SCHED;
            PG8_LDA(At, 0, 1); PG8_STAGE(PG8_SB(0, 0), b2, RB, pB2); PG8_STAGE(PG8_SB(0, 1), b2 + hB2, RB, pB2); PG8_STAGE(PG8_SA(0, 0), a2, RA, pA2);
            PG8_WAIT_V(8); PG8_WAIT_L(0); PG8_BAR; PG8_MMA(1, 0, At, B0); PG8_MMA(1, 1, At, B1); PG8_BAR; PG8_SCHED;
            PG8_LDB(B0, 1, 0); PG8_LDB(B1, 1, 1); PG8_SCHED; PG8_LDA(At, 1, 0); PG8_STAGE(PG8_SA(0, 1), a2 + hA2, RA, pA2);
            PG8_WAIT_V(8); PG8_WAIT_L(0); PG8_BAR; PG8_MMA(0, 0, At, B0); PG8_MMA(0, 1, At, B1); PG8_BAR; PG8_SCHED;
            PG8_LDA(At, 1, 1); PG8_STAGE(PG8_SB(1, 0), b3, RB, pB2); PG8_STAGE(PG8_SB(1, 1), b3 + hB2, RB, pB2); PG8_STAGE(PG8_SA(1, 0), a3, RA, pA2);
            PG8_WAIT_V(8); PG8_WAIT_L(0); PG8_BAR; PG8_MMA(1, 0, At, B0); PG8_MMA(1, 1, At, B1); PG8_BAR; PG8_SCHED;
        }
        if constexpr (ALIGN_EPI) { if (wr == 0) PG8_BAR; }
        { int fr_ = fr, fq_ = fq; asm volatile("" : "+v"(fr_), "+v"(fq_)); E(acc, cur, wr, wc, fr_, fq_); }
        if (!has_next) break;
        PG8_ZERO();
        cur = nxt; cA = nA; cB = nB; pAc = pAn; pBc = pBn; ntc = nxt.nt; ++ui;
        if constexpr (ALIGN_EPI) { if (wr == 1) PG8_BAR; }
    }
    PG8_WAIT_V(0);
    if constexpr (!ALIGN_EPI) { if (wr == 0) PG8_BAR; }
    PG8_BAR;
#undef PG8_SA
#undef PG8_SB
#undef PG8_STAGE
#undef PG8_LDA
#undef PG8_LDB
#undef PG8_MMA
#undef PG8_WAIT_V
#undef PG8_WAIT_L
#undef PG8_BAR
#undef PG8_SCHED
#undef PG8_ZERO
}

struct PlainSched {
    TileOrder T; const char* A; const char* B; unsigned lda2, ldb2; int nt;
    __device__ bool next(int i, Unit& u) const { int pm, pn; if (!T.tile(i, pm, pn)) return false;
        u.A = A + (size_t)pm * 256 * lda2; u.B = B + (size_t)pn * 256 * ldb2; u.lda2 = lda2; u.ldb2 = ldb2; u.nt = nt; u.pm = pm; u.pn = pn; u.aux = 0; return true; }
};
struct OneSched { Unit u0; __device__ bool next(int i, Unit& u) const { if (i != 0) return false; u = u0; return true; } };
struct EpiStoreBf16 {
    static constexpr bool PERM = true;
    bf16_t* O; int ldc;
    __device__ __forceinline__ void operator()(const f32x4 (&acc)[2][2][4][2], const Unit& u, int wr, int wc, int fr, int fq) const {
        const int row0 = u.pm * BM + wr * 64 + fr, col0 = u.pn * BM + wc * 32 + 8 * fq;
#pragma unroll
        for (int ai = 0; ai < 2; ++ai)
#pragma unroll
            for (int m = 0; m < 4; ++m) { bf16_t* rowp = O + (size_t)(row0 + ai * HALF + m * 16) * ldc + col0;
#pragma unroll
                for (int bj = 0; bj < 2; ++bj) { const f32x4 v0 = acc[ai][bj][m][0], v1 = acc[ai][bj][m][1];
                    u32x4 w; w.x = cvt_pk_bf16(v0[0], v0[1]); w.y = cvt_pk_bf16(v0[2], v0[3]); w.z = cvt_pk_bf16(v1[0], v1[1]); w.w = cvt_pk_bf16(v1[2], v1[3]);
                    *(u32x4*)(rowp + bj * HALF) = w; } }
    }
};
__device__ __forceinline__ float fast_sigmoid(float x) { return __builtin_amdgcn_rcpf(1.f + __expf(-x)); }
struct EpiSwiglu {
    static constexpr bool PERM = true;
    bf16_t* H;
    __device__ __forceinline__ void operator()(const f32x4 (&acc)[2][2][4][2], const Unit& u, int wr, int wc, int fr, int fq) const {
        const int row0 = u.pm * BM + wr * 64 + fr, col0 = u.pn * HALF + wc * 32 + 8 * fq;
#pragma unroll
        for (int ai = 0; ai < 2; ++ai)
#pragma unroll
            for (int m = 0; m < 4; ++m) { float v[8];
#pragma unroll
                for (int n = 0; n < 2; ++n)
#pragma unroll
                    for (int e = 0; e < 4; ++e) { const float g = acc[ai][0][m][n][e], up = acc[ai][1][m][n][e]; v[n * 4 + e] = g * fast_sigmoid(g) * up; }
                u32x4 w; w.x = cvt_pk_bf16(v[0], v[1]); w.y = cvt_pk_bf16(v[2], v[3]); w.z = cvt_pk_bf16(v[4], v[5]); w.w = cvt_pk_bf16(v[6], v[7]);
                *(u32x4*)(H + (size_t)(row0 + ai * HALF + m * 16) * DFF + col0) = w; }
    }
};
struct EpiResidual {
    static constexpr bool PERM = false;
    const float* res; float* out;
    __device__ __forceinline__ void operator()(const f32x4 (&acc)[2][2][4][2], const Unit& u, int wr, int wc, int fr, int fq) const {
        const int row0 = u.pm * BM + wr * 64 + fr, col0 = u.pn * BM + wc * 32 + 4 * fq;
#pragma unroll
        for (int ai = 0; ai < 2; ++ai)
#pragma unroll
            for (int m = 0; m < 4; ++m) { const size_t off = (size_t)(row0 + ai * HALF + m * 16) * D + col0;
#pragma unroll
                for (int bj = 0; bj < 2; ++bj)
#pragma unroll
                    for (int n = 0; n < 2; ++n) { const f32x4 r = *(const f32x4*)(res + off + bj * HALF + n * 16); *(f32x4*)(out + off + bj * HALF + n * 16) = r + acc[ai][bj][m][n]; } }
    }
};
struct EpiGate {
    static constexpr bool PERM = true;
    bf16_t* PROJ; bf16_t* XC;
    __device__ __forceinline__ void operator()(const f32x4 (&acc)[2][2][4][2], const Unit& u, int wr, int wc, int fr, int fq) const {
        const int br = u.pn >> 2, row0 = u.pm * BM + wr * 64 + fr, col0 = (u.pn & 3) * BM + wc * 32 + 8 * fq;
        bf16_t* base = br < 3 ? PROJ + 512 + 1536 * br : XC;
        const int ld = br < 3 ? NPROJ : 1024;
#pragma unroll
        for (int ai = 0; ai < 2; ++ai)
#pragma unroll
            for (int m = 0; m < 4; ++m) { bf16_t* rowp = base + (size_t)(row0 + ai * HALF + m * 16) * ld + col0;
#pragma unroll
                for (int bj = 0; bj < 2; ++bj) { const f32x4 v0 = acc[ai][bj][m][0], v1 = acc[ai][bj][m][1];
                    u32x4 w; w.x = cvt_pk_bf16(fast_sigmoid(v0[0]), fast_sigmoid(v0[1])); w.y = cvt_pk_bf16(fast_sigmoid(v0[2]), fast_sigmoid(v0[3]));
                    w.z = cvt_pk_bf16(fast_sigmoid(v1[0]), fast_sigmoid(v1[1])); w.w = cvt_pk_bf16(fast_sigmoid(v1[2]), fast_sigmoid(v1[3]));
                    *(u32x4*)(rowp + bj * HALF) = w; } }
    }
};
struct BranchSched {
    TileOrder T; const char* PROJ; const char* WBR;
    __device__ bool next(int i, Unit& u) const { int pm, pn; if (!T.tile(i >> 2, pm, pn)) return false;
        const int br = i & 3; u.pm = pm; u.pn = pn; u.aux = br;
        u.A = PROJ + (size_t)pm * 256 * (NPROJ * 2) + 1536 * 2 * br; u.lda2 = NPROJ * 2; u.B = WBR + ((size_t)br * 1024 + pn * 256) * (512 * 2); u.ldb2 = 512 * 2; u.nt = 512 / 64; return true; }
};
struct EpiBranch {
    static constexpr bool PERM = true;
    const bf16_t* PROJ; const bf16_t* XC; bf16_t* MIX;
    __device__ __forceinline__ void operator()(const f32x4 (&acc)[2][2][4][2], const Unit& u, int wr, int wc, int fr, int fq) const {
        const int br = u.aux, row0 = u.pm * BM + wr * 64 + fr, col0 = u.pn * BM + wc * 32 + 8 * fq;
        const bf16_t* G = br < 3 ? PROJ + 512 + 1536 * br : XC; const int ldg = br < 3 ? NPROJ : 1024;
        if (br == 0) run<true>(acc, G, ldg, row0, col0); else run<false>(acc, G, ldg, row0, col0);
    }
    template <bool FIRST>
    __device__ __forceinline__ void run(const f32x4 (&acc)[2][2][4][2], const bf16_t* G, int ldg, int row0, int col0) const {
#pragma unroll
        for (int gb = 0; gb < 16; gb += 4) {
            u32x4 g[4], o[4];
#pragma unroll
            for (int k = 0; k < 4; ++k) { const int i = gb + k, ai = i >> 3, m = (i >> 1) & 3, bj = i & 1; const size_t row = (size_t)(row0 + ai * HALF + m * 16);
                g[k] = *(const u32x4*)(G + row * ldg + col0 + bj * HALF); if (!FIRST) o[k] = *(const u32x4*)(MIX + row * D + col0 + bj * HALF); }
#pragma unroll
            for (int k = 0; k < 4; ++k) { const int i = gb + k, ai = i >> 3, m = (i >> 1) & 3, bj = i & 1; const size_t row = (size_t)(row0 + ai * HALF + m * 16);
                f32x4 p0 = acc[ai][bj][m][0], p1 = acc[ai][bj][m][1];
                p0[0] *= bflo(g[k].x); p0[1] *= bfhi(g[k].x); p0[2] *= bflo(g[k].y); p0[3] *= bfhi(g[k].y); p1[0] *= bflo(g[k].z); p1[1] *= bfhi(g[k].z); p1[2] *= bflo(g[k].w); p1[3] *= bfhi(g[k].w);
                if (!FIRST) { p0[0] += bflo(o[k].x); p0[1] += bfhi(o[k].x); p0[2] += bflo(o[k].y); p0[3] += bfhi(o[k].y); p1[0] += bflo(o[k].z); p1[1] += bfhi(o[k].z); p1[2] += bflo(o[k].w); p1[3] += bfhi(o[k].w); }
                u32x4 w; w.x = cvt_pk_bf16(p0[0], p0[1]); w.y = cvt_pk_bf16(p0[2], p0[3]); w.z = cvt_pk_bf16(p1[0], p1[1]); w.w = cvt_pk_bf16(p1[2], p1[3]);
                *(u32x4*)(MIX + row * D + col0 + bj * HALF) = w; }
            asm volatile("" ::: "memory");
        }
    }
};
}

#define LAS __attribute__((address_space(3)))
__device__ __forceinline__ void wt_item(const float* W, int ldw, int src_col0, int k0, bf16_t* WT, int ldwt, int dst_row0, LAS float* scr, int lane) {
#pragma unroll
    for (int i = 0; i < 8; ++i) { const int k = 4 * i + (lane >> 4), n4 = (lane & 15) * 4;
        const float4 v = *(const float4*)(W + (size_t)(k0 + k) * ldw + src_col0 + n4);
        LAS float* d = scr + k * 65 + n4; d[0] = v.x; d[1] = v.y; d[2] = v.z; d[3] = v.w; }
    asm volatile("s_waitcnt lgkmcnt(0)" ::: "memory");
    unsigned w[16];
#pragma unroll
    for (int j = 0; j < 16; ++j) w[j] = pk2(scr[(2 * j) * 65 + lane], scr[(2 * j + 1) * 65 + lane]);
    uint4* o = (uint4*)(WT + (size_t)(dst_row0 + lane) * ldwt + k0);
#pragma unroll
    for (int j = 0; j < 4; ++j) o[j] = make_uint4(w[4 * j], w[4 * j + 1], w[4 * j + 2], w[4 * j + 3]);
    asm volatile("s_waitcnt lgkmcnt(0)" ::: "memory");
}
constexpr int WCV_IN = 32 * (NPROJ / 64), WCV_ALL = WCV_IN + 32 * 64 + 4 * 16 * 16 + 32 * 16 + 32 * (2 * DFF / 64) + (DFF / 32) * 16, WCV_CHUNK = 16;
__device__ __forceinline__ void ph_wconv(unsigned char* ws, const float* w_in, const float* w_branch, const float* w_out, const float* w_gate, const float* w_up, const float* w_down, LAS float* scr_base,
                                         int lo, int hi, int first, int stride) {
    const int tx_ = ltid();
    const int lane = tx_ & 63, wave = tx_ >> 6;
    LAS float* scr = scr_base + wave * (32 * 65);
    constexpr int I_IN = 32 * (NPROJ / 64), I_G = 32 * 64, I_BR = 4 * 16 * 16, I_OUT = 32 * 16, I_GU = 32 * (2 * DFF / 64), I_DN = (DFF / 32) * 16;
    static_assert(I_IN + I_G + I_BR + I_OUT + I_GU + I_DN == WCV_ALL && (WCV_ALL - WCV_IN) % WCV_CHUNK == 0, "conversion list");
    for (int it = lo + first * 8 + wave; it < hi; it += stride * 8) {
        int r = it;
        if (r < I_IN) { const int nb = r % (NPROJ / 64), kb = r / (NPROJ / 64), c0 = nb * 64;
            wt_item(w_in, DIN, c0 + (c0 >= 1536 ? 8 : 0) + (c0 >= 4608 ? 8 : 0), kb * 32, (bf16_t*)(ws + WS_WIN), D, c0, scr, lane); continue; } r -= I_IN;
        if (r < I_G) { const int nb = r % 64, kb = r / 64; wt_item(w_in, DIN, WC_GATE + nb * 64, kb * 32, (bf16_t*)(ws + WS_WG), D, nb * 64, scr, lane); continue; } r -= I_G;
        if (r < I_BR) { const int br = r / 256, q = r % 256, nb = q % 16, kb = q / 16;
            wt_item(w_branch + (size_t)br * 512 * 1024, D, nb * 64, kb * 32, (bf16_t*)(ws + WS_WBR) + (size_t)br * 1024 * 512, 512, nb * 64, scr, lane); continue; } r -= I_BR;
        if (r < I_OUT) { const int nb = r % 16, kb = r / 16; wt_item(w_out, D, nb * 64, kb * 32, (bf16_t*)(ws + WS_WOUT), D, nb * 64, scr, lane); continue; } r -= I_OUT;
        if (r < I_GU) { const int nb = r % (2 * DFF / 64), kb = r / (2 * DFF / 64), r0 = nb * 64, t = r0 >> 8, j = r0 & 255;
            wt_item(j < 128 ? w_gate : w_up, DFF, t * 128 + (j & 127), kb * 32, (bf16_t*)(ws + WS_WGU), D, r0, scr, lane); continue; } r -= I_GU;
        { const int nb = r % 16, kb = r / 16; wt_item(w_down, D, nb * 64, kb * 32, (bf16_t*)(ws + WS_WDN), DFF, nb * 64, scr, lane); }
    }
}

__device__ __forceinline__ float silu_fast(float x) { return x * __builtin_amdgcn_rcpf(1.f + __expf(-x)); }
__device__ __forceinline__ void ph_pre(unsigned char* lds, const bf16_t* PROJ, const float* conv_w, const float* conv_b, bf16_t* XC, float* KMEAN, float* KMAXP) {
    const int tx_ = ltid();
    const int lane = tx_ & 63, gw = blockIdx.x * 8 + (tx_ >> 6), NGW = gridDim.x * 8;
    int* smax = (int*)lds;
    if (tx_ < 16) smax[tx_] = 0;
    for (int it = gw; it < (M / 16) * 2; it += NGW) {
        const int r0 = (it >> 1) * 16, c8 = (it & 1) * 512 + lane * 8;
        const bool head = (r0 & (SEQ - 1)) == 0;
        uint4 xr[19];
        const bf16_t* src = PROJ + (size_t)r0 * NPROJ + PC_XBC + c8;
#pragma unroll
        for (int j = 0; j < 3; ++j) xr[j] = head ? make_uint4(0u, 0u, 0u, 0u) : *(const uint4*)(src + (ptrdiff_t)(j - 3) * NPROJ);
#pragma unroll
        for (int j = 3; j < 19; ++j) xr[j] = *(const uint4*)(src + (size_t)(j - 3) * NPROJ);
        float w[4][8], b[8];
#pragma unroll
        for (int i = 0; i < 4; ++i) { const float4 w0 = *(const float4*)(conv_w + i * 1024 + c8), w1 = *(const float4*)(conv_w + i * 1024 + c8 + 4);
            w[i][0] = w0.x; w[i][1] = w0.y; w[i][2] = w0.z; w[i][3] = w0.w; w[i][4] = w1.x; w[i][5] = w1.y; w[i][6] = w1.z; w[i][7] = w1.w; }
        { const float4 b0 = *(const float4*)(conv_b + c8), b1 = *(const float4*)(conv_b + c8 + 4); b[0] = b0.x; b[1] = b0.y; b[2] = b0.z; b[3] = b0.w; b[4] = b1.x; b[5] = b1.y; b[6] = b1.z; b[7] = b1.w; }
        bf16_t* dst = XC + (size_t)r0 * 1024 + c8;
#pragma unroll
        for (int j = 0; j < 16; ++j) {
            float acc[8];
#pragma unroll
            for (int c = 0; c < 8; ++c) acc[c] = b[c];
#pragma unroll
            for (int i = 0; i < 4; ++i) { const uint4 u = xr[j + i];
                acc[0] += w[i][0] * bflo(u.x); acc[1] += w[i][1] * bfhi(u.x); acc[2] += w[i][2] * bflo(u.y); acc[3] += w[i][3] * bfhi(u.y);
                acc[4] += w[i][4] * bflo(u.z); acc[5] += w[i][5] * bfhi(u.z); acc[6] += w[i][6] * bflo(u.w); acc[7] += w[i][7] * bfhi(u.w); }
            uint4 o; o.x = pk2(silu_fast(acc[0]), silu_fast(acc[1])); o.y = pk2(silu_fast(acc[2]), silu_fast(acc[3])); o.z = pk2(silu_fast(acc[4]), silu_fast(acc[5])); o.w = pk2(silu_fast(acc[6]), silu_fast(acc[7]));
            *(uint4*)(dst + (size_t)j * 1024) = o;
        }
    }
    for (int it = gw; it < 64 * 16; it += NGW) {
        const int bb = it >> 4, cg = it & 15, rr = lane >> 2, c8 = cg * 32 + (lane & 3) * 8;
        uint4 u[16];
#pragma unroll
        for (int st = 0; st < 16; ++st) u[st] = *(const uint4*)(PROJ + ((size_t)bb * 256 + st * 16 + rr) * NPROJ + PC_MK + c8);
        float sm[8];
#pragma unroll
        for (int j = 0; j < 8; ++j) sm[j] = 0.f;
#pragma unroll
        for (int st = 0; st < 16; ++st) { sm[0] += bflo(u[st].x); sm[1] += bfhi(u[st].x); sm[2] += bflo(u[st].y); sm[3] += bfhi(u[st].y); sm[4] += bflo(u[st].z); sm[5] += bfhi(u[st].z); sm[6] += bflo(u[st].w); sm[7] += bfhi(u[st].w); }
#pragma unroll
        for (int j = 0; j < 8; ++j) { sm[j] += __shfl_xor(sm[j], 4); sm[j] += __shfl_xor(sm[j], 8); sm[j] += __shfl_xor(sm[j], 16); sm[j] += __shfl_xor(sm[j], 32); }
        if (lane < 4) { float* kp = KMEAN + (size_t)bb * 512 + c8;
            *(float4*)kp = make_float4(sm[0] * (1.0f / 256.0f), sm[1] * (1.0f / 256.0f), sm[2] * (1.0f / 256.0f), sm[3] * (1.0f / 256.0f));
            *(float4*)(kp + 4) = make_float4(sm[4] * (1.0f / 256.0f), sm[5] * (1.0f / 256.0f), sm[6] * (1.0f / 256.0f), sm[7] * (1.0f / 256.0f)); }
    }
    {
        const size_t gt = (size_t)blockIdx.x * NT + tx_, tot = (size_t)gridDim.x * NT;
        __syncthreads();
        for (size_t e = gt; e < (size_t)M * 8; e += tot) { const int row = (int)(e >> 3), h = (int)(e & 7);
            const bf16_t* kp = PROJ + (size_t)row * NPROJ + PC_FK + h * 64; float n2 = 0.f;
#pragma unroll
            for (int c = 0; c < 8; ++c) { const uint4 u = *(const uint4*)(kp + c * 8);
                n2 += bflo(u.x) * bflo(u.x) + bfhi(u.x) * bfhi(u.x) + bflo(u.y) * bflo(u.y) + bfhi(u.y) * bfhi(u.y) + bflo(u.z) * bflo(u.z) + bfhi(u.z) * bfhi(u.z) + bflo(u.w) * bflo(u.w) + bfhi(u.w) * bfhi(u.w); }
            atomicMax(&smax[(row >> 13) * 8 + h], __float_as_int(n2)); }
        __syncthreads();
        if (tx_ < 16) KMAXP[blockIdx.x * 16 + tx_] = sqrtf(__int_as_float(smax[tx_]));
    }
}

__device__ __forceinline__ void ph_mamba_norm(bf16_t* PROJ, const bf16_t* XC, const float* nw) {
    const int tx_ = ltid();
    const int lane = tx_ & 63, gw = blockIdx.x * 8 + (tx_ >> 6), NGW = gridDim.x * 8;
    for (int row = gw; row < M; row += NGW) {
        const uint4 yv = *(const uint4*)(XC + (size_t)row * 1024 + lane * 8); const uint4 zv = *(const uint4*)(PROJ + (size_t)row * NPROJ + PC_Z + lane * 8);
        float y[8] = {bflo(yv.x), bfhi(yv.x), bflo(yv.y), bfhi(yv.y), bflo(yv.z), bfhi(yv.z), bflo(yv.w), bfhi(yv.w)};
        const float z[8] = {bflo(zv.x), bfhi(zv.x), bflo(zv.y), bfhi(zv.y), bflo(zv.z), bfhi(zv.z), bflo(zv.w), bfhi(zv.w)};
        float ss = 0.f;
#pragma unroll
        for (int i = 0; i < 8; ++i) { y[i] *= silu_f(z[i]); ss += y[i] * y[i]; }
        ss = wave_sum(ss); const float rstd = 1.0f / sqrtf(ss * (1.0f / 512.0f) + 1e-6f);
        const float4 w0 = *(const float4*)(nw + lane * 8), w1 = *(const float4*)(nw + lane * 8 + 4);
        uint4 o; o.x = pk2(y[0] * rstd * w0.x, y[1] * rstd * w0.y); o.y = pk2(y[2] * rstd * w0.z, y[3] * rstd * w0.w); o.z = pk2(y[4] * rstd * w1.x, y[5] * rstd * w1.y); o.w = pk2(y[6] * rstd * w1.z, y[7] * rstd * w1.w);
        *(uint4*)(PROJ + (size_t)row * NPROJ + PC_Z + lane * 8) = o;
    }
}
__device__ __forceinline__ void ph_final(float* out, const float* nw) {
    const int tx_ = ltid();
    const int lane = tx_ & 63, gw = blockIdx.x * 8 + (tx_ >> 6), NGW = gridDim.x * 8;
    for (int row = gw; row < M; row += NGW) {
        float4* xr = (float4*)(out + (size_t)row * D);
        float4 v[4]; float ss = 0.f;
#pragma unroll
        for (int j = 0; j < 4; ++j) { v[j] = xr[lane + 64 * j]; ss += v[j].x * v[j].x + v[j].y * v[j].y + v[j].z * v[j].z + v[j].w * v[j].w; }
        ss = wave_sum(ss); const float rstd = 1.0f / sqrtf(ss * (1.0f / D) + 1e-6f);
#pragma unroll
        for (int j = 0; j < 4; ++j) { const float4 w4 = ((const float4*)nw)[lane + 64 * j]; xr[lane + 64 * j] = make_float4(v[j].x * rstd * w4.x, v[j].y * rstd * w4.y, v[j].z * rstd * w4.z, v[j].w * rstd * w4.w); }
    }
}


namespace att {
typedef short bf16x8 __attribute__((ext_vector_type(8)));
typedef short s16x4 __attribute__((ext_vector_type(4)));
typedef float f32x16 __attribute__((ext_vector_type(16)));
typedef float f32x2_t __attribute__((ext_vector_type(2))); typedef __bf16 bf16x2_t __attribute__((ext_vector_type(2)));
__device__ __forceinline__ unsigned cvtpk(float lo, float hi) { f32x2_t v = {lo, hi}; bf16x2_t b = __builtin_convertvector(v, bf16x2_t); return __builtin_bit_cast(unsigned, b); }
constexpr float LOG2E = 1.4426950408889634f, C2 = 0.125f * LOG2E;
constexpr int ST_BYTES = 16384, OFF_BIAS = 65536, OFF_EB = OFF_BIAS + 1024, OFF_KMAX = OFF_EB + 32, OFF_TAB = OFF_BIAS + 2048, TAB_N = 1280, OFF_END = OFF_TAB + TAB_N * 4;
constexpr float FOX_THR = 25.f;
enum { MODE_FOX = 0, MODE_SWA = 1, MODE_MOBA = 2, MODE_MOWN = 3 };
#define LASC __attribute__((address_space(3)))
typedef short v4i16_t __attribute__((ext_vector_type(4)));

template <int MODE>
__device__ __forceinline__ void attn_unit(unsigned char* lds, bf16_t* PROJ, const float* AUX, const float* btab, int bcol, float sink, int b, int hq, int hk, int qb, int qcol, int kcol, int vcol, bool dry = false, const void* ex0 = nullptr, const void* ex1 = nullptr) {
    const int tid = ltid(), lane = tid & 63, wave = __builtin_amdgcn_readfirstlane(tid >> 6), r32 = lane & 31, hi = lane >> 5;
    const int q0 = qb * 256, qw = q0 + wave * 32, q = qw + r32;
    const size_t rowbase = (size_t)b * SEQ;
    float* tab = (float*)(lds + OFF_TAB);
    if constexpr (MODE == MODE_SWA) {
        if (tid < 512) { const int d = tid - 128; tab[tid] = (d >= 0 && d < 128) ? btab[rel_bucket(d) * 16 + bcol] * LOG2E : 0.f; }
    }
    if constexpr (MODE == MODE_MOBA || MODE == MODE_MOWN) {
        for (int d = tid; d < 1024; d += NT) tab[d] = btab[rel_bucket(d) * 16 + bcol] * LOG2E;
    }
    bf16x8 qr[4]; float gq[32]; float qn2 = 0.f;
    { const bf16_t* qp = PROJ + (rowbase + q) * NPROJ + qcol + hq * 64 + 8 * hi;
#pragma unroll
      for (int d0 = 0; d0 < 4; ++d0) { const uint4 u = *(const uint4*)(qp + 16 * d0);
          const float f[8] = {bflo(u.x), bfhi(u.x), bflo(u.y), bfhi(u.y), bflo(u.z), bfhi(u.z), bflo(u.w), bfhi(u.w)};
          if constexpr (MODE == MODE_MOBA) {
#pragma unroll
              for (int e = 0; e < 8; ++e) gq[d0 * 8 + e] = f[e]; }
          if constexpr (MODE == MODE_FOX) {
#pragma unroll
              for (int e = 0; e < 8; ++e) qn2 += f[e] * f[e]; }
          uint4 w; w.x = cvtpk(f[0] * C2, f[1] * C2); w.y = cvtpk(f[2] * C2, f[3] * C2); w.z = cvtpk(f[4] * C2, f[5] * C2); w.w = cvtpk(f[6] * C2, f[7] * C2);
          qr[d0] = __builtin_bit_cast(bf16x8, w); } }
    unsigned selmask = 0u;
    if constexpr (MODE == MODE_MOBA) {
        float g0 = -INFINITY, g1 = -INFINITY, g2 = -INFINITY; int i0 = -1, i1 = -1, i2 = -1;
        for (int n = 0; n < qb; ++n) {
            const float* km = AUX + ((size_t)(b * 32 + n)) * 512 + hk * 64 + 8 * hi; float g = 0.f;
#pragma unroll
            for (int d0 = 0; d0 < 4; ++d0) { const float4 k0 = *(const float4*)(km + 16 * d0), k1 = *(const float4*)(km + 16 * d0 + 4);
                g += gq[d0 * 8] * k0.x + gq[d0 * 8 + 1] * k0.y + gq[d0 * 8 + 2] * k0.z + gq[d0 * 8 + 3] * k0.w + gq[d0 * 8 + 4] * k1.x + gq[d0 * 8 + 5] * k1.y + gq[d0 * 8 + 6] * k1.z + gq[d0 * 8 + 7] * k1.w; }
            g += __shfl_xor(g, 32);
            if (g > g0) { g2 = g1; i2 = i1; g1 = g0; i1 = i0; g0 = g; i0 = n; }
            else if (g > g1) { g2 = g1; i2 = i1; g1 = g; i1 = n; }
            else if (g > g2) { g2 = g; i2 = n; }
        }
        if (i0 >= 0) selmask |= 1u << i0; if (i1 >= 0) selmask |= 1u << i1; if (i2 >= 0) selmask |= 1u << i2;
    }
    float carry = 0.f;
    f32x16 o0, o1;
#pragma unroll
    for (int r = 0; r < 16; ++r) { o0[r] = 0.f; o1[r] = 0.f; }
    float m = -1e30f, l = 0.f;
    if constexpr (MODE == MODE_SWA) { m = sink * LOG2E; l = hi == 0 ? 1.f : 0.f; }
    const int t_beg = (MODE == MODE_SWA) ? (qb > 0 ? 4 * qb - 2 : 0) : (MODE == MODE_MOWN ? 4 * qb : 0), t_end = 4 * (qb + 1);
    const int skey = tid >> 3, sch = tid & 7;
    const bf16_t* kg = PROJ + (rowbase + skey) * NPROJ + kcol + hk * 64 + sch * 8;
    const bf16_t* vg = PROJ + (rowbase + skey) * NPROJ + vcol + hk * 64 + sch * 8;
    const int kdst = skey * 128 + ((sch ^ ((skey >> 1) & 7)) * 16);
    uint4 kreg0, kreg1, vreg0, vreg1; float breg0 = 0.f, breg1 = 0.f;
#define ATT_LOAD1(t_, KR, VR, BR) do { KR = *(const uint4*)(kg + (size_t)(t_) * 64 * NPROJ); VR = *(const uint4*)(vg + (size_t)(t_) * 64 * NPROJ); \
        if (MODE == MODE_FOX) { if (tid < 64) BR = AUX[(rowbase + (t_) * 64 + tid) * 8 + hq]; } } while (0)
#define ATT_LOAD(s_) do { ATT_LOAD1(ATT_TI(2 * (s_)), kreg0, vreg0, breg0); ATT_LOAD1(ATT_TI(2 * (s_) + 1), kreg1, vreg1, breg1); } while (0)
#define ATT_STORE1(ts_, KR, VR, BR) do { unsigned char* sb_ = lds + (ts_) * ST_BYTES; \
        *(uint4*)(sb_ + kdst) = KR; *(uint4*)(sb_ + 8192 + skey * 128 + ((sch ^ (((skey >> 1) & 1) << 2)) * 16)) = VR; \
        if (MODE == MODE_FOX) { if (tid < 64) { float inc_ = BR; \
            _Pragma("unroll") for (int o_ = 1; o_ < 64; o_ <<= 1) { const float v_ = __shfl_up(inc_, o_); if (lane >= o_) inc_ += v_; } \
            const float tot_ = __shfl(inc_, 63); \
            ((float*)(lds + OFF_BIAS))[(ts_) * 64 + tid] = (carry + tot_ - inc_) * LOG2E;        \
            carry += tot_; if (tid == 0) ((float*)(lds + OFF_EB))[(ts_)] = carry * LOG2E; } } } while (0)
#define ATT_STORE(st) do { ATT_STORE1((st) * 2, kreg0, vreg0, breg0); ATT_STORE1((st) * 2 + 1, kreg1, vreg1, breg1); } while (0)
    const int ntile = t_end - t_beg;
#define ATT_TI(i) ((MODE == MODE_FOX) ? (t_end - 1 - (i)) : (t_beg + (i)))
    float qkb = 0.f;
    if constexpr (MODE == MODE_FOX) {
        if (tid < 64) { float km = 0.f;
#pragma unroll
            for (int i = 0; i < 4; ++i) km = fmaxf(km, btab[(tid * 4 + i) * 16 + b * 8 + hq]);
#pragma unroll
            for (int o = 1; o < 64; o <<= 1) km = fmaxf(km, __shfl_xor(km, o));
            if (tid == 0) *(float*)(lds + OFF_KMAX) = km; }
    }
    const int nstep = ntile >> 1;
    ATT_LOAD(0); ATT_STORE(0);
    if (1 < nstep) ATT_LOAD(1);
    __syncthreads();
    if constexpr (MODE == MODE_FOX) { qn2 += __shfl_xor(qn2, 32); qkb = sqrtf(qn2) * C2 * 1.01f * *(const float*)(lds + OFF_KMAX); }
    const int vtr_off = ((lane & 15) >> 2) * 128 + (16 * ((lane >> 4) & 1) + 4 * (lane & 3)) * 2 + 4 * hi * 128;
    bool started = false;
    for (int i = 0; i < nstep; ++i) {
        const int st = i & 1;
        if (i + 1 < nstep) ATT_STORE(st ^ 1);
        if (i + 2 < nstep) ATT_LOAD(i + 2);
#pragma unroll 1
        for (int sub = 0; sub < 2; ++sub) {
        const int t = ATT_TI(2 * i + sub), ts = st * 2 + sub;
        bool act = (64 * t <= qw + 31);
        if constexpr (MODE == MODE_SWA) act = act && (64 * t + 63 >= qw - 127);
        if constexpr (MODE == MODE_MOBA) { if (t < 4 * qb) act = __builtin_amdgcn_ballot_w64(((selmask >> (t >> 2)) & 1u) != 0u) != 0ull; }
        if (act) {
            const unsigned char* Ks = lds + ts * ST_BYTES; const unsigned char* Vt = Ks + 8192;
            f32x16 p0, p1;
            if constexpr (MODE == MODE_FOX) { const float* bt = (const float*)(lds + OFF_BIAS) + ts * 64;
#pragma unroll
                for (int g = 0; g < 4; ++g) { const float4 b0 = *(const float4*)(bt + 8 * g + 4 * hi), b1 = *(const float4*)(bt + 32 + 8 * g + 4 * hi);
                    p0[4 * g] = b0.x; p0[4 * g + 1] = b0.y; p0[4 * g + 2] = b0.z; p0[4 * g + 3] = b0.w; p1[4 * g] = b1.x; p1[4 * g + 1] = b1.y; p1[4 * g + 2] = b1.z; p1[4 * g + 3] = b1.w; }
            } else if constexpr (MODE == MODE_SWA) { const float* tp = tab + 128 + (q - 64 * t - 4 * hi);
#pragma unroll
                for (int r = 0; r < 16; ++r) { const int kofs = (r & 3) + 8 * (r >> 2); p0[r] = tp[-kofs]; p1[r] = tp[-kofs - 32]; }
            } else { const int dq = q - 64 * t - 4 * hi;
                if (64 * t + 63 + 790 <= qw) { const float c31 = tab[1023];
#pragma unroll
                    for (int r = 0; r < 16; ++r) { p0[r] = c31; p1[r] = c31; } }
                else {
#pragma unroll
                    for (int r = 0; r < 16; ++r) { const int kofs = (r & 3) + 8 * (r >> 2); const int d0_ = dq - kofs, d1_ = dq - kofs - 32;
                        p0[r] = tab[d0_ < 0 ? 0 : (d0_ > 1023 ? 1023 : d0_)]; p1[r] = tab[d1_ < 0 ? 0 : (d1_ > 1023 ? 1023 : d1_)]; } }
            }
#pragma unroll
            for (int d0 = 0; d0 < 4; ++d0) {
                const bf16x8 a0 = *(const bf16x8*)(Ks + r32 * 128 + (((2 * d0 + hi) ^ ((r32 >> 1) & 7)) * 16));
                const bf16x8 a1 = *(const bf16x8*)(Ks + (32 + r32) * 128 + (((2 * d0 + hi) ^ ((r32 >> 1) & 7)) * 16));
                p0 = __builtin_amdgcn_mfma_f32_32x32x16_bf16(a0, qr[d0], p0, 0, 0, 0);
                p1 = __builtin_amdgcn_mfma_f32_32x32x16_bf16(a1, qr[d0], p1, 0, 0, 0);
            }
            const int kb = 64 * t + 4 * hi;
            if constexpr (MODE == MODE_SWA) {
#pragma unroll
                for (int r = 0; r < 16; ++r) { const int kv = kb + (r & 3) + 8 * (r >> 2); if (kv > q || kv < q - 127) p0[r] = -INFINITY; if (kv + 32 > q || kv + 32 < q - 127) p1[r] = -INFINITY; }
            } else {
                if (64 * t + 63 > qw) {
#pragma unroll
                    for (int r = 0; r < 16; ++r) { const int kv = kb + (r & 3) + 8 * (r >> 2); if (kv > q) p0[r] = -INFINITY; if (kv + 32 > q) p1[r] = -INFINITY; }
                }
                if constexpr (MODE == MODE_MOBA) { if (t < 4 * qb && ((selmask >> (t >> 2)) & 1u) == 0u) {
#pragma unroll
                    for (int r = 0; r < 16; ++r) { p0[r] = -INFINITY; p1[r] = -INFINITY; } } }
            }
            float mx = fmaxf(p0[0], p1[0]);
#pragma unroll
            for (int r = 1; r < 16; ++r) mx = fmaxf(mx, fmaxf(p0[r], p1[r]));
            mx = fmaxf(mx, __shfl_xor(mx, 32));
            const float mn = fmaxf(m, mx);
            if (__builtin_amdgcn_ballot_w64(mn > m) != 0ull) {
                const float alpha = __builtin_amdgcn_exp2f(m - mn); l *= alpha;
#pragma unroll
                for (int r = 0; r < 16; ++r) { o0[r] *= alpha; o1[r] *= alpha; }
            }
            m = mn;
            float sum = 0.f;
#pragma unroll
            for (int r = 0; r < 16; ++r) { p0[r] = __builtin_amdgcn_exp2f(p0[r] - mn); p1[r] = __builtin_amdgcn_exp2f(p1[r] - mn); sum += p0[r] + p1[r]; }
            l += sum;
            bf16x8 pa[4];
#pragma unroll
            for (int ks = 0; ks < 4; ++ks) { uint4 w;
                if (ks < 2) { w.x = cvtpk(p0[8 * ks], p0[8 * ks + 1]); w.y = cvtpk(p0[8 * ks + 2], p0[8 * ks + 3]); w.z = cvtpk(p0[8 * ks + 4], p0[8 * ks + 5]); w.w = cvtpk(p0[8 * ks + 6], p0[8 * ks + 7]); }
                else { const int k2 = ks - 2; w.x = cvtpk(p1[8 * k2], p1[8 * k2 + 1]); w.y = cvtpk(p1[8 * k2 + 2], p1[8 * k2 + 3]); w.z = cvtpk(p1[8 * k2 + 4], p1[8 * k2 + 5]); w.w = cvtpk(p1[8 * k2 + 6], p1[8 * k2 + 7]); }
                pa[ks] = __builtin_bit_cast(bf16x8, w); }
#pragma unroll
            for (int ks = 0; ks < 4; ++ks) {
#pragma unroll
                for (int db = 0; db < 2; ++db) {
                    const LASC unsigned char* vp = (const LASC unsigned char*)(Vt + vtr_off + ks * 16 * 128 + ((db ^ ((lane >> 3) & 1)) * 64));
                    const s16x4 lo = __builtin_bit_cast(s16x4, __builtin_amdgcn_ds_read_tr16_b64_v4i16((LASC v4i16_t*)vp));
                    const s16x4 hh = __builtin_bit_cast(s16x4, __builtin_amdgcn_ds_read_tr16_b64_v4i16((LASC v4i16_t*)(vp + 8 * 128)));
                    const bf16x8 vf = {lo[0], lo[1], lo[2], lo[3], hh[0], hh[1], hh[2], hh[3]};
                    if (db == 0) o0 = __builtin_amdgcn_mfma_f32_32x32x16_bf16(vf, pa[ks], o0, 0, 0, 0);
                    else o1 = __builtin_amdgcn_mfma_f32_32x32x16_bf16(vf, pa[ks], o1, 0, 0, 0); }
            }
            started = true;
        }
        }
        if constexpr (MODE == MODE_FOX) {
            const float eb = ((const float*)(lds + OFF_EB))[st * 2 + 1];
            if (__syncthreads_and((started && (qkb + eb - m < -FOX_THR)) ? 1 : 0)) break;
        } else __syncthreads();
    }
    if constexpr (MODE == MODE_FOX) __syncthreads();
#undef ATT_LOAD
#undef ATT_STORE
#undef ATT_LOAD1
#undef ATT_STORE1
#undef ATT_TI
    l += __shfl_xor(l, 32);
    float inv = 1.0f / l;
    bf16_t* op = PROJ + (rowbase + q) * NPROJ + qcol + hq * 64 + 4 * hi;
    if (dry && inv != 123.4567f) return;
    if constexpr (MODE == MODE_MOWN) {
        const unsigned sel = ((const unsigned*)AUX)[(size_t)(b * 8 + hq) * SEQ + q]; const int cnt = (int)((sel >> 15) & 3u);
        const float* pl = (const float*)ex1 + ((rowbase + q) * 8 + hq) * 4;
        float R = m + __builtin_amdgcn_logf(l), wsum = 1.f;
#pragma unroll
        for (int r = 0; r < 16; ++r) { o0[r] *= inv; o1[r] *= inv; }
#pragma unroll 1
        for (int sl = 0; sl < cnt; ++sl) {
            const float ls = pl[sl]; const float Rn = fmaxf(R, ls), sc = __builtin_amdgcn_exp2f(R - Rn), ws_ = __builtin_amdgcn_exp2f(ls - Rn);
            const bf16_t* pp = (sl < 2) ? PROJ + (rowbase + q) * NPROJ + PC_XBC + (hq * 2 + sl) * 64 + 4 * hi : (const bf16_t*)ex0 + ((rowbase + q) * 8 + hq) * 64 + 4 * hi;
#pragma unroll
            for (int g = 0; g < 4; ++g) { const uint2 a0 = *(const uint2*)(pp + 8 * g), a1 = *(const uint2*)(pp + 32 + 8 * g);
                o0[4 * g] = o0[4 * g] * sc + ws_ * bflo(a0.x); o0[4 * g + 1] = o0[4 * g + 1] * sc + ws_ * bfhi(a0.x); o0[4 * g + 2] = o0[4 * g + 2] * sc + ws_ * bflo(a0.y); o0[4 * g + 3] = o0[4 * g + 3] * sc + ws_ * bfhi(a0.y);
                o1[4 * g] = o1[4 * g] * sc + ws_ * bflo(a1.x); o1[4 * g + 1] = o1[4 * g + 1] * sc + ws_ * bfhi(a1.x); o1[4 * g + 2] = o1[4 * g + 2] * sc + ws_ * bflo(a1.y); o1[4 * g + 3] = o1[4 * g + 3] * sc + ws_ * bfhi(a1.y); }
            wsum = wsum * sc + ws_; R = Rn;
        }
        inv = 1.0f / wsum;
    }
#pragma unroll
    for (int g = 0; g < 4; ++g) {
        *(uint2*)(op + 8 * g) = make_uint2(cvtpk(o0[4 * g] * inv, o0[4 * g + 1] * inv), cvtpk(o0[4 * g + 2] * inv, o0[4 * g + 3] * inv));
        *(uint2*)(op + 32 + 8 * g) = make_uint2(cvtpk(o1[4 * g] * inv, o1[4 * g + 1] * inv), cvtpk(o1[4 * g + 2] * inv, o1[4 * g + 3] * inv));
    }
}
}
namespace ssd {
using att::bf16x8; using att::s16x4; using att::f32x16; using att::cvtpk; using att::LOG2E;
#define LASC __attribute__((address_space(3)))
constexpr int STB = 40960;
constexpr int OFF_AL2 = 2 * STB, OFF_DTV = OFF_AL2 + 1024, OFF_E = OFF_DTV + 1024, OFF_HIN = 0;
__device__ __forceinline__ float chunk_scan(unsigned char* lds, const float* DT, size_t row0, int h, float A, int tid) {
    float* al = (float*)(lds + OFF_AL2); float* dtv = (float*)(lds + OFF_DTV);
    if (tid < 256) { const float d = DT[(row0 + tid) * 8 + h]; dtv[tid] = d; al[tid] = d * A; }
    __syncthreads();
    if (tid < 64) { const float4 a4 = *(const float4*)(al + 4 * tid); const float s = (a4.x + a4.y) + (a4.z + a4.w); float incl = s;
#pragma unroll
        for (int o = 1; o < 64; o <<= 1) { const float v = __shfl_up(incl, o); if (tid >= o) incl += v; }
        const float base = incl - s; float4 c4; c4.x = base + a4.x; c4.y = c4.x + a4.y; c4.z = c4.y + a4.z; c4.w = c4.z + a4.w; *(float4*)(al + 4 * tid) = c4; }
    __syncthreads();
    return al[255];
}
__device__ __forceinline__ void m1_unit(unsigned char* lds, bf16_t* XC, const float* DT, const float* a_log, const float* d_skip, bf16_t* STATES, float* CDEC, int b, int c, int h) {
    const int tid = ltid(), lane = tid & 63, wave = __builtin_amdgcn_readfirstlane(tid >> 6), r32 = lane & 31, hi = lane >> 5, g = h >> 2;
    const size_t row0 = (size_t)b * SEQ + c * 256; const int l = wave * 32 + r32;
    const float A = -expf(a_log[h]);
    float* al = (float*)(lds + OFF_AL2); float* dtv = (float*)(lds + OFF_DTV); float* ev = (float*)(lds + OFF_E);
    const float alast = chunk_scan(lds, DT, row0, h, A, tid);
    float myac = 0.f; if (tid < 256) myac = al[tid];
    __syncthreads();
    if (tid < 256) { ev[tid] = expf(alast - myac); al[tid] = myac * LOG2E; }
    if (tid == 0) CDEC[(b * 32 + c) * 8 + h] = expf(alast);
    __syncthreads();
    const float al_l = al[l];
    bf16x8 cfr[8];
    { const bf16_t* cp = XC + (row0 + l) * 1024 + 768 + g * 128 + 8 * hi;
#pragma unroll
      for (int k0 = 0; k0 < 8; ++k0) cfr[k0] = *(const bf16x8*)(cp + 16 * k0); }
    f32x16 o0, o1, sacc;
#pragma unroll
    for (int r = 0; r < 16; ++r) { o0[r] = 0.f; o1[r] = 0.f; sacc[r] = 0.f; }
    const int ss = tid >> 3, pc = tid & 7;
    const bf16_t* bg = XC + (row0 + ss) * 1024 + 512 + g * 128 + 16 * pc;
    const bf16_t* xg = XC + (row0 + ss) * 1024 + h * 64 + 8 * pc;
    uint4 b0r, b1r, xr;
#define SSD_LOAD(t) do { b0r = *(const uint4*)(bg + (size_t)(t) * 64 * 1024); b1r = *(const uint4*)(bg + (size_t)(t) * 64 * 1024 + 8); xr = *(const uint4*)(xg + (size_t)(t) * 64 * 1024); } while (0)
#define SSD_SC2(w, f) cvtpk(bflo(w) * (f), bfhi(w) * (f))
#define SSD_STORE(st, t) do { unsigned char* sb_ = lds + (st) * STB; \
        *(uint4*)(sb_ + ss * 256 + (((2 * pc) ^ (ss & 15)) * 16)) = b0r; *(uint4*)(sb_ + ss * 256 + (((2 * pc + 1) ^ (ss & 15)) * 16)) = b1r; \
        const float es_ = ev[(t) * 64 + ss], ds_ = dtv[(t) * 64 + ss]; \
        *(uint4*)(sb_ + 16384 + ss * 256 + pc * 32) = make_uint4(SSD_SC2(b0r.x, es_), SSD_SC2(b0r.y, es_), SSD_SC2(b0r.z, es_), SSD_SC2(b0r.w, es_));         \
        *(uint4*)(sb_ + 16384 + ss * 256 + pc * 32 + 16) = make_uint4(SSD_SC2(b1r.x, es_), SSD_SC2(b1r.y, es_), SSD_SC2(b1r.z, es_), SSD_SC2(b1r.w, es_)); \
        *(uint4*)(sb_ + 32768 + ss * 128 + pc * 16) = make_uint4(SSD_SC2(xr.x, ds_), SSD_SC2(xr.y, ds_), SSD_SC2(xr.z, ds_), SSD_SC2(xr.w, ds_)); } while (0)
    SSD_LOAD(0); SSD_STORE(0, 0);
    __syncthreads();
    const int nb = wave >> 1, pb = wave & 1;
    const int trx = ((lane & 15) >> 2) * 128 + (16 * ((lane >> 4) & 1) + 4 * (lane & 3)) * 2, trb = ((lane & 15) >> 2) * 256 + (16 * ((lane >> 4) & 1) + 4 * (lane & 3)) * 2;
#pragma unroll 1
    for (int t = 0; t < 4; ++t) {
        const int st = t & 1;
        if (t + 1 < 4) SSD_LOAD(t + 1);
        const unsigned char* Bs = lds + st * STB; const unsigned char* Bt = Bs + 16384; const unsigned char* Xt = Bs + 32768;
        if (64 * t <= wave * 32 + 31) {
            f32x16 p0, p1;
#pragma unroll
            for (int r = 0; r < 16; ++r) { p0[r] = 0.f; p1[r] = 0.f; }
#pragma unroll
            for (int k0 = 0; k0 < 8; ++k0) {
                const bf16x8 a0 = *(const bf16x8*)(Bs + r32 * 256 + (((2 * k0 + hi) ^ (r32 & 15)) * 16));
                const bf16x8 a1 = *(const bf16x8*)(Bs + (32 + r32) * 256 + (((2 * k0 + hi) ^ (r32 & 15)) * 16));
                p0 = __builtin_amdgcn_mfma_f32_32x32x16_bf16(a0, cfr[k0], p0, 0, 0, 0);
                p1 = __builtin_amdgcn_mfma_f32_32x32x16_bf16(a1, cfr[k0], p1, 0, 0, 0);
            }
#pragma unroll
            for (int gq = 0; gq < 4; ++gq) { const int sb0 = 64 * t + 8 * gq + 4 * hi;
                const float4 s0 = *(const float4*)(al + sb0), s1 = *(const float4*)(al + sb0 + 32);
                const float a0[4] = {s0.x, s0.y, s0.z, s0.w}, a1[4] = {s1.x, s1.y, s1.z, s1.w};
#pragma unroll
                for (int e = 0; e < 4; ++e) { const int r = 4 * gq + e;
                    p0[r] = (sb0 + e <= l) ? p0[r] * __builtin_amdgcn_exp2f(al_l - a0[e]) : 0.f;
                    p1[r] = (sb0 + 32 + e <= l) ? p1[r] * __builtin_amdgcn_exp2f(al_l - a1[e]) : 0.f; } }
            bf16x8 pa[4];
#pragma unroll
            for (int ks = 0; ks < 4; ++ks) { uint4 w;
                if (ks < 2) { w.x = cvtpk(p0[8 * ks], p0[8 * ks + 1]); w.y = cvtpk(p0[8 * ks + 2], p0[8 * ks + 3]); w.z = cvtpk(p0[8 * ks + 4], p0[8 * ks + 5]); w.w = cvtpk(p0[8 * ks + 6], p0[8 * ks + 7]); }
                else { const int k2 = ks - 2; w.x = cvtpk(p1[8 * k2], p1[8 * k2 + 1]); w.y = cvtpk(p1[8 * k2 + 2], p1[8 * k2 + 3]); w.z = cvtpk(p1[8 * k2 + 4], p1[8 * k2 + 5]); w.w = cvtpk(p1[8 * k2 + 6], p1[8 * k2 + 7]); }
                pa[ks] = __builtin_bit_cast(bf16x8, w); }
#pragma unroll
            for (int ks = 0; ks < 4; ++ks) {
#pragma unroll
                for (int db = 0; db < 2; ++db) {
                    const LASC unsigned char* vp = (const LASC unsigned char*)(Xt + trx + 4 * hi * 128 + ks * 16 * 128 + db * 64);
                    const s16x4 lo = __builtin_bit_cast(s16x4, __builtin_amdgcn_ds_read_tr16_b64_v4i16((LASC att::v4i16_t*)vp));
                    const s16x4 hh = __builtin_bit_cast(s16x4, __builtin_amdgcn_ds_read_tr16_b64_v4i16((LASC att::v4i16_t*)(vp + 8 * 128)));
                    const bf16x8 vf = {lo[0], lo[1], lo[2], lo[3], hh[0], hh[1], hh[2], hh[3]};
                    if (db == 0) o0 = __builtin_amdgcn_mfma_f32_32x32x16_bf16(vf, pa[ks], o0, 0, 0, 0);
                    else o1 = __builtin_amdgcn_mfma_f32_32x32x16_bf16(vf, pa[ks], o1, 0, 0, 0); } }
        }
        {
#pragma unroll
            for (int ks = 0; ks < 4; ++ks) {
                const LASC unsigned char* bp = (const LASC unsigned char*)(Bt + trb + (16 * ks + 8 * hi) * 256 + nb * 64);
                const s16x4 a_lo = __builtin_bit_cast(s16x4, __builtin_amdgcn_ds_read_tr16_b64_v4i16((LASC att::v4i16_t*)bp));
                const s16x4 a_hi = __builtin_bit_cast(s16x4, __builtin_amdgcn_ds_read_tr16_b64_v4i16((LASC att::v4i16_t*)(bp + 4 * 256)));
                const LASC unsigned char* xp = (const LASC unsigned char*)(Xt + trx + (16 * ks + 8 * hi) * 128 + pb * 64);
                const s16x4 x_lo = __builtin_bit_cast(s16x4, __builtin_amdgcn_ds_read_tr16_b64_v4i16((LASC att::v4i16_t*)xp));
                const s16x4 x_hi = __builtin_bit_cast(s16x4, __builtin_amdgcn_ds_read_tr16_b64_v4i16((LASC att::v4i16_t*)(xp + 4 * 128)));
                const bf16x8 af = {a_lo[0], a_lo[1], a_lo[2], a_lo[3], a_hi[0], a_hi[1], a_hi[2], a_hi[3]};
                const bf16x8 xf = {x_lo[0], x_lo[1], x_lo[2], x_lo[3], x_hi[0], x_hi[1], x_hi[2], x_hi[3]};
                sacc = __builtin_amdgcn_mfma_f32_32x32x16_bf16(af, xf, sacc, 0, 0, 0);
            }
        }
        if (t + 1 < 4) SSD_STORE(st ^ 1, t + 1);
        __syncthreads();
    }
#undef SSD_LOAD
#undef SSD_STORE
    { const float Dh = d_skip[h]; bf16_t* yp = XC + (row0 + l) * 1024 + h * 64 + 4 * hi;
#pragma unroll
      for (int gq = 0; gq < 4; ++gq) {
          const uint2 x0 = *(const uint2*)(yp + 8 * gq), x1 = *(const uint2*)(yp + 32 + 8 * gq);
          *(uint2*)(yp + 8 * gq) = make_uint2(cvtpk(o0[4 * gq] + Dh * bflo(x0.x), o0[4 * gq + 1] + Dh * bfhi(x0.x)), cvtpk(o0[4 * gq + 2] + Dh * bflo(x0.y), o0[4 * gq + 3] + Dh * bfhi(x0.y)));
          *(uint2*)(yp + 32 + 8 * gq) = make_uint2(cvtpk(o1[4 * gq] + Dh * bflo(x1.x), o1[4 * gq + 1] + Dh * bfhi(x1.x)), cvtpk(o1[4 * gq + 2] + Dh * bflo(x1.y), o1[4 * gq + 3] + Dh * bfhi(x1.y))); } }
    { bf16_t* sp = STATES + ((size_t)((b * 32 + c) * 8 + h)) * 8192 + (size_t)(r32 + 32 * pb) * 128 + 32 * nb + 4 * hi;
#pragma unroll
      for (int gq = 0; gq < 4; ++gq) *(uint2*)(sp + 8 * gq) = make_uint2(cvtpk(sacc[4 * gq], sacc[4 * gq + 1]), cvtpk(sacc[4 * gq + 2], sacc[4 * gq + 3])); }
    __syncthreads();
}
__device__ __forceinline__ void m2_unit(unsigned char* lds, bf16_t* XC, const float* DT, const float* a_log, const bf16_t* STATES, const float* CDEC, int b, int c, int h) {
    if (c == 0) return;
    const int tid = ltid(), lane = tid & 63, wave = __builtin_amdgcn_readfirstlane(tid >> 6), r32 = lane & 31, hi = lane >> 5, g = h >> 2;
    const size_t row0 = (size_t)b * SEQ + c * 256; const int l = wave * 32 + r32;
    const float A = -expf(a_log[h]);
    float* al = (float*)(lds + OFF_AL2);
    (void)chunk_scan(lds, DT, row0, h, A, tid);
    const float ea = expf(al[l]);
    float4 hin[4];
#pragma unroll
    for (int j = 0; j < 4; ++j) hin[j] = make_float4(0.f, 0.f, 0.f, 0.f);
    const bf16_t* sbase = STATES + ((size_t)((b * 32) * 8 + h)) * 8192 + 4 * tid;
    for (int c0 = 0; c0 < c; c0 += 4) {
        uint2 sv[4][4]; float dec[4];
#pragma unroll
        for (int k = 0; k < 4; ++k) { const int cc = (c0 + k < c) ? c0 + k : c - 1; dec[k] = CDEC[(b * 32 + cc) * 8 + h];
#pragma unroll
            for (int j = 0; j < 4; ++j) sv[k][j] = *(const uint2*)(sbase + (size_t)cc * 8 * 8192 + 2048 * j); }
#pragma unroll
        for (int k = 0; k < 4; ++k) if (c0 + k < c) {
#pragma unroll
            for (int j = 0; j < 4; ++j) { hin[j].x = hin[j].x * dec[k] + bflo(sv[k][j].x); hin[j].y = hin[j].y * dec[k] + bfhi(sv[k][j].x); hin[j].z = hin[j].z * dec[k] + bflo(sv[k][j].y); hin[j].w = hin[j].w * dec[k] + bfhi(sv[k][j].y); } } }
#pragma unroll
    for (int j = 0; j < 4; ++j) { const int idx = 4 * tid + 2048 * j, p = idx >> 7, n = idx & 127;
        *(uint2*)(lds + OFF_HIN + p * 256 + (((n >> 3) ^ (p & 15)) * 16) + (n & 7) * 2) = make_uint2(cvtpk(hin[j].x, hin[j].y), cvtpk(hin[j].z, hin[j].w)); }
    __syncthreads();
    bf16x8 cfr[8];
    { const bf16_t* cp = XC + (row0 + l) * 1024 + 768 + g * 128 + 8 * hi;
#pragma unroll
      for (int k0 = 0; k0 < 8; ++k0) cfr[k0] = *(const bf16x8*)(cp + 16 * k0); }
    f32x16 o0, o1;
#pragma unroll
    for (int r = 0; r < 16; ++r) { o0[r] = 0.f; o1[r] = 0.f; }
#pragma unroll
    for (int k0 = 0; k0 < 8; ++k0) {
        const bf16x8 h0 = *(const bf16x8*)(lds + OFF_HIN + r32 * 256 + (((2 * k0 + hi) ^ (r32 & 15)) * 16));
        const bf16x8 h1 = *(const bf16x8*)(lds + OFF_HIN + (32 + r32) * 256 + (((2 * k0 + hi) ^ (r32 & 15)) * 16));
        o0 = __builtin_amdgcn_mfma_f32_32x32x16_bf16(h0, cfr[k0], o0, 0, 0, 0);
        o1 = __builtin_amdgcn_mfma_f32_32x32x16_bf16(h1, cfr[k0], o1, 0, 0, 0);
    }
    { bf16_t* yp = XC + (row0 + l) * 1024 + h * 64 + 4 * hi;
#pragma unroll
      for (int gq = 0; gq < 4; ++gq) {
          const uint2 y0 = *(const uint2*)(yp + 8 * gq), y1 = *(const uint2*)(yp + 32 + 8 * gq);
          *(uint2*)(yp + 8 * gq) = make_uint2(cvtpk(bflo(y0.x) + ea * o0[4 * gq], bfhi(y0.x) + ea * o0[4 * gq + 1]), cvtpk(bflo(y0.y) + ea * o0[4 * gq + 2], bfhi(y0.y) + ea * o0[4 * gq + 3]));
          *(uint2*)(yp + 32 + 8 * gq) = make_uint2(cvtpk(bflo(y1.x) + ea * o1[4 * gq], bfhi(y1.x) + ea * o1[4 * gq + 1]), cvtpk(bflo(y1.y) + ea * o1[4 * gq + 2], bfhi(y1.y) + ea * o1[4 * gq + 3])); } }
    __syncthreads();
}
}

__device__ __forceinline__ void moba_select_unit(unsigned char* lds, const bf16_t* PROJ, const float* KMEAN, unsigned* SEL, int b, int h, int qb) {
    const int tid = ltid(), lane = tid & 63, hf = lane & 1;
    const int q = qb * 256 + (tid >> 1);
    float* km_s = (float*)lds;
    { const int n = tid >> 4, c4 = (tid & 15) * 4; *(float4*)(km_s + n * 64 + c4) = *(const float4*)(KMEAN + ((size_t)(b * 32 + n)) * 512 + h * 64 + c4); }
    __syncthreads();
    const bf16_t* qp = PROJ + ((size_t)b * SEQ + q) * NPROJ + PC_MQ + h * 64 + hf * 32;
    float qv[32];
#pragma unroll
    for (int c = 0; c < 4; ++c) { const uint4 u = *(const uint4*)(qp + c * 8);
        qv[c * 8 + 0] = bflo(u.x); qv[c * 8 + 1] = bfhi(u.x); qv[c * 8 + 2] = bflo(u.y); qv[c * 8 + 3] = bfhi(u.y); qv[c * 8 + 4] = bflo(u.z); qv[c * 8 + 5] = bfhi(u.z); qv[c * 8 + 6] = bflo(u.w); qv[c * 8 + 7] = bfhi(u.w); }
    float g0 = -INFINITY, g1 = -INFINITY, g2 = -INFINITY; int i0 = 31, i1 = 31, i2 = 31;
    for (int n = 0; n < qb; ++n) {
        const float* km = km_s + n * 64 + hf * 32; float g = 0.f;
#pragma unroll
        for (int c = 0; c < 8; ++c) { const float4 k4 = *(const float4*)(km + 4 * c); g += qv[4 * c] * k4.x + qv[4 * c + 1] * k4.y + qv[4 * c + 2] * k4.z + qv[4 * c + 3] * k4.w; }
        g += __shfl_xor(g, 1);
        if (g > g0) { g2 = g1; i2 = i1; g1 = g0; i1 = i0; g0 = g; i0 = n; }
        else if (g > g1) { g2 = g1; i2 = i1; g1 = g; i1 = n; }
        else if (g > g2) { g2 = g; i2 = n; }
    }
    const int cnt = qb < 3 ? qb : 3;
    if (hf == 0) SEL[(size_t)(b * 8 + h) * SEQ + q] = (unsigned)i0 | ((unsigned)i1 << 5) | ((unsigned)i2 << 10) | ((unsigned)cnt << 15);
    __syncthreads();
}
namespace gat { constexpr int OFF_LIST = 65536, OFF_TABG = 98304, OFF_CNT = 102400; }
__device__ __forceinline__ void moba_gather_unit(unsigned char* lds, bf16_t* PROJ, const unsigned* SEL, const float* btab, bf16_t* PO2, float* PL, int b, int h, int j, int qc) {
    using namespace att;
    const int tid = ltid(), lane = tid & 63, wave = __builtin_amdgcn_readfirstlane(tid >> 6), r32 = lane & 31, hi = lane >> 5;
    const size_t rowbase = (size_t)b * SEQ;
    float* tab = (float*)(lds + gat::OFF_TABG); unsigned* list = (unsigned*)(lds + gat::OFF_LIST); unsigned* cntp = (unsigned*)(lds + gat::OFF_CNT);
    for (int d = tid; d < 1024; d += NT) tab[d] = btab[rel_bucket(d) * 16 + h] * LOG2E;
    if (tid == 0) *cntp = 0u;
    { const int skey = tid >> 3, sch = tid & 7;
#pragma unroll
      for (int t = 0; t < 4; ++t) { const bf16_t* kp = PROJ + (rowbase + j * 256 + t * 64 + skey) * NPROJ + h * 64 + sch * 8;
          *(uint4*)(lds + t * ST_BYTES + skey * 128 + ((sch ^ ((skey >> 1) & 7)) * 16)) = *(const uint4*)(kp + PC_MK);
          *(uint4*)(lds + t * ST_BYTES + 8192 + skey * 128 + ((sch ^ (((skey >> 1) & 1) << 2)) * 16)) = *(const uint4*)(kp + PC_MV); } }
    __syncthreads();
    for (int half = 0; half < 2; ++half) {
        const int qf = 4096 * qc + 2048 * half + 4 * tid, qmin = 256 * (j + 1);
        const uint4 sv4 = *(const uint4*)(SEL + (size_t)(b * 8 + h) * SEQ + qf); const unsigned sv[4] = {sv4.x, sv4.y, sv4.z, sv4.w};
#pragma unroll
        for (int e = 0; e < 4; ++e) { int slot = -1; const int cnt = (int)((sv[e] >> 15) & 3u);
            if (qf + e >= qmin) { if ((int)(sv[e] & 31u) == j && cnt > 0) slot = 0; else if ((int)((sv[e] >> 5) & 31u) == j && cnt > 1) slot = 1; else if ((int)((sv[e] >> 10) & 31u) == j && cnt > 2) slot = 2; }
            const unsigned long long bal = __builtin_amdgcn_ballot_w64(slot >= 0);
            unsigned pos = 0u;
            if (lane == 0 && bal) pos = atomicAdd(cntp, (unsigned)__builtin_popcountll(bal));
            pos = __shfl(pos, 0);
            if (slot >= 0) list[pos + __builtin_popcountll(bal & ((1ull << lane) - 1ull))] = (unsigned)(qf + e) | ((unsigned)slot << 13); }
    }
    __syncthreads();
    const int n = (int)*cntp, ngroups = (n + 31) >> 5;
    const int vtr_off = ((lane & 15) >> 2) * 128 + (16 * ((lane >> 4) & 1) + 4 * (lane & 3)) * 2 + 4 * hi * 128;
    for (int grp = wave; grp < ngroups; grp += 8) {
        const int ei = 32 * grp + r32; const bool valid = ei < n; const unsigned ent = list[valid ? ei : n - 1];
        const int q = (int)(ent & 8191u), slot = (int)(ent >> 13);
        bf16x8 qr[4];
        { const bf16_t* qp = PROJ + (rowbase + q) * NPROJ + PC_MQ + h * 64 + 8 * hi;
#pragma unroll
          for (int d0 = 0; d0 < 4; ++d0) { const uint4 u = *(const uint4*)(qp + 16 * d0);
              uint4 w; w.x = cvtpk(bflo(u.x) * C2, bfhi(u.x) * C2); w.y = cvtpk(bflo(u.y) * C2, bfhi(u.y) * C2); w.z = cvtpk(bflo(u.z) * C2, bfhi(u.z) * C2); w.w = cvtpk(bflo(u.w) * C2, bfhi(u.w) * C2);
              qr[d0] = __builtin_bit_cast(bf16x8, w); } }
        f32x16 o0, o1;
#pragma unroll
        for (int r = 0; r < 16; ++r) { o0[r] = 0.f; o1[r] = 0.f; }
        float m = -1e30f, l = 0.f;
#pragma unroll 1
        for (int t = 0; t < 4; ++t) {
            const unsigned char* Ks = lds + t * ST_BYTES; const unsigned char* Vt = Ks + 8192;
            const int key0 = j * 256 + t * 64; f32x16 p0, p1;
            { const int dq = q - key0 - 4 * hi;
              if (__builtin_amdgcn_ballot_w64(q - (key0 + 63) >= 790) == ~0ull) { const float c31 = tab[1023];
#pragma unroll
                  for (int r = 0; r < 16; ++r) { p0[r] = c31; p1[r] = c31; } }
              else {
#pragma unroll
                  for (int r = 0; r < 16; ++r) { const int kofs = (r & 3) + 8 * (r >> 2); const int d0_ = dq - kofs, d1_ = dq - kofs - 32;
                      p0[r] = tab[d0_ > 1023 ? 1023 : d0_]; p1[r] = tab[d1_ > 1023 ? 1023 : d1_]; } } }
#pragma unroll
            for (int d0 = 0; d0 < 4; ++d0) {
                const bf16x8 a0 = *(const bf16x8*)(Ks + r32 * 128 + (((2 * d0 + hi) ^ ((r32 >> 1) & 7)) * 16));
                const bf16x8 a1 = *(const bf16x8*)(Ks + (32 + r32) * 128 + (((2 * d0 + hi) ^ ((r32 >> 1) & 7)) * 16));
                p0 = __builtin_amdgcn_mfma_f32_32x32x16_bf16(a0, qr[d0], p0, 0, 0, 0);
                p1 = __builtin_amdgcn_mfma_f32_32x32x16_bf16(a1, qr[d0], p1, 0, 0, 0);
            }
            float mx = fmaxf(p0[0], p1[0]);
#pragma unroll
            for (int r = 1; r < 16; ++r) mx = fmaxf(mx, fmaxf(p0[r], p1[r]));
            mx = fmaxf(mx, __shfl_xor(mx, 32));
            const float mn = fmaxf(m, mx);
            if (__builtin_amdgcn_ballot_w64(mn > m) != 0ull) {
                const float alpha = __builtin_amdgcn_exp2f(m - mn); l *= alpha;
#pragma unroll
                for (int r = 0; r < 16; ++r) { o0[r] *= alpha; o1[r] *= alpha; }
            }
            m = mn;
            float sum = 0.f;
#pragma unroll
            for (int r = 0; r < 16; ++r) { p0[r] = __builtin_amdgcn_exp2f(p0[r] - mn); p1[r] = __builtin_amdgcn_exp2f(p1[r] - mn); sum += p0[r] + p1[r]; }
            l += sum;
            bf16x8 pa[4];
#pragma unroll
            for (int ks = 0; ks < 4; ++ks) { uint4 w;
                if (ks < 2) { w.x = cvtpk(p0[8 * ks], p0[8 * ks + 1]); w.y = cvtpk(p0[8 * ks + 2], p0[8 * ks + 3]); w.z = cvtpk(p0[8 * ks + 4], p0[8 * ks + 5]); w.w = cvtpk(p0[8 * ks + 6], p0[8 * ks + 7]); }
                else { const int k2 = ks - 2; w.x = cvtpk(p1[8 * k2], p1[8 * k2 + 1]); w.y = cvtpk(p1[8 * k2 + 2], p1[8 * k2 + 3]); w.z = cvtpk(p1[8 * k2 + 4], p1[8 * k2 + 5]); w.w = cvtpk(p1[8 * k2 + 6], p1[8 * k2 + 7]); }
                pa[ks] = __builtin_bit_cast(bf16x8, w); }
#pragma unroll
            for (int ks = 0; ks < 4; ++ks) {
#pragma unroll
                for (int db = 0; db < 2; ++db) {
                    const LASC unsigned char* vp = (const LASC unsigned char*)(Vt + vtr_off + ks * 16 * 128 + ((db ^ ((lane >> 3) & 1)) * 64));
                    const s16x4 lo = __builtin_bit_cast(s16x4, __builtin_amdgcn_ds_read_tr16_b64_v4i16((LASC v4i16_t*)vp));
                    const s16x4 hh = __builtin_bit_cast(s16x4, __builtin_amdgcn_ds_read_tr16_b64_v4i16((LASC v4i16_t*)(vp + 8 * 128)));
                    const bf16x8 vf = {lo[0], lo[1], lo[2], lo[3], hh[0], hh[1], hh[2], hh[3]};
                    if (db == 0) o0 = __builtin_amdgcn_mfma_f32_32x32x16_bf16(vf, pa[ks], o0, 0, 0, 0);
                    else o1 = __builtin_amdgcn_mfma_f32_32x32x16_bf16(vf, pa[ks], o1, 0, 0, 0); }
            }
        }
        l += __shfl_xor(l, 32);
        const float inv = 1.0f / l;
        if (valid) {
            bf16_t* pp = (slot < 2) ? PROJ + (rowbase + q) * NPROJ + PC_XBC + (h * 2 + slot) * 64 + 4 * hi : PO2 + ((rowbase + q) * 8 + h) * 64 + 4 * hi;
#pragma unroll
            for (int g = 0; g < 4; ++g) {
                *(uint2*)(pp + 8 * g) = make_uint2(cvtpk(o0[4 * g] * inv, o0[4 * g + 1] * inv), cvtpk(o0[4 * g + 2] * inv, o0[4 * g + 3] * inv));
                *(uint2*)(pp + 32 + 8 * g) = make_uint2(cvtpk(o1[4 * g] * inv, o1[4 * g + 1] * inv), cvtpk(o1[4 * g + 2] * inv, o1[4 * g + 3] * inv)); }
            if (hi == 0) PL[((rowbase + q) * 8 + h) * 4 + slot] = m + __builtin_amdgcn_logf(l);
        }
    }
    __syncthreads();
}
#define MIX_WS ({ unsigned char* p_ = ws0; asm volatile("" : "+s"(p_)); p_; })
#define QUEUE_NEXT(u, word) do { if (tid == 0) *(volatile unsigned*)(lds + 131072 + 64) = atomicAdd((unsigned*)(MIX_WS + WS_CTL + 32768) + 64 * (word), 1u); \
        __syncthreads(); u = *(volatile unsigned*)(lds + 131072 + 64); __syncthreads(); } while (0)
__device__ __forceinline__ void ph_mixers(unsigned char* lds, unsigned char* ws0, const float* a_log, const float* d_skip, const float* sinks, const float* btab, int l) {
    const int tid = ltid();
    bool swa_ok = false;
    for (;;) {
        unsigned u; QUEUE_NEXT(u, 3 * l);
        if (u >= 2048u + 64u) break;
        if (u < 64u) {
            unsigned char* ws = MIX_WS;
            pg8::OneSched S; S.u0.A = (const char*)P_XN(ws) + (size_t)u * 256 * (D * 2); S.u0.B = (const char*)(ws + WS_WIN) + (size_t)INP_TILES * 256 * (D * 2);
            S.u0.lda2 = D * 2; S.u0.ldb2 = D * 2; S.u0.nt = D / 64; S.u0.pm = (int)u; S.u0.pn = INP_TILES; S.u0.aux = 0;
            pg8::EpiStoreBf16 E{P_PROJ(ws), NPROJ}; pg8::gemm_phase<pg8::EpiStoreBf16, pg8::OneSched, true>((LAS unsigned char*)lds, S, E);
            if (tid == 0) { __builtin_amdgcn_fence(__ATOMIC_RELEASE, "agent"); asm volatile("s_waitcnt vmcnt(0)" ::: "memory"); (void)q_add((unsigned*)(ws + WS_CTL + 32768) + 64 * (6 + l), 1u); }
            continue;
        }
        u -= 64u;
        const int k = (int)(u & 511u);
        if (u < 512u) { const int qb = 31 - (k >> 4), bh = k & 15; unsigned char* ws = MIX_WS;
            att::attn_unit<att::MODE_FOX>(lds, P_PROJ(ws), (const float*)(ws + WS_LF), (const float*)(ws + WS_CUM), 0, 0.f, bh >> 3, bh & 7, bh & 7, qb, PC_FQ, PC_FK, PC_FV); }
        else if (u < 1024u) { unsigned char* ws = MIX_WS; ssd::m1_unit(lds, P_XC(ws), (const float*)(ws + WS_DT), a_log, d_skip, (bf16_t*)(ws + WS_STATES), (float*)(ws + WS_CDEC), k >> 8, (k >> 3) & 31, k & 7); }
        else if (u < 1536u) { const int bh = k >> 5, qb = k & 31, hq = bh & 7; unsigned char* ws = MIX_WS;
            if (!swa_ok) {
                if (tid == 0) { unsigned sp = 0; while (q_ld((unsigned*)(ws + WS_CTL + 32768) + 64 * (6 + l)) < 64u) { __builtin_amdgcn_s_sleep(2); if (++sp > (1u << 22)) break; } }
                __syncthreads();
                __builtin_amdgcn_fence(__ATOMIC_ACQUIRE, "agent"); asm volatile("s_waitcnt vmcnt(0)" ::: "memory");
                __syncthreads();
                swa_ok = true; }
            att::attn_unit<att::MODE_SWA>(lds, P_PROJ(ws), nullptr, btab, 8 + hq, sinks[hq], bh >> 3, hq, hq >> 2, qb, PC_SQ, PC_SK, PC_SV); }
        else { const int qb = 31 - (k >> 4), bh = k & 15; unsigned char* ws = MIX_WS;
            moba_select_unit(lds, P_PROJ(ws), (const float*)(ws + WS_KMEAN), (unsigned*)(ws + WS_SEL), bh >> 3, bh & 7, qb); }
    }
}
__device__ __forceinline__ void ph_mixers_b(unsigned char* lds, unsigned char* ws0, const float* a_log, const float* btab, int l, const float* const* in) {
    const int tid = ltid();
    for (;;) {
        unsigned u; QUEUE_NEXT(u, 3 * l + 1);
        if (u >= 736u + 512u + (unsigned)((WCV_ALL - WCV_IN) / WCV_CHUNK)) break;
        if (u >= 736u + 512u) {
            const int lo = WCV_IN + (int)(u - (736u + 512u)) * WCV_CHUNK; unsigned char* ws = MIX_WS;
            ph_wconv(ws, in[1] + (size_t)l * D * DIN, in[11] + (size_t)l * 4 * 512 * 1024, in[12] + (size_t)l * D * D, in[15] + (size_t)l * D * DFF, in[16] + (size_t)l * D * DFF, in[17] + (size_t)l * DFF * D,
                     (LAS float*)lds, lo, lo + WCV_CHUNK, 0, 1);
            continue; }
        if (u < 736u) { const int bh = (int)u & 15, idx = (int)u >> 4;
            const int qc = idx < 15 ? 0 : 1, j = idx - (qc == 0 ? 0 : 15); unsigned char* ws = MIX_WS;
            moba_gather_unit(lds, P_PROJ(ws), (const unsigned*)(ws + WS_SEL), btab, (bf16_t*)(ws + WS_PO2), (float*)(ws + WS_PL), bh >> 3, bh & 7, j, qc); }
        else { const int k = (int)u - 736, c = 31 - (k >> 4), bh = k & 15; unsigned char* ws = MIX_WS;
            ssd::m2_unit(lds, P_XC(ws), (const float*)(ws + WS_DT), a_log, (const bf16_t*)(ws + WS_STATES), (const float*)(ws + WS_CDEC), bh >> 3, c, bh & 7); }
    }
}
__device__ __forceinline__ void ph_mixers_c(unsigned char* lds, unsigned char* ws0, const float* btab, const float* ssm_norm_w, int l) {
    const int tid = ltid();
    for (;;) {
        unsigned u; QUEUE_NEXT(u, 3 * l + 2);
        if (u >= 512u) break;
        const int qb = 31 - ((int)u >> 4), bh = (int)u & 15, h = bh & 7; unsigned char* ws = MIX_WS;
        att::attn_unit<att::MODE_MOWN>(lds, P_PROJ(ws), (const float*)(ws + WS_SEL), btab, h, 0.f, bh >> 3, h, h, qb, PC_MQ, PC_MK, PC_MV, false, (const void*)(ws + WS_PO2), (const void*)(ws + WS_PL));
    }
    { unsigned char* ws = MIX_WS; ph_mamba_norm(P_PROJ(ws), P_XC(ws), ssm_norm_w); }
}
#define XB_TMO      128
#define XB_XCNT(j)  (256  + 64 * (j))
#define XB_XSUB(j)  (1280 + 64 * (j))
#define XB_XGEN(j)  (2304 + 64 * (j))
#define XB_TOP      3328
#define XB_TOPGEN   3392
#define XCD_BAR_WORDS 3456
#define XB_SPIN_CAP (1u << 18)

__device__ __forceinline__ unsigned xb_ld(unsigned* p)              { return __hip_atomic_load(p, __ATOMIC_RELAXED, __HIP_MEMORY_SCOPE_AGENT); }
__device__ __forceinline__ unsigned xb_add(unsigned* p, unsigned v) { return __hip_atomic_fetch_add(p, v, __ATOMIC_RELAXED, __HIP_MEMORY_SCOPE_AGENT); }
__device__ __forceinline__ unsigned xb_xcc_id() { return (unsigned)__builtin_amdgcn_s_getreg((3 << 11) | 20) & 0xFu; }
#define XB_SPIN(cond, bar) do { unsigned _sp = 0; while (cond) { __builtin_amdgcn_s_sleep(1); \
    if ((++_sp & 255u) == 0u) { if (xb_ld(&(bar)[XB_TMO])) break; if (_sp > XB_SPIN_CAP) { atomicAdd(&(bar)[XB_TMO], 1u); break; } } } } while (0)

struct XcdBarrier {
    unsigned* bar; unsigned x;
    volatile LAS unsigned* st;
};

__device__ __forceinline__ XcdBarrier xcd_barrier_post(unsigned* bar, volatile LAS unsigned* st) {
    XcdBarrier b; b.bar = bar; b.x = xb_xcc_id(); b.st = st;
    if (threadIdx.x == 0) (void)xb_add(&bar[XB_XCNT(b.x)], 1u);
    return b;
}
__device__ __forceinline__ void xcd_barrier_complete(unsigned* bar, unsigned x, unsigned& nloc, unsigned& nx) {
    const unsigned G = gridDim.x * gridDim.y * gridDim.z;
    unsigned sum, cnt, mine, sp = 0u;
    for (;;) {
        sum = 0u; cnt = 0u; mine = 0u;
#pragma unroll
        for (unsigned j = 0; j < 16; ++j) { const unsigned c = xb_ld(&bar[XB_XCNT(j)]); sum += c; cnt += (c > 0u) ? 1u : 0u; mine = (j == x) ? c : mine; }
        if (sum == G) break;
        __builtin_amdgcn_s_sleep(1);
        if ((++sp & 255u) == 0u) { if (xb_ld(&bar[XB_TMO])) break; if (sp > XB_SPIN_CAP) { atomicAdd(&bar[XB_TMO], 1u); break; } }
    }
    nloc = mine > 0u ? mine : 1u; nx = cnt > 0u ? cnt : 1u;
}

__device__ __forceinline__ void xcd_barrier(const XcdBarrier& b) {
    asm volatile("s_waitcnt vmcnt(0)" ::: "memory");
    __syncthreads();
    if (threadIdx.x == 0) {
        unsigned* bar = b.bar;
        __builtin_amdgcn_s_waitcnt(0);
        unsigned nloc = b.st[0], nx = b.st[1];
        if (nloc == 0u) { xcd_barrier_complete(bar, b.x, nloc, nx); b.st[0] = nloc; b.st[1] = nx; }
        const unsigned old = xb_add(&bar[XB_XSUB(b.x)], 1u);
        const unsigned gen = old / nloc;
        if (old + 1u == (gen + 1u) * nloc) {
            __builtin_amdgcn_fence(__ATOMIC_RELEASE, "agent");
            asm volatile("s_waitcnt vmcnt(0)" ::: "memory");
            const unsigned og = xb_add(&bar[XB_TOP], 1u);
            const unsigned tg = og / nx;
            if (og + 1u == (tg + 1u) * nx) xb_add(&bar[XB_TOPGEN], 1u);
            else XB_SPIN(xb_ld(&bar[XB_TOPGEN]) == tg, bar);
            __builtin_amdgcn_fence(__ATOMIC_ACQUIRE, "agent");
            xb_add(&bar[XB_XGEN(b.x)], 1u);
            asm volatile("s_waitcnt vmcnt(0)" ::: "memory");
        } else {
            XB_SPIN(xb_ld(&bar[XB_XGEN(b.x)]) == gen, bar);
            __builtin_amdgcn_fence(__ATOMIC_ACQUIRE, "agent");
            asm volatile("s_waitcnt vmcnt(0)" ::: "memory");
        }
    }
    __syncthreads();
}

constexpr int MISC_OFF = 131072 + 320;
constexpr int LDS_BYTES = 147456;
constexpr int HROW_OFF = 69632;
#define GRID_SYNC() xcd_barrier(bar)
#define WSL ({ unsigned char* p_ = a.ws; asm volatile("" : "+s"(p_)); p_; })
__global__ void __launch_bounds__(NT, 2) fwd(Args a) {
    extern __shared__ __attribute__((aligned(16))) unsigned char lds[];
    LAS unsigned char* L = (LAS unsigned char*)lds;
    volatile LAS unsigned* MISC = (volatile LAS unsigned*)(L + MISC_OFF);
    if (threadIdx.x < 32) MISC[threadIdx.x] = 0u;
    __syncthreads();
    XcdBarrier bar = xcd_barrier_post((unsigned*)(a.ws + WS_CTL) + 4096, MISC + 8);
#pragma unroll 1
    for (int l = 0; l < 2; ++l) {
        {
            unsigned char* ws = WSL; const float* xin = (l == 0) ? a.in[0] : a.out; const float* w_in = a.in[1] + (size_t)l * D * DIN;
            ph_wconv(ws, w_in, a.in[11] + (size_t)l * 4 * 512 * 1024, a.in[12] + (size_t)l * D * D, a.in[15] + (size_t)l * D * DFF, a.in[16] + (size_t)l * D * DFF, a.in[17] + (size_t)l * DFF * D, (LAS float*)L, 0, WCV_IN, blockIdx.x, gridDim.x);
            __syncthreads();
            ph_norm((float*)lds, xin, a.in[13] + l * D, P_XN(ws), true, w_in, a.in[4] + l * 8, a.in[8] + l * 8, (float*)(ws + WS_DT), (float*)(ws + WS_LF));
        }
        GRID_SYNC();
        {
            unsigned char* ws = WSL;
            pg8::PlainSched S; S.T.init(M / 256, INP_TILES, gridDim.x, blockIdx.x); S.A = (const char*)P_XN(ws); S.B = (const char*)(ws + WS_WIN); S.lda2 = D * 2; S.ldb2 = D * 2; S.nt = D / 64;
            pg8::EpiStoreBf16 E{P_PROJ(ws), NPROJ}; pg8::gemm_phase<pg8::EpiStoreBf16, pg8::PlainSched, true>(L, S, E);
        }
        GRID_SYNC();
        { unsigned char* ws = WSL; ph_pre(lds, P_PROJ(ws), a.in[2] + (size_t)l * 4 * 1024, a.in[3] + l * 1024, P_XC(ws), (float*)(ws + WS_KMEAN), (float*)(ws + WS_CUM)); }
        GRID_SYNC();
        ph_mixers(lds, a.ws, a.in[5] + l * 8, a.in[6] + l * 8, a.in[9] + l * 8, a.in[10], l);
        GRID_SYNC();
        ph_mixers_b(lds, a.ws, a.in[5] + l * 8, a.in[10], l, a.in);
        GRID_SYNC();
        ph_mixers_c(lds, a.ws, a.in[10], a.in[7] + l * 512, l);
        GRID_SYNC();
        {
            unsigned char* ws = WSL;
            pg8::PlainSched S; S.T.init(M / 256, 4096 / 256, gridDim.x, blockIdx.x); S.A = (const char*)P_XN(ws); S.B = (const char*)(ws + WS_WG); S.lda2 = D * 2; S.ldb2 = D * 2; S.nt = D / 64;
            pg8::EpiGate E{P_PROJ(ws), P_XC(ws)}; pg8::gemm_phase<pg8::EpiGate, pg8::PlainSched, true>(L, S, E);
        }
        GRID_SYNC();
        {
            unsigned char* ws = WSL;
            pg8::BranchSched S; S.T.init(M / 256, D / 256, gridDim.x, blockIdx.x); S.PROJ = (const char*)P_PROJ(ws); S.WBR = (const char*)(ws + WS_WBR);
            pg8::EpiBranch E{P_PROJ(ws), P_XC(ws), P_XN(ws)}; pg8::gemm_phase<pg8::EpiBranch, pg8::BranchSched, true>(L, S, E);
        }
        GRID_SYNC();
        {
            unsigned char* ws = WSL; const float* xin = (l == 0) ? a.in[0] : a.out;
            pg8::PlainSched S; S.T.init(M / 256, D / 256, gridDim.x, blockIdx.x); S.A = (const char*)P_XN(ws); S.B = (const char*)(ws + WS_WOUT); S.lda2 = D * 2; S.ldb2 = D * 2; S.nt = D / 64;
            pg8::EpiResidual E{xin, a.out}; pg8::gemm_phase<pg8::EpiResidual, pg8::PlainSched, false>(L, S, E);
        }
        GRID_SYNC();
        { unsigned char* ws = WSL; ph_norm(nullptr, a.out, a.in[14] + l * D, P_XN(ws), false, nullptr, nullptr, nullptr, nullptr, nullptr); }
        GRID_SYNC();
        {
            unsigned char* ws = WSL;
            pg8::PlainSched S; S.T.init(M / 256, 2 * DFF / 256, gridDim.x, blockIdx.x); S.A = (const char*)P_XN(ws); S.B = (const char*)(ws + WS_WGU); S.lda2 = D * 2; S.ldb2 = D * 2; S.nt = D / 64;
            pg8::EpiSwiglu E{P_PROJ(ws)}; pg8::gemm_phase<pg8::EpiSwiglu, pg8::PlainSched, true>(L, S, E);
        }
        GRID_SYNC();
        {
            unsigned char* ws = WSL;
            pg8::PlainSched S; S.T.init(M / 256, D / 256, gridDim.x, blockIdx.x); S.A = (const char*)P_PROJ(ws); S.B = (const char*)(ws + WS_WDN); S.lda2 = DFF * 2; S.ldb2 = DFF * 2; S.nt = DFF / 64;
            pg8::EpiResidual E{a.out, a.out}; pg8::gemm_phase<pg8::EpiResidual, pg8::PlainSched, false>(L, S, E);
        }
        GRID_SYNC();
    }
    ph_final(a.out, a.in[18]);
}

extern "C" void kernel_launch(void* const* d_in, const int* in_sizes, int n_in, void* d_out, int out_size, void* d_ws, size_t ws_size, hipStream_t stream) {
    static int grid = 0;
    if (grid == 0) {
        if (n_in != 19 || out_size != M * D || ws_size < WS_TOTAL) { fprintf(stderr, "kernel_launch: unexpected shapes (n_in %d out %d ws %zu)\n", n_in, out_size, ws_size); grid = -1; return; }
        int dev = 0, cus = 0, per_cu = 0;
        (void)hipGetDevice(&dev); (void)hipDeviceGetAttribute(&cus, hipDeviceAttributeMultiprocessorCount, dev);
        if (hipFuncSetAttribute((const void*)fwd, hipFuncAttributeMaxDynamicSharedMemorySize, LDS_BYTES) != hipSuccess) { fprintf(stderr, "kernel_launch: hipFuncSetAttribute failed\n"); grid = -1; return; }
        (void)hipOccupancyMaxActiveBlocksPerMultiprocessor(&per_cu, (const void*)fwd, NT, LDS_BYTES);
        if (per_cu < 1) { fprintf(stderr, "kernel_launch: occupancy query says 0 blocks per CU\n"); grid = -1; return; }
        grid = cus < 256 ? cus : 256;
    }
    if (grid < 0) return;
    if (hipMemsetAsync((char*)d_ws + WS_CTL, 0, CTL_ZERO_BYTES, stream) != hipSuccess) { fprintf(stderr, "kernel_launch: memset of the control words failed\n"); return; }
    Args a{};
    for (int i = 0; i < 19; ++i) a.in[i] = (const float*)d_in[i];
    a.out = (float*)d_out; a.ws = (unsigned char*)d_ws;
    hipLaunchKernelGGL(fwd, dim3(grid), dim3(NT), LDS_BYTES, stream, a);
}
```

```cpp
#include <hip/hip_runtime.h>
#include <hip/hip_cooperative_groups.h>
#include <cstdio>
#include <cstdint>
namespace cg = cooperative_groups;

#ifndef SINGLE_LAUNCH
#define SINGLE_LAUNCH 0
#endif

typedef unsigned short bf16_t;
constexpr int M = 16384, SEQ = 8192, D = 1024, DIN = 9488, NPROJ = 5376, DFF = 2816;
constexpr int NT = 512;
constexpr int INP_TILES = 20;
constexpr int PC_Z = 0, PC_XBC = 512, PC_MQ = 1536, PC_MK = 2048, PC_MV = 2560, PC_FQ = 3072, PC_FK = 3584, PC_FV = 4096, PC_SQ = 4608, PC_SK = 5120, PC_SV = 5248;
constexpr int WC_DT = 1536, WC_F = 4616, WC_GATE = 5392;
constexpr size_t MiB = 1u << 20;
constexpr size_t WS_XN = 0, WS_PROJ = 32 * MiB, WS_XC = 200 * MiB, WS_DT = 232 * MiB, WS_LF = WS_DT + MiB / 2, WS_CUM = 233 * MiB, WS_KMEAN = WS_CUM + MiB / 2;
constexpr size_t WS_WIN = 234 * MiB;
constexpr size_t WS_WG = WS_WIN + (size_t)NPROJ * D * 2;
constexpr size_t WS_WBR = WS_WG + (size_t)4096 * D * 2;
constexpr size_t WS_WOUT = WS_WBR + (size_t)4 * D * 512 * 2;
constexpr size_t WS_WGU = WS_WOUT + (size_t)D * D * 2;
constexpr size_t WS_WDN = WS_WGU + (size_t)2 * DFF * D * 2;
constexpr size_t WS_END = WS_WDN + (size_t)D * DFF * 2;
static_assert(WS_END <= 276 * MiB, "workspace map");

constexpr size_t WS_CTL = 276 * MiB, CTL_ZERO_BYTES = 65536, WS_CDEC = WS_CTL + 131072, WS_TOTAL = 294 * MiB;
constexpr size_t WS_STATES = 234 * MiB, WS_PL = WS_STATES + 8 * MiB;
constexpr size_t WS_PO2 = 277 * MiB, WS_SEL = 293 * MiB;
#define P_XN(w) ((bf16_t*)((w) + WS_XN))
#define P_PROJ(w) ((bf16_t*)((w) + WS_PROJ))
#define P_XC(w) ((bf16_t*)((w) + WS_XC))
struct Args { const float* in[19]; float* out; unsigned char* ws; int ph_lo, ph_hi, coop, pad; };

__device__ __forceinline__ float bf2f(unsigned v) { return __uint_as_float(v << 16); }
__device__ __forceinline__ float bflo(unsigned v) { return __uint_as_float(v << 16); }
__device__ __forceinline__ float bfhi(unsigned v) { return __uint_as_float(v & 0xffff0000u); }
__device__ __forceinline__ unsigned f2bf(float f) { unsigned u = __float_as_uint(f); return (u + 0x7fffu + ((u >> 16) & 1u)) >> 16; }
__device__ __forceinline__ unsigned pk2(float lo, float hi) { return f2bf(lo) | (f2bf(hi) << 16); }
__device__ __forceinline__ float wave_sum(float v) {
#pragma unroll
    for (int o = 1; o < 64; o <<= 1) v += __shfl_xor(v, o);
    return v;
}
__device__ __forceinline__ unsigned q_ld(unsigned* p)              { return __hip_atomic_load(p, __ATOMIC_RELAXED, __HIP_MEMORY_SCOPE_AGENT); }
__device__ __forceinline__ unsigned q_add(unsigned* p, unsigned v) { return __hip_atomic_fetch_add(p, v, __ATOMIC_RELAXED, __HIP_MEMORY_SCOPE_AGENT); }
__device__ __forceinline__ int ltid() { int t = threadIdx.x; asm volatile("" : "+v"(t)); return t; }
__device__ __forceinline__ float log1p_pos(float e) {
    const float small = e * (1.f + e * (-0.5f + e * (0.33333333f + e * (-0.25f + e * 0.2f))));
    return e < 0.02f ? small : logf(1.f + e);
}
__device__ __forceinline__ float softplus_f(float x) { return fmaxf(x, 0.f) + log1p_pos(expf(-fabsf(x))); }
__device__ __forceinline__ float silu_f(float x) { return x / (1.f + expf(-x)); }
__device__ __forceinline__ float sigmoid_f(float x) { return 1.f / (1.f + expf(-x)); }
__device__ __forceinline__ int rel_bucket(int d) {
    if (d < 16) return d;
    int b = 16;
    b += (d >= 21); b += (d >= 27); b += (d >= 35); b += (d >= 46); b += (d >= 59); b += (d >= 77); b += (d >= 99); b += (d >= 128);
    b += (d >= 166); b += (d >= 216); b += (d >= 280); b += (d >= 363); b += (d >= 470); b += (d >= 609); b += (d >= 790);
    return b;
}

template <bool IN_BF16>
__device__ __forceinline__ void ph_norm(float* wd, const void* xin, const float* nw, bf16_t* XN, bool dots, const float* w_in, const float* dt_bias, const float* fbias, float* DT, float* LF, bf16_t* R0) {
    const int tx_ = ltid();
    const int lane = tx_ & 63, wave = tx_ >> 6;
    const int gw = blockIdx.x * 8 + wave, NGW = gridDim.x * 8;
    if (dots) {
        for (int i = tx_; i < 1024 * 4; i += NT) { const int k = i >> 2, part = i & 3;
            *(float4*)((char*)wd + (k >> 2) * 272 + (k & 3) * 64 + part * 16) = *(const float4*)(w_in + (size_t)k * DIN + (part < 2 ? WC_DT + part * 4 : WC_F + (part - 2) * 4)); }
        __syncthreads();
    }
    float4 nwv[4];
#pragma unroll
    for (int j = 0; j < 4; ++j) nwv[j] = ((const float4*)nw)[lane + 64 * j];
    for (int row0 = gw; row0 < M; row0 += 4 * NGW) {
    float4 vb[IN_BF16 ? 1 : 4][4]; uint2 ub[IN_BF16 ? 4 : 1][4];
#pragma unroll
    for (int k = 0; k < 4; ++k) { const int rk = row0 + k * NGW; if (rk < M) {
        if constexpr (IN_BF16) { const uint2* xr = (const uint2*)((const bf16_t*)xin + (size_t)rk * D);
#pragma unroll
            for (int j = 0; j < 4; ++j) ub[k][j] = xr[lane + 64 * j]; }
        else { const float4* xr = (const float4*)((const float*)xin + (size_t)rk * D);
#pragma unroll
            for (int j = 0; j < 4; ++j) vb[k][j] = xr[lane + 64 * j]; } } }
#pragma unroll
    for (int k = 0; k < 4; ++k) {
        const int row = row0 + k * NGW; if (row >= M) break;
        float4 v[4]; float ss = 0.f;
#pragma unroll
        for (int j = 0; j < 4; ++j) {
            if constexpr (IN_BF16) v[j] = make_float4(bflo(ub[k][j].x), bfhi(ub[k][j].x), bflo(ub[k][j].y), bfhi(ub[k][j].y)); else v[j] = vb[k][j];
            ss += v[j].x * v[j].x + v[j].y * v[j].y + v[j].z * v[j].z + v[j].w * v[j].w; }
        if constexpr (!IN_BF16) { if (R0) { uint2* rp = (uint2*)(R0 + (size_t)row * D);
#pragma unroll
            for (int j = 0; j < 4; ++j) rp[lane + 64 * j] = make_uint2(pk2(v[j].x, v[j].y), pk2(v[j].z, v[j].w)); } }
        ss = wave_sum(ss);
        const float rstd = 1.0f / sqrtf(ss * (1.0f / D) + 1e-6f);
#pragma unroll
        for (int j = 0; j < 4; ++j) { const float4 w4 = nwv[j]; v[j].x *= rstd * w4.x; v[j].y *= rstd * w4.y; v[j].z *= rstd * w4.z; v[j].w *= rstd * w4.w; }
        uint2* o = (uint2*)(XN + (size_t)row * D);
#pragma unroll
        for (int j = 0; j < 4; ++j) o[lane + 64 * j] = make_uint2(pk2(v[j].x, v[j].y), pk2(v[j].z, v[j].w));
        if (dots) {
            float d[16];
#pragma unroll
            for (int c = 0; c < 16; ++c) d[c] = 0.f;
#pragma unroll
            for (int j = 0; j < 4; ++j) { const float hv[4] = {v[j].x, v[j].y, v[j].z, v[j].w};
#pragma unroll
                for (int e = 0; e < 4; ++e) { const float* wr = (const float*)((const char*)wd + (lane + 64 * j) * 272 + e * 64); const float h = hv[e];
                    const float4 a0 = *(const float4*)(wr), a1 = *(const float4*)(wr + 4), b0 = *(const float4*)(wr + 8), b1 = *(const float4*)(wr + 12);
                    d[0] += h * a0.x; d[1] += h * a0.y; d[2] += h * a0.z; d[3] += h * a0.w; d[4] += h * a1.x; d[5] += h * a1.y; d[6] += h * a1.z; d[7] += h * a1.w;
                    d[8] += h * b0.x; d[9] += h * b0.y; d[10] += h * b0.z; d[11] += h * b0.w; d[12] += h * b1.x; d[13] += h * b1.y; d[14] += h * b1.z; d[15] += h * b1.w; }
                asm volatile("" ::: "memory"); }
            float r8[8], r4[4], r2[2];
            { const bool up = (lane & 32) != 0;
#pragma unroll
              for (int i = 0; i < 8; ++i) { const float keep = up ? d[i + 8] : d[i], send = up ? d[i] : d[i + 8]; r8[i] = keep + __shfl_xor(send, 32); } }
            { const bool up = (lane & 16) != 0;
#pragma unroll
              for (int i = 0; i < 4; ++i) { const float keep = up ? r8[i + 4] : r8[i], send = up ? r8[i] : r8[i + 4]; r4[i] = keep + __shfl_xor(send, 16); } }
            { const bool up = (lane & 8) != 0;
#pragma unroll
              for (int i = 0; i < 2; ++i) { const float keep = up ? r4[i + 2] : r4[i], send = up ? r4[i] : r4[i + 2]; r2[i] = keep + __shfl_xor(send, 8); } }
            float mine; { const bool up = (lane & 4) != 0; const float keep = up ? r2[1] : r2[0], send = up ? r2[0] : r2[1]; mine = keep + __shfl_xor(send, 4); }
            mine += __shfl_xor(mine, 2); mine += __shfl_xor(mine, 1);
            const int col = ((lane >> 5) & 1) * 8 + ((lane >> 4) & 1) * 4 + ((lane >> 3) & 1) * 2 + ((lane >> 2) & 1);
            if ((lane & 3) == 0) { if (col < 8) DT[(size_t)row * 8 + col] = softplus_f(mine + dt_bias[col]); else LF[(size_t)row * 8 + (col - 8)] = -softplus_f(-(mine + fbias[col - 8])); }
        }
    }    }
}

namespace pg8 {
#define PG8_LAS __attribute__((address_space(3)))
typedef short bf16x8 __attribute__((ext_vector_type(8)));
typedef float f32x4 __attribute__((ext_vector_type(4)));
typedef unsigned u32x4 __attribute__((ext_vector_type(4)));
constexpr int BM = 256, BK = 64, HALF = 128, HTB = HALF * BK * 2, STAGE_BYTES = 8 * HTB, NXCD = 8, WGM = 8;
__host__ __device__ __forceinline__ int lds_byte(int r, int c) { const int st = (r >> 4) * 2 + (c >> 5), rr = r & 15, cc = c & 31, ob = rr * 64 + cc * 2; return st * 1024 + (ob ^ (((ob >> 9) & 1) << 5)); }
__host__ __device__ __forceinline__ void stage_rc(int b, int& R, int& C) { const int st = b / 1024, sb = b % 1024, swz = sb ^ (((sb >> 9) & 1) << 5); R = (st >> 1) * 16 + swz / 64; C = (st & 1) * 32 + (swz % 64) / 2; }
__host__ __device__ __forceinline__ int perm32(int rho) { const int n = rho >> 4, i = rho & 15; return 8 * (i >> 2) + 4 * n + (i & 3); }
struct Unit { const char* A; const char* B; unsigned lda2, ldb2; int nt, pm, pn, aux; };
struct TileOrder {
    int nM, nN, nwg, G, c;
    __device__ void init(int nM_, int nN_, int G_, int c_) { nM = nM_; nN = nN_; nwg = nM * nN; G = G_; c = c_; }
    __device__ bool tile(int i, int& pm, int& pn) const {
        const long L = (long)i * G + c; if (L >= nwg) return false;
        int wgid = (int)L; { const int q = nwg / NXCD, r = nwg % NXCD, xcd = wgid % NXCD, off = wgid / NXCD; wgid = (xcd < r ? xcd * (q + 1) : r * (q + 1) + (xcd - r) * q) + off; }
        const int nig = WGM * nN, gid = wgid / nig, fm = gid * WGM, gsz = (nM - fm) < WGM ? (nM - fm) : WGM;
        pm = fm + ((wgid % nig) % gsz); pn = (wgid % nig) / gsz; return true;
    }
};
typedef float f32x2_t __attribute__((ext_vector_type(2))); typedef __bf16 bf16x2_t __attribute__((ext_vector_type(2)));
__device__ __forceinline__ unsigned cvt_pk_bf16(float lo, float hi) { f32x2_t v = {lo, hi}; bf16x2_t b = __builtin_convertvector(v, bf16x2_t); return __builtin_bit_cast(unsigned, b); }

template <class Epi, class Sched, bool ALIGN_EPI>
__device__ __forceinline__ void gemm_phase(PG8_LAS unsigned char* lds, const Sched& S, const Epi& E) {
    int tid = threadIdx.x; asm volatile("" : "+v"(tid));
    const int wid = __builtin_amdgcn_readfirstlane(tid >> 6), lane = tid & 63, wr = wid >> 2, wc = wid & 3, fr = lane & 15, fq = lane >> 4;
    unsigned RA[2], RB[2], C2[2];
#pragma unroll
    for (int i = 0; i < 2; ++i) { int R, C; stage_rc(tid * 16 + i * 8192, R, C); RA[i] = (unsigned)R; RB[i] = (unsigned)(Epi::PERM ? ((R & ~31) + perm32(R & 31)) : R); C2[i] = (unsigned)(C * 2); }
    const unsigned ldsw = (unsigned)wid * 1024u;
    const int aoff = lds_byte(wr * 64 + fr, fq * 8), boff = lds_byte(wc * 32 + fr, fq * 8);
#define PG8_SA(b, h) (((b) * 2 + (h)) * HTB)
#define PG8_SB(b, h) ((4 + (b) * 2 + (h)) * HTB)
#define PG8_STAGE(bufoff, gbase, RR, pitch) do { _Pragma("unroll") for (int _i = 0; _i < 2; ++_i) \
        __builtin_amdgcn_global_load_lds((const unsigned*)((const char*)(gbase) + (RR[_i] * (pitch) + C2[_i])), (PG8_LAS unsigned*)(lds + (bufoff) + ldsw + _i * 8192), 16, 0, 0); } while (0)
#define PG8_LDA(dst, b, h) do { _Pragma("unroll") for (int m = 0; m < 4; ++m) _Pragma("unroll") for (int k = 0; k < 2; ++k) dst[m][k] = *(const PG8_LAS bf16x8*)(lds + PG8_SA(b, h) + aoff + m * 2048 + k * 1024); } while (0)
#define PG8_LDB(dst, b, h) do { _Pragma("unroll") for (int n = 0; n < 2; ++n) _Pragma("unroll") for (int k = 0; k < 2; ++k) dst[n][k] = *(const PG8_LAS bf16x8*)(lds + PG8_SB(b, h) + boff + n * 2048 + k * 1024); } while (0)
#define PG8_MMA(ai, bj, At, Bt) do { __builtin_amdgcn_s_setprio(1); _Pragma("unroll") for (int m = 0; m < 4; ++m) _Pragma("unroll") for (int n = 0; n < 2; ++n) _Pragma("unroll") for (int k = 0; k < 2; ++k) \
        acc[ai][bj][m][n] = __builtin_amdgcn_mfma_f32_16x16x32_bf16(Bt[n][k], At[m][k], acc[ai][bj][m][n], 0, 0, 0); __builtin_amdgcn_s_setprio(0); } while (0)
#define PG8_WAIT_V(n) asm volatile("s_waitcnt vmcnt(" #n ")" ::: "memory")
#define PG8_WAIT_L(n) asm volatile("s_waitcnt lgkmcnt(" #n ")" ::: "memory")
#define PG8_BAR __builtin_amdgcn_s_barrier()
#define PG8_SCHED __builtin_amdgcn_sched_barrier(0)
#define PG8_ZERO() do { _Pragma("unroll") for (int a_ = 0; a_ < 2; ++a_) _Pragma("unroll") for (int b_ = 0; b_ < 2; ++b_) _Pragma("unroll") for (int m_ = 0; m_ < 4; ++m_) _Pragma("unroll") for (int n_ = 0; n_ < 2; ++n_) acc[a_][b_][m_][n_] = (f32x4){0.f, 0.f, 0.f, 0.f}; } while (0)
    Unit cur, nxt; int ui = 0;
    if (!S.next(0, cur)) return;
    f32x4 acc[2][2][4][2];
    PG8_ZERO();
    bf16x8 At[4][2], B0[2][2], B1[2][2];
    const char* cA = cur.A; const char* cB = cur.B; unsigned pAc = cur.lda2, pBc = cur.ldb2; int ntc = cur.nt;
    const unsigned kstep = BK * 2;
    {
        const size_t hA = (size_t)HALF * pAc, hB = (size_t)HALF * pBc;
        PG8_STAGE(PG8_SB(0, 0), cB, RB, pBc); PG8_STAGE(PG8_SB(0, 1), cB + hB, RB, pBc); PG8_STAGE(PG8_SA(0, 0), cA, RA, pAc); PG8_STAGE(PG8_SA(0, 1), cA + hA, RA, pAc);
        if (wr == 1) PG8_BAR;
        PG8_WAIT_V(2); PG8_BAR;
        PG8_STAGE(PG8_SB(1, 0), cB + kstep, RB, pBc); PG8_STAGE(PG8_SA(1, 0), cA + kstep, RA, pAc); PG8_STAGE(PG8_SB(1, 1), cB + hB + kstep, RB, pBc);
        PG8_WAIT_V(6); PG8_BAR;
    }
    for (;;) {
        const bool has_next = S.next(ui + 1, nxt);
        const char* nA = has_next ? nxt.A : cA; const char* nB = has_next ? nxt.B : cB;
        const unsigned pAn = has_next ? nxt.lda2 : pAc, pBn = has_next ? nxt.ldb2 : pBc;
        const size_t hAc = (size_t)HALF * pAc;
        for (int t = 0; t < ntc; t += 2) {
            const bool last = (t == ntc - 2);
            const char* a1 = cA + (size_t)(t + 1) * kstep;
            const char* a2 = last ? nA : cA + (size_t)(t + 2) * kstep; const char* b2 = last ? nB : cB + (size_t)(t + 2) * kstep;
            const char* a3 = a2 + kstep; const char* b3 = b2 + kstep;
            const unsigned pA2 = last ? pAn : pAc, pB2 = last ? pBn : pBc;
            const size_t hA2 = (size_t)HALF * pA2, hB2 = (size_t)HALF * pB2;
            PG8_LDB(B0, 0, 0); PG8_LDB(B1, 0, 1); PG8_SCHED; PG8_LDA(At, 0, 0); PG8_STAGE(PG8_SA(1, 1), a1 + hAc, RA, pAc);
            PG8_WAIT_V(8); PG8_WAIT_L(0); PG8_BAR; PG8_MMA(0, 0, At, B0); PG8_MMA(0, 1, At, B1); PG8_BAR; PG8_SCHED;
            PG8_LDA(At, 0, 1); PG8_STAGE(PG8_SB(0, 0), b2, RB, pB2); PG8_STAGE(PG8_SB(0, 1), b2 + hB2, RB, pB2); PG8_STAGE(PG8_SA(0, 0), a2, RA, pA2);
            PG8_WAIT_V(8); PG8_WAIT_L(0); PG8_BAR; PG8_MMA(1, 0, At, B0); PG8_MMA(1, 1, At, B1); PG8_BAR; PG8_SCHED;
            PG8_LDB(B0, 1, 0); PG8_LDB(B1, 1, 1); PG8_SCHED; PG8_LDA(At, 1, 0); PG8_STAGE(PG8_SA(0, 1), a2 + hA2, RA, pA2);
            PG8_WAIT_V(8); PG8_WAIT_L(0); PG8_BAR; PG8_MMA(0, 0, At, B0); PG8_MMA(0, 1, At, B1); PG8_BAR; PG8_SCHED;
            PG8_LDA(At, 1, 1); PG8_STAGE(PG8_SB(1, 0), b3, RB, pB2); PG8_STAGE(PG8_SB(1, 1), b3 + hB2, RB, pB2); PG8_STAGE(PG8_SA(1, 0), a3, RA, pA2);
            PG8_WAIT_V(8); PG8_WAIT_L(0); PG8_BAR; PG8_MMA(1, 0, At, B0); PG8_MMA(1, 1, At, B1); PG8_BAR; PG8_SCHED;
        }
        if constexpr (ALIGN_EPI) { if (wr == 0) PG8_BAR; }
        { int fr_ = fr, fq_ = fq; asm volatile("" : "+v"(fr_), "+v"(fq_)); E(acc, cur, wr, wc, fr_, fq_); }
        if (!has_next) break;
        PG8_ZERO();
        cur = nxt; cA = nA; cB = nB; pAc = pAn; pBc = pBn; ntc = nxt.nt; ++ui;
        if constexpr (ALIGN_EPI) { if (wr == 1) PG8_BAR; }
    }
    PG8_WAIT_V(0);
    if constexpr (!ALIGN_EPI) { if (wr == 0) PG8_BAR; }
    PG8_BAR;
#undef PG8_SA
#undef PG8_SB
#undef PG8_STAGE
#undef PG8_LDA
#undef PG8_LDB
#undef PG8_MMA
#undef PG8_WAIT_V
#undef PG8_WAIT_L
#undef PG8_BAR
#undef PG8_SCHED
#undef PG8_ZERO
}

struct PlainSched {
    TileOrder T; const char* A; const char* B; unsigned lda2, ldb2; int nt;
    __device__ bool next(int i, Unit& u) const { int pm, pn; if (!T.tile(i, pm, pn)) return false;
        u.A = A + (size_t)pm * 256 * lda2; u.B = B + (size_t)pn * 256 * ldb2; u.lda2 = lda2; u.ldb2 = ldb2; u.nt = nt; u.pm = pm; u.pn = pn; u.aux = 0; return true; }
};
struct OneSched { Unit u0; __device__ bool next(int i, Unit& u) const { if (i != 0) return false; u = u0; return true; } };
struct EpiStoreBf16 {
    static constexpr bool PERM = true;
    bf16_t* O; int ldc;
    __device__ __forceinline__ void operator()(const f32x4 (&acc)[2][2][4][2], const Unit& u, int wr, int wc, int fr, int fq) const {
        const int row0 = u.pm * BM + wr * 64 + fr, col0 = u.pn * BM + wc * 32 + 8 * fq;
#pragma unroll
        for (int ai = 0; ai < 2; ++ai)
#pragma unroll
            for (int m = 0; m < 4; ++m) { bf16_t* rowp = O + (size_t)(row0 + ai * HALF + m * 16) * ldc + col0;
#pragma unroll
                for (int bj = 0; bj < 2; ++bj) { const f32x4 v0 = acc[ai][bj][m][0], v1 = acc[ai][bj][m][1];
                    u32x4 w; w.x = cvt_pk_bf16(v0[0], v0[1]); w.y = cvt_pk_bf16(v0[2], v0[3]); w.z = cvt_pk_bf16(v1[0], v1[1]); w.w = cvt_pk_bf16(v1[2], v1[3]);
                    *(u32x4*)(rowp + bj * HALF) = w; } }
    }
};
__device__ __forceinline__ float fast_sigmoid(float x) { return __builtin_amdgcn_rcpf(1.f + __expf(-x)); }
struct EpiSwiglu {
    static constexpr bool PERM = true;
    bf16_t* H;
    __device__ __forceinline__ void operator()(const f32x4 (&acc)[2][2][4][2], const Unit& u, int wr, int wc, int fr, int fq) const {
        const int row0 = u.pm * BM + wr * 64 + fr, col0 = u.pn * HALF + wc * 32 + 8 * fq;
#pragma unroll
        for (int ai = 0; ai < 2; ++ai)
#pragma unroll
            for (int m = 0; m < 4; ++m) { float v[8];
#pragma unroll
                for (int n = 0; n < 2; ++n)
#pragma unroll
                    for (int e = 0; e < 4; ++e) { const float g = acc[ai][0][m][n][e], up = acc[ai][1][m][n][e]; v[n * 4 + e] = g * fast_sigmoid(g) * up; }
                u32x4 w; w.x = cvt_pk_bf16(v[0], v[1]); w.y = cvt_pk_bf16(v[2], v[3]); w.z = cvt_pk_bf16(v[4], v[5]); w.w = cvt_pk_bf16(v[6], v[7]);
                *(u32x4*)(H + (size_t)(row0 + ai * HALF + m * 16) * DFF + col0) = w; }
    }
};
struct EpiRes {
    static constexpr bool PERM = true;
    const bf16_t* res; void* out; bool out_f32;
    __device__ __forceinline__ void operator()(const f32x4 (&acc)[2][2][4][2], const Unit& u, int wr, int wc, int fr, int fq) const {
        const int row0 = u.pm * BM + wr * 64 + fr, col0 = u.pn * BM + wc * 32 + 8 * fq;
#pragma unroll
        for (int gb = 0; gb < 16; gb += 8) {
            u32x4 r[8];
#pragma unroll
            for (int k = 0; k < 8; ++k) { const int i = gb + k, ai = i >> 3, m = (i >> 1) & 3, bj = i & 1; r[k] = *(const u32x4*)(res + (size_t)(row0 + ai * HALF + m * 16) * D + col0 + bj * HALF); }
#pragma unroll
            for (int k = 0; k < 8; ++k) { const int i = gb + k, ai = i >> 3, m = (i >> 1) & 3, bj = i & 1; const size_t off = (size_t)(row0 + ai * HALF + m * 16) * D + col0 + bj * HALF;
                f32x4 p0 = acc[ai][bj][m][0], p1 = acc[ai][bj][m][1];
                p0[0] += bflo(r[k].x); p0[1] += bfhi(r[k].x); p0[2] += bflo(r[k].y); p0[3] += bfhi(r[k].y); p1[0] += bflo(r[k].z); p1[1] += bfhi(r[k].z); p1[2] += bflo(r[k].w); p1[3] += bfhi(r[k].w);
                if (out_f32) { *(f32x4*)((float*)out + off) = p0; *(f32x4*)((float*)out + off + 4) = p1; }
                else { u32x4 w; w.x = cvt_pk_bf16(p0[0], p0[1]); w.y = cvt_pk_bf16(p0[2], p0[3]); w.z = cvt_pk_bf16(p1[0], p1[1]); w.w = cvt_pk_bf16(p1[2], p1[3]); *(u32x4*)((bf16_t*)out + off) = w; } }
            asm volatile("" ::: "memory");
        }
    }
};
struct EpiGate {
    static constexpr bool PERM = true;
    bf16_t* PROJ; bf16_t* XC;
    __device__ __forceinline__ void operator()(const f32x4 (&acc)[2][2][4][2], const Unit& u, int wr, int wc, int fr, int fq) const {
        const int br = u.pn >> 2, row0 = u.pm * BM + wr * 64 + fr, col0 = (u.pn & 3) * BM + wc * 32 + 8 * fq;
        bf16_t* base = br < 3 ? PROJ + 512 + 1536 * br : XC;
        const int ld = br < 3 ? NPROJ : 1024;
#pragma unroll
        for (int ai = 0; ai < 2; ++ai)
#pragma unroll
            for (int m = 0; m < 4; ++m) { bf16_t* rowp = base + (size_t)(row0 + ai * HALF + m * 16) * ld + col0;
#pragma unroll
                for (int bj = 0; bj < 2; ++bj) { const f32x4 v0 = acc[ai][bj][m][0], v1 = acc[ai][bj][m][1];
                    u32x4 w; w.x = cvt_pk_bf16(fast_sigmoid(v0[0]), fast_sigmoid(v0[1])); w.y = cvt_pk_bf16(fast_sigmoid(v0[2]), fast_sigmoid(v0[3]));
                    w.z = cvt_pk_bf16(fast_sigmoid(v1[0]), fast_sigmoid(v1[1])); w.w = cvt_pk_bf16(fast_sigmoid(v1[2]), fast_sigmoid(v1[3]));
                    *(u32x4*)(rowp + bj * HALF) = w; } }
    }
};
struct BranchSched {
    TileOrder T; const char* PROJ; const char* WBR;
    __device__ bool next(int i, Unit& u) const { int pm, pn; if (!T.tile(i >> 2, pm, pn)) return false;
        const int br = i & 3; u.pm = pm; u.pn = pn; u.aux = br;
        u.A = PROJ + (size_t)pm * 256 * (NPROJ * 2) + 1536 * 2 * br; u.lda2 = NPROJ * 2; u.B = WBR + ((size_t)br * 1024 + pn * 256) * (512 * 2); u.ldb2 = 512 * 2; u.nt = 512 / 64; return true; }
};
struct EpiBranch {
    static constexpr bool PERM = true;
    const bf16_t* PROJ; const bf16_t* XC; bf16_t* MIX;
    __device__ __forceinline__ void operator()(const f32x4 (&acc)[2][2][4][2], const Unit& u, int wr, int wc, int fr, int fq) const {
        const int br = u.aux, row0 = u.pm * BM + wr * 64 + fr, col0 = u.pn * BM + wc * 32 + 8 * fq;
        const bf16_t* G = br < 3 ? PROJ + 512 + 1536 * br : XC; const int ldg = br < 3 ? NPROJ : 1024;
        if (br == 0) run<true>(acc, G, ldg, row0, col0); else run<false>(acc, G, ldg, row0, col0);
    }
    template <bool FIRST>
    __device__ __forceinline__ void run(const f32x4 (&acc)[2][2][4][2], const bf16_t* G, int ldg, int row0, int col0) const {
#pragma unroll
        for (int gb = 0; gb < 16; gb += 4) {
            u32x4 g[4], o[4];
#pragma unroll
            for (int k = 0; k < 4; ++k) { const int i = gb + k, ai = i >> 3, m = (i >> 1) & 3, bj = i & 1; const size_t row = (size_t)(row0 + ai * HALF + m * 16);
                g[k] = *(const u32x4*)(G + row * ldg + col0 + bj * HALF); if (!FIRST) o[k] = *(const u32x4*)(MIX + row * D + col0 + bj * HALF); }
#pragma unroll
            for (int k = 0; k < 4; ++k) { const int i = gb + k, ai = i >> 3, m = (i >> 1) & 3, bj = i & 1; const size_t row = (size_t)(row0 + ai * HALF + m * 16);
                f32x4 p0 = acc[ai][bj][m][0], p1 = acc[ai][bj][m][1];
                p0[0] *= bflo(g[k].x); p0[1] *= bfhi(g[k].x); p0[2] *= bflo(g[k].y); p0[3] *= bfhi(g[k].y); p1[0] *= bflo(g[k].z); p1[1] *= bfhi(g[k].z); p1[2] *= bflo(g[k].w); p1[3] *= bfhi(g[k].w);
                if (!FIRST) { p0[0] += bflo(o[k].x); p0[1] += bfhi(o[k].x); p0[2] += bflo(o[k].y); p0[3] += bfhi(o[k].y); p1[0] += bflo(o[k].z); p1[1] += bfhi(o[k].z); p1[2] += bflo(o[k].w); p1[3] += bfhi(o[k].w); }
                u32x4 w; w.x = cvt_pk_bf16(p0[0], p0[1]); w.y = cvt_pk_bf16(p0[2], p0[3]); w.z = cvt_pk_bf16(p1[0], p1[1]); w.w = cvt_pk_bf16(p1[2], p1[3]);
                *(u32x4*)(MIX + row * D + col0 + bj * HALF) = w; }
            asm volatile("" ::: "memory");
        }
    }
};
}

#define LAS __attribute__((address_space(3)))
__device__ __forceinline__ void wt_item(const float* W, int ldw, int src_col0, int k0, bf16_t* WT, int ldwt, int dst_row0, LAS float* scr, int lane) {
#pragma unroll
    for (int i = 0; i < 8; ++i) { const int k = 4 * i + (lane >> 4), n4 = (lane & 15) * 4;
        const float4 v = *(const float4*)(W + (size_t)(k0 + k) * ldw + src_col0 + n4);
        LAS float* d = scr + k * 65 + n4; d[0] = v.x; d[1] = v.y; d[2] = v.z; d[3] = v.w; }
    asm volatile("s_waitcnt lgkmcnt(0)" ::: "memory");
    unsigned w[16];
#pragma unroll
    for (int j = 0; j < 16; ++j) w[j] = pk2(scr[(2 * j) * 65 + lane], scr[(2 * j + 1) * 65 + lane]);
    uint4* o = (uint4*)(WT + (size_t)(dst_row0 + lane) * ldwt + k0);
#pragma unroll
    for (int j = 0; j < 4; ++j) o[j] = make_uint4(w[4 * j], w[4 * j + 1], w[4 * j + 2], w[4 * j + 3]);
    asm volatile("s_waitcnt lgkmcnt(0)" ::: "memory");
}
constexpr int WCV_IN = 32 * (NPROJ / 64), WCV_ALL = WCV_IN + 32 * 64 + 4 * 16 * 16 + 32 * 16 + 32 * (2 * DFF / 64) + (DFF / 32) * 16, WCV_CHUNK = 16;
__device__ __forceinline__ void ph_wconv(unsigned char* ws, const float* w_in, const float* w_branch, const float* w_out, const float* w_gate, const float* w_up, const float* w_down, LAS float* scr_base,
                                         int lo, int hi, int first, int stride) {
    const int tx_ = ltid();
    const int lane = tx_ & 63, wave = tx_ >> 6;
    LAS float* scr = scr_base + wave * (32 * 65);
    constexpr int I_IN = 32 * (NPROJ / 64), I_G = 32 * 64, I_BR = 4 * 16 * 16, I_OUT = 32 * 16, I_GU = 32 * (2 * DFF / 64), I_DN = (DFF / 32) * 16;
    static_assert(I_IN + I_G + I_BR + I_OUT + I_GU + I_DN == WCV_ALL && (WCV_ALL - WCV_IN) % WCV_CHUNK == 0, "conversion list");
    for (int it = lo + first * 8 + wave; it < hi; it += stride * 8) {
        int r = it;
        if (r < I_IN) { const int nb = r % (NPROJ / 64), kb = r / (NPROJ / 64), c0 = nb * 64;
            wt_item(w_in, DIN, c0 + (c0 >= 1536 ? 8 : 0) + (c0 >= 4608 ? 8 : 0), kb * 32, (bf16_t*)(ws + WS_WIN), D, c0, scr, lane); continue; } r -= I_IN;
        if (r < I_G) { const int nb = r % 64, kb = r / 64; wt_item(w_in, DIN, WC_GATE + nb * 64, kb * 32, (bf16_t*)(ws + WS_WG), D, nb * 64, scr, lane); continue; } r -= I_G;
        if (r < I_BR) { const int br = r / 256, q = r % 256, nb = q % 16, kb = q / 16;
            wt_item(w_branch + (size_t)br * 512 * 1024, D, nb * 64, kb * 32, (bf16_t*)(ws + WS_WBR) + (size_t)br * 1024 * 512, 512, nb * 64, scr, lane); continue; } r -= I_BR;
        if (r < I_OUT) { const int nb = r % 16, kb = r / 16; wt_item(w_out, D, nb * 64, kb * 32, (bf16_t*)(ws + WS_WOUT), D, nb * 64, scr, lane); continue; } r -= I_OUT;
        if (r < I_GU) { const int nb = r % (2 * DFF / 64), kb = r / (2 * DFF / 64), r0 = nb * 64, t = r0 >> 8, j = r0 & 255;
            wt_item(j < 128 ? w_gate : w_up, DFF, t * 128 + (j & 127), kb * 32, (bf16_t*)(ws + WS_WGU), D, r0, scr, lane); continue; } r -= I_GU;
        { const int nb = r % 16, kb = r / 16; wt_item(w_down, D, nb * 64, kb * 32, (bf16_t*)(ws + WS_WDN), DFF, nb * 64, scr, lane); }
    }
}

__device__ __forceinline__ float silu_fast(float x) { return x * __builtin_amdgcn_rcpf(1.f + __expf(-x)); }
__device__ __forceinline__ void ph_pre(unsigned char* lds, const bf16_t* PROJ, const float* conv_w, const float* conv_b, bf16_t* XC, float* KMEAN, float* KMAXP) {
    const int tx_ = ltid();
    const int lane = tx_ & 63, gw = blockIdx.x * 8 + (tx_ >> 6), NGW = gridDim.x * 8;
    int* smax = (int*)lds;
    if (tx_ < 16) smax[tx_] = 0;
    for (int it = gw; it < (M / 16) * 2; it += NGW) {
        const int r0 = (it >> 1) * 16, c8 = (it & 1) * 512 + lane * 8;
        const bool head = (r0 & (SEQ - 1)) == 0;
        uint4 xr[19];
        const bf16_t* src = PROJ + (size_t)r0 * NPROJ + PC_XBC + c8;
#pragma unroll
        for (int j = 0; j < 3; ++j) xr[j] = head ? make_uint4(0u, 0u, 0u, 0u) : *(const uint4*)(src + (ptrdiff_t)(j - 3) * NPROJ);
#pragma unroll
        for (int j = 3; j < 19; ++j) xr[j] = *(const uint4*)(src + (size_t)(j - 3) * NPROJ);
        float w[4][8], b[8];
#pragma unroll
        for (int i = 0; i < 4; ++i) { const float4 w0 = *(const float4*)(conv_w + i * 1024 + c8), w1 = *(const float4*)(conv_w + i * 1024 + c8 + 4);
            w[i][0] = w0.x; w[i][1] = w0.y; w[i][2] = w0.z; w[i][3] = w0.w; w[i][4] = w1.x; w[i][5] = w1.y; w[i][6] = w1.z; w[i][7] = w1.w; }
        { const float4 b0 = *(const float4*)(conv_b + c8), b1 = *(const float4*)(conv_b + c8 + 4); b[0] = b0.x; b[1] = b0.y; b[2] = b0.z; b[3] = b0.w; b[4] = b1.x; b[5] = b1.y; b[6] = b1.z; b[7] = b1.w; }
        bf16_t* dst = XC + (size_t)r0 * 1024 + c8;
#pragma unroll
        for (int j = 0; j < 16; ++j) {
            float acc[8];
#pragma unroll
            for (int c = 0; c < 8; ++c) acc[c] = b[c];
#pragma unroll
            for (int i = 0; i < 4; ++i) { const uint4 u = xr[j + i];
                acc[0] += w[i][0] * bflo(u.x); acc[1] += w[i][1] * bfhi(u.x); acc[2] += w[i][2] * bflo(u.y); acc[3] += w[i][3] * bfhi(u.y);
                acc[4] += w[i][4] * bflo(u.z); acc[5] += w[i][5] * bfhi(u.z); acc[6] += w[i][6] * bflo(u.w); acc[7] += w[i][7] * bfhi(u.w); }
            uint4 o; o.x = pk2(silu_fast(acc[0]), silu_fast(acc[1])); o.y = pk2(silu_fast(acc[2]), silu_fast(acc[3])); o.z = pk2(silu_fast(acc[4]), silu_fast(acc[5])); o.w = pk2(silu_fast(acc[6]), silu_fast(acc[7]));
            *(uint4*)(dst + (size_t)j * 1024) = o;
        }
    }
    for (int it = gw; it < 64 * 16; it += NGW) {
        const int bb = it >> 4, cg = it & 15, rr = lane >> 2, c8 = cg * 32 + (lane & 3) * 8;
        uint4 u[16];
#pragma unroll
        for (int st = 0; st < 16; ++st) u[st] = *(const uint4*)(PROJ + ((size_t)bb * 256 + st * 16 + rr) * NPROJ + PC_MK + c8);
        float sm[8];
#pragma unroll
        for (int j = 0; j < 8; ++j) sm[j] = 0.f;
#pragma unroll
        for (int st = 0; st < 16; ++st) { sm[0] += bflo(u[st].x); sm[1] += bfhi(u[st].x); sm[2] += bflo(u[st].y); sm[3] += bfhi(u[st].y); sm[4] += bflo(u[st].z); sm[5] += bfhi(u[st].z); sm[6] += bflo(u[st].w); sm[7] += bfhi(u[st].w); }
#pragma unroll
        for (int j = 0; j < 8; ++j) { sm[j] += __shfl_xor(sm[j], 4); sm[j] += __shfl_xor(sm[j], 8); sm[j] += __shfl_xor(sm[j], 16); sm[j] += __shfl_xor(sm[j], 32); }
        if (lane < 4) { float* kp = KMEAN + (size_t)bb * 512 + c8;
            *(float4*)kp = make_float4(sm[0] * (1.0f / 256.0f), sm[1] * (1.0f / 256.0f), sm[2] * (1.0f / 256.0f), sm[3] * (1.0f / 256.0f));
            *(float4*)(kp + 4) = make_float4(sm[4] * (1.0f / 256.0f), sm[5] * (1.0f / 256.0f), sm[6] * (1.0f / 256.0f), sm[7] * (1.0f / 256.0f)); }
    }
    {
        const size_t gt = (size_t)blockIdx.x * NT + tx_, tot = (size_t)gridDim.x * NT;
        __syncthreads();
        for (size_t e = gt; e < (size_t)M * 8; e += tot) { const int row = (int)(e >> 3), h = (int)(e & 7);
            const bf16_t* kp = PROJ + (size_t)row * NPROJ + PC_FK + h * 64; float n2 = 0.f;
#pragma unroll
            for (int c = 0; c < 8; ++c) { const uint4 u = *(const uint4*)(kp + c * 8);
                n2 += bflo(u.x) * bflo(u.x) + bfhi(u.x) * bfhi(u.x) + bflo(u.y) * bflo(u.y) + bfhi(u.y) * bfhi(u.y) + bflo(u.z) * bflo(u.z) + bfhi(u.z) * bfhi(u.z) + bflo(u.w) * bflo(u.w) + bfhi(u.w) * bfhi(u.w); }
            atomicMax(&smax[(row >> 13) * 8 + h], __float_as_int(n2)); }
        __syncthreads();
        if (tx_ < 16) KMAXP[blockIdx.x * 16 + tx_] = sqrtf(__int_as_float(smax[tx_]));
    }
}

__device__ __forceinline__ void ph_mamba_norm(bf16_t* PROJ, const bf16_t* XC, const float* nw) {
    const int tx_ = ltid();
    const int lane = tx_ & 63, gw = blockIdx.x * 8 + (tx_ >> 6), NGW = gridDim.x * 8;
    const float4 w0 = *(const float4*)(nw + lane * 8), w1 = *(const float4*)(nw + lane * 8 + 4);
    for (int row0 = gw; row0 < M; row0 += 8 * NGW) {
        uint4 yb[8], zb[8];
#pragma unroll
        for (int k = 0; k < 8; ++k) { const int rk = row0 + k * NGW; if (rk < M) { yb[k] = *(const uint4*)(XC + (size_t)rk * 1024 + lane * 8); zb[k] = *(const uint4*)(PROJ + (size_t)rk * NPROJ + PC_Z + lane * 8); } }
#pragma unroll
        for (int k = 0; k < 8; ++k) {
            const int row = row0 + k * NGW; if (row >= M) break;
            const uint4 yv = yb[k], zv = zb[k];
            float y[8] = {bflo(yv.x), bfhi(yv.x), bflo(yv.y), bfhi(yv.y), bflo(yv.z), bfhi(yv.z), bflo(yv.w), bfhi(yv.w)};
            const float z[8] = {bflo(zv.x), bfhi(zv.x), bflo(zv.y), bfhi(zv.y), bflo(zv.z), bfhi(zv.z), bflo(zv.w), bfhi(zv.w)};
            float ss = 0.f;
#pragma unroll
            for (int i = 0; i < 8; ++i) { y[i] *= silu_fast(z[i]); ss += y[i] * y[i]; }
            ss = wave_sum(ss); const float rstd = 1.0f / sqrtf(ss * (1.0f / 512.0f) + 1e-6f);
            uint4 o; o.x = pk2(y[0] * rstd * w0.x, y[1] * rstd * w0.y); o.y = pk2(y[2] * rstd * w0.z, y[3] * rstd * w0.w); o.z = pk2(y[4] * rstd * w1.x, y[5] * rstd * w1.y); o.w = pk2(y[6] * rstd * w1.z, y[7] * rstd * w1.w);
            *(uint4*)(PROJ + (size_t)row * NPROJ + PC_Z + lane * 8) = o;
        }
    }
}
__device__ __forceinline__ void ph_final(float* out, const float* nw) {
    const int tx_ = ltid();
    const int lane = tx_ & 63, gw = blockIdx.x * 8 + (tx_ >> 6), NGW = gridDim.x * 8;
    float4 nwv[4];
#pragma unroll
    for (int j = 0; j < 4; ++j) nwv[j] = ((const float4*)nw)[lane + 64 * j];
    for (int row0 = gw; row0 < M; row0 += 4 * NGW) {
        float4 vb[4][4];
#pragma unroll
        for (int k = 0; k < 4; ++k) { const int rk = row0 + k * NGW; if (rk < M) { const float4* xr = (const float4*)(out + (size_t)rk * D);
#pragma unroll
            for (int j = 0; j < 4; ++j) vb[k][j] = xr[lane + 64 * j]; } }
#pragma unroll
        for (int k = 0; k < 4; ++k) {
            const int row = row0 + k * NGW; if (row >= M) break;
            float4* xr = (float4*)(out + (size_t)row * D);
            float ss = 0.f;
#pragma unroll
            for (int j = 0; j < 4; ++j) { const float4 v = vb[k][j]; ss += v.x * v.x + v.y * v.y + v.z * v.z + v.w * v.w; }
            ss = wave_sum(ss); const float rstd = 1.0f / sqrtf(ss * (1.0f / D) + 1e-6f);
#pragma unroll
            for (int j = 0; j < 4; ++j) { const float4 v = vb[k][j], w4 = nwv[j]; xr[lane + 64 * j] = make_float4(v.x * rstd * w4.x, v.y * rstd * w4.y, v.z * rstd * w4.z, v.w * rstd * w4.w); }
        }
    }
}

namespace att {
typedef short bf16x8 __attribute__((ext_vector_type(8)));
typedef short s16x4 __attribute__((ext_vector_type(4)));
typedef float f32x16 __attribute__((ext_vector_type(16)));
typedef float f32x2_t __attribute__((ext_vector_type(2))); typedef __bf16 bf16x2_t __attribute__((ext_vector_type(2)));
__device__ __forceinline__ unsigned cvtpk(float lo, float hi) { f32x2_t v = {lo, hi}; bf16x2_t b = __builtin_convertvector(v, bf16x2_t); return __builtin_bit_cast(unsigned, b); }
constexpr float LOG2E = 1.4426950408889634f, C2 = 0.125f * LOG2E;
constexpr int ST_BYTES = 16384, OFF_BIAS = 65536, OFF_EB = OFF_BIAS + 1024, OFF_KMAX = OFF_EB + 32, OFF_TAB = OFF_BIAS + 2048, TAB_N = 1280, OFF_END = OFF_TAB + TAB_N * 4;
constexpr float FOX_THR = 25.f;
enum { MODE_FOX = 0, MODE_SWA = 1, MODE_MOBA = 2, MODE_MOWN = 3 };
#define LASC __attribute__((address_space(3)))
typedef short v4i16_t __attribute__((ext_vector_type(4)));

template <int MODE>
__device__ __forceinline__ void attn_unit(unsigned char* lds, bf16_t* PROJ, const float* AUX, const float* btab, int bcol, float sink, int b, int hq, int hk, int qb, int qcol, int kcol, int vcol, bool dry = false, const void* ex0 = nullptr, const void* ex1 = nullptr) {
    const int tid = ltid(), lane = tid & 63, wave = __builtin_amdgcn_readfirstlane(tid >> 6), r32 = lane & 31, hi = lane >> 5;
    const int q0 = qb * 256, qw = q0 + wave * 32, q = qw + r32;
    const size_t rowbase = (size_t)b * SEQ;
    float* tab = (float*)(lds + OFF_TAB);
    if constexpr (MODE == MODE_SWA) {
        if (tid < 512) { const int d = tid - 128; tab[tid] = (d >= 0 && d < 128) ? btab[rel_bucket(d) * 16 + bcol] * LOG2E : 0.f; }
    }
    if constexpr (MODE == MODE_MOBA || MODE == MODE_MOWN) {
        for (int d = tid; d < 1024; d += NT) tab[d] = btab[rel_bucket(d) * 16 + bcol] * LOG2E;
    }
    bf16x8 qr[4]; float gq[32]; float qn2 = 0.f;
    { const bf16_t* qp = PROJ + (rowbase + q) * NPROJ + qcol + hq * 64 + 8 * hi;
#pragma unroll
      for (int d0 = 0; d0 < 4; ++d0) { const uint4 u = *(const uint4*)(qp + 16 * d0);
          const float f[8] = {bflo(u.x), bfhi(u.x), bflo(u.y), bfhi(u.y), bflo(u.z), bfhi(u.z), bflo(u.w), bfhi(u.w)};
          if constexpr (MODE == MODE_MOBA) {
#pragma unroll
              for (int e = 0; e < 8; ++e) gq[d0 * 8 + e] = f[e]; }
          if constexpr (MODE == MODE_FOX) {
#pragma unroll
              for (int e = 0; e < 8; ++e) qn2 += f[e] * f[e]; }
          uint4 w; w.x = cvtpk(f[0] * C2, f[1] * C2); w.y = cvtpk(f[2] * C2, f[3] * C2); w.z = cvtpk(f[4] * C2, f[5] * C2); w.w = cvtpk(f[6] * C2, f[7] * C2);
          qr[d0] = __builtin_bit_cast(bf16x8, w); } }
    unsigned selmask = 0u;
    if constexpr (MODE == MODE_MOBA) {
        float g0 = -INFINITY, g1 = -INFINITY, g2 = -INFINITY; int i0 = -1, i1 = -1, i2 = -1;
        for (int n = 0; n < qb; ++n) {
            const float* km = AUX + ((size_t)(b * 32 + n)) * 512 + hk * 64 + 8 * hi; float g = 0.f;
#pragma unroll
            for (int d0 = 0; d0 < 4; ++d0) { const float4 k0 = *(const float4*)(km + 16 * d0), k1 = *(const float4*)(km + 16 * d0 + 4);
                g += gq[d0 * 8] * k0.x + gq[d0 * 8 + 1] * k0.y + gq[d0 * 8 + 2] * k0.z + gq[d0 * 8 + 3] * k0.w + gq[d0 * 8 + 4] * k1.x + gq[d0 * 8 + 5] * k1.y + gq[d0 * 8 + 6] * k1.z + gq[d0 * 8 + 7] * k1.w; }
            g += __shfl_xor(g, 32);
            if (g > g0) { g2 = g1; i2 = i1; g1 = g0; i1 = i0; g0 = g; i0 = n; }
            else if (g > g1) { g2 = g1; i2 = i1; g1 = g; i1 = n; }
            else if (g > g2) { g2 = g; i2 = n; }
        }
        if (i0 >= 0) selmask |= 1u << i0; if (i1 >= 0) selmask |= 1u << i1; if (i2 >= 0) selmask |= 1u << i2;
    }
    float carry = 0.f;
    f32x16 o0, o1;
#pragma unroll
    for (int r = 0; r < 16; ++r) { o0[r] = 0.f; o1[r] = 0.f; }
    float m = -1e30f, l = 0.f;
    if constexpr (MODE == MODE_SWA) { m = sink * LOG2E; l = hi == 0 ? 1.f : 0.f; }
    const int t_beg = (MODE == MODE_SWA) ? (qb > 0 ? 4 * qb - 2 : 0) : (MODE == MODE_MOWN ? 4 * qb : 0), t_end = 4 * (qb + 1);
    const int skey = tid >> 3, sch = tid & 7;
    const bf16_t* kg = PROJ + (rowbase + skey) * NPROJ + kcol + hk * 64 + sch * 8;
    const bf16_t* vg = PROJ + (rowbase + skey) * NPROJ + vcol + hk * 64 + sch * 8;
    const int kdst = skey * 128 + ((sch ^ ((skey >> 1) & 7)) * 16);
    uint4 kreg0, kreg1, vreg0, vreg1; float breg0 = 0.f, breg1 = 0.f;
#define ATT_LOAD1(t_, KR, VR, BR) do { KR = *(const uint4*)(kg + (size_t)(t_) * 64 * NPROJ); VR = *(const uint4*)(vg + (size_t)(t_) * 64 * NPROJ); \
        if (MODE == MODE_FOX) { if (tid < 64) BR = AUX[(rowbase + (t_) * 64 + tid) * 8 + hq]; } } while (0)
#define ATT_LOAD(s_) do { ATT_LOAD1(ATT_TI(2 * (s_)), kreg0, vreg0, breg0); ATT_LOAD1(ATT_TI(2 * (s_) + 1), kreg1, vreg1, breg1); } while (0)
#define ATT_STORE1(ts_, KR, VR, BR) do { unsigned char* sb_ = lds + (ts_) * ST_BYTES; \
        *(uint4*)(sb_ + kdst) = KR; *(uint4*)(sb_ + 8192 + skey * 128 + ((sch ^ (((skey >> 1) & 1) << 2)) * 16)) = VR; \
        if (MODE == MODE_FOX) { if (tid < 64) { float inc_ = BR; \
            _Pragma("unroll") for (int o_ = 1; o_ < 64; o_ <<= 1) { const float v_ = __shfl_up(inc_, o_); if (lane >= o_) inc_ += v_; } \
            const float tot_ = __shfl(inc_, 63); \
            ((float*)(lds + OFF_BIAS))[(ts_) * 64 + tid] = (carry + tot_ - inc_) * LOG2E;        \
            carry += tot_; if (tid == 0) ((float*)(lds + OFF_EB))[(ts_)] = carry * LOG2E; } } } while (0)
#define ATT_STORE(st) do { ATT_STORE1((st) * 2, kreg0, vreg0, breg0); ATT_STORE1((st) * 2 + 1, kreg1, vreg1, breg1); } while (0)
    const int ntile = t_end - t_beg;
#define ATT_TI(i) ((MODE == MODE_FOX) ? (t_end - 1 - (i)) : (t_beg + (i)))
    float qkb = 0.f;
    if constexpr (MODE == MODE_FOX) {
        if (tid < 64) { float km = 0.f;
#pragma unroll
            for (int i = 0; i < 4; ++i) km = fmaxf(km, btab[(tid * 4 + i) * 16 + b * 8 + hq]);
#pragma unroll
            for (int o = 1; o < 64; o <<= 1) km = fmaxf(km, __shfl_xor(km, o));
            if (tid == 0) *(float*)(lds + OFF_KMAX) = km; }
    }
    const int nstep = ntile >> 1;
    ATT_LOAD(0); ATT_STORE(0);
    if (1 < nstep) ATT_LOAD(1);
    __syncthreads();
    if constexpr (MODE == MODE_FOX) { qn2 += __shfl_xor(qn2, 32); qkb = sqrtf(qn2) * C2 * 1.01f * *(const float*)(lds + OFF_KMAX); }
    const int vtr_off = ((lane & 15) >> 2) * 128 + (16 * ((lane >> 4) & 1) + 4 * (lane & 3)) * 2 + 4 * hi * 128;
    bool started = false;
    for (int i = 0; i < nstep; ++i) {
        const int st = i & 1;
        if (i + 1 < nstep) ATT_STORE(st ^ 1);
        if (i + 2 < nstep) ATT_LOAD(i + 2);
#pragma unroll 1
        for (int sub = 0; sub < 2; ++sub) {
        const int t = ATT_TI(2 * i + sub), ts = st * 2 + sub;
        bool act = (64 * t <= qw + 31);
        if constexpr (MODE == MODE_SWA) act = act && (64 * t + 63 >= qw - 127);
        if constexpr (MODE == MODE_MOBA) { if (t < 4 * qb) act = __builtin_amdgcn_ballot_w64(((selmask >> (t >> 2)) & 1u) != 0u) != 0ull; }
        if (act) {
            const unsigned char* Ks = lds + ts * ST_BYTES; const unsigned char* Vt = Ks + 8192;
            f32x16 p0, p1;
            if constexpr (MODE == MODE_FOX) { const float* bt = (const float*)(lds + OFF_BIAS) + ts * 64;
#pragma unroll
                for (int g = 0; g < 4; ++g) { const float4 b0 = *(const float4*)(bt + 8 * g + 4 * hi), b1 = *(const float4*)(bt + 32 + 8 * g + 4 * hi);
                    p0[4 * g] = b0.x; p0[4 * g + 1] = b0.y; p0[4 * g + 2] = b0.z; p0[4 * g + 3] = b0.w; p1[4 * g] = b1.x; p1[4 * g + 1] = b1.y; p1[4 * g + 2] = b1.z; p1[4 * g + 3] = b1.w; }
            } else if constexpr (MODE == MODE_SWA) { const float* tp = tab + 128 + (q - 64 * t - 4 * hi);
#pragma unroll
                for (int r = 0; r < 16; ++r) { const int kofs = (r & 3) + 8 * (r >> 2); p0[r] = tp[-kofs]; p1[r] = tp[-kofs - 32]; }
            } else { const int dq = q - 64 * t - 4 * hi;
                if (64 * t + 63 + 790 <= qw) { const float c31 = tab[1023];
#pragma unroll
                    for (int r = 0; r < 16; ++r) { p0[r] = c31; p1[r] = c31; } }
                else {
#pragma unroll
                    for (int r = 0; r < 16; ++r) { const int kofs = (r & 3) + 8 * (r >> 2); const int d0_ = dq - kofs, d1_ = dq - kofs - 32;
                        p0[r] = tab[d0_ < 0 ? 0 : (d0_ > 1023 ? 1023 : d0_)]; p1[r] = tab[d1_ < 0 ? 0 : (d1_ > 1023 ? 1023 : d1_)]; } }
            }
#pragma unroll
            for (int d0 = 0; d0 < 4; ++d0) {
                const bf16x8 a0 = *(const bf16x8*)(Ks + r32 * 128 + (((2 * d0 + hi) ^ ((r32 >> 1) & 7)) * 16));
                const bf16x8 a1 = *(const bf16x8*)(Ks + (32 + r32) * 128 + (((2 * d0 + hi) ^ ((r32 >> 1) & 7)) * 16));
                p0 = __builtin_amdgcn_mfma_f32_32x32x16_bf16(a0, qr[d0], p0, 0, 0, 0);
                p1 = __builtin_amdgcn_mfma_f32_32x32x16_bf16(a1, qr[d0], p1, 0, 0, 0);
            }
            const int kb = 64 * t + 4 * hi;
            if constexpr (MODE == MODE_SWA) {
#pragma unroll
                for (int r = 0; r < 16; ++r) { const int kv = kb + (r & 3) + 8 * (r >> 2); if (kv > q || kv < q - 127) p0[r] = -INFINITY; if (kv + 32 > q || kv + 32 < q - 127) p1[r] = -INFINITY; }
            } else {
                if (64 * t + 63 > qw) {
#pragma unroll
                    for (int r = 0; r < 16; ++r) { const int kv = kb + (r & 3) + 8 * (r >> 2); if (kv > q) p0[r] = -INFINITY; if (kv + 32 > q) p1[r] = -INFINITY; }
                }
                if constexpr (MODE == MODE_MOBA) { if (t < 4 * qb && ((selmask >> (t >> 2)) & 1u) == 0u) {
#pragma unroll
                    for (int r = 0; r < 16; ++r) { p0[r] = -INFINITY; p1[r] = -INFINITY; } } }
            }
            float mx = fmaxf(p0[0], p1[0]);
#pragma unroll
            for (int r = 1; r < 16; ++r) mx = fmaxf(mx, fmaxf(p0[r], p1[r]));
            mx = fmaxf(mx, __shfl_xor(mx, 32));
            const float mn = fmaxf(m, mx);
            if (__builtin_amdgcn_ballot_w64(mn > m) != 0ull) {
                const float alpha = __builtin_amdgcn_exp2f(m - mn); l *= alpha;
#pragma unroll
                for (int r = 0; r < 16; ++r) { o0[r] *= alpha; o1[r] *= alpha; }
            }
            m = mn;
            float sum = 0.f;
#pragma unroll
            for (int r = 0; r < 16; ++r) { p0[r] = __builtin_amdgcn_exp2f(p0[r] - mn); p1[r] = __builtin_amdgcn_exp2f(p1[r] - mn); sum += p0[r] + p1[r]; }
            l += sum;
            bf16x8 pa[4];
#pragma unroll
            for (int ks = 0; ks < 4; ++ks) { uint4 w;
                if (ks < 2) { w.x = cvtpk(p0[8 * ks], p0[8 * ks + 1]); w.y = cvtpk(p0[8 * ks + 2], p0[8 * ks + 3]); w.z = cvtpk(p0[8 * ks + 4], p0[8 * ks + 5]); w.w = cvtpk(p0[8 * ks + 6], p0[8 * ks + 7]); }
                else { const int k2 = ks - 2; w.x = cvtpk(p1[8 * k2], p1[8 * k2 + 1]); w.y = cvtpk(p1[8 * k2 + 2], p1[8 * k2 + 3]); w.z = cvtpk(p1[8 * k2 + 4], p1[8 * k2 + 5]); w.w = cvtpk(p1[8 * k2 + 6], p1[8 * k2 + 7]); }
                pa[ks] = __builtin_bit_cast(bf16x8, w); }
#pragma unroll
            for (int ks = 0; ks < 4; ++ks) {
#pragma unroll
                for (int db = 0; db < 2; ++db) {
                    const LASC unsigned char* vp = (const LASC unsigned char*)(Vt + vtr_off + ks * 16 * 128 + ((db ^ ((lane >> 3) & 1)) * 64));
                    const s16x4 lo = __builtin_bit_cast(s16x4, __builtin_amdgcn_ds_read_tr16_b64_v4i16((LASC v4i16_t*)vp));
                    const s16x4 hh = __builtin_bit_cast(s16x4, __builtin_amdgcn_ds_read_tr16_b64_v4i16((LASC v4i16_t*)(vp + 8 * 128)));
                    const bf16x8 vf = {lo[0], lo[1], lo[2], lo[3], hh[0], hh[1], hh[2], hh[3]};
                    if (db == 0) o0 = __builtin_amdgcn_mfma_f32_32x32x16_bf16(vf, pa[ks], o0, 0, 0, 0);
                    else o1 = __builtin_amdgcn_mfma_f32_32x32x16_bf16(vf, pa[ks], o1, 0, 0, 0); }
            }
            started = true;
        }
        }
        if constexpr (MODE == MODE_FOX) {
            const float eb = ((const float*)(lds + OFF_EB))[st * 2 + 1];
            if (__syncthreads_and((started && (qkb + eb - m < -FOX_THR)) ? 1 : 0)) break;
        } else __syncthreads();
    }
    if constexpr (MODE == MODE_FOX) __syncthreads();
#undef ATT_LOAD
#undef ATT_STORE
#undef ATT_LOAD1
#undef ATT_STORE1
#undef ATT_TI
    l += __shfl_xor(l, 32);
    float inv = 1.0f / l;
    bf16_t* op = PROJ + (rowbase + q) * NPROJ + qcol + hq * 64 + 4 * hi;
    if (dry && inv != 123.4567f) return;
    if constexpr (MODE == MODE_MOWN) {
        const unsigned sel = ((const unsigned*)AUX)[(size_t)(b * 8 + hq) * SEQ + q]; const int cnt = (int)((sel >> 15) & 3u);
        const float* pl = (const float*)ex1 + ((rowbase + q) * 8 + hq) * 4;
        float R = m + __builtin_amdgcn_logf(l), wsum = 1.f;
#pragma unroll
        for (int r = 0; r < 16; ++r) { o0[r] *= inv; o1[r] *= inv; }
#pragma unroll 1
        for (int sl = 0; sl < cnt; ++sl) {
            const float ls = pl[sl]; const float Rn = fmaxf(R, ls), sc = __builtin_amdgcn_exp2f(R - Rn), ws_ = __builtin_amdgcn_exp2f(ls - Rn);
            const bf16_t* pp = (sl < 2) ? PROJ + (rowbase + q) * NPROJ + PC_XBC + (hq * 2 + sl) * 64 + 4 * hi : (const bf16_t*)ex0 + ((rowbase + q) * 8 + hq) * 64 + 4 * hi;
#pragma unroll
            for (int g = 0; g < 4; ++g) { const uint2 a0 = *(const uint2*)(pp + 8 * g), a1 = *(const uint2*)(pp + 32 + 8 * g);
                o0[4 * g] = o0[4 * g] * sc + ws_ * bflo(a0.x); o0[4 * g + 1] = o0[4 * g + 1] * sc + ws_ * bfhi(a0.x); o0[4 * g + 2] = o0[4 * g + 2] * sc + ws_ * bflo(a0.y); o0[4 * g + 3] = o0[4 * g + 3] * sc + ws_ * bfhi(a0.y);
                o1[4 * g] = o1[4 * g] * sc + ws_ * bflo(a1.x); o1[4 * g + 1] = o1[4 * g + 1] * sc + ws_ * bfhi(a1.x); o1[4 * g + 2] = o1[4 * g + 2] * sc + ws_ * bflo(a1.y); o1[4 * g + 3] = o1[4 * g + 3] * sc + ws_ * bfhi(a1.y); }
            wsum = wsum * sc + ws_; R = Rn;
        }
        inv = 1.0f / wsum;
    }
#pragma unroll
    for (int g = 0; g < 4; ++g) {
        *(uint2*)(op + 8 * g) = make_uint2(cvtpk(o0[4 * g] * inv, o0[4 * g + 1] * inv), cvtpk(o0[4 * g + 2] * inv, o0[4 * g + 3] * inv));
        *(uint2*)(op + 32 + 8 * g) = make_uint2(cvtpk(o1[4 * g] * inv, o1[4 * g + 1] * inv), cvtpk(o1[4 * g + 2] * inv, o1[4 * g + 3] * inv));
    }
}
}
namespace ssd {
using att::bf16x8; using att::s16x4; using att::f32x16; using att::cvtpk; using att::LOG2E;
#define LASC __attribute__((address_space(3)))
constexpr int STB = 40960;
constexpr int OFF_AL2 = 2 * STB, OFF_DTV = OFF_AL2 + 1024, OFF_E = OFF_DTV + 1024, OFF_HIN = 0;
__device__ __forceinline__ float chunk_scan(unsigned char* lds, const float* DT, size_t row0, int h, float A, int tid) {
    float* al = (float*)(lds + OFF_AL2); float* dtv = (float*)(lds + OFF_DTV);
    if (tid < 256) { const float d = DT[(row0 + tid) * 8 + h]; dtv[tid] = d; al[tid] = d * A; }
    __syncthreads();
    if (tid < 64) { const float4 a4 = *(const float4*)(al + 4 * tid); const float s = (a4.x + a4.y) + (a4.z + a4.w); float incl = s;
#pragma unroll
        for (int o = 1; o < 64; o <<= 1) { const float v = __shfl_up(incl, o); if (tid >= o) incl += v; }
        const float base = incl - s; float4 c4; c4.x = base + a4.x; c4.y = c4.x + a4.y; c4.z = c4.y + a4.z; c4.w = c4.z + a4.w; *(float4*)(al + 4 * tid) = c4; }
    __syncthreads();
    return al[255];
}
__device__ __forceinline__ void m1_unit(unsigned char* lds, bf16_t* XC, const float* DT, const float* a_log, const float* d_skip, bf16_t* STATES, float* CDEC, int b, int c, int h) {
    const int tid = ltid(), lane = tid & 63, wave = __builtin_amdgcn_readfirstlane(tid >> 6), r32 = lane & 31, hi = lane >> 5, g = h >> 2;
    const size_t row0 = (size_t)b * SEQ + c * 256; const int l = wave * 32 + r32;
    const float A = -expf(a_log[h]);
    float* al = (float*)(lds + OFF_AL2); float* dtv = (float*)(lds + OFF_DTV); float* ev = (float*)(lds + OFF_E);
    const float alast = chunk_scan(lds, DT, row0, h, A, tid);
    float myac = 0.f; if (tid < 256) myac = al[tid];
    __syncthreads();
    if (tid < 256) { ev[tid] = expf(alast - myac); al[tid] = myac * LOG2E; }
    if (tid == 0) CDEC[(b * 32 + c) * 8 + h] = expf(alast);
    __syncthreads();
    const float al_l = al[l];
    bf16x8 cfr[8];
    { const bf16_t* cp = XC + (row0 + l) * 1024 + 768 + g * 128 + 8 * hi;
#pragma unroll
      for (int k0 = 0; k0 < 8; ++k0) cfr[k0] = *(const bf16x8*)(cp + 16 * k0); }
    f32x16 o0, o1, sacc;
#pragma unroll
    for (int r = 0; r < 16; ++r) { o0[r] = 0.f; o1[r] = 0.f; sacc[r] = 0.f; }
    const int ss = tid >> 3, pc = tid & 7;
    const bf16_t* bg = XC + (row0 + ss) * 1024 + 512 + g * 128 + 16 * pc;
    const bf16_t* xg = XC + (row0 + ss) * 1024 + h * 64 + 8 * pc;
    uint4 b0r, b1r, xr;
#define SSD_LOAD(t) do { b0r = *(const uint4*)(bg + (size_t)(t) * 64 * 1024); b1r = *(const uint4*)(bg + (size_t)(t) * 64 * 1024 + 8); xr = *(const uint4*)(xg + (size_t)(t) * 64 * 1024); } while (0)
#define SSD_SC2(w, f) cvtpk(bflo(w) * (f), bfhi(w) * (f))
#define SSD_STORE(st, t) do { unsigned char* sb_ = lds + (st) * STB; \
        *(uint4*)(sb_ + ss * 256 + (((2 * pc) ^ (ss & 15)) * 16)) = b0r; *(uint4*)(sb_ + ss * 256 + (((2 * pc + 1) ^ (ss & 15)) * 16)) = b1r; \
        const float es_ = ev[(t) * 64 + ss], ds_ = dtv[(t) * 64 + ss]; \
        *(uint4*)(sb_ + 16384 + ss * 256 + pc * 32) = make_uint4(SSD_SC2(b0r.x, es_), SSD_SC2(b0r.y, es_), SSD_SC2(b0r.z, es_), SSD_SC2(b0r.w, es_));         \
        *(uint4*)(sb_ + 16384 + ss * 256 + pc * 32 + 16) = make_uint4(SSD_SC2(b1r.x, es_), SSD_SC2(b1r.y, es_), SSD_SC2(b1r.z, es_), SSD_SC2(b1r.w, es_)); \
        *(uint4*)(sb_ + 32768 + ss * 128 + pc * 16) = make_uint4(SSD_SC2(xr.x, ds_), SSD_SC2(xr.y, ds_), SSD_SC2(xr.z, ds_), SSD_SC2(xr.w, ds_)); } while (0)
    SSD_LOAD(0); SSD_STORE(0, 0);
    __syncthreads();
    const int nb = wave >> 1, pb = wave & 1;
    const int trx = ((lane & 15) >> 2) * 128 + (16 * ((lane >> 4) & 1) + 4 * (lane & 3)) * 2, trb = ((lane & 15) >> 2) * 256 + (16 * ((lane >> 4) & 1) + 4 * (lane & 3)) * 2;
#pragma unroll 1
    for (int t = 0; t < 4; ++t) {
        const int st = t & 1;
        if (t + 1 < 4) SSD_LOAD(t + 1);
        const unsigned char* Bs = lds + st * STB; const unsigned char* Bt = Bs + 16384; const unsigned char* Xt = Bs + 32768;
        if (64 * t <= wave * 32 + 31) {
            f32x16 p0, p1;
#pragma unroll
            for (int r = 0; r < 16; ++r) { p0[r] = 0.f; p1[r] = 0.f; }
#pragma unroll
            for (int k0 = 0; k0 < 8; ++k0) {
                const bf16x8 a0 = *(const bf16x8*)(Bs + r32 * 256 + (((2 * k0 + hi) ^ (r32 & 15)) * 16));
                const bf16x8 a1 = *(const bf16x8*)(Bs + (32 + r32) * 256 + (((2 * k0 + hi) ^ (r32 & 15)) * 16));
                p0 = __builtin_amdgcn_mfma_f32_32x32x16_bf16(a0, cfr[k0], p0, 0, 0, 0);
                p1 = __builtin_amdgcn_mfma_f32_32x32x16_bf16(a1, cfr[k0], p1, 0, 0, 0);
            }
#pragma unroll
            for (int gq = 0; gq < 4; ++gq) { const int sb0 = 64 * t + 8 * gq + 4 * hi;
                const float4 s0 = *(const float4*)(al + sb0), s1 = *(const float4*)(al + sb0 + 32);
                const float a0[4] = {s0.x, s0.y, s0.z, s0.w}, a1[4] = {s1.x, s1.y, s1.z, s1.w};
#pragma unroll
                for (int e = 0; e < 4; ++e) { const int r = 4 * gq + e;
                    p0[r] = (sb0 + e <= l) ? p0[r] * __builtin_amdgcn_exp2f(al_l - a0[e]) : 0.f;
                    p1[r] = (sb0 + 32 + e <= l) ? p1[r] * __builtin_amdgcn_exp2f(al_l - a1[e]) : 0.f; } }
            bf16x8 pa[4];
#pragma unroll
            for (int ks = 0; ks < 4; ++ks) { uint4 w;
                if (ks < 2) { w.x = cvtpk(p0[8 * ks], p0[8 * ks + 1]); w.y = cvtpk(p0[8 * ks + 2], p0[8 * ks + 3]); w.z = cvtpk(p0[8 * ks + 4], p0[8 * ks + 5]); w.w = cvtpk(p0[8 * ks + 6], p0[8 * ks + 7]); }
                else { const int k2 = ks - 2; w.x = cvtpk(p1[8 * k2], p1[8 * k2 + 1]); w.y = cvtpk(p1[8 * k2 + 2], p1[8 * k2 + 3]); w.z = cvtpk(p1[8 * k2 + 4], p1[8 * k2 + 5]); w.w = cvtpk(p1[8 * k2 + 6], p1[8 * k2 + 7]); }
                pa[ks] = __builtin_bit_cast(bf16x8, w); }
#pragma unroll
            for (int ks = 0; ks < 4; ++ks) {
#pragma unroll
                for (int db = 0; db < 2; ++db) {
                    const LASC unsigned char* vp = (const LASC unsigned char*)(Xt + trx + 4 * hi * 128 + ks * 16 * 128 + db * 64);
                    const s16x4 lo = __builtin_bit_cast(s16x4, __builtin_amdgcn_ds_read_tr16_b64_v4i16((LASC att::v4i16_t*)vp));
                    const s16x4 hh = __builtin_bit_cast(s16x4, __builtin_amdgcn_ds_read_tr16_b64_v4i16((LASC att::v4i16_t*)(vp + 8 * 128)));
                    const bf16x8 vf = {lo[0], lo[1], lo[2], lo[3], hh[0], hh[1], hh[2], hh[3]};
                    if (db == 0) o0 = __builtin_amdgcn_mfma_f32_32x32x16_bf16(vf, pa[ks], o0, 0, 0, 0);
                    else o1 = __builtin_amdgcn_mfma_f32_32x32x16_bf16(vf, pa[ks], o1, 0, 0, 0); } }
        }
        {
#pragma unroll
            for (int ks = 0; ks < 4; ++ks) {
                const LASC unsigned char* bp = (const LASC unsigned char*)(Bt + trb + (16 * ks + 8 * hi) * 256 + nb * 64);
                const s16x4 a_lo = __builtin_bit_cast(s16x4, __builtin_amdgcn_ds_read_tr16_b64_v4i16((LASC att::v4i16_t*)bp));
                const s16x4 a_hi = __builtin_bit_cast(s16x4, __builtin_amdgcn_ds_read_tr16_b64_v4i16((LASC att::v4i16_t*)(bp + 4 * 256)));
                const LASC unsigned char* xp = (const LASC unsigned char*)(Xt + trx + (16 * ks + 8 * hi) * 128 + pb * 64);
                const s16x4 x_lo = __builtin_bit_cast(s16x4, __builtin_amdgcn_ds_read_tr16_b64_v4i16((LASC att::v4i16_t*)xp));
                const s16x4 x_hi = __builtin_bit_cast(s16x4, __builtin_amdgcn_ds_read_tr16_b64_v4i16((LASC att::v4i16_t*)(xp + 4 * 128)));
                const bf16x8 af = {a_lo[0], a_lo[1], a_lo[2], a_lo[3], a_hi[0], a_hi[1], a_hi[2], a_hi[3]};
                const bf16x8 xf = {x_lo[0], x_lo[1], x_lo[2], x_lo[3], x_hi[0], x_hi[1], x_hi[2], x_hi[3]};
                sacc = __builtin_amdgcn_mfma_f32_32x32x16_bf16(af, xf, sacc, 0, 0, 0);
            }
        }
        if (t + 1 < 4) SSD_STORE(st ^ 1, t + 1);
        __syncthreads();
    }
#undef SSD_LOAD
#undef SSD_STORE
    { const float Dh = d_skip[h]; bf16_t* yp = XC + (row0 + l) * 1024 + h * 64 + 4 * hi;
#pragma unroll
      for (int gq = 0; gq < 4; ++gq) {
          const uint2 x0 = *(const uint2*)(yp + 8 * gq), x1 = *(const uint2*)(yp + 32 + 8 * gq);
          *(uint2*)(yp + 8 * gq) = make_uint2(cvtpk(o0[4 * gq] + Dh * bflo(x0.x), o0[4 * gq + 1] + Dh * bfhi(x0.x)), cvtpk(o0[4 * gq + 2] + Dh * bflo(x0.y), o0[4 * gq + 3] + Dh * bfhi(x0.y)));
          *(uint2*)(yp + 32 + 8 * gq) = make_uint2(cvtpk(o1[4 * gq] + Dh * bflo(x1.x), o1[4 * gq + 1] + Dh * bfhi(x1.x)), cvtpk(o1[4 * gq + 2] + Dh * bflo(x1.y), o1[4 * gq + 3] + Dh * bfhi(x1.y))); } }
    { bf16_t* sp = STATES + ((size_t)((b * 32 + c) * 8 + h)) * 8192 + (size_t)(r32 + 32 * pb) * 128 + 32 * nb + 4 * hi;
#pragma unroll
      for (int gq = 0; gq < 4; ++gq) *(uint2*)(sp + 8 * gq) = make_uint2(cvtpk(sacc[4 * gq], sacc[4 * gq + 1]), cvtpk(sacc[4 * gq + 2], sacc[4 * gq + 3])); }
    __syncthreads();
}
__device__ __forceinline__ void m2_unit(unsigned char* lds, bf16_t* XC, const float* DT, const float* a_log, const bf16_t* STATES, const float* CDEC, int b, int c, int h) {
    if (c == 0) return;
    const int tid = ltid(), lane = tid & 63, wave = __builtin_amdgcn_readfirstlane(tid >> 6), r32 = lane & 31, hi = lane >> 5, g = h >> 2;
    const size_t row0 = (size_t)b * SEQ + c * 256; const int l = wave * 32 + r32;
    const float A = -expf(a_log[h]);
    float* al = (float*)(lds + OFF_AL2);
    (void)chunk_scan(lds, DT, row0, h, A, tid);
    const float ea = expf(al[l]);
    float4 hin[4];
#pragma unroll
    for (int j = 0; j < 4; ++j) hin[j] = make_float4(0.f, 0.f, 0.f, 0.f);
    const bf16_t* sbase = STATES + ((size_t)((b * 32) * 8 + h)) * 8192 + 4 * tid;
    for (int c0 = 0; c0 < c; c0 += 4) {
        uint2 sv[4][4]; float dec[4];
#pragma unroll
        for (int k = 0; k < 4; ++k) { const int cc = (c0 + k < c) ? c0 + k : c - 1; dec[k] = CDEC[(b * 32 + cc) * 8 + h];
#pragma unroll
            for (int j = 0; j < 4; ++j) sv[k][j] = *(const uint2*)(sbase + (size_t)cc * 8 * 8192 + 2048 * j); }
#pragma unroll
        for (int k = 0; k < 4; ++k) if (c0 + k < c) {
#pragma unroll
            for (int j = 0; j < 4; ++j) { hin[j].x = hin[j].x * dec[k] + bflo(sv[k][j].x); hin[j].y = hin[j].y * dec[k] + bfhi(sv[k][j].x); hin[j].z = hin[j].z * dec[k] + bflo(sv[k][j].y); hin[j].w = hin[j].w * dec[k] + bfhi(sv[k][j].y); } } }
#pragma unroll
    for (int j = 0; j < 4; ++j) { const int idx = 4 * tid + 2048 * j, p = idx >> 7, n = idx & 127;
        *(uint2*)(lds + OFF_HIN + p * 256 + (((n >> 3) ^ (p & 15)) * 16) + (n & 7) * 2) = make_uint2(cvtpk(hin[j].x, hin[j].y), cvtpk(hin[j].z, hin[j].w)); }
    __syncthreads();
    bf16x8 cfr[8];
    { const bf16_t* cp = XC + (row0 + l) * 1024 + 768 + g * 128 + 8 * hi;
#pragma unroll
      for (int k0 = 0; k0 < 8; ++k0) cfr[k0] = *(const bf16x8*)(cp + 16 * k0); }
    f32x16 o0, o1;
#pragma unroll
    for (int r = 0; r < 16; ++r) { o0[r] = 0.f; o1[r] = 0.f; }
#pragma unroll
    for (int k0 = 0; k0 < 8; ++k0) {
        const bf16x8 h0 = *(const bf16x8*)(lds + OFF_HIN + r32 * 256 + (((2 * k0 + hi) ^ (r32 & 15)) * 16));
        const bf16x8 h1 = *(const bf16x8*)(lds + OFF_HIN + (32 + r32) * 256 + (((2 * k0 + hi) ^ (r32 & 15)) * 16));
        o0 = __builtin_amdgcn_mfma_f32_32x32x16_bf16(h0, cfr[k0], o0, 0, 0, 0);
        o1 = __builtin_amdgcn_mfma_f32_32x32x16_bf16(h1, cfr[k0], o1, 0, 0, 0);
    }
    { bf16_t* yp = XC + (row0 + l) * 1024 + h * 64 + 4 * hi;
#pragma unroll
      for (int gq = 0; gq < 4; ++gq) {
          const uint2 y0 = *(const uint2*)(yp + 8 * gq), y1 = *(const uint2*)(yp + 32 + 8 * gq);
          *(uint2*)(yp + 8 * gq) = make_uint2(cvtpk(bflo(y0.x) + ea * o0[4 * gq], bfhi(y0.x) + ea * o0[4 * gq + 1]), cvtpk(bflo(y0.y) + ea * o0[4 * gq + 2], bfhi(y0.y) + ea * o0[4 * gq + 3]));
          *(uint2*)(yp + 32 + 8 * gq) = make_uint2(cvtpk(bflo(y1.x) + ea * o1[4 * gq], bfhi(y1.x) + ea * o1[4 * gq + 1]), cvtpk(bflo(y1.y) + ea * o1[4 * gq + 2], bfhi(y1.y) + ea * o1[4 * gq + 3])); } }
    __syncthreads();
}
}

__device__ __forceinline__ void moba_select_unit(unsigned char* lds, const bf16_t* PROJ, const float* KMEAN, unsigned* SEL, int b, int h, int qb) {
    const int tid = ltid(), lane = tid & 63, hf = lane & 1;
    const int q = qb * 256 + (tid >> 1);
    float* km_s = (float*)lds;
    { const int n = tid >> 4, c4 = (tid & 15) * 4; *(float4*)(km_s + n * 64 + c4) = *(const float4*)(KMEAN + ((size_t)(b * 32 + n)) * 512 + h * 64 + c4); }
    __syncthreads();
    const bf16_t* qp = PROJ + ((size_t)b * SEQ + q) * NPROJ + PC_MQ + h * 64 + hf * 32;
    float qv[32];
#pragma unroll
    for (int c = 0; c < 4; ++c) { const uint4 u = *(const uint4*)(qp + c * 8);
        qv[c * 8 + 0] = bflo(u.x); qv[c * 8 + 1] = bfhi(u.x); qv[c * 8 + 2] = bflo(u.y); qv[c * 8 + 3] = bfhi(u.y); qv[c * 8 + 4] = bflo(u.z); qv[c * 8 + 5] = bfhi(u.z); qv[c * 8 + 6] = bflo(u.w); qv[c * 8 + 7] = bfhi(u.w); }
    float g0 = -INFINITY, g1 = -INFINITY, g2 = -INFINITY; int i0 = 31, i1 = 31, i2 = 31;
    for (int n = 0; n < qb; ++n) {
        const float* km = km_s + n * 64 + hf * 32; float g = 0.f;
#pragma unroll
        for (int c = 0; c < 8; ++c) { const float4 k4 = *(const float4*)(km + 4 * c); g += qv[4 * c] * k4.x + qv[4 * c + 1] * k4.y + qv[4 * c + 2] * k4.z + qv[4 * c + 3] * k4.w; }
        g += __shfl_xor(g, 1);
        if (g > g0) { g2 = g1; i2 = i1; g1 = g0; i1 = i0; g0 = g; i0 = n; }
        else if (g > g1) { g2 = g1; i2 = i1; g1 = g; i1 = n; }
        else if (g > g2) { g2 = g; i2 = n; }
    }
    const int cnt = qb < 3 ? qb : 3;
    if (hf == 0) SEL[(size_t)(b * 8 + h) * SEQ + q] = (unsigned)i0 | ((unsigned)i1 << 5) | ((unsigned)i2 << 10) | ((unsigned)cnt << 15);
    __syncthreads();
}
namespace gat { constexpr int OFF_LIST = 65536, OFF_TABG = 98304, OFF_CNT = 102400; }
__device__ __forceinline__ void moba_gather_unit(unsigned char* lds, bf16_t* PROJ, const unsigned* SEL, const float* btab, bf16_t* PO2, float* PL, int b, int h, int j, int qc) {
    using namespace att;
    const int tid = ltid(), lane = tid & 63, wave = __builtin_amdgcn_readfirstlane(tid >> 6), r32 = lane & 31, hi = lane >> 5;
    const size_t rowbase = (size_t)b * SEQ;
    float* tab = (float*)(lds + gat::OFF_TABG); unsigned* list = (unsigned*)(lds + gat::OFF_LIST); unsigned* cntp = (unsigned*)(lds + gat::OFF_CNT);
    for (int d = tid; d < 1024; d += NT) tab[d] = btab[rel_bucket(d) * 16 + h] * LOG2E;
    if (tid == 0) *cntp = 0u;
    { const int skey = tid >> 3, sch = tid & 7;
#pragma unroll
      for (int t = 0; t < 4; ++t) { const bf16_t* kp = PROJ + (rowbase + j * 256 + t * 64 + skey) * NPROJ + h * 64 + sch * 8;
          *(uint4*)(lds + t * ST_BYTES + skey * 128 + ((sch ^ ((skey >> 1) & 7)) * 16)) = *(const uint4*)(kp + PC_MK);
          *(uint4*)(lds + t * ST_BYTES + 8192 + skey * 128 + ((sch ^ (((skey >> 1) & 1) << 2)) * 16)) = *(const uint4*)(kp + PC_MV); } }
    __syncthreads();
    for (int half = 0; half < 2; ++half) {
        const int qf = 4096 * qc + 2048 * half + 4 * tid, qmin = 256 * (j + 1);
        const uint4 sv4 = *(const uint4*)(SEL + (size_t)(b * 8 + h) * SEQ + qf); const unsigned sv[4] = {sv4.x, sv4.y, sv4.z, sv4.w};
#pragma unroll
        for (int e = 0; e < 4; ++e) { int slot = -1; const int cnt = (int)((sv[e] >> 15) & 3u);
            if (qf + e >= qmin) { if ((int)(sv[e] & 31u) == j && cnt > 0) slot = 0; else if ((int)((sv[e] >> 5) & 31u) == j && cnt > 1) slot = 1; else if ((int)((sv[e] >> 10) & 31u) == j && cnt > 2) slot = 2; }
            const unsigned long long bal = __builtin_amdgcn_ballot_w64(slot >= 0);
            unsigned pos = 0u;
            if (lane == 0 && bal) pos = atomicAdd(cntp, (unsigned)__builtin_popcountll(bal));
            pos = __shfl(pos, 0);
            if (slot >= 0) list[pos + __builtin_popcountll(bal & ((1ull << lane) - 1ull))] = (unsigned)(qf + e) | ((unsigned)slot << 13); }
    }
    __syncthreads();
    const int n = (int)*cntp, ngroups = (n + 31) >> 5;
    const int vtr_off = ((lane & 15) >> 2) * 128 + (16 * ((lane >> 4) & 1) + 4 * (lane & 3)) * 2 + 4 * hi * 128;
    for (int grp = wave; grp < ngroups; grp += 8) {
        const int ei = 32 * grp + r32; const bool valid = ei < n; const unsigned ent = list[valid ? ei : n - 1];
        const int q = (int)(ent & 8191u), slot = (int)(ent >> 13);
        bf16x8 qr[4];
        { const bf16_t* qp = PROJ + (rowbase + q) * NPROJ + PC_MQ + h * 64 + 8 * hi;
#pragma unroll
          for (int d0 = 0; d0 < 4; ++d0) { const uint4 u = *(const uint4*)(qp + 16 * d0);
              uint4 w; w.x = cvtpk(bflo(u.x) * C2, bfhi(u.x) * C2); w.y = cvtpk(bflo(u.y) * C2, bfhi(u.y) * C2); w.z = cvtpk(bflo(u.z) * C2, bfhi(u.z) * C2); w.w = cvtpk(bflo(u.w) * C2, bfhi(u.w) * C2);
              qr[d0] = __builtin_bit_cast(bf16x8, w); } }
        f32x16 o0, o1;
#pragma unroll
        for (int r = 0; r < 16; ++r) { o0[r] = 0.f; o1[r] = 0.f; }
        float m = -1e30f, l = 0.f;
#pragma unroll 1
        for (int t = 0; t < 4; ++t) {
            const unsigned char* Ks = lds + t * ST_BYTES; const unsigned char* Vt = Ks + 8192;
            const int key0 = j * 256 + t * 64; f32x16 p0, p1;
            { const int dq = q - key0 - 4 * hi;
              if (__builtin_amdgcn_ballot_w64(q - (key0 + 63) >= 790) == ~0ull) { const float c31 = tab[1023];
#pragma unroll
                  for (int r = 0; r < 16; ++r) { p0[r] = c31; p1[r] = c31; } }
              else {
#pragma unroll
                  for (int r = 0; r < 16; ++r) { const int kofs = (r & 3) + 8 * (r >> 2); const int d0_ = dq - kofs, d1_ = dq - kofs - 32;
                      p0[r] = tab[d0_ > 1023 ? 1023 : d0_]; p1[r] = tab[d1_ > 1023 ? 1023 : d1_]; } } }
#pragma unroll
            for (int d0 = 0; d0 < 4; ++d0) {
                const bf16x8 a0 = *(const bf16x8*)(Ks + r32 * 128 + (((2 * d0 + hi) ^ ((r32 >> 1) & 7)) * 16));
                const bf16x8 a1 = *(const bf16x8*)(Ks + (32 + r32) * 128 + (((2 * d0 + hi) ^ ((r32 >> 1) & 7)) * 16));
                p0 = __builtin_amdgcn_mfma_f32_32x32x16_bf16(a0, qr[d0], p0, 0, 0, 0);
                p1 = __builtin_amdgcn_mfma_f32_32x32x16_bf16(a1, qr[d0], p1, 0, 0, 0);
            }
            float mx = fmaxf(p0[0], p1[0]);
#pragma unroll
            for (int r = 1; r < 16; ++r) mx = fmaxf(mx, fmaxf(p0[r], p1[r]));
            mx = fmaxf(mx, __shfl_xor(mx, 32));
            const float mn = fmaxf(m, mx);
            if (__builtin_amdgcn_ballot_w64(mn > m) != 0ull) {
                const float alpha = __builtin_amdgcn_exp2f(m - mn); l *= alpha;
#pragma unroll
                for (int r = 0; r < 16; ++r) { o0[r] *= alpha; o1[r] *= alpha; }
            }
            m = mn;
            float sum = 0.f;
#pragma unroll
            for (int r = 0; r < 16; ++r) { p0[r] = __builtin_amdgcn_exp2f(p0[r] - mn); p1[r] = __builtin_amdgcn_exp2f(p1[r] - mn); sum += p0[r] + p1[r]; }
            l += sum;
            bf16x8 pa[4];
#pragma unroll
            for (int ks = 0; ks < 4; ++ks) { uint4 w;
                if (ks < 2) { w.x = cvtpk(p0[8 * ks], p0[8 * ks + 1]); w.y = cvtpk(p0[8 * ks + 2], p0[8 * ks + 3]); w.z = cvtpk(p0[8 * ks + 4], p0[8 * ks + 5]); w.w = cvtpk(p0[8 * ks + 6], p0[8 * ks + 7]); }
                else { const int k2 = ks - 2; w.x = cvtpk(p1[8 * k2], p1[8 * k2 + 1]); w.y = cvtpk(p1[8 * k2 + 2], p1[8 * k2 + 3]); w.z = cvtpk(p1[8 * k2 + 4], p1[8 * k2 + 5]); w.w = cvtpk(p1[8 * k2 + 6], p1[8 * k2 + 7]); }
                pa[ks] = __builtin_bit_cast(bf16x8, w); }
#pragma unroll
            for (int ks = 0; ks < 4; ++ks) {
#pragma unroll
                for (int db = 0; db < 2; ++db) {
                    const LASC unsigned char* vp = (const LASC unsigned char*)(Vt + vtr_off + ks * 16 * 128 + ((db ^ ((lane >> 3) & 1)) * 64));
                    const s16x4 lo = __builtin_bit_cast(s16x4, __builtin_amdgcn_ds_read_tr16_b64_v4i16((LASC v4i16_t*)vp));
                    const s16x4 hh = __builtin_bit_cast(s16x4, __builtin_amdgcn_ds_read_tr16_b64_v4i16((LASC v4i16_t*)(vp + 8 * 128)));
                    const bf16x8 vf = {lo[0], lo[1], lo[2], lo[3], hh[0], hh[1], hh[2], hh[3]};
                    if (db == 0) o0 = __builtin_amdgcn_mfma_f32_32x32x16_bf16(vf, pa[ks], o0, 0, 0, 0);
                    else o1 = __builtin_amdgcn_mfma_f32_32x32x16_bf16(vf, pa[ks], o1, 0, 0, 0); }
            }
        }
        l += __shfl_xor(l, 32);
        const float inv = 1.0f / l;
        if (valid) {
            bf16_t* pp = (slot < 2) ? PROJ + (rowbase + q) * NPROJ + PC_XBC + (h * 2 + slot) * 64 + 4 * hi : PO2 + ((rowbase + q) * 8 + h) * 64 + 4 * hi;
#pragma unroll
            for (int g = 0; g < 4; ++g) {
                *(uint2*)(pp + 8 * g) = make_uint2(cvtpk(o0[4 * g] * inv, o0[4 * g + 1] * inv), cvtpk(o0[4 * g + 2] * inv, o0[4 * g + 3] * inv));
                *(uint2*)(pp + 32 + 8 * g) = make_uint2(cvtpk(o1[4 * g] * inv, o1[4 * g + 1] * inv), cvtpk(o1[4 * g + 2] * inv, o1[4 * g + 3] * inv)); }
            if (hi == 0) PL[((rowbase + q) * 8 + h) * 4 + slot] = m + __builtin_amdgcn_logf(l);
        }
    }
    __syncthreads();
}
#define MIX_WS ({ unsigned char* p_ = ws0; asm volatile("" : "+s"(p_)); p_; })
#define QUEUE_NEXT(u, word) do { if (tid == 0) *(volatile unsigned*)(lds + 131072 + 64) = atomicAdd((unsigned*)(MIX_WS + WS_CTL + 32768) + 64 * (word), 1u); \
        __syncthreads(); u = *(volatile unsigned*)(lds + 131072 + 64); __syncthreads(); } while (0)
__device__ __forceinline__ void ph_mixers(unsigned char* lds, unsigned char* ws0, const float* a_log, const float* d_skip, const float* sinks, const float* btab, int l) {
    const int tid = ltid();
    bool swa_ok = false;
    for (;;) {
        unsigned u; QUEUE_NEXT(u, 3 * l);
        if (u >= 2048u + 64u) break;
        if (u < 64u) {
            unsigned char* ws = MIX_WS;
            pg8::OneSched S; S.u0.A = (const char*)P_XN(ws) + (size_t)u * 256 * (D * 2); S.u0.B = (const char*)(ws + WS_WIN) + (size_t)INP_TILES * 256 * (D * 2);
            S.u0.lda2 = D * 2; S.u0.ldb2 = D * 2; S.u0.nt = D / 64; S.u0.pm = (int)u; S.u0.pn = INP_TILES; S.u0.aux = 0;
            pg8::EpiStoreBf16 E{P_PROJ(ws), NPROJ}; pg8::gemm_phase<pg8::EpiStoreBf16, pg8::OneSched, true>((LAS unsigned char*)lds, S, E);
            if (tid == 0) { __builtin_amdgcn_fence(__ATOMIC_RELEASE, "agent"); asm volatile("s_waitcnt vmcnt(0)" ::: "memory"); (void)q_add((unsigned*)(ws + WS_CTL + 32768) + 64 * (6 + l), 1u); }
            continue;
        }
        u -= 64u;
        const int k = (int)(u & 511u);
        if (u < 512u) { const int qb = 31 - (k >> 4), bh = k & 15; unsigned char* ws = MIX_WS;
            att::attn_unit<att::MODE_FOX>(lds, P_PROJ(ws), (const float*)(ws + WS_LF), (const float*)(ws + WS_CUM), 0, 0.f, bh >> 3, bh & 7, bh & 7, qb, PC_FQ, PC_FK, PC_FV); }
        else if (u < 1024u) { unsigned char* ws = MIX_WS; ssd::m1_unit(lds, P_XC(ws), (const float*)(ws + WS_DT), a_log, d_skip, (bf16_t*)(ws + WS_STATES), (float*)(ws + WS_CDEC), k >> 8, (k >> 3) & 31, k & 7); }
        else if (u < 1536u) { const int bh = k >> 5, qb = k & 31, hq = bh & 7; unsigned char* ws = MIX_WS;
            if (!swa_ok) {
                if (tid == 0) { unsigned sp = 0; while (q_ld((unsigned*)(ws + WS_CTL + 32768) + 64 * (6 + l)) < 64u) { __builtin_amdgcn_s_sleep(2); if (++sp > (1u << 22)) break; } }
                __syncthreads();
                __builtin_amdgcn_fence(__ATOMIC_ACQUIRE, "agent"); asm volatile("s_waitcnt vmcnt(0)" ::: "memory");
                __syncthreads();
                swa_ok = true; }
            att::attn_unit<att::MODE_SWA>(lds, P_PROJ(ws), nullptr, btab, 8 + hq, sinks[hq], bh >> 3, hq, hq >> 2, qb, PC_SQ, PC_SK, PC_SV); }
        else { const int qb = 31 - (k >> 4), bh = k & 15; unsigned char* ws = MIX_WS;
            moba_select_unit(lds, P_PROJ(ws), (const float*)(ws + WS_KMEAN), (unsigned*)(ws + WS_SEL), bh >> 3, bh & 7, qb); }
    }
}
__device__ __forceinline__ void ph_mixers_b(unsigned char* lds, unsigned char* ws0, const float* a_log, const float* btab, int l, const float* const* in) {
    const int tid = ltid();
    for (;;) {
        unsigned u; QUEUE_NEXT(u, 3 * l + 1);
        if (u >= 736u + 512u + (unsigned)((WCV_ALL - WCV_IN) / WCV_CHUNK)) break;
        if (u >= 736u + 512u) {
            const int lo = WCV_IN + (int)(u - (736u + 512u)) * WCV_CHUNK; unsigned char* ws = MIX_WS;
            ph_wconv(ws, in[1] + (size_t)l * D * DIN, in[11] + (size_t)l * 4 * 512 * 1024, in[12] + (size_t)l * D * D, in[15] + (size_t)l * D * DFF, in[16] + (size_t)l * D * DFF, in[17] + (size_t)l * DFF * D,
                     (LAS float*)lds, lo, lo + WCV_CHUNK, 0, 1);
            continue; }
        if (u < 736u) { const int bh = (int)u & 15, idx = (int)u >> 4;
            const int qc = idx < 15 ? 0 : 1, j = idx - (qc == 0 ? 0 : 15); unsigned char* ws = MIX_WS;
            moba_gather_unit(lds, P_PROJ(ws), (const unsigned*)(ws + WS_SEL), btab, (bf16_t*)(ws + WS_PO2), (float*)(ws + WS_PL), bh >> 3, bh & 7, j, qc); }
        else { const int k = (int)u - 736, c = 31 - (k >> 4), bh = k & 15; unsigned char* ws = MIX_WS;
            ssd::m2_unit(lds, P_XC(ws), (const float*)(ws + WS_DT), a_log, (const bf16_t*)(ws + WS_STATES), (const float*)(ws + WS_CDEC), bh >> 3, c, bh & 7); }
    }
}
__device__ __forceinline__ void ph_mixers_c(unsigned char* lds, unsigned char* ws0, const float* btab, const float* ssm_norm_w, int l) {
    const int tid = ltid();
    for (;;) {
        unsigned u; QUEUE_NEXT(u, 3 * l + 2);
        if (u >= 512u) break;
        const int qb = 31 - ((int)u >> 4), bh = (int)u & 15, h = bh & 7; unsigned char* ws = MIX_WS;
        att::attn_unit<att::MODE_MOWN>(lds, P_PROJ(ws), (const float*)(ws + WS_SEL), btab, h, 0.f, bh >> 3, h, h, qb, PC_MQ, PC_MK, PC_MV, false, (const void*)(ws + WS_PO2), (const void*)(ws + WS_PL));
    }
    { unsigned char* ws = MIX_WS; ph_mamba_norm(P_PROJ(ws), P_XC(ws), ssm_norm_w); }
}
#define XB_TMO      128
#define XB_XCNT(j)  (256  + 64 * (j))
#define XB_XSUB(j)  (1280 + 64 * (j))
#define XB_XGEN(j)  (2304 + 64 * (j))
#define XB_TOP      3328
#define XB_TOPGEN   3392
#define XCD_BAR_WORDS 3456
#define XB_SPIN_CAP (1u << 18)

__device__ __forceinline__ unsigned xb_ld(unsigned* p)              { return __hip_atomic_load(p, __ATOMIC_RELAXED, __HIP_MEMORY_SCOPE_AGENT); }
__device__ __forceinline__ unsigned xb_add(unsigned* p, unsigned v) { return __hip_atomic_fetch_add(p, v, __ATOMIC_RELAXED, __HIP_MEMORY_SCOPE_AGENT); }
__device__ __forceinline__ unsigned xb_xcc_id() { return (unsigned)__builtin_amdgcn_s_getreg((3 << 11) | 20) & 0xFu; }
#define XB_SPIN(cond, bar) do { unsigned _sp = 0; while (cond) { __builtin_amdgcn_s_sleep(1); \
    if ((++_sp & 255u) == 0u) { if (xb_ld(&(bar)[XB_TMO])) break; if (_sp > XB_SPIN_CAP) { atomicAdd(&(bar)[XB_TMO], 1u); break; } } } } while (0)

struct XcdBarrier {
    unsigned* bar; unsigned x;
    volatile LAS unsigned* st;
};

__device__ __forceinline__ XcdBarrier xcd_barrier_post(unsigned* bar, volatile LAS unsigned* st) {
    XcdBarrier b; b.bar = bar; b.x = xb_xcc_id(); b.st = st;
    if (threadIdx.x == 0) (void)xb_add(&bar[XB_XCNT(b.x)], 1u);
    return b;
}
__device__ __forceinline__ void xcd_barrier_complete(unsigned* bar, unsigned x, unsigned& nloc, unsigned& nx) {
    const unsigned G = gridDim.x * gridDim.y * gridDim.z;
    unsigned sum, cnt, mine, sp = 0u;
    for (;;) {
        sum = 0u; cnt = 0u; mine = 0u;
#pragma unroll
        for (unsigned j = 0; j < 16; ++j) { const unsigned c = xb_ld(&bar[XB_XCNT(j)]); sum += c; cnt += (c > 0u) ? 1u : 0u; mine = (j == x) ? c : mine; }
        if (sum == G) break;
        __builtin_amdgcn_s_sleep(1);
        if ((++sp & 255u) == 0u) { if (xb_ld(&bar[XB_TMO])) break; if (sp > XB_SPIN_CAP) { atomicAdd(&bar[XB_TMO], 1u); break; } }
    }
    nloc = mine > 0u ? mine : 1u; nx = cnt > 0u ? cnt : 1u;
}

__device__ __forceinline__ void xcd_barrier(const XcdBarrier& b) {
    asm volatile("s_waitcnt vmcnt(0)" ::: "memory");
    __syncthreads();
    if (threadIdx.x == 0) {
        unsigned* bar = b.bar;
        __builtin_amdgcn_s_waitcnt(0);
        unsigned nloc = b.st[0], nx = b.st[1];
        if (nloc == 0u) { xcd_barrier_complete(bar, b.x, nloc, nx); b.st[0] = nloc; b.st[1] = nx; }
        const unsigned old = xb_add(&bar[XB_XSUB(b.x)], 1u);
        const unsigned gen = old / nloc;
        if (old + 1u == (gen + 1u) * nloc) {
            __builtin_amdgcn_fence(__ATOMIC_RELEASE, "agent");
            asm volatile("s_waitcnt vmcnt(0)" ::: "memory");
            const unsigned og = xb_add(&bar[XB_TOP], 1u);
            const unsigned tg = og / nx;
            if (og + 1u == (tg + 1u) * nx) xb_add(&bar[XB_TOPGEN], 1u);
            else XB_SPIN(xb_ld(&bar[XB_TOPGEN]) == tg, bar);
            __builtin_amdgcn_fence(__ATOMIC_ACQUIRE, "agent");
            xb_add(&bar[XB_XGEN(b.x)], 1u);
            asm volatile("s_waitcnt vmcnt(0)" ::: "memory");
        } else {
            XB_SPIN(xb_ld(&bar[XB_XGEN(b.x)]) == gen, bar);
            __builtin_amdgcn_fence(__ATOMIC_ACQUIRE, "agent");
            asm volatile("s_waitcnt vmcnt(0)" ::: "memory");
        }
    }
    __syncthreads();
}

constexpr int MISC_OFF = 131072 + 320;
constexpr int LDS_BYTES = 147456;
constexpr int HROW_OFF = 69632;
#define GRID_SYNC() xcd_barrier(bar)
#define WSL ({ unsigned char* p_ = a.ws; asm volatile("" : "+s"(p_)); p_; })
__global__ void __launch_bounds__(NT, 2) fwd(Args a) {
    extern __shared__ __attribute__((aligned(16))) unsigned char lds[];
    LAS unsigned char* L = (LAS unsigned char*)lds;
    volatile LAS unsigned* MISC = (volatile LAS unsigned*)(L + MISC_OFF);
    if (threadIdx.x < 32) MISC[threadIdx.x] = 0u;
    __syncthreads();
    XcdBarrier bar = xcd_barrier_post((unsigned*)(a.ws + WS_CTL) + 4096, MISC + 8);
#pragma unroll 1
    for (int l = 0; l < 2; ++l) {
        {
            unsigned char* ws = WSL; const float* w_in = a.in[1] + (size_t)l * D * DIN;
            ph_wconv(ws, w_in, a.in[11] + (size_t)l * 4 * 512 * 1024, a.in[12] + (size_t)l * D * D, a.in[15] + (size_t)l * D * DFF, a.in[16] + (size_t)l * D * DFF, a.in[17] + (size_t)l * DFF * D, (LAS float*)L, 0, WCV_IN, blockIdx.x, gridDim.x);
            __syncthreads();
            if (l == 0) ph_norm<false>((float*)lds, a.in[0], a.in[13] + l * D, P_XN(ws), true, w_in, a.in[4] + l * 8, a.in[8] + l * 8, (float*)(ws + WS_DT), (float*)(ws + WS_LF), (bf16_t*)a.out);
            else ph_norm<true>((float*)lds, a.out, a.in[13] + l * D, P_XN(ws), true, w_in, a.in[4] + l * 8, a.in[8] + l * 8, (float*)(ws + WS_DT), (float*)(ws + WS_LF), nullptr);
        }
        GRID_SYNC();
        {
            unsigned char* ws = WSL;
            pg8::PlainSched S; S.T.init(M / 256, INP_TILES, gridDim.x, blockIdx.x); S.A = (const char*)P_XN(ws); S.B = (const char*)(ws + WS_WIN); S.lda2 = D * 2; S.ldb2 = D * 2; S.nt = D / 64;
            pg8::EpiStoreBf16 E{P_PROJ(ws), NPROJ}; pg8::gemm_phase<pg8::EpiStoreBf16, pg8::PlainSched, true>(L, S, E);
        }
        GRID_SYNC();
        { unsigned char* ws = WSL; ph_pre(lds, P_PROJ(ws), a.in[2] + (size_t)l * 4 * 1024, a.in[3] + l * 1024, P_XC(ws), (float*)(ws + WS_KMEAN), (float*)(ws + WS_CUM)); }
        GRID_SYNC();
        ph_mixers(lds, a.ws, a.in[5] + l * 8, a.in[6] + l * 8, a.in[9] + l * 8, a.in[10], l);
        GRID_SYNC();
        ph_mixers_b(lds, a.ws, a.in[5] + l * 8, a.in[10], l, a.in);
        GRID_SYNC();
        ph_mixers_c(lds, a.ws, a.in[10], a.in[7] + l * 512, l);
        GRID_SYNC();
        {
            unsigned char* ws = WSL;
            pg8::PlainSched S; S.T.init(M / 256, 4096 / 256, gridDim.x, blockIdx.x); S.A = (const char*)P_XN(ws); S.B = (const char*)(ws + WS_WG); S.lda2 = D * 2; S.ldb2 = D * 2; S.nt = D / 64;
            pg8::EpiGate E{P_PROJ(ws), P_XC(ws)}; pg8::gemm_phase<pg8::EpiGate, pg8::PlainSched, true>(L, S, E);
        }
        GRID_SYNC();
        {
            unsigned char* ws = WSL;
            pg8::BranchSched S; S.T.init(M / 256, D / 256, gridDim.x, blockIdx.x); S.PROJ = (const char*)P_PROJ(ws); S.WBR = (const char*)(ws + WS_WBR);
            pg8::EpiBranch E{P_PROJ(ws), P_XC(ws), P_XN(ws)}; pg8::gemm_phase<pg8::EpiBranch, pg8::BranchSched, true>(L, S, E);
        }
        GRID_SYNC();
        {
            unsigned char* ws = WSL;
            pg8::PlainSched S; S.T.init(M / 256, D / 256, gridDim.x, blockIdx.x); S.A = (const char*)P_XN(ws); S.B = (const char*)(ws + WS_WOUT); S.lda2 = D * 2; S.ldb2 = D * 2; S.nt = D / 64;
            pg8::EpiRes E{(const bf16_t*)a.out, (void*)P_XC(ws), false}; pg8::gemm_phase<pg8::EpiRes, pg8::PlainSched, false>(L, S, E);
        }
        GRID_SYNC();
        { unsigned char* ws = WSL; ph_norm<true>(nullptr, P_XC(ws), a.in[14] + l * D, P_XN(ws), false, nullptr, nullptr, nullptr, nullptr, nullptr, nullptr); }
        GRID_SYNC();
        {
            unsigned char* ws = WSL;
            pg8::PlainSched S; S.T.init(M / 256, 2 * DFF / 256, gridDim.x, blockIdx.x); S.A = (const char*)P_XN(ws); S.B = (const char*)(ws + WS_WGU); S.lda2 = D * 2; S.ldb2 = D * 2; S.nt = D / 64;
            pg8::EpiSwiglu E{P_PROJ(ws)}; pg8::gemm_phase<pg8::EpiSwiglu, pg8::PlainSched, true>(L, S, E);
        }
        GRID_SYNC();
        {
            unsigned char* ws = WSL;
            pg8::PlainSched S; S.T.init(M / 256, D / 256, gridDim.x, blockIdx.x); S.A = (const char*)P_PROJ(ws); S.B = (const char*)(ws + WS_WDN); S.lda2 = DFF * 2; S.ldb2 = DFF * 2; S.nt = DFF / 64;
            pg8::EpiRes E{P_XC(ws), (void*)a.out, l == 1}; pg8::gemm_phase<pg8::EpiRes, pg8::PlainSched, false>(L, S, E);
        }
        GRID_SYNC();
    }
    ph_final(a.out, a.in[18]);
}

extern "C" void kernel_launch(void* const* d_in, const int* in_sizes, int n_in, void* d_out, int out_size, void* d_ws, size_t ws_size, hipStream_t stream) {
    static int grid = 0;
    if (grid == 0) {
        if (n_in != 19 || out_size != M * D || ws_size < WS_TOTAL) { fprintf(stderr, "kernel_launch: unexpected shapes (n_in %d out %d ws %zu)\n", n_in, out_size, ws_size); grid = -1; return; }
        int dev = 0, cus = 0, per_cu = 0;
        (void)hipGetDevice(&dev); (void)hipDeviceGetAttribute(&cus, hipDeviceAttributeMultiprocessorCount, dev);
        if (hipFuncSetAttribute((const void*)fwd, hipFuncAttributeMaxDynamicSharedMemorySize, LDS_BYTES) != hipSuccess) { fprintf(stderr, "kernel_launch: hipFuncSetAttribute failed\n"); grid = -1; return; }
        (void)hipOccupancyMaxActiveBlocksPerMultiprocessor(&per_cu, (const void*)fwd, NT, LDS_BYTES);
        if (per_cu < 1) { fprintf(stderr, "kernel_launch: occupancy query says 0 blocks per CU\n"); grid = -1; return; }
        grid = cus < 256 ? cus : 256;
    }
    if (grid < 0) return;
    if (hipMemsetAsync((char*)d_ws + WS_CTL, 0, CTL_ZERO_BYTES, stream) != hipSuccess) { fprintf(stderr, "kernel_launch: memset of the control words failed\n"); return; }
    Args a{};
    for (int i = 0; i < 19; ++i) a.in[i] = (const float*)d_in[i];
    a.out = (float*)d_out; a.ws = (unsigned char*)d_ws;
    hipLaunchKernelGGL(fwd, dim3(grid), dim3(NT), LDS_BYTES, stream, a);
}
```

```cpp
#include <hip/hip_runtime.h>
#include <hip/hip_cooperative_groups.h>
#include <cstdio>
#include <cstdint>
namespace cg = cooperative_groups;

#ifndef SINGLE_LAUNCH
#define SINGLE_LAUNCH 0
#endif

typedef unsigned short bf16_t;
constexpr int M = 16384, SEQ = 8192, D = 1024, DIN = 9488, NPROJ = 5376, DFF = 2816;
constexpr int NT = 512;
constexpr int INP_TILES = 20;
constexpr int PC_Z = 0, PC_XBC = 512, PC_MQ = 1536, PC_MK = 2048, PC_MV = 2560, PC_FQ = 3072, PC_FK = 3584, PC_FV = 4096, PC_SQ = 4608, PC_SK = 5120, PC_SV = 5248;
constexpr int WC_DT = 1536, WC_F = 4616, WC_GATE = 5392;
constexpr size_t MiB = 1u << 20;
constexpr size_t WS_XN = 0, WS_PROJ = 32 * MiB, WS_XC = 200 * MiB, WS_DT = 232 * MiB, WS_LF = WS_DT + MiB / 2, WS_CUM = 233 * MiB, WS_KMEAN = WS_CUM + MiB / 2;
constexpr size_t WS_WIN = 234 * MiB;
constexpr size_t WS_WG = WS_WIN + (size_t)NPROJ * D * 2;
constexpr size_t WS_WBR = WS_WG + (size_t)4096 * D * 2;
constexpr size_t WS_WOUT = WS_WBR + (size_t)4 * D * 512 * 2;
constexpr size_t WS_WGU = WS_WOUT + (size_t)D * D * 2;
constexpr size_t WS_WDN = WS_WGU + (size_t)2 * DFF * D * 2;
constexpr size_t WS_END = WS_WDN + (size_t)D * DFF * 2;
static_assert(WS_END <= 276 * MiB, "workspace map");

constexpr size_t WS_CTL = 276 * MiB, CTL_ZERO_BYTES = 65536, WS_CDEC = WS_CTL + 131072, WS_TOTAL = 294 * MiB;
constexpr size_t WS_STATES = 234 * MiB, WS_PL = WS_STATES + 8 * MiB;
constexpr size_t WS_PO2 = 277 * MiB, WS_SEL = 293 * MiB;
#define P_XN(w) ((bf16_t*)((w) + WS_XN))
#define P_PROJ(w) ((bf16_t*)((w) + WS_PROJ))
#define P_XC(w) ((bf16_t*)((w) + WS_XC))
struct Args { const float* in[19]; float* out; unsigned char* ws; int ph_lo, ph_hi, coop, pad; };

__device__ __forceinline__ float bf2f(unsigned v) { return __uint_as_float(v << 16); }
__device__ __forceinline__ float bflo(unsigned v) { return __uint_as_float(v << 16); }
__device__ __forceinline__ float bfhi(unsigned v) { return __uint_as_float(v & 0xffff0000u); }
__device__ __forceinline__ unsigned f2bf(float f) { unsigned u = __float_as_uint(f); return (u + 0x7fffu + ((u >> 16) & 1u)) >> 16; }
__device__ __forceinline__ unsigned pk2(float lo, float hi) { return f2bf(lo) | (f2bf(hi) << 16); }
__device__ __forceinline__ float wave_sum(float v) {
#pragma unroll
    for (int o = 1; o < 64; o <<= 1) v += __shfl_xor(v, o);
    return v;
}
__device__ __forceinline__ unsigned q_ld(unsigned* p)              { return __hip_atomic_load(p, __ATOMIC_RELAXED, __HIP_MEMORY_SCOPE_AGENT); }
__device__ __forceinline__ unsigned q_add(unsigned* p, unsigned v) { return __hip_atomic_fetch_add(p, v, __ATOMIC_RELAXED, __HIP_MEMORY_SCOPE_AGENT); }
__device__ __forceinline__ int ltid() { int t = threadIdx.x; asm volatile("" : "+v"(t)); return t; }
__device__ __forceinline__ float log1p_pos(float e) {
    const float small = e * (1.f + e * (-0.5f + e * (0.33333333f + e * (-0.25f + e * 0.2f))));
    return e < 0.02f ? small : logf(1.f + e);
}
__device__ __forceinline__ float softplus_f(float x) { return fmaxf(x, 0.f) + log1p_pos(expf(-fabsf(x))); }
__device__ __forceinline__ float silu_f(float x) { return x / (1.f + expf(-x)); }
__device__ __forceinline__ float sigmoid_f(float x) { return 1.f / (1.f + expf(-x)); }
__device__ __forceinline__ int rel_bucket(int d) {
    if (d < 16) return d;
    int b = 16;
    b += (d >= 21); b += (d >= 27); b += (d >= 35); b += (d >= 46); b += (d >= 59); b += (d >= 77); b += (d >= 99); b += (d >= 128);
    b += (d >= 166); b += (d >= 216); b += (d >= 280); b += (d >= 363); b += (d >= 470); b += (d >= 609); b += (d >= 790);
    return b;
}

template <bool IN_BF16>
__device__ __forceinline__ void ph_norm(float* wd, const void* xin, const float* nw, bf16_t* XN, bool dots, const float* w_in, const float* dt_bias, const float* fbias, float* DT, float* LF, bf16_t* R0) {
    const int tx_ = ltid();
    const int lane = tx_ & 63, wave = tx_ >> 6;
    const int gw = blockIdx.x * 8 + wave, NGW = gridDim.x * 8;
    if (dots) {
        for (int i = tx_; i < 1024 * 4; i += NT) { const int k = i >> 2, part = i & 3;
            *(float4*)((char*)wd + (k >> 2) * 272 + (k & 3) * 64 + part * 16) = *(const float4*)(w_in + (size_t)k * DIN + (part < 2 ? WC_DT + part * 4 : WC_F + (part - 2) * 4)); }
        __syncthreads();
    }
    float4 nwv[4];
#pragma unroll
    for (int j = 0; j < 4; ++j) nwv[j] = ((const float4*)nw)[lane + 64 * j];
    for (int row0 = gw; row0 < M; row0 += 4 * NGW) {
    float4 vb[IN_BF16 ? 1 : 4][4]; uint2 ub[IN_BF16 ? 4 : 1][4];
#pragma unroll
    for (int k = 0; k < 4; ++k) { const int rk = row0 + k * NGW; if (rk < M) {
        if constexpr (IN_BF16) { const uint2* xr = (const uint2*)((const bf16_t*)xin + (size_t)rk * D);
#pragma unroll
            for (int j = 0; j < 4; ++j) ub[k][j] = xr[lane + 64 * j]; }
        else { const float4* xr = (const float4*)((const float*)xin + (size_t)rk * D);
#pragma unroll
            for (int j = 0; j < 4; ++j) vb[k][j] = xr[lane + 64 * j]; } } }
#pragma unroll
    for (int k = 0; k < 4; ++k) {
        const int row = row0 + k * NGW; if (row >= M) break;
        float4 v[4]; float ss = 0.f;
#pragma unroll
        for (int j = 0; j < 4; ++j) {
            if constexpr (IN_BF16) v[j] = make_float4(bflo(ub[k][j].x), bfhi(ub[k][j].x), bflo(ub[k][j].y), bfhi(ub[k][j].y)); else v[j] = vb[k][j];
            ss += v[j].x * v[j].x + v[j].y * v[j].y + v[j].z * v[j].z + v[j].w * v[j].w; }
        if constexpr (!IN_BF16) { if (R0) { uint2* rp = (uint2*)(R0 + (size_t)row * D);
#pragma unroll
            for (int j = 0; j < 4; ++j) rp[lane + 64 * j] = make_uint2(pk2(v[j].x, v[j].y), pk2(v[j].z, v[j].w)); } }
        ss = wave_sum(ss);
        const float rstd = 1.0f / sqrtf(ss * (1.0f / D) + 1e-6f);
#pragma unroll
        for (int j = 0; j < 4; ++j) { const float4 w4 = nwv[j]; v[j].x *= rstd * w4.x; v[j].y *= rstd * w4.y; v[j].z *= rstd * w4.z; v[j].w *= rstd * w4.w; }
        uint2* o = (uint2*)(XN + (size_t)row * D);
#pragma unroll
        for (int j = 0; j < 4; ++j) o[lane + 64 * j] = make_uint2(pk2(v[j].x, v[j].y), pk2(v[j].z, v[j].w));
        if (dots) {
            float d[16];
#pragma unroll
            for (int c = 0; c < 16; ++c) d[c] = 0.f;
#pragma unroll
            for (int j = 0; j < 4; ++j) { const float hv[4] = {v[j].x, v[j].y, v[j].z, v[j].w};
#pragma unroll
                for (int e = 0; e < 4; ++e) { const float* wr = (const float*)((const char*)wd + (lane + 64 * j) * 272 + e * 64); const float h = hv[e];
                    const float4 a0 = *(const float4*)(wr), a1 = *(const float4*)(wr + 4), b0 = *(const float4*)(wr + 8), b1 = *(const float4*)(wr + 12);
                    d[0] += h * a0.x; d[1] += h * a0.y; d[2] += h * a0.z; d[3] += h * a0.w; d[4] += h * a1.x; d[5] += h * a1.y; d[6] += h * a1.z; d[7] += h * a1.w;
                    d[8] += h * b0.x; d[9] += h * b0.y; d[10] += h * b0.z; d[11] += h * b0.w; d[12] += h * b1.x; d[13] += h * b1.y; d[14] += h * b1.z; d[15] += h * b1.w; }
                asm volatile("" ::: "memory"); }
            float r8[8], r4[4], r2[2];
            { const bool up = (lane & 32) != 0;
#pragma unroll
              for (int i = 0; i < 8; ++i) { const float keep = up ? d[i + 8] : d[i], send = up ? d[i] : d[i + 8]; r8[i] = keep + __shfl_xor(send, 32); } }
            { const bool up = (lane & 16) != 0;
#pragma unroll
              for (int i = 0; i < 4; ++i) { const float keep = up ? r8[i + 4] : r8[i], send = up ? r8[i] : r8[i + 4]; r4[i] = keep + __shfl_xor(send, 16); } }
            { const bool up = (lane & 8) != 0;
#pragma unroll
              for (int i = 0; i < 2; ++i) { const float keep = up ? r4[i + 2] : r4[i], send = up ? r4[i] : r4[i + 2]; r2[i] = keep + __shfl_xor(send, 8); } }
            float mine; { const bool up = (lane & 4) != 0; const float keep = up ? r2[1] : r2[0], send = up ? r2[0] : r2[1]; mine = keep + __shfl_xor(send, 4); }
            mine += __shfl_xor(mine, 2); mine += __shfl_xor(mine, 1);
            const int col = ((lane >> 5) & 1) * 8 + ((lane >> 4) & 1) * 4 + ((lane >> 3) & 1) * 2 + ((lane >> 2) & 1);
            if ((lane & 3) == 0) { if (col < 8) DT[(size_t)row * 8 + col] = softplus_f(mine + dt_bias[col]); else LF[(size_t)row * 8 + (col - 8)] = -softplus_f(-(mine + fbias[col - 8])); }
        }
    }    }
}

namespace pg8 {
#define PG8_LAS __attribute__((address_space(3)))
typedef short bf16x8 __attribute__((ext_vector_type(8)));
typedef float f32x4 __attribute__((ext_vector_type(4)));
typedef unsigned u32x4 __attribute__((ext_vector_type(4)));
constexpr int BM = 256, BK = 64, HALF = 128, HTB = HALF * BK * 2, STAGE_BYTES = 8 * HTB, NXCD = 8, WGM = 8;
__host__ __device__ __forceinline__ int lds_byte(int r, int c) { const int st = (r >> 4) * 2 + (c >> 5), rr = r & 15, cc = c & 31, ob = rr * 64 + cc * 2; return st * 1024 + (ob ^ (((ob >> 9) & 1) << 5)); }
__host__ __device__ __forceinline__ void stage_rc(int b, int& R, int& C) { const int st = b / 1024, sb = b % 1024, swz = sb ^ (((sb >> 9) & 1) << 5); R = (st >> 1) * 16 + swz / 64; C = (st & 1) * 32 + (swz % 64) / 2; }
__host__ __device__ __forceinline__ int perm32(int rho) { const int n = rho >> 4, i = rho & 15; return 8 * (i >> 2) + 4 * n + (i & 3); }
struct Unit { const char* A; const char* B; unsigned lda2, ldb2; int nt, pm, pn, aux; };
struct TileOrder {
    int nM, nN, nwg, G, c;
    __device__ void init(int nM_, int nN_, int G_, int c_) { nM = nM_; nN = nN_; nwg = nM * nN; G = G_; c = c_; }
    __device__ bool tile(int i, int& pm, int& pn) const {
        const long L = (long)i * G + c; if (L >= nwg) return false;
        int wgid = (int)L; { const int q = nwg / NXCD, r = nwg % NXCD, xcd = wgid % NXCD, off = wgid / NXCD; wgid = (xcd < r ? xcd * (q + 1) : r * (q + 1) + (xcd - r) * q) + off; }
        const int nig = WGM * nN, gid = wgid / nig, fm = gid * WGM, gsz = (nM - fm) < WGM ? (nM - fm) : WGM;
        pm = fm + ((wgid % nig) % gsz); pn = (wgid % nig) / gsz; return true;
    }
};
typedef float f32x2_t __attribute__((ext_vector_type(2))); typedef __bf16 bf16x2_t __attribute__((ext_vector_type(2)));
__device__ __forceinline__ unsigned cvt_pk_bf16(float lo, float hi) { f32x2_t v = {lo, hi}; bf16x2_t b = __builtin_convertvector(v, bf16x2_t); return __builtin_bit_cast(unsigned, b); }

template <class Epi, class Sched, bool ALIGN_EPI>
__device__ __forceinline__ void gemm_phase(PG8_LAS unsigned char* lds, const Sched& S, const Epi& E) {
    int tid = threadIdx.x; asm volatile("" : "+v"(tid));
    const int wid = __builtin_amdgcn_readfirstlane(tid >> 6), lane = tid & 63, wr = wid >> 2, wc = wid & 3, fr = lane & 15, fq = lane >> 4;
    unsigned RA[2], RB[2], C2[2];
#pragma unroll
    for (int i = 0; i < 2; ++i) { int R, C; stage_rc(tid * 16 + i * 8192, R, C); RA[i] = (unsigned)R; RB[i] = (unsigned)(Epi::PERM ? ((R & ~31) + perm32(R & 31)) : R); C2[i] = (unsigned)(C * 2); }
    const unsigned ldsw = (unsigned)wid * 1024u;
    const int aoff = lds_byte(wr * 64 + fr, fq * 8), boff = lds_byte(wc * 32 + fr, fq * 8);
#define PG8_SA(b, h) (((b) * 2 + (h)) * HTB)
#define PG8_SB(b, h) ((4 + (b) * 2 + (h)) * HTB)
#define PG8_STAGE(bufoff, gbase, RR, pitch) do { _Pragma("unroll") for (int _i = 0; _i < 2; ++_i) \
        __builtin_amdgcn_global_load_lds((const unsigned*)((const char*)(gbase) + (RR[_i] * (pitch) + C2[_i])), (PG8_LAS unsigned*)(lds + (bufoff) + ldsw + _i * 8192), 16, 0, 0); } while (0)
#define PG8_LDA(dst, b, h) do { _Pragma("unroll") for (int m = 0; m < 4; ++m) _Pragma("unroll") for (int k = 0; k < 2; ++k) dst[m][k] = *(const PG8_LAS bf16x8*)(lds + PG8_SA(b, h) + aoff + m * 2048 + k * 1024); } while (0)
#define PG8_LDB(dst, b, h) do { _Pragma("unroll") for (int n = 0; n < 2; ++n) _Pragma("unroll") for (int k = 0; k < 2; ++k) dst[n][k] = *(const PG8_LAS bf16x8*)(lds + PG8_SB(b, h) + boff + n * 2048 + k * 1024); } while (0)
#define PG8_MMA(ai, bj, At, Bt) do { __builtin_amdgcn_s_setprio(1); _Pragma("unroll") for (int m = 0; m < 4; ++m) _Pragma("unroll") for (int n = 0; n < 2; ++n) _Pragma("unroll") for (int k = 0; k < 2; ++k) \
        acc[ai][bj][m][n] = __builtin_amdgcn_mfma_f32_16x16x32_bf16(Bt[n][k], At[m][k], acc[ai][bj][m][n], 0, 0, 0); __builtin_amdgcn_s_setprio(0); } while (0)
#define PG8_WAIT_V(n) asm volatile("s_waitcnt vmcnt(" #n ")" ::: "memory")
#define PG8_WAIT_L(n) asm volatile("s_waitcnt lgkmcnt(" #n ")" ::: "memory")
#define PG8_BAR __builtin_amdgcn_s_barrier()
#define PG8_SCHED __builtin_amdgcn_sched_barrier(0)
#define PG8_ZERO() do { _Pragma("unroll") for (int a_ = 0; a_ < 2; ++a_) _Pragma("unroll") for (int b_ = 0; b_ < 2; ++b_) _Pragma("unroll") for (int m_ = 0; m_ < 4; ++m_) _Pragma("unroll") for (int n_ = 0; n_ < 2; ++n_) acc[a_][b_][m_][n_] = (f32x4){0.f, 0.f, 0.f, 0.f}; } while (0)
    Unit cur, nxt; int ui = 0;
    if (!S.next(0, cur)) return;
    f32x4 acc[2][2][4][2];
    PG8_ZERO();
    bf16x8 At[4][2], B0[2][2], B1[2][2];
    const char* cA = cur.A; const char* cB = cur.B; unsigned pAc = cur.lda2, pBc = cur.ldb2; int ntc = cur.nt;
    const unsigned kstep = BK * 2;
    {
        const size_t hA = (size_t)HALF * pAc, hB = (size_t)HALF * pBc;
        PG8_STAGE(PG8_SB(0, 0), cB, RB, pBc); PG8_STAGE(PG8_SB(0, 1), cB + hB, RB, pBc); PG8_STAGE(PG8_SA(0, 0), cA, RA, pAc); PG8_STAGE(PG8_SA(0, 1), cA + hA, RA, pAc);
        if (wr == 1) PG8_BAR;
        PG8_WAIT_V(2); PG8_BAR;
        PG8_STAGE(PG8_SB(1, 0), cB + kstep, RB, pBc); PG8_STAGE(PG8_SA(1, 0), cA + kstep, RA, pAc); PG8_STAGE(PG8_SB(1, 1), cB + hB + kstep, RB, pBc);
        PG8_WAIT_V(6); PG8_BAR;
    }
    for (;;) {
        const bool has_next = S.next(ui + 1, nxt);
        const char* nA = has_next ? nxt.A : cA; const char* nB = has_next ? nxt.B : cB;
        const unsigned pAn = has_next ? nxt.lda2 : pAc, pBn = has_next ? nxt.ldb2 : pBc;
        const size_t hAc = (size_t)HALF * pAc;
        for (int t = 0; t < ntc; t += 2) {
            const bool last = (t == ntc - 2);
            const char* a1 = cA + (size_t)(t + 1) * kstep;
            const char* a2 = last ? nA : cA + (size_t)(t + 2) * kstep; const char* b2 = last ? nB : cB + (size_t)(t + 2) * kstep;
            const char* a3 = a2 + kstep; const char* b3 = b2 + kstep;
            const unsigned pA2 = last ? pAn : pAc, pB2 = last ? pBn : pBc;
            const size_t hA2 = (size_t)HALF * pA2, hB2 = (size_t)HALF * pB2;
            PG8_LDB(B0, 0, 0); PG8_LDB(B1, 0, 1); PG8_SCHED; PG8_LDA(At, 0, 0); PG8_STAGE(PG8_SA(1, 1), a1 + hAc, RA, pAc);
            PG8_WAIT_V(8); PG8_WAIT_L(0); PG8_BAR; PG8_MMA(0, 0, At, B0); PG8_MMA(0, 1, At, B1); PG8_BAR; PG8_SCHED;
            PG8_LDA(At, 0, 1); PG8_STAGE(PG8_SB(0, 0), b2, RB, pB2); PG8_STAGE(PG8_SB(0, 1), b2 + hB2, RB, pB2); PG8_STAGE(PG8_SA(0, 0), a2, RA, pA2);
            PG8_WAIT_V(8); PG8_WAIT_L(0); PG8_BAR; PG8_MMA(1, 0, At, B0); PG8_MMA(1, 1, At, B1); PG8_BAR; PG8_SCHED;
            PG8_LDB(B0, 1, 0); PG8_LDB(B1, 1, 1); PG8_SCHED; PG8_LDA(At, 1, 0); PG8_STAGE(PG8_SA(0, 1), a2 + hA2, RA, pA2);
            PG8_WAIT_V(8); PG8_WAIT_L(0); PG8_BAR; PG8_MMA(0, 0, At, B0); PG8_MMA(0, 1, At, B1); PG8_BAR; PG8_SCHED;
            PG8_LDA(At, 1, 1); PG8_STAGE(PG8_SB(1, 0), b3, RB, pB2); PG8_STAGE(PG8_SB(1, 1), b3 + hB2, RB, pB2); PG8_STAGE(PG8_SA(1, 0), a3, RA, pA2);
            PG8_WAIT_V(8); PG8_WAIT_L(0); PG8_BAR; PG8_MMA(1, 0, At, B0); PG8_MMA(1, 1, At, B1); PG8_BAR; PG8_SCHED;
        }
        if constexpr (ALIGN_EPI) { if (wr == 0) PG8_BAR; }
        { int fr_ = fr, fq_ = fq; asm volatile("" : "+v"(fr_), "+v"(fq_)); E(acc, cur, wr, wc, fr_, fq_); }
        if (!has_next) break;
        PG8_ZERO();
        cur = nxt; cA = nA; cB = nB; pAc = pAn; pBc = pBn; ntc = nxt.nt; ++ui;
        if constexpr (ALIGN_EPI) { if (wr == 1) PG8_BAR; }
    }
    PG8_WAIT_V(0);
    if constexpr (!ALIGN_EPI) { if (wr == 0) PG8_BAR; }
    PG8_BAR;
#undef PG8_SA
#undef PG8_SB
#undef PG8_STAGE
#undef PG8_LDA
#undef PG8_LDB
#undef PG8_MMA
#undef PG8_WAIT_V
#undef PG8_WAIT_L
#undef PG8_BAR
#undef PG8_SCHED
#undef PG8_ZERO
}

struct PlainSched {
    TileOrder T; const char* A; const char* B; unsigned lda2, ldb2; int nt;
    __device__ bool next(int i, Unit& u) const { int pm, pn; if (!T.tile(i, pm, pn)) return false;
        u.A = A + (size_t)pm * 256 * lda2; u.B = B + (size_t)pn * 256 * ldb2; u.lda2 = lda2; u.ldb2 = ldb2; u.nt = nt; u.pm = pm; u.pn = pn; u.aux = 0; return true; }
};
struct OneSched { Unit u0; __device__ bool next(int i, Unit& u) const { if (i != 0) return false; u = u0; return true; } };
struct EpiStoreBf16 {
    static constexpr bool PERM = true;
    bf16_t* O; int ldc;
    __device__ __forceinline__ void operator()(const f32x4 (&acc)[2][2][4][2], const Unit& u, int wr, int wc, int fr, int fq) const {
        const int row0 = u.pm * BM + wr * 64 + fr, col0 = u.pn * BM + wc * 32 + 8 * fq;
#pragma unroll
        for (int ai = 0; ai < 2; ++ai)
#pragma unroll
            for (int m = 0; m < 4; ++m) { bf16_t* rowp = O + (size_t)(row0 + ai * HALF + m * 16) * ldc + col0;
#pragma unroll
                for (int bj = 0; bj < 2; ++bj) { const f32x4 v0 = acc[ai][bj][m][0], v1 = acc[ai][bj][m][1];
                    u32x4 w; w.x = cvt_pk_bf16(v0[0], v0[1]); w.y = cvt_pk_bf16(v0[2], v0[3]); w.z = cvt_pk_bf16(v1[0], v1[1]); w.w = cvt_pk_bf16(v1[2], v1[3]);
                    *(u32x4*)(rowp + bj * HALF) = w; } }
    }
};
__device__ __forceinline__ float fast_sigmoid(float x) { return __builtin_amdgcn_rcpf(1.f + __expf(-x)); }
struct EpiSwiglu {
    static constexpr bool PERM = true;
    bf16_t* H;
    __device__ __forceinline__ void operator()(const f32x4 (&acc)[2][2][4][2], const Unit& u, int wr, int wc, int fr, int fq) const {
        const int row0 = u.pm * BM + wr * 64 + fr, col0 = u.pn * HALF + wc * 32 + 8 * fq;
#pragma unroll
        for (int ai = 0; ai < 2; ++ai)
#pragma unroll
            for (int m = 0; m < 4; ++m) { float v[8];
#pragma unroll
                for (int n = 0; n < 2; ++n)
#pragma unroll
                    for (int e = 0; e < 4; ++e) { const float g = acc[ai][0][m][n][e], up = acc[ai][1][m][n][e]; v[n * 4 + e] = g * fast_sigmoid(g) * up; }
                u32x4 w; w.x = cvt_pk_bf16(v[0], v[1]); w.y = cvt_pk_bf16(v[2], v[3]); w.z = cvt_pk_bf16(v[4], v[5]); w.w = cvt_pk_bf16(v[6], v[7]);
                *(u32x4*)(H + (size_t)(row0 + ai * HALF + m * 16) * DFF + col0) = w; }
    }
};
struct EpiRes {
    static constexpr bool PERM = true;
    const bf16_t* res; void* out; bool out_f32;
    __device__ __forceinline__ void operator()(const f32x4 (&acc)[2][2][4][2], const Unit& u, int wr, int wc, int fr, int fq) const {
        const int row0 = u.pm * BM + wr * 64 + fr, col0 = u.pn * BM + wc * 32 + 8 * fq;
#pragma unroll
        for (int gb = 0; gb < 16; gb += 8) {
            u32x4 r[8];
#pragma unroll
            for (int k = 0; k < 8; ++k) { const int i = gb + k, ai = i >> 3, m = (i >> 1) & 3, bj = i & 1; r[k] = *(const u32x4*)(res + (size_t)(row0 + ai * HALF + m * 16) * D + col0 + bj * HALF); }
#pragma unroll
            for (int k = 0; k < 8; ++k) { const int i = gb + k, ai = i >> 3, m = (i >> 1) & 3, bj = i & 1; const size_t off = (size_t)(row0 + ai * HALF + m * 16) * D + col0 + bj * HALF;
                f32x4 p0 = acc[ai][bj][m][0], p1 = acc[ai][bj][m][1];
                p0[0] += bflo(r[k].x); p0[1] += bfhi(r[k].x); p0[2] += bflo(r[k].y); p0[3] += bfhi(r[k].y); p1[0] += bflo(r[k].z); p1[1] += bfhi(r[k].z); p1[2] += bflo(r[k].w); p1[3] += bfhi(r[k].w);
                if (out_f32) { *(f32x4*)((float*)out + off) = p0; *(f32x4*)((float*)out + off + 4) = p1; }
                else { u32x4 w; w.x = cvt_pk_bf16(p0[0], p0[1]); w.y = cvt_pk_bf16(p0[2], p0[3]); w.z = cvt_pk_bf16(p1[0], p1[1]); w.w = cvt_pk_bf16(p1[2], p1[3]); *(u32x4*)((bf16_t*)out + off) = w; } }
            asm volatile("" ::: "memory");
        }
    }
};
struct EpiGate {
    static constexpr bool PERM = true;
    bf16_t* PROJ; bf16_t* XC;
    __device__ __forceinline__ void operator()(const f32x4 (&acc)[2][2][4][2], const Unit& u, int wr, int wc, int fr, int fq) const {
        const int br = u.pn >> 2, row0 = u.pm * BM + wr * 64 + fr, col0 = (u.pn & 3) * BM + wc * 32 + 8 * fq;
        bf16_t* base = br < 3 ? PROJ + 512 + 1536 * br : XC;
        const int ld = br < 3 ? NPROJ : 1024;
#pragma unroll
        for (int ai = 0; ai < 2; ++ai)
#pragma unroll
            for (int m = 0; m < 4; ++m) { bf16_t* rowp = base + (size_t)(row0 + ai * HALF + m * 16) * ld + col0;
#pragma unroll
                for (int bj = 0; bj < 2; ++bj) { const f32x4 v0 = acc[ai][bj][m][0], v1 = acc[ai][bj][m][1];
                    u32x4 w; w.x = cvt_pk_bf16(fast_sigmoid(v0[0]), fast_sigmoid(v0[1])); w.y = cvt_pk_bf16(fast_sigmoid(v0[2]), fast_sigmoid(v0[3]));
                    w.z = cvt_pk_bf16(fast_sigmoid(v1[0]), fast_sigmoid(v1[1])); w.w = cvt_pk_bf16(fast_sigmoid(v1[2]), fast_sigmoid(v1[3]));
                    *(u32x4*)(rowp + bj * HALF) = w; } }
    }
};
struct BranchSched {
    TileOrder T; const char* PROJ; const char* WBR;
    __device__ bool next(int i, Unit& u) const { int pm, pn; if (!T.tile(i >> 2, pm, pn)) return false;
        const int br = i & 3; u.pm = pm; u.pn = pn; u.aux = br;
        u.A = PROJ + (size_t)pm * 256 * (NPROJ * 2) + 1536 * 2 * br; u.lda2 = NPROJ * 2; u.B = WBR + ((size_t)br * 1024 + pn * 256) * (512 * 2); u.ldb2 = 512 * 2; u.nt = 512 / 64; return true; }
};
struct EpiBranch {
    static constexpr bool PERM = true;
    const bf16_t* PROJ; const bf16_t* XC; bf16_t* MIX;
    __device__ __forceinline__ void operator()(const f32x4 (&acc)[2][2][4][2], const Unit& u, int wr, int wc, int fr, int fq) const {
        const int br = u.aux, row0 = u.pm * BM + wr * 64 + fr, col0 = u.pn * BM + wc * 32 + 8 * fq;
        const bf16_t* G = br < 3 ? PROJ + 512 + 1536 * br : XC; const int ldg = br < 3 ? NPROJ : 1024;
        if (br == 0) run<true>(acc, G, ldg, row0, col0); else run<false>(acc, G, ldg, row0, col0);
    }
    template <bool FIRST>
    __device__ __forceinline__ void run(const f32x4 (&acc)[2][2][4][2], const bf16_t* G, int ldg, int row0, int col0) const {
#pragma unroll
        for (int gb = 0; gb < 16; gb += 4) {
            u32x4 g[4], o[4];
#pragma unroll
            for (int k = 0; k < 4; ++k) { const int i = gb + k, ai = i >> 3, m = (i >> 1) & 3, bj = i & 1; const size_t row = (size_t)(row0 + ai * HALF + m * 16);
                g[k] = *(const u32x4*)(G + row * ldg + col0 + bj * HALF); if (!FIRST) o[k] = *(const u32x4*)(MIX + row * D + col0 + bj * HALF); }
#pragma unroll
            for (int k = 0; k < 4; ++k) { const int i = gb + k, ai = i >> 3, m = (i >> 1) & 3, bj = i & 1; const size_t row = (size_t)(row0 + ai * HALF + m * 16);
                f32x4 p0 = acc[ai][bj][m][0], p1 = acc[ai][bj][m][1];
                p0[0] *= bflo(g[k].x); p0[1] *= bfhi(g[k].x); p0[2] *= bflo(g[k].y); p0[3] *= bfhi(g[k].y); p1[0] *= bflo(g[k].z); p1[1] *= bfhi(g[k].z); p1[2] *= bflo(g[k].w); p1[3] *= bfhi(g[k].w);
                if (!FIRST) { p0[0] += bflo(o[k].x); p0[1] += bfhi(o[k].x); p0[2] += bflo(o[k].y); p0[3] += bfhi(o[k].y); p1[0] += bflo(o[k].z); p1[1] += bfhi(o[k].z); p1[2] += bflo(o[k].w); p1[3] += bfhi(o[k].w); }
                u32x4 w; w.x = cvt_pk_bf16(p0[0], p0[1]); w.y = cvt_pk_bf16(p0[2], p0[3]); w.z = cvt_pk_bf16(p1[0], p1[1]); w.w = cvt_pk_bf16(p1[2], p1[3]);
                *(u32x4*)(MIX + row * D + col0 + bj * HALF) = w; }
            asm volatile("" ::: "memory");
        }
    }
};
struct GBSched {
    TileOrder T; const char* XN; const char* WG; const char* PROJ; const char* WBR;
    __device__ bool next(int i, Unit& u) const { int pm, pn; if (!T.tile(i >> 3, pm, pn)) return false;
        const int sub = i & 7, br = sub >> 1; u.pm = pm; u.pn = pn; u.aux = sub;
        if ((sub & 1) == 0) { u.A = XN + (size_t)pm * 256 * (D * 2); u.lda2 = D * 2; u.B = WG + ((size_t)br * 1024 + pn * 256) * (D * 2); u.ldb2 = D * 2; u.nt = D / 64; }
        else { u.A = PROJ + (size_t)pm * 256 * (NPROJ * 2) + 1536 * 2 * br; u.lda2 = NPROJ * 2; u.B = WBR + ((size_t)br * 1024 + pn * 256) * (512 * 2); u.ldb2 = 512 * 2; u.nt = 512 / 64; }
        return true; }
};
struct EpiGB {
    static constexpr bool PERM = true;
    bf16_t* PROJ; bf16_t* XC; bf16_t* MIX;
    __device__ __forceinline__ void operator()(const f32x4 (&acc)[2][2][4][2], const Unit& u, int wr, int wc, int fr, int fq) const {
        const int br = u.aux >> 1, row0 = u.pm * BM + wr * 64 + fr, col0 = u.pn * BM + wc * 32 + 8 * fq;
        bf16_t* G = br < 3 ? PROJ + 512 + 1536 * br : XC; const int ldg = br < 3 ? NPROJ : 1024;
        if ((u.aux & 1) == 0) {
#pragma unroll
            for (int ai = 0; ai < 2; ++ai)
#pragma unroll
                for (int m = 0; m < 4; ++m) { bf16_t* rowp = G + (size_t)(row0 + ai * HALF + m * 16) * ldg + col0;
#pragma unroll
                    for (int bj = 0; bj < 2; ++bj) { const f32x4 v0 = acc[ai][bj][m][0], v1 = acc[ai][bj][m][1];
                        u32x4 w; w.x = cvt_pk_bf16(fast_sigmoid(v0[0]), fast_sigmoid(v0[1])); w.y = cvt_pk_bf16(fast_sigmoid(v0[2]), fast_sigmoid(v0[3]));
                        w.z = cvt_pk_bf16(fast_sigmoid(v1[0]), fast_sigmoid(v1[1])); w.w = cvt_pk_bf16(fast_sigmoid(v1[2]), fast_sigmoid(v1[3]));
                        *(u32x4*)(rowp + bj * HALF) = w; } }
        } else { EpiBranch B{PROJ, XC, MIX}; if (br == 0) B.run<true>(acc, G, ldg, row0, col0); else B.run<false>(acc, G, ldg, row0, col0); }
    }
};
}

#define LAS __attribute__((address_space(3)))
__device__ __forceinline__ void wt_item(const float* W, int ldw, int src_col0, int k0, bf16_t* WT, int ldwt, int dst_row0, LAS float* scr, int lane) {
#pragma unroll
    for (int i = 0; i < 8; ++i) { const int k = 4 * i + (lane >> 4), n4 = (lane & 15) * 4;
        const float4 v = *(const float4*)(W + (size_t)(k0 + k) * ldw + src_col0 + n4);
        LAS float* d = scr + k * 65 + n4; d[0] = v.x; d[1] = v.y; d[2] = v.z; d[3] = v.w; }
    asm volatile("s_waitcnt lgkmcnt(0)" ::: "memory");
    unsigned w[16];
#pragma unroll
    for (int j = 0; j < 16; ++j) w[j] = pk2(scr[(2 * j) * 65 + lane], scr[(2 * j + 1) * 65 + lane]);
    uint4* o = (uint4*)(WT + (size_t)(dst_row0 + lane) * ldwt + k0);
#pragma unroll
    for (int j = 0; j < 4; ++j) o[j] = make_uint4(w[4 * j], w[4 * j + 1], w[4 * j + 2], w[4 * j + 3]);
    asm volatile("s_waitcnt lgkmcnt(0)" ::: "memory");
}
constexpr int WCV_IN = 32 * (NPROJ / 64), WCV_ALL = WCV_IN + 32 * 64 + 4 * 16 * 16 + 32 * 16 + 32 * (2 * DFF / 64) + (DFF / 32) * 16, WCV_CHUNK = 16;
__device__ __forceinline__ void ph_wconv(unsigned char* ws, const float* w_in, const float* w_branch, const float* w_out, const float* w_gate, const float* w_up, const float* w_down, LAS float* scr_base,
                                         int lo, int hi, int first, int stride) {
    const int tx_ = ltid();
    const int lane = tx_ & 63, wave = tx_ >> 6;
    LAS float* scr = scr_base + wave * (32 * 65);
    constexpr int I_IN = 32 * (NPROJ / 64), I_G = 32 * 64, I_BR = 4 * 16 * 16, I_OUT = 32 * 16, I_GU = 32 * (2 * DFF / 64), I_DN = (DFF / 32) * 16;
    static_assert(I_IN + I_G + I_BR + I_OUT + I_GU + I_DN == WCV_ALL && (WCV_ALL - WCV_IN) % WCV_CHUNK == 0, "conversion list");
    for (int it = lo + first * 8 + wave; it < hi; it += stride * 8) {
        int r = it;
        if (r < I_IN) { const int nb = r % (NPROJ / 64), kb = r / (NPROJ / 64), c0 = nb * 64;
            wt_item(w_in, DIN, c0 + (c0 >= 1536 ? 8 : 0) + (c0 >= 4608 ? 8 : 0), kb * 32, (bf16_t*)(ws + WS_WIN), D, c0, scr, lane); continue; } r -= I_IN;
        if (r < I_G) { const int nb = r % 64, kb = r / 64; wt_item(w_in, DIN, WC_GATE + nb * 64, kb * 32, (bf16_t*)(ws + WS_WG), D, nb * 64, scr, lane); continue; } r -= I_G;
        if (r < I_BR) { const int br = r / 256, q = r % 256, nb = q % 16, kb = q / 16;
            wt_item(w_branch + (size_t)br * 512 * 1024, D, nb * 64, kb * 32, (bf16_t*)(ws + WS_WBR) + (size_t)br * 1024 * 512, 512, nb * 64, scr, lane); continue; } r -= I_BR;
        if (r < I_OUT) { const int nb = r % 16, kb = r / 16; wt_item(w_out, D, nb * 64, kb * 32, (bf16_t*)(ws + WS_WOUT), D, nb * 64, scr, lane); continue; } r -= I_OUT;
        if (r < I_GU) { const int nb = r % (2 * DFF / 64), kb = r / (2 * DFF / 64), r0 = nb * 64, t = r0 >> 8, j = r0 & 255;
            wt_item(j < 128 ? w_gate : w_up, DFF, t * 128 + (j & 127), kb * 32, (bf16_t*)(ws + WS_WGU), D, r0, scr, lane); continue; } r -= I_GU;
        { const int nb = r % 16, kb = r / 16; wt_item(w_down, D, nb * 64, kb * 32, (bf16_t*)(ws + WS_WDN), DFF, nb * 64, scr, lane); }
    }
}

__device__ __forceinline__ float silu_fast(float x) { return x * __builtin_amdgcn_rcpf(1.f + __expf(-x)); }
__device__ __forceinline__ void ph_pre(unsigned char* lds, const bf16_t* PROJ, const float* conv_w, const float* conv_b, bf16_t* XC, float* KMEAN, float* KMAXP) {
    const int tx_ = ltid();
    const int lane = tx_ & 63, gw = blockIdx.x * 8 + (tx_ >> 6), NGW = gridDim.x * 8;
    int* smax = (int*)lds;
    if (tx_ < 16) smax[tx_] = 0;
    for (int it = gw; it < (M / 16) * 2; it += NGW) {
        const int r0 = (it >> 1) * 16, c8 = (it & 1) * 512 + lane * 8;
        const bool head = (r0 & (SEQ - 1)) == 0;
        uint4 xr[19];
        const bf16_t* src = PROJ + (size_t)r0 * NPROJ + PC_XBC + c8;
#pragma unroll
        for (int j = 0; j < 3; ++j) xr[j] = head ? make_uint4(0u, 0u, 0u, 0u) : *(const uint4*)(src + (ptrdiff_t)(j - 3) * NPROJ);
#pragma unroll
        for (int j = 3; j < 19; ++j) xr[j] = *(const uint4*)(src + (size_t)(j - 3) * NPROJ);
        float w[4][8], b[8];
#pragma unroll
        for (int i = 0; i < 4; ++i) { const float4 w0 = *(const float4*)(conv_w + i * 1024 + c8), w1 = *(const float4*)(conv_w + i * 1024 + c8 + 4);
            w[i][0] = w0.x; w[i][1] = w0.y; w[i][2] = w0.z; w[i][3] = w0.w; w[i][4] = w1.x; w[i][5] = w1.y; w[i][6] = w1.z; w[i][7] = w1.w; }
        { const float4 b0 = *(const float4*)(conv_b + c8), b1 = *(const float4*)(conv_b + c8 + 4); b[0] = b0.x; b[1] = b0.y; b[2] = b0.z; b[3] = b0.w; b[4] = b1.x; b[5] = b1.y; b[6] = b1.z; b[7] = b1.w; }
        bf16_t* dst = XC + (size_t)r0 * 1024 + c8;
#pragma unroll
        for (int j = 0; j < 16; ++j) {
            float acc[8];
#pragma unroll
            for (int c = 0; c < 8; ++c) acc[c] = b[c];
#pragma unroll
            for (int i = 0; i < 4; ++i) { const uint4 u = xr[j + i];
                acc[0] += w[i][0] * bflo(u.x); acc[1] += w[i][1] * bfhi(u.x); acc[2] += w[i][2] * bflo(u.y); acc[3] += w[i][3] * bfhi(u.y);
                acc[4] += w[i][4] * bflo(u.z); acc[5] += w[i][5] * bfhi(u.z); acc[6] += w[i][6] * bflo(u.w); acc[7] += w[i][7] * bfhi(u.w); }
            uint4 o; o.x = pk2(silu_fast(acc[0]), silu_fast(acc[1])); o.y = pk2(silu_fast(acc[2]), silu_fast(acc[3])); o.z = pk2(silu_fast(acc[4]), silu_fast(acc[5])); o.w = pk2(silu_fast(acc[6]), silu_fast(acc[7]));
            *(uint4*)(dst + (size_t)j * 1024) = o;
        }
    }
    for (int it = gw; it < 64 * 16; it += NGW) {
        const int bb = it >> 4, cg = it & 15, rr = lane >> 2, c8 = cg * 32 + (lane & 3) * 8;
        uint4 u[16];
#pragma unroll
        for (int st = 0; st < 16; ++st) u[st] = *(const uint4*)(PROJ + ((size_t)bb * 256 + st * 16 + rr) * NPROJ + PC_MK + c8);
        float sm[8];
#pragma unroll
        for (int j = 0; j < 8; ++j) sm[j] = 0.f;
#pragma unroll
        for (int st = 0; st < 16; ++st) { sm[0] += bflo(u[st].x); sm[1] += bfhi(u[st].x); sm[2] += bflo(u[st].y); sm[3] += bfhi(u[st].y); sm[4] += bflo(u[st].z); sm[5] += bfhi(u[st].z); sm[6] += bflo(u[st].w); sm[7] += bfhi(u[st].w); }
#pragma unroll
        for (int j = 0; j < 8; ++j) { sm[j] += __shfl_xor(sm[j], 4); sm[j] += __shfl_xor(sm[j], 8); sm[j] += __shfl_xor(sm[j], 16); sm[j] += __shfl_xor(sm[j], 32); }
        if (lane < 4) { float* kp = KMEAN + (size_t)bb * 512 + c8;
            *(float4*)kp = make_float4(sm[0] * (1.0f / 256.0f), sm[1] * (1.0f / 256.0f), sm[2] * (1.0f / 256.0f), sm[3] * (1.0f / 256.0f));
            *(float4*)(kp + 4) = make_float4(sm[4] * (1.0f / 256.0f), sm[5] * (1.0f / 256.0f), sm[6] * (1.0f / 256.0f), sm[7] * (1.0f / 256.0f)); }
    }
    {
        const size_t gt = (size_t)blockIdx.x * NT + tx_, tot = (size_t)gridDim.x * NT;
        __syncthreads();
        for (size_t e = gt; e < (size_t)M * 8; e += tot) { const int row = (int)(e >> 3), h = (int)(e & 7);
            const bf16_t* kp = PROJ + (size_t)row * NPROJ + PC_FK + h * 64; float n2 = 0.f;
#pragma unroll
            for (int c = 0; c < 8; ++c) { const uint4 u = *(const uint4*)(kp + c * 8);
                n2 += bflo(u.x) * bflo(u.x) + bfhi(u.x) * bfhi(u.x) + bflo(u.y) * bflo(u.y) + bfhi(u.y) * bfhi(u.y) + bflo(u.z) * bflo(u.z) + bfhi(u.z) * bfhi(u.z) + bflo(u.w) * bflo(u.w) + bfhi(u.w) * bfhi(u.w); }
            atomicMax(&smax[(row >> 13) * 8 + h], __float_as_int(n2)); }
        __syncthreads();
        if (tx_ < 16) KMAXP[blockIdx.x * 16 + tx_] = sqrtf(__int_as_float(smax[tx_]));
    }
}

__device__ __forceinline__ void ph_mamba_norm(bf16_t* PROJ, const bf16_t* XC, const float* nw) {
    const int tx_ = ltid();
    const int lane = tx_ & 63, gw = blockIdx.x * 8 + (tx_ >> 6), NGW = gridDim.x * 8;
    const float4 w0 = *(const float4*)(nw + lane * 8), w1 = *(const float4*)(nw + lane * 8 + 4);
    for (int row0 = gw; row0 < M; row0 += 8 * NGW) {
        uint4 yb[8], zb[8];
#pragma unroll
        for (int k = 0; k < 8; ++k) { const int rk = row0 + k * NGW; if (rk < M) { yb[k] = *(const uint4*)(XC + (size_t)rk * 1024 + lane * 8); zb[k] = *(const uint4*)(PROJ + (size_t)rk * NPROJ + PC_Z + lane * 8); } }
#pragma unroll
        for (int k = 0; k < 8; ++k) {
            const int row = row0 + k * NGW; if (row >= M) break;
            const uint4 yv = yb[k], zv = zb[k];
            float y[8] = {bflo(yv.x), bfhi(yv.x), bflo(yv.y), bfhi(yv.y), bflo(yv.z), bfhi(yv.z), bflo(yv.w), bfhi(yv.w)};
            const float z[8] = {bflo(zv.x), bfhi(zv.x), bflo(zv.y), bfhi(zv.y), bflo(zv.z), bfhi(zv.z), bflo(zv.w), bfhi(zv.w)};
            float ss = 0.f;
#pragma unroll
            for (int i = 0; i < 8; ++i) { y[i] *= silu_fast(z[i]); ss += y[i] * y[i]; }
            ss = wave_sum(ss); const float rstd = 1.0f / sqrtf(ss * (1.0f / 512.0f) + 1e-6f);
            uint4 o; o.x = pk2(y[0] * rstd * w0.x, y[1] * rstd * w0.y); o.y = pk2(y[2] * rstd * w0.z, y[3] * rstd * w0.w); o.z = pk2(y[4] * rstd * w1.x, y[5] * rstd * w1.y); o.w = pk2(y[6] * rstd * w1.z, y[7] * rstd * w1.w);
            *(uint4*)(PROJ + (size_t)row * NPROJ + PC_Z + lane * 8) = o;
        }
    }
}
__device__ __forceinline__ void ph_final(float* out, const float* nw) {
    const int tx_ = ltid();
    const int lane = tx_ & 63, gw = blockIdx.x * 8 + (tx_ >> 6), NGW = gridDim.x * 8;
    float4 nwv[4];
#pragma unroll
    for (int j = 0; j < 4; ++j) nwv[j] = ((const float4*)nw)[lane + 64 * j];
    for (int row0 = gw; row0 < M; row0 += 4 * NGW) {
        float4 vb[4][4];
#pragma unroll
        for (int k = 0; k < 4; ++k) { const int rk = row0 + k * NGW; if (rk < M) { const float4* xr = (const float4*)(out + (size_t)rk * D);
#pragma unroll
            for (int j = 0; j < 4; ++j) vb[k][j] = xr[lane + 64 * j]; } }
#pragma unroll
        for (int k = 0; k < 4; ++k) {
            const int row = row0 + k * NGW; if (row >= M) break;
            float4* xr = (float4*)(out + (size_t)row * D);
            float ss = 0.f;
#pragma unroll
            for (int j = 0; j < 4; ++j) { const float4 v = vb[k][j]; ss += v.x * v.x + v.y * v.y + v.z * v.z + v.w * v.w; }
            ss = wave_sum(ss); const float rstd = 1.0f / sqrtf(ss * (1.0f / D) + 1e-6f);
#pragma unroll
            for (int j = 0; j < 4; ++j) { const float4 v = vb[k][j], w4 = nwv[j]; xr[lane + 64 * j] = make_float4(v.x * rstd * w4.x, v.y * rstd * w4.y, v.z * rstd * w4.z, v.w * rstd * w4.w); }
        }
    }
}

namespace att {
typedef short bf16x8 __attribute__((ext_vector_type(8)));
typedef short s16x4 __attribute__((ext_vector_type(4)));
typedef float f32x16 __attribute__((ext_vector_type(16)));
typedef float f32x2_t __attribute__((ext_vector_type(2))); typedef __bf16 bf16x2_t __attribute__((ext_vector_type(2)));
__device__ __forceinline__ unsigned cvtpk(float lo, float hi) { f32x2_t v = {lo, hi}; bf16x2_t b = __builtin_convertvector(v, bf16x2_t); return __builtin_bit_cast(unsigned, b); }
constexpr float LOG2E = 1.4426950408889634f, C2 = 0.125f * LOG2E;
constexpr int ST_BYTES = 16384, OFF_BIAS = 65536, OFF_EB = OFF_BIAS + 1024, OFF_KMAX = OFF_EB + 32, OFF_TAB = OFF_BIAS + 2048, TAB_N = 1280, OFF_END = OFF_TAB + TAB_N * 4;
constexpr float FOX_THR = 25.f;
enum { MODE_FOX = 0, MODE_SWA = 1, MODE_MOBA = 2, MODE_MOWN = 3 };
#define LASC __attribute__((address_space(3)))
typedef short v4i16_t __attribute__((ext_vector_type(4)));

template <int MODE>
__device__ __forceinline__ void attn_unit(unsigned char* lds, bf16_t* PROJ, const float* AUX, const float* btab, int bcol, float sink, int b, int hq, int hk, int qb, int qcol, int kcol, int vcol, bool dry = false, const void* ex0 = nullptr, const void* ex1 = nullptr) {
    const int tid = ltid(), lane = tid & 63, wave = __builtin_amdgcn_readfirstlane(tid >> 6), r32 = lane & 31, hi = lane >> 5;
    const int q0 = qb * 256, qw = q0 + wave * 32, q = qw + r32;
    const size_t rowbase = (size_t)b * SEQ;
    float* tab = (float*)(lds + OFF_TAB);
    float tv0 = 0.f, tv1 = 0.f;
    if constexpr (MODE == MODE_SWA) { const int d = tid - 128; if (d >= 0 && d < 128) tv0 = btab[rel_bucket(d) * 16 + bcol]; }
    if constexpr (MODE == MODE_MOBA || MODE == MODE_MOWN) { tv0 = btab[rel_bucket(tid) * 16 + bcol]; tv1 = btab[rel_bucket(tid + 512) * 16 + bcol]; }
    const bf16_t* qp = PROJ + (rowbase + q) * NPROJ + qcol + hq * 64 + 8 * hi;
    const uint4 qu0 = *(const uint4*)(qp), qu1 = *(const uint4*)(qp + 16), qu2 = *(const uint4*)(qp + 32), qu3 = *(const uint4*)(qp + 48);
    float km0 = 0.f, km1 = 0.f, km2 = 0.f, km3 = 0.f;
    if constexpr (MODE == MODE_FOX) { if (tid < 64) { const float* kmp = btab + (tid * 4) * 16 + b * 8 + hq; km0 = kmp[0]; km1 = kmp[16]; km2 = kmp[32]; km3 = kmp[48]; } }
    unsigned msel = 0u; float4 mpl = make_float4(0.f, 0.f, 0.f, 0.f);
    if constexpr (MODE == MODE_MOWN) { msel = ((const unsigned*)AUX)[(size_t)(b * 8 + hq) * SEQ + q]; mpl = *(const float4*)((const float*)ex1 + ((rowbase + q) * 8 + hq) * 4); }
    const int t_beg = (MODE == MODE_SWA) ? (qb > 0 ? 4 * qb - 2 : 0) : (MODE == MODE_MOWN ? 4 * qb : 0), t_end = 4 * (qb + 1);
    const int skey = tid >> 3, sch = tid & 7;
    const bf16_t* kg = PROJ + (rowbase + skey) * NPROJ + kcol + hk * 64 + sch * 8;
    const bf16_t* vg = PROJ + (rowbase + skey) * NPROJ + vcol + hk * 64 + sch * 8;
    const int kdst = skey * 128 + ((sch ^ ((skey >> 1) & 7)) * 16);
    uint4 kreg0, kreg1, vreg0, vreg1; float breg0 = 0.f, breg1 = 0.f;
#define ATT_LOAD1(t_, KR, VR, BR) do { KR = *(const uint4*)(kg + (size_t)(t_) * 64 * NPROJ); VR = *(const uint4*)(vg + (size_t)(t_) * 64 * NPROJ); \
        if (MODE == MODE_FOX) { if (tid < 64) BR = AUX[(rowbase + (t_) * 64 + tid) * 8 + hq]; } } while (0)
#define ATT_LOAD(s_) do { ATT_LOAD1(ATT_TI(2 * (s_)), kreg0, vreg0, breg0); ATT_LOAD1(ATT_TI(2 * (s_) + 1), kreg1, vreg1, breg1); } while (0)
#define ATT_STORE1(ts_, KR, VR, BR) do { unsigned char* sb_ = lds + (ts_) * ST_BYTES; \
        *(uint4*)(sb_ + kdst) = KR; *(uint4*)(sb_ + 8192 + skey * 128 + ((sch ^ (((skey >> 1) & 1) << 2)) * 16)) = VR; \
        if (MODE == MODE_FOX) { if (tid < 64) { float inc_ = BR; \
            _Pragma("unroll") for (int o_ = 1; o_ < 64; o_ <<= 1) { const float v_ = __shfl_up(inc_, o_); if (lane >= o_) inc_ += v_; } \
            const float tot_ = __shfl(inc_, 63); \
            ((float*)(lds + OFF_BIAS))[(ts_) * 64 + tid] = (carry + tot_ - inc_) * LOG2E;        \
            carry += tot_; if (tid == 0) ((float*)(lds + OFF_EB))[(ts_)] = carry * LOG2E; } } } while (0)
#define ATT_STORE(st) do { ATT_STORE1((st) * 2, kreg0, vreg0, breg0); ATT_STORE1((st) * 2 + 1, kreg1, vreg1, breg1); } while (0)
    const int ntile = t_end - t_beg;
#define ATT_TI(i) ((MODE == MODE_FOX) ? (t_end - 1 - (i)) : (t_beg + (i)))
    const int nstep = ntile >> 1;
    ATT_LOAD(0);
    if constexpr (MODE == MODE_SWA) tab[tid] = tv0 * LOG2E;
    if constexpr (MODE == MODE_MOBA || MODE == MODE_MOWN) { tab[tid] = tv0 * LOG2E; tab[tid + 512] = tv1 * LOG2E; }
    bf16x8 qr[4]; float gq[32]; float qn2 = 0.f;
    {
#pragma unroll
      for (int d0 = 0; d0 < 4; ++d0) { const uint4 u = d0 == 0 ? qu0 : d0 == 1 ? qu1 : d0 == 2 ? qu2 : qu3;
          const float f[8] = {bflo(u.x), bfhi(u.x), bflo(u.y), bfhi(u.y), bflo(u.z), bfhi(u.z), bflo(u.w), bfhi(u.w)};
          if constexpr (MODE == MODE_MOBA) {
#pragma unroll
              for (int e = 0; e < 8; ++e) gq[d0 * 8 + e] = f[e]; }
          if constexpr (MODE == MODE_FOX) {
#pragma unroll
              for (int e = 0; e < 8; ++e) qn2 += f[e] * f[e]; }
          uint4 w; w.x = cvtpk(f[0] * C2, f[1] * C2); w.y = cvtpk(f[2] * C2, f[3] * C2); w.z = cvtpk(f[4] * C2, f[5] * C2); w.w = cvtpk(f[6] * C2, f[7] * C2);
          qr[d0] = __builtin_bit_cast(bf16x8, w); } }
    unsigned selmask = 0u;
    if constexpr (MODE == MODE_MOBA) {
        float g0 = -INFINITY, g1 = -INFINITY, g2 = -INFINITY; int i0 = -1, i1 = -1, i2 = -1;
        for (int n = 0; n < qb; ++n) {
            const float* km = AUX + ((size_t)(b * 32 + n)) * 512 + hk * 64 + 8 * hi; float g = 0.f;
#pragma unroll
            for (int d0 = 0; d0 < 4; ++d0) { const float4 k0 = *(const float4*)(km + 16 * d0), k1 = *(const float4*)(km + 16 * d0 + 4);
                g += gq[d0 * 8] * k0.x + gq[d0 * 8 + 1] * k0.y + gq[d0 * 8 + 2] * k0.z + gq[d0 * 8 + 3] * k0.w + gq[d0 * 8 + 4] * k1.x + gq[d0 * 8 + 5] * k1.y + gq[d0 * 8 + 6] * k1.z + gq[d0 * 8 + 7] * k1.w; }
            g += __shfl_xor(g, 32);
            if (g > g0) { g2 = g1; i2 = i1; g1 = g0; i1 = i0; g0 = g; i0 = n; }
            else if (g > g1) { g2 = g1; i2 = i1; g1 = g; i1 = n; }
            else if (g > g2) { g2 = g; i2 = n; }
        }
        if (i0 >= 0) selmask |= 1u << i0; if (i1 >= 0) selmask |= 1u << i1; if (i2 >= 0) selmask |= 1u << i2;
    }
    float carry = 0.f;
    f32x16 o0, o1;
#pragma unroll
    for (int r = 0; r < 16; ++r) { o0[r] = 0.f; o1[r] = 0.f; }
    float m = -1e30f, l = 0.f;
    if constexpr (MODE == MODE_SWA) { m = sink * LOG2E; l = hi == 0 ? 1.f : 0.f; }
    float qkb = 0.f;
    if constexpr (MODE == MODE_FOX) {
        if (tid < 64) { float km = fmaxf(fmaxf(km0, km1), fmaxf(km2, km3));
#pragma unroll
            for (int o = 1; o < 64; o <<= 1) km = fmaxf(km, __shfl_xor(km, o));
            if (tid == 0) *(float*)(lds + OFF_KMAX) = km; }
    }
    ATT_STORE(0);
    if (1 < nstep) ATT_LOAD(1);
    __syncthreads();
    if constexpr (MODE == MODE_FOX) { qn2 += __shfl_xor(qn2, 32); qkb = sqrtf(qn2) * C2 * 1.01f * *(const float*)(lds + OFF_KMAX); }
    const int vtr_off = ((lane & 15) >> 2) * 128 + (16 * ((lane >> 4) & 1) + 4 * (lane & 3)) * 2 + 4 * hi * 128;
    bool started = false;
    for (int i = 0; i < nstep; ++i) {
        const int st = i & 1;
        if (i + 1 < nstep) ATT_STORE(st ^ 1);
        if (i + 2 < nstep) ATT_LOAD(i + 2);
#pragma unroll 1
        for (int sub = 0; sub < 2; ++sub) {
        const int t = ATT_TI(2 * i + sub), ts = st * 2 + sub;
        bool act = (64 * t <= qw + 31);
        if constexpr (MODE == MODE_SWA) act = act && (64 * t + 63 >= qw - 127);
        if constexpr (MODE == MODE_MOBA) { if (t < 4 * qb) act = __builtin_amdgcn_ballot_w64(((selmask >> (t >> 2)) & 1u) != 0u) != 0ull; }
        if (act) {
            const unsigned char* Ks = lds + ts * ST_BYTES; const unsigned char* Vt = Ks + 8192;
            f32x16 p0, p1;
            if constexpr (MODE == MODE_FOX) { const float* bt = (const float*)(lds + OFF_BIAS) + ts * 64;
#pragma unroll
                for (int g = 0; g < 4; ++g) { const float4 b0 = *(const float4*)(bt + 8 * g + 4 * hi), b1 = *(const float4*)(bt + 32 + 8 * g + 4 * hi);
                    p0[4 * g] = b0.x; p0[4 * g + 1] = b0.y; p0[4 * g + 2] = b0.z; p0[4 * g + 3] = b0.w; p1[4 * g] = b1.x; p1[4 * g + 1] = b1.y; p1[4 * g + 2] = b1.z; p1[4 * g + 3] = b1.w; }
            } else if constexpr (MODE == MODE_SWA) { const float* tp = tab + 128 + (q - 64 * t - 4 * hi);
#pragma unroll
                for (int r = 0; r < 16; ++r) { const int kofs = (r & 3) + 8 * (r >> 2); p0[r] = tp[-kofs]; p1[r] = tp[-kofs - 32]; }
            } else { const int dq = q - 64 * t - 4 * hi;
                if (64 * t + 63 + 790 <= qw) { const float c31 = tab[1023];
#pragma unroll
                    for (int r = 0; r < 16; ++r) { p0[r] = c31; p1[r] = c31; } }
                else {
#pragma unroll
                    for (int r = 0; r < 16; ++r) { const int kofs = (r & 3) + 8 * (r >> 2); const int d0_ = dq - kofs, d1_ = dq - kofs - 32;
                        p0[r] = tab[d0_ < 0 ? 0 : (d0_ > 1023 ? 1023 : d0_)]; p1[r] = tab[d1_ < 0 ? 0 : (d1_ > 1023 ? 1023 : d1_)]; } }
            }
#pragma unroll
            for (int d0 = 0; d0 < 4; ++d0) {
                const bf16x8 a0 = *(const bf16x8*)(Ks + r32 * 128 + (((2 * d0 + hi) ^ ((r32 >> 1) & 7)) * 16));
                const bf16x8 a1 = *(const bf16x8*)(Ks + (32 + r32) * 128 + (((2 * d0 + hi) ^ ((r32 >> 1) & 7)) * 16));
                p0 = __builtin_amdgcn_mfma_f32_32x32x16_bf16(a0, qr[d0], p0, 0, 0, 0);
                p1 = __builtin_amdgcn_mfma_f32_32x32x16_bf16(a1, qr[d0], p1, 0, 0, 0);
            }
            const int kb = 64 * t + 4 * hi;
            if constexpr (MODE == MODE_SWA) {
#pragma unroll
                for (int r = 0; r < 16; ++r) { const int kv = kb + (r & 3) + 8 * (r >> 2); if (kv > q || kv < q - 127) p0[r] = -INFINITY; if (kv + 32 > q || kv + 32 < q - 127) p1[r] = -INFINITY; }
            } else {
                if (64 * t + 63 > qw) {
#pragma unroll
                    for (int r = 0; r < 16; ++r) { const int kv = kb + (r & 3) + 8 * (r >> 2); if (kv > q) p0[r] = -INFINITY; if (kv + 32 > q) p1[r] = -INFINITY; }
                }
                if constexpr (MODE == MODE_MOBA) { if (t < 4 * qb && ((selmask >> (t >> 2)) & 1u) == 0u) {
#pragma unroll
                    for (int r = 0; r < 16; ++r) { p0[r] = -INFINITY; p1[r] = -INFINITY; } } }
            }
            float mx = fmaxf(p0[0], p1[0]);
#pragma unroll
            for (int r = 1; r < 16; ++r) mx = fmaxf(mx, fmaxf(p0[r], p1[r]));
            mx = fmaxf(mx, __shfl_xor(mx, 32));
            const float mn = fmaxf(m, mx);
            if (__builtin_amdgcn_ballot_w64(mn > m) != 0ull) {
                const float alpha = __builtin_amdgcn_exp2f(m - mn); l *= alpha;
#pragma unroll
                for (int r = 0; r < 16; ++r) { o0[r] *= alpha; o1[r] *= alpha; }
            }
            m = mn;
            float sum = 0.f;
#pragma unroll
            for (int r = 0; r < 16; ++r) { p0[r] = __builtin_amdgcn_exp2f(p0[r] - mn); p1[r] = __builtin_amdgcn_exp2f(p1[r] - mn); sum += p0[r] + p1[r]; }
            l += sum;
            bf16x8 pa[4];
#pragma unroll
            for (int ks = 0; ks < 4; ++ks) { uint4 w;
                if (ks < 2) { w.x = cvtpk(p0[8 * ks], p0[8 * ks + 1]); w.y = cvtpk(p0[8 * ks + 2], p0[8 * ks + 3]); w.z = cvtpk(p0[8 * ks + 4], p0[8 * ks + 5]); w.w = cvtpk(p0[8 * ks + 6], p0[8 * ks + 7]); }
                else { const int k2 = ks - 2; w.x = cvtpk(p1[8 * k2], p1[8 * k2 + 1]); w.y = cvtpk(p1[8 * k2 + 2], p1[8 * k2 + 3]); w.z = cvtpk(p1[8 * k2 + 4], p1[8 * k2 + 5]); w.w = cvtpk(p1[8 * k2 + 6], p1[8 * k2 + 7]); }
                pa[ks] = __builtin_bit_cast(bf16x8, w); }
#pragma unroll
            for (int ks = 0; ks < 4; ++ks) {
#pragma unroll
                for (int db = 0; db < 2; ++db) {
                    const LASC unsigned char* vp = (const LASC unsigned char*)(Vt + vtr_off + ks * 16 * 128 + ((db ^ ((lane >> 3) & 1)) * 64));
                    const s16x4 lo = __builtin_bit_cast(s16x4, __builtin_amdgcn_ds_read_tr16_b64_v4i16((LASC v4i16_t*)vp));
                    const s16x4 hh = __builtin_bit_cast(s16x4, __builtin_amdgcn_ds_read_tr16_b64_v4i16((LASC v4i16_t*)(vp + 8 * 128)));
                    const bf16x8 vf = {lo[0], lo[1], lo[2], lo[3], hh[0], hh[1], hh[2], hh[3]};
                    if (db == 0) o0 = __builtin_amdgcn_mfma_f32_32x32x16_bf16(vf, pa[ks], o0, 0, 0, 0);
                    else o1 = __builtin_amdgcn_mfma_f32_32x32x16_bf16(vf, pa[ks], o1, 0, 0, 0); }
            }
            started = true;
        }
        }
        if constexpr (MODE == MODE_FOX) {
            const float eb = ((const float*)(lds + OFF_EB))[st * 2 + 1];
            if (__syncthreads_and((started && (qkb + eb - m < -FOX_THR)) ? 1 : 0)) break;
        } else __syncthreads();
    }
    if constexpr (MODE == MODE_FOX) __syncthreads();
#undef ATT_LOAD
#undef ATT_STORE
#undef ATT_LOAD1
#undef ATT_STORE1
#undef ATT_TI
    l += __shfl_xor(l, 32);
    float inv = 1.0f / l;
    bf16_t* op = PROJ + (rowbase + q) * NPROJ + qcol + hq * 64 + 4 * hi;
    if (dry && inv != 123.4567f) return;
    if constexpr (MODE == MODE_MOWN) {
        const int cnt = (int)((msel >> 15) & 3u);
        const float pls[3] = {mpl.x, mpl.y, mpl.z};
        float R = m + __builtin_amdgcn_logf(l), wsum = 1.f;
#pragma unroll
        for (int r = 0; r < 16; ++r) { o0[r] *= inv; o1[r] *= inv; }
        uint2 pa0[3][4], pa1[3][4];
#pragma unroll
        for (int sl = 0; sl < 3; ++sl) { if (sl < cnt) {
            const bf16_t* pp = (sl < 2) ? PROJ + (rowbase + q) * NPROJ + PC_XBC + (hq * 2 + sl) * 64 + 4 * hi : (const bf16_t*)ex0 + ((rowbase + q) * 8 + hq) * 64 + 4 * hi;
#pragma unroll
            for (int g = 0; g < 4; ++g) { pa0[sl][g] = *(const uint2*)(pp + 8 * g); pa1[sl][g] = *(const uint2*)(pp + 32 + 8 * g); } } }
#pragma unroll
        for (int sl = 0; sl < 3; ++sl) { if (sl >= cnt) break;
            const float ls = pls[sl]; const float Rn = fmaxf(R, ls), sc = __builtin_amdgcn_exp2f(R - Rn), ws_ = __builtin_amdgcn_exp2f(ls - Rn);
#pragma unroll
            for (int g = 0; g < 4; ++g) { const uint2 a0 = pa0[sl][g], a1 = pa1[sl][g];
                o0[4 * g] = o0[4 * g] * sc + ws_ * bflo(a0.x); o0[4 * g + 1] = o0[4 * g + 1] * sc + ws_ * bfhi(a0.x); o0[4 * g + 2] = o0[4 * g + 2] * sc + ws_ * bflo(a0.y); o0[4 * g + 3] = o0[4 * g + 3] * sc + ws_ * bfhi(a0.y);
                o1[4 * g] = o1[4 * g] * sc + ws_ * bflo(a1.x); o1[4 * g + 1] = o1[4 * g + 1] * sc + ws_ * bfhi(a1.x); o1[4 * g + 2] = o1[4 * g + 2] * sc + ws_ * bflo(a1.y); o1[4 * g + 3] = o1[4 * g + 3] * sc + ws_ * bfhi(a1.y); }
            wsum = wsum * sc + ws_; R = Rn;
        }
        inv = 1.0f / wsum;
    }
#pragma unroll
    for (int g = 0; g < 4; ++g) {
        *(uint2*)(op + 8 * g) = make_uint2(cvtpk(o0[4 * g] * inv, o0[4 * g + 1] * inv), cvtpk(o0[4 * g + 2] * inv, o0[4 * g + 3] * inv));
        *(uint2*)(op + 32 + 8 * g) = make_uint2(cvtpk(o1[4 * g] * inv, o1[4 * g + 1] * inv), cvtpk(o1[4 * g + 2] * inv, o1[4 * g + 3] * inv));
    }
}
}
namespace ssd {
using att::bf16x8; using att::s16x4; using att::f32x16; using att::cvtpk; using att::LOG2E;
#define LASC __attribute__((address_space(3)))
constexpr int STB = 40960;
constexpr int OFF_AL2 = 2 * STB, OFF_DTV = OFF_AL2 + 1024, OFF_E = OFF_DTV + 1024, OFF_HIN = 0;
__device__ __forceinline__ float chunk_scan(unsigned char* lds, const float* DT, size_t row0, int h, float A, int tid) {
    float* al = (float*)(lds + OFF_AL2); float* dtv = (float*)(lds + OFF_DTV);
    if (tid < 256) { const float d = DT[(row0 + tid) * 8 + h]; dtv[tid] = d; al[tid] = d * A; }
    __syncthreads();
    if (tid < 64) { const float4 a4 = *(const float4*)(al + 4 * tid); const float s = (a4.x + a4.y) + (a4.z + a4.w); float incl = s;
#pragma unroll
        for (int o = 1; o < 64; o <<= 1) { const float v = __shfl_up(incl, o); if (tid >= o) incl += v; }
        const float base = incl - s; float4 c4; c4.x = base + a4.x; c4.y = c4.x + a4.y; c4.z = c4.y + a4.z; c4.w = c4.z + a4.w; *(float4*)(al + 4 * tid) = c4; }
    __syncthreads();
    return al[255];
}
__device__ __forceinline__ void m1_unit(unsigned char* lds, bf16_t* XC, const float* DT, const float* a_log, const float* d_skip, bf16_t* STATES, float* CDEC, int b, int c, int h) {
    const int tid = ltid(), lane = tid & 63, wave = __builtin_amdgcn_readfirstlane(tid >> 6), r32 = lane & 31, hi = lane >> 5, g = h >> 2;
    const size_t row0 = (size_t)b * SEQ + c * 256; const int l = wave * 32 + r32;
    const float A = -expf(a_log[h]);
    float* al = (float*)(lds + OFF_AL2); float* dtv = (float*)(lds + OFF_DTV); float* ev = (float*)(lds + OFF_E);
    const float alast = chunk_scan(lds, DT, row0, h, A, tid);
    float myac = 0.f; if (tid < 256) myac = al[tid];
    __syncthreads();
    if (tid < 256) { ev[tid] = expf(alast - myac); al[tid] = myac * LOG2E; }
    if (tid == 0) CDEC[(b * 32 + c) * 8 + h] = expf(alast);
    __syncthreads();
    const float al_l = al[l];
    bf16x8 cfr[8];
    { const bf16_t* cp = XC + (row0 + l) * 1024 + 768 + g * 128 + 8 * hi;
#pragma unroll
      for (int k0 = 0; k0 < 8; ++k0) cfr[k0] = *(const bf16x8*)(cp + 16 * k0); }
    f32x16 o0, o1, sacc;
#pragma unroll
    for (int r = 0; r < 16; ++r) { o0[r] = 0.f; o1[r] = 0.f; sacc[r] = 0.f; }
    const int ss = tid >> 3, pc = tid & 7;
    const bf16_t* bg = XC + (row0 + ss) * 1024 + 512 + g * 128 + 16 * pc;
    const bf16_t* xg = XC + (row0 + ss) * 1024 + h * 64 + 8 * pc;
    uint4 b0r, b1r, xr;
#define SSD_LOAD(t) do { b0r = *(const uint4*)(bg + (size_t)(t) * 64 * 1024); b1r = *(const uint4*)(bg + (size_t)(t) * 64 * 1024 + 8); xr = *(const uint4*)(xg + (size_t)(t) * 64 * 1024); } while (0)
#define SSD_SC2(w, f) cvtpk(bflo(w) * (f), bfhi(w) * (f))
#define SSD_STORE(st, t) do { unsigned char* sb_ = lds + (st) * STB; \
        *(uint4*)(sb_ + ss * 256 + (((2 * pc) ^ (ss & 15)) * 16)) = b0r; *(uint4*)(sb_ + ss * 256 + (((2 * pc + 1) ^ (ss & 15)) * 16)) = b1r; \
        const float es_ = ev[(t) * 64 + ss], ds_ = dtv[(t) * 64 + ss]; \
        *(uint4*)(sb_ + 16384 + ss * 256 + pc * 32) = make_uint4(SSD_SC2(b0r.x, es_), SSD_SC2(b0r.y, es_), SSD_SC2(b0r.z, es_), SSD_SC2(b0r.w, es_));         \
        *(uint4*)(sb_ + 16384 + ss * 256 + pc * 32 + 16) = make_uint4(SSD_SC2(b1r.x, es_), SSD_SC2(b1r.y, es_), SSD_SC2(b1r.z, es_), SSD_SC2(b1r.w, es_)); \
        *(uint4*)(sb_ + 32768 + ss * 128 + pc * 16) = make_uint4(SSD_SC2(xr.x, ds_), SSD_SC2(xr.y, ds_), SSD_SC2(xr.z, ds_), SSD_SC2(xr.w, ds_)); } while (0)
    SSD_LOAD(0); SSD_STORE(0, 0);
    __syncthreads();
    const int nb = wave >> 1, pb = wave & 1;
    const int trx = ((lane & 15) >> 2) * 128 + (16 * ((lane >> 4) & 1) + 4 * (lane & 3)) * 2, trb = ((lane & 15) >> 2) * 256 + (16 * ((lane >> 4) & 1) + 4 * (lane & 3)) * 2;
#pragma unroll 1
    for (int t = 0; t < 4; ++t) {
        const int st = t & 1;
        if (t + 1 < 4) SSD_LOAD(t + 1);
        const unsigned char* Bs = lds + st * STB; const unsigned char* Bt = Bs + 16384; const unsigned char* Xt = Bs + 32768;
        if (64 * t <= wave * 32 + 31) {
            f32x16 p0, p1;
#pragma unroll
            for (int r = 0; r < 16; ++r) { p0[r] = 0.f; p1[r] = 0.f; }
#pragma unroll
            for (int k0 = 0; k0 < 8; ++k0) {
                const bf16x8 a0 = *(const bf16x8*)(Bs + r32 * 256 + (((2 * k0 + hi) ^ (r32 & 15)) * 16));
                const bf16x8 a1 = *(const bf16x8*)(Bs + (32 + r32) * 256 + (((2 * k0 + hi) ^ (r32 & 15)) * 16));
                p0 = __builtin_amdgcn_mfma_f32_32x32x16_bf16(a0, cfr[k0], p0, 0, 0, 0);
                p1 = __builtin_amdgcn_mfma_f32_32x32x16_bf16(a1, cfr[k0], p1, 0, 0, 0);
            }
#pragma unroll
            for (int gq = 0; gq < 4; ++gq) { const int sb0 = 64 * t + 8 * gq + 4 * hi;
                const float4 s0 = *(const float4*)(al + sb0), s1 = *(const float4*)(al + sb0 + 32);
                const float a0[4] = {s0.x, s0.y, s0.z, s0.w}, a1[4] = {s1.x, s1.y, s1.z, s1.w};
#pragma unroll
                for (int e = 0; e < 4; ++e) { const int r = 4 * gq + e;
                    p0[r] = (sb0 + e <= l) ? p0[r] * __builtin_amdgcn_exp2f(al_l - a0[e]) : 0.f;
                    p1[r] = (sb0 + 32 + e <= l) ? p1[r] * __builtin_amdgcn_exp2f(al_l - a1[e]) : 0.f; } }
            bf16x8 pa[4];
#pragma unroll
            for (int ks = 0; ks < 4; ++ks) { uint4 w;
                if (ks < 2) { w.x = cvtpk(p0[8 * ks], p0[8 * ks + 1]); w.y = cvtpk(p0[8 * ks + 2], p0[8 * ks + 3]); w.z = cvtpk(p0[8 * ks + 4], p0[8 * ks + 5]); w.w = cvtpk(p0[8 * ks + 6], p0[8 * ks + 7]); }
                else { const int k2 = ks - 2; w.x = cvtpk(p1[8 * k2], p1[8 * k2 + 1]); w.y = cvtpk(p1[8 * k2 + 2], p1[8 * k2 + 3]); w.z = cvtpk(p1[8 * k2 + 4], p1[8 * k2 + 5]); w.w = cvtpk(p1[8 * k2 + 6], p1[8 * k2 + 7]); }
                pa[ks] = __builtin_bit_cast(bf16x8, w); }
#pragma unroll
            for (int ks = 0; ks < 4; ++ks) {
#pragma unroll
                for (int db = 0; db < 2; ++db) {
                    const LASC unsigned char* vp = (const LASC unsigned char*)(Xt + trx + 4 * hi * 128 + ks * 16 * 128 + db * 64);
                    const s16x4 lo = __builtin_bit_cast(s16x4, __builtin_amdgcn_ds_read_tr16_b64_v4i16((LASC att::v4i16_t*)vp));
                    const s16x4 hh = __builtin_bit_cast(s16x4, __builtin_amdgcn_ds_read_tr16_b64_v4i16((LASC att::v4i16_t*)(vp + 8 * 128)));
                    const bf16x8 vf = {lo[0], lo[1], lo[2], lo[3], hh[0], hh[1], hh[2], hh[3]};
                    if (db == 0) o0 = __builtin_amdgcn_mfma_f32_32x32x16_bf16(vf, pa[ks], o0, 0, 0, 0);
                    else o1 = __builtin_amdgcn_mfma_f32_32x32x16_bf16(vf, pa[ks], o1, 0, 0, 0); } }
        }
        {
#pragma unroll
            for (int ks = 0; ks < 4; ++ks) {
                const LASC unsigned char* bp = (const LASC unsigned char*)(Bt + trb + (16 * ks + 8 * hi) * 256 + nb * 64);
                const s16x4 a_lo = __builtin_bit_cast(s16x4, __builtin_amdgcn_ds_read_tr16_b64_v4i16((LASC att::v4i16_t*)bp));
                const s16x4 a_hi = __builtin_bit_cast(s16x4, __builtin_amdgcn_ds_read_tr16_b64_v4i16((LASC att::v4i16_t*)(bp + 4 * 256)));
                const LASC unsigned char* xp = (const LASC unsigned char*)(Xt + trx + (16 * ks + 8 * hi) * 128 + pb * 64);
                const s16x4 x_lo = __builtin_bit_cast(s16x4, __builtin_amdgcn_ds_read_tr16_b64_v4i16((LASC att::v4i16_t*)xp));
                const s16x4 x_hi = __builtin_bit_cast(s16x4, __builtin_amdgcn_ds_read_tr16_b64_v4i16((LASC att::v4i16_t*)(xp + 4 * 128)));
                const bf16x8 af = {a_lo[0], a_lo[1], a_lo[2], a_lo[3], a_hi[0], a_hi[1], a_hi[2], a_hi[3]};
                const bf16x8 xf = {x_lo[0], x_lo[1], x_lo[2], x_lo[3], x_hi[0], x_hi[1], x_hi[2], x_hi[3]};
                sacc = __builtin_amdgcn_mfma_f32_32x32x16_bf16(af, xf, sacc, 0, 0, 0);
            }
        }
        if (t + 1 < 4) SSD_STORE(st ^ 1, t + 1);
        __syncthreads();
    }
#undef SSD_LOAD
#undef SSD_STORE
    { const float Dh = d_skip[h]; bf16_t* yp = XC + (row0 + l) * 1024 + h * 64 + 4 * hi;
#pragma unroll
      for (int gq = 0; gq < 4; ++gq) {
          const uint2 x0 = *(const uint2*)(yp + 8 * gq), x1 = *(const uint2*)(yp + 32 + 8 * gq);
          *(uint2*)(yp + 8 * gq) = make_uint2(cvtpk(o0[4 * gq] + Dh * bflo(x0.x), o0[4 * gq + 1] + Dh * bfhi(x0.x)), cvtpk(o0[4 * gq + 2] + Dh * bflo(x0.y), o0[4 * gq + 3] + Dh * bfhi(x0.y)));
          *(uint2*)(yp + 32 + 8 * gq) = make_uint2(cvtpk(o1[4 * gq] + Dh * bflo(x1.x), o1[4 * gq + 1] + Dh * bfhi(x1.x)), cvtpk(o1[4 * gq + 2] + Dh * bflo(x1.y), o1[4 * gq + 3] + Dh * bfhi(x1.y))); } }
    { bf16_t* sp = STATES + ((size_t)((b * 32 + c) * 8 + h)) * 8192 + (size_t)(r32 + 32 * pb) * 128 + 32 * nb + 4 * hi;
#pragma unroll
      for (int gq = 0; gq < 4; ++gq) *(uint2*)(sp + 8 * gq) = make_uint2(cvtpk(sacc[4 * gq], sacc[4 * gq + 1]), cvtpk(sacc[4 * gq + 2], sacc[4 * gq + 3])); }
    __syncthreads();
}
__device__ __forceinline__ void m2_unit(unsigned char* lds, bf16_t* XC, const float* DT, const float* a_log, const bf16_t* STATES, const float* CDEC, int b, int c, int h) {
    if (c == 0) return;
    const int tid = ltid(), lane = tid & 63, wave = __builtin_amdgcn_readfirstlane(tid >> 6), r32 = lane & 31, hi = lane >> 5, g = h >> 2;
    const size_t row0 = (size_t)b * SEQ + c * 256; const int l = wave * 32 + r32;
    const float A = -expf(a_log[h]);
    float* al = (float*)(lds + OFF_AL2);
    (void)chunk_scan(lds, DT, row0, h, A, tid);
    const float ea = expf(al[l]);
    float4 hin[4];
#pragma unroll
    for (int j = 0; j < 4; ++j) hin[j] = make_float4(0.f, 0.f, 0.f, 0.f);
    const bf16_t* sbase = STATES + ((size_t)((b * 32) * 8 + h)) * 8192 + 4 * tid;
    for (int c0 = 0; c0 < c; c0 += 4) {
        uint2 sv[4][4]; float dec[4];
#pragma unroll
        for (int k = 0; k < 4; ++k) { const int cc = (c0 + k < c) ? c0 + k : c - 1; dec[k] = CDEC[(b * 32 + cc) * 8 + h];
#pragma unroll
            for (int j = 0; j < 4; ++j) sv[k][j] = *(const uint2*)(sbase + (size_t)cc * 8 * 8192 + 2048 * j); }
#pragma unroll
        for (int k = 0; k < 4; ++k) if (c0 + k < c) {
#pragma unroll
            for (int j = 0; j < 4; ++j) { hin[j].x = hin[j].x * dec[k] + bflo(sv[k][j].x); hin[j].y = hin[j].y * dec[k] + bfhi(sv[k][j].x); hin[j].z = hin[j].z * dec[k] + bflo(sv[k][j].y); hin[j].w = hin[j].w * dec[k] + bfhi(sv[k][j].y); } } }
#pragma unroll
    for (int j = 0; j < 4; ++j) { const int idx = 4 * tid + 2048 * j, p = idx >> 7, n = idx & 127;
        *(uint2*)(lds + OFF_HIN + p * 256 + (((n >> 3) ^ (p & 15)) * 16) + (n & 7) * 2) = make_uint2(cvtpk(hin[j].x, hin[j].y), cvtpk(hin[j].z, hin[j].w)); }
    __syncthreads();
    bf16x8 cfr[8];
    { const bf16_t* cp = XC + (row0 + l) * 1024 + 768 + g * 128 + 8 * hi;
#pragma unroll
      for (int k0 = 0; k0 < 8; ++k0) cfr[k0] = *(const bf16x8*)(cp + 16 * k0); }
    f32x16 o0, o1;
#pragma unroll
    for (int r = 0; r < 16; ++r) { o0[r] = 0.f; o1[r] = 0.f; }
#pragma unroll
    for (int k0 = 0; k0 < 8; ++k0) {
        const bf16x8 h0 = *(const bf16x8*)(lds + OFF_HIN + r32 * 256 + (((2 * k0 + hi) ^ (r32 & 15)) * 16));
        const bf16x8 h1 = *(const bf16x8*)(lds + OFF_HIN + (32 + r32) * 256 + (((2 * k0 + hi) ^ (r32 & 15)) * 16));
        o0 = __builtin_amdgcn_mfma_f32_32x32x16_bf16(h0, cfr[k0], o0, 0, 0, 0);
        o1 = __builtin_amdgcn_mfma_f32_32x32x16_bf16(h1, cfr[k0], o1, 0, 0, 0);
    }
    { bf16_t* yp = XC + (row0 + l) * 1024 + h * 64 + 4 * hi;
#pragma unroll
      for (int gq = 0; gq < 4; ++gq) {
          const uint2 y0 = *(const uint2*)(yp + 8 * gq), y1 = *(const uint2*)(yp + 32 + 8 * gq);
          *(uint2*)(yp + 8 * gq) = make_uint2(cvtpk(bflo(y0.x) + ea * o0[4 * gq], bfhi(y0.x) + ea * o0[4 * gq + 1]), cvtpk(bflo(y0.y) + ea * o0[4 * gq + 2], bfhi(y0.y) + ea * o0[4 * gq + 3]));
          *(uint2*)(yp + 32 + 8 * gq) = make_uint2(cvtpk(bflo(y1.x) + ea * o1[4 * gq], bfhi(y1.x) + ea * o1[4 * gq + 1]), cvtpk(bflo(y1.y) + ea * o1[4 * gq + 2], bfhi(y1.y) + ea * o1[4 * gq + 3])); } }
    __syncthreads();
}
}

__device__ __forceinline__ void moba_select_unit(unsigned char* lds, const bf16_t* PROJ, const float* KMEAN, unsigned* SEL, int b, int h, int qb) {
    const int tid = ltid(), lane = tid & 63, hf = lane & 1;
    const int q = qb * 256 + (tid >> 1);
    float* km_s = (float*)lds;
    { const int n = tid >> 4, c4 = (tid & 15) * 4; *(float4*)(km_s + n * 64 + c4) = *(const float4*)(KMEAN + ((size_t)(b * 32 + n)) * 512 + h * 64 + c4); }
    __syncthreads();
    const bf16_t* qp = PROJ + ((size_t)b * SEQ + q) * NPROJ + PC_MQ + h * 64 + hf * 32;
    float qv[32];
#pragma unroll
    for (int c = 0; c < 4; ++c) { const uint4 u = *(const uint4*)(qp + c * 8);
        qv[c * 8 + 0] = bflo(u.x); qv[c * 8 + 1] = bfhi(u.x); qv[c * 8 + 2] = bflo(u.y); qv[c * 8 + 3] = bfhi(u.y); qv[c * 8 + 4] = bflo(u.z); qv[c * 8 + 5] = bfhi(u.z); qv[c * 8 + 6] = bflo(u.w); qv[c * 8 + 7] = bfhi(u.w); }
    float g0 = -INFINITY, g1 = -INFINITY, g2 = -INFINITY; int i0 = 31, i1 = 31, i2 = 31;
    for (int n = 0; n < qb; ++n) {
        const float* km = km_s + n * 64 + hf * 32; float g = 0.f;
#pragma unroll
        for (int c = 0; c < 8; ++c) { const float4 k4 = *(const float4*)(km + 4 * c); g += qv[4 * c] * k4.x + qv[4 * c + 1] * k4.y + qv[4 * c + 2] * k4.z + qv[4 * c + 3] * k4.w; }
        g += __shfl_xor(g, 1);
        if (g > g0) { g2 = g1; i2 = i1; g1 = g0; i1 = i0; g0 = g; i0 = n; }
        else if (g > g1) { g2 = g1; i2 = i1; g1 = g; i1 = n; }
        else if (g > g2) { g2 = g; i2 = n; }
    }
    const int cnt = qb < 3 ? qb : 3;
    if (hf == 0) SEL[(size_t)(b * 8 + h) * SEQ + q] = (unsigned)i0 | ((unsigned)i1 << 5) | ((unsigned)i2 << 10) | ((unsigned)cnt << 15);
    __syncthreads();
}
namespace gat { constexpr int OFF_LIST = 65536, OFF_TABG = 98304, OFF_CNT = 102400; }
__device__ __forceinline__ void moba_gather_unit(unsigned char* lds, bf16_t* PROJ, const unsigned* SEL, const float* btab, bf16_t* PO2, float* PL, int b, int h, int j, int qc) {
    using namespace att;
    const int tid = ltid(), lane = tid & 63, wave = __builtin_amdgcn_readfirstlane(tid >> 6), r32 = lane & 31, hi = lane >> 5;
    const size_t rowbase = (size_t)b * SEQ;
    float* tab = (float*)(lds + gat::OFF_TABG); unsigned* list = (unsigned*)(lds + gat::OFF_LIST); unsigned* cntp = (unsigned*)(lds + gat::OFF_CNT);
    for (int d = tid; d < 1024; d += NT) tab[d] = btab[rel_bucket(d) * 16 + h] * LOG2E;
    if (tid == 0) *cntp = 0u;
    const uint4 selv0 = *(const uint4*)(SEL + (size_t)(b * 8 + h) * SEQ + 4096 * qc + 4 * tid), selv1 = *(const uint4*)(SEL + (size_t)(b * 8 + h) * SEQ + 4096 * qc + 2048 + 4 * tid);
    { const int skey = tid >> 3, sch = tid & 7;
      const bf16_t* kp = PROJ + (rowbase + j * 256 + skey) * NPROJ + h * 64 + sch * 8;
      const uint4 k0 = *(const uint4*)(kp + PC_MK), v0 = *(const uint4*)(kp + PC_MV), k1 = *(const uint4*)(kp + (size_t)64 * NPROJ + PC_MK), v1 = *(const uint4*)(kp + (size_t)64 * NPROJ + PC_MV);
      const uint4 k2 = *(const uint4*)(kp + (size_t)128 * NPROJ + PC_MK), v2 = *(const uint4*)(kp + (size_t)128 * NPROJ + PC_MV), k3 = *(const uint4*)(kp + (size_t)192 * NPROJ + PC_MK), v3 = *(const uint4*)(kp + (size_t)192 * NPROJ + PC_MV);
      unsigned char* kd = lds + skey * 128 + ((sch ^ ((skey >> 1) & 7)) * 16); unsigned char* vd = lds + 8192 + skey * 128 + ((sch ^ (((skey >> 1) & 1) << 2)) * 16);
      *(uint4*)(kd) = k0; *(uint4*)(vd) = v0; *(uint4*)(kd + ST_BYTES) = k1; *(uint4*)(vd + ST_BYTES) = v1;
      *(uint4*)(kd + 2 * ST_BYTES) = k2; *(uint4*)(vd + 2 * ST_BYTES) = v2; *(uint4*)(kd + 3 * ST_BYTES) = k3; *(uint4*)(vd + 3 * ST_BYTES) = v3; }
    __syncthreads();
#pragma unroll
    for (int half = 0; half < 2; ++half) {
        const int qf = 4096 * qc + 2048 * half + 4 * tid, qmin = 256 * (j + 1);
        const uint4 sv4 = half ? selv1 : selv0; const unsigned sv[4] = {sv4.x, sv4.y, sv4.z, sv4.w};
#pragma unroll
        for (int e = 0; e < 4; ++e) { int slot = -1; const int cnt = (int)((sv[e] >> 15) & 3u);
            if (qf + e >= qmin) { if ((int)(sv[e] & 31u) == j && cnt > 0) slot = 0; else if ((int)((sv[e] >> 5) & 31u) == j && cnt > 1) slot = 1; else if ((int)((sv[e] >> 10) & 31u) == j && cnt > 2) slot = 2; }
            const unsigned long long bal = __builtin_amdgcn_ballot_w64(slot >= 0);
            unsigned pos = 0u;
            if (lane == 0 && bal) pos = atomicAdd(cntp, (unsigned)__builtin_popcountll(bal));
            pos = __shfl(pos, 0);
            if (slot >= 0) list[pos + __builtin_popcountll(bal & ((1ull << lane) - 1ull))] = (unsigned)(qf + e) | ((unsigned)slot << 13); }
    }
    __syncthreads();
    const int n = (int)*cntp, ngroups = (n + 31) >> 5;
    const int vtr_off = ((lane & 15) >> 2) * 128 + (16 * ((lane >> 4) & 1) + 4 * (lane & 3)) * 2 + 4 * hi * 128;
    uint4 qraw[4]; unsigned entn = 0u;
    if (wave < ngroups) { const int ei = 32 * wave + r32; entn = list[ei < n ? ei : n - 1];
        const bf16_t* qp = PROJ + (rowbase + (int)(entn & 8191u)) * NPROJ + PC_MQ + h * 64 + 8 * hi;
#pragma unroll
        for (int d0 = 0; d0 < 4; ++d0) qraw[d0] = *(const uint4*)(qp + 16 * d0); }
    for (int grp = wave; grp < ngroups; grp += 8) {
        const int ei = 32 * grp + r32; const bool valid = ei < n; const unsigned ent = entn;
        const int q = (int)(ent & 8191u), slot = (int)(ent >> 13);
        bf16x8 qr[4];
        {
#pragma unroll
          for (int d0 = 0; d0 < 4; ++d0) { const uint4 u = qraw[d0];
              uint4 w; w.x = cvtpk(bflo(u.x) * C2, bfhi(u.x) * C2); w.y = cvtpk(bflo(u.y) * C2, bfhi(u.y) * C2); w.z = cvtpk(bflo(u.z) * C2, bfhi(u.z) * C2); w.w = cvtpk(bflo(u.w) * C2, bfhi(u.w) * C2);
              qr[d0] = __builtin_bit_cast(bf16x8, w); } }
        if (grp + 8 < ngroups) { const int ein = 32 * (grp + 8) + r32; entn = list[ein < n ? ein : n - 1];
            const bf16_t* qp = PROJ + (rowbase + (int)(entn & 8191u)) * NPROJ + PC_MQ + h * 64 + 8 * hi;
#pragma unroll
            for (int d0 = 0; d0 < 4; ++d0) qraw[d0] = *(const uint4*)(qp + 16 * d0); }
        f32x16 o0, o1;
#pragma unroll
        for (int r = 0; r < 16; ++r) { o0[r] = 0.f; o1[r] = 0.f; }
        float m = -1e30f, l = 0.f;
#pragma unroll 1
        for (int t = 0; t < 4; ++t) {
            const unsigned char* Ks = lds + t * ST_BYTES; const unsigned char* Vt = Ks + 8192;
            const int key0 = j * 256 + t * 64; f32x16 p0, p1;
            { const int dq = q - key0 - 4 * hi;
              if (__builtin_amdgcn_ballot_w64(q - (key0 + 63) >= 790) == ~0ull) { const float c31 = tab[1023];
#pragma unroll
                  for (int r = 0; r < 16; ++r) { p0[r] = c31; p1[r] = c31; } }
              else {
#pragma unroll
                  for (int r = 0; r < 16; ++r) { const int kofs = (r & 3) + 8 * (r >> 2); const int d0_ = dq - kofs, d1_ = dq - kofs - 32;
                      p0[r] = tab[d0_ > 1023 ? 1023 : d0_]; p1[r] = tab[d1_ > 1023 ? 1023 : d1_]; } } }
#pragma unroll
            for (int d0 = 0; d0 < 4; ++d0) {
                const bf16x8 a0 = *(const bf16x8*)(Ks + r32 * 128 + (((2 * d0 + hi) ^ ((r32 >> 1) & 7)) * 16));
                const bf16x8 a1 = *(const bf16x8*)(Ks + (32 + r32) * 128 + (((2 * d0 + hi) ^ ((r32 >> 1) & 7)) * 16));
                p0 = __builtin_amdgcn_mfma_f32_32x32x16_bf16(a0, qr[d0], p0, 0, 0, 0);
                p1 = __builtin_amdgcn_mfma_f32_32x32x16_bf16(a1, qr[d0], p1, 0, 0, 0);
            }
            float mx = fmaxf(p0[0], p1[0]);
#pragma unroll
            for (int r = 1; r < 16; ++r) mx = fmaxf(mx, fmaxf(p0[r], p1[r]));
            mx = fmaxf(mx, __shfl_xor(mx, 32));
            const float mn = fmaxf(m, mx);
            if (__builtin_amdgcn_ballot_w64(mn > m) != 0ull) {
                const float alpha = __builtin_amdgcn_exp2f(m - mn); l *= alpha;
#pragma unroll
                for (int r = 0; r < 16; ++r) { o0[r] *= alpha; o1[r] *= alpha; }
            }
            m = mn;
            float sum = 0.f;
#pragma unroll
            for (int r = 0; r < 16; ++r) { p0[r] = __builtin_amdgcn_exp2f(p0[r] - mn); p1[r] = __builtin_amdgcn_exp2f(p1[r] - mn); sum += p0[r] + p1[r]; }
            l += sum;
            bf16x8 pa[4];
#pragma unroll
            for (int ks = 0; ks < 4; ++ks) { uint4 w;
                if (ks < 2) { w.x = cvtpk(p0[8 * ks], p0[8 * ks + 1]); w.y = cvtpk(p0[8 * ks + 2], p0[8 * ks + 3]); w.z = cvtpk(p0[8 * ks + 4], p0[8 * ks + 5]); w.w = cvtpk(p0[8 * ks + 6], p0[8 * ks + 7]); }
                else { const int k2 = ks - 2; w.x = cvtpk(p1[8 * k2], p1[8 * k2 + 1]); w.y = cvtpk(p1[8 * k2 + 2], p1[8 * k2 + 3]); w.z = cvtpk(p1[8 * k2 + 4], p1[8 * k2 + 5]); w.w = cvtpk(p1[8 * k2 + 6], p1[8 * k2 + 7]); }
                pa[ks] = __builtin_bit_cast(bf16x8, w); }
#pragma unroll
            for (int ks = 0; ks < 4; ++ks) {
#pragma unroll
                for (int db = 0; db < 2; ++db) {
                    const LASC unsigned char* vp = (const LASC unsigned char*)(Vt + vtr_off + ks * 16 * 128 + ((db ^ ((lane >> 3) & 1)) * 64));
                    const s16x4 lo = __builtin_bit_cast(s16x4, __builtin_amdgcn_ds_read_tr16_b64_v4i16((LASC v4i16_t*)vp));
                    const s16x4 hh = __builtin_bit_cast(s16x4, __builtin_amdgcn_ds_read_tr16_b64_v4i16((LASC v4i16_t*)(vp + 8 * 128)));
                    const bf16x8 vf = {lo[0], lo[1], lo[2], lo[3], hh[0], hh[1], hh[2], hh[3]};
                    if (db == 0) o0 = __builtin_amdgcn_mfma_f32_32x32x16_bf16(vf, pa[ks], o0, 0, 0, 0);
                    else o1 = __builtin_amdgcn_mfma_f32_32x32x16_bf16(vf, pa[ks], o1, 0, 0, 0); }
            }
        }
        l += __shfl_xor(l, 32);
        const float inv = 1.0f / l;
        if (valid) {
            bf16_t* pp = (slot < 2) ? PROJ + (rowbase + q) * NPROJ + PC_XBC + (h * 2 + slot) * 64 + 4 * hi : PO2 + ((rowbase + q) * 8 + h) * 64 + 4 * hi;
#pragma unroll
            for (int g = 0; g < 4; ++g) {
                *(uint2*)(pp + 8 * g) = make_uint2(cvtpk(o0[4 * g] * inv, o0[4 * g + 1] * inv), cvtpk(o0[4 * g + 2] * inv, o0[4 * g + 3] * inv));
                *(uint2*)(pp + 32 + 8 * g) = make_uint2(cvtpk(o1[4 * g] * inv, o1[4 * g + 1] * inv), cvtpk(o1[4 * g + 2] * inv, o1[4 * g + 3] * inv)); }
            if (hi == 0) PL[((rowbase + q) * 8 + h) * 4 + slot] = m + __builtin_amdgcn_logf(l);
        }
    }
    __syncthreads();
}
#define MIX_WS ({ unsigned char* p_ = ws0; asm volatile("" : "+s"(p_)); p_; })
#define QUEUE_NEXT(u, word) do { if (tid == 0) *(volatile unsigned*)(lds + 131072 + 64) = atomicAdd((unsigned*)(MIX_WS + WS_CTL + 32768) + 64 * (word), 1u); \
        __syncthreads(); u = *(volatile unsigned*)(lds + 131072 + 64); __syncthreads(); } while (0)
__device__ __forceinline__ void ph_mixers(unsigned char* lds, unsigned char* ws0, const float* a_log, const float* d_skip, const float* sinks, const float* btab, int l) {
    const int tid = ltid();
    bool swa_ok = false;
    for (;;) {
        unsigned u; QUEUE_NEXT(u, 3 * l);
        if (u >= 2048u + 64u) break;
        if (u < 64u) {
            unsigned char* ws = MIX_WS;
            pg8::OneSched S; S.u0.A = (const char*)P_XN(ws) + (size_t)u * 256 * (D * 2); S.u0.B = (const char*)(ws + WS_WIN) + (size_t)INP_TILES * 256 * (D * 2);
            S.u0.lda2 = D * 2; S.u0.ldb2 = D * 2; S.u0.nt = D / 64; S.u0.pm = (int)u; S.u0.pn = INP_TILES; S.u0.aux = 0;
            pg8::EpiStoreBf16 E{P_PROJ(ws), NPROJ}; pg8::gemm_phase<pg8::EpiStoreBf16, pg8::OneSched, true>((LAS unsigned char*)lds, S, E);
            if (tid == 0) { __builtin_amdgcn_fence(__ATOMIC_RELEASE, "agent"); asm volatile("s_waitcnt vmcnt(0)" ::: "memory"); (void)q_add((unsigned*)(ws + WS_CTL + 32768) + 64 * (6 + l), 1u); }
            continue;
        }
        u -= 64u;
        const int k = (int)(u & 511u);
        if (u < 512u) { const int qb = 31 - (k >> 4), bh = k & 15; unsigned char* ws = MIX_WS;
            att::attn_unit<att::MODE_FOX>(lds, P_PROJ(ws), (const float*)(ws + WS_LF), (const float*)(ws + WS_CUM), 0, 0.f, bh >> 3, bh & 7, bh & 7, qb, PC_FQ, PC_FK, PC_FV); }
        else if (u < 1024u) { unsigned char* ws = MIX_WS; ssd::m1_unit(lds, P_XC(ws), (const float*)(ws + WS_DT), a_log, d_skip, (bf16_t*)(ws + WS_STATES), (float*)(ws + WS_CDEC), k >> 8, (k >> 3) & 31, k & 7); }
        else if (u < 1536u) { const int bh = k >> 5, qb = k & 31, hq = bh & 7; unsigned char* ws = MIX_WS;
            if (!swa_ok) {
                if (tid == 0) { unsigned sp = 0; while (q_ld((unsigned*)(ws + WS_CTL + 32768) + 64 * (6 + l)) < 64u) { __builtin_amdgcn_s_sleep(2); if (++sp > (1u << 22)) break; } }
                __syncthreads();
                __builtin_amdgcn_fence(__ATOMIC_ACQUIRE, "agent"); asm volatile("s_waitcnt vmcnt(0)" ::: "memory");
                __syncthreads();
                swa_ok = true; }
            att::attn_unit<att::MODE_SWA>(lds, P_PROJ(ws), nullptr, btab, 8 + hq, sinks[hq], bh >> 3, hq, hq >> 2, qb, PC_SQ, PC_SK, PC_SV); }
        else { const int qb = 31 - (k >> 4), bh = k & 15; unsigned char* ws = MIX_WS;
            moba_select_unit(lds, P_PROJ(ws), (const float*)(ws + WS_KMEAN), (unsigned*)(ws + WS_SEL), bh >> 3, bh & 7, qb); }
    }
}
__device__ __forceinline__ void ph_mixers_b(unsigned char* lds, unsigned char* ws0, const float* a_log, const float* btab, int l, const float* const* in) {
    const int tid = ltid();
    for (;;) {
        unsigned u; QUEUE_NEXT(u, 3 * l + 1);
        if (u >= 736u + 512u + (unsigned)((WCV_ALL - WCV_IN) / WCV_CHUNK)) break;
        if (u >= 736u + 512u) {
            const int lo = WCV_IN + (int)(u - (736u + 512u)) * WCV_CHUNK; unsigned char* ws = MIX_WS;
            ph_wconv(ws, in[1] + (size_t)l * D * DIN, in[11] + (size_t)l * 4 * 512 * 1024, in[12] + (size_t)l * D * D, in[15] + (size_t)l * D * DFF, in[16] + (size_t)l * D * DFF, in[17] + (size_t)l * DFF * D,
                     (LAS float*)lds, lo, lo + WCV_CHUNK, 0, 1);
            continue; }
        if (u < 736u) { const int bh = (int)u & 15, idx = (int)u >> 4;
            const int qc = idx < 15 ? 0 : 1, j = idx - (qc == 0 ? 0 : 15); unsigned char* ws = MIX_WS;
            moba_gather_unit(lds, P_PROJ(ws), (const unsigned*)(ws + WS_SEL), btab, (bf16_t*)(ws + WS_PO2), (float*)(ws + WS_PL), bh >> 3, bh & 7, j, qc); }
        else { const int k = (int)u - 736, c = 31 - (k >> 4), bh = k & 15; unsigned char* ws = MIX_WS;
            ssd::m2_unit(lds, P_XC(ws), (const float*)(ws + WS_DT), a_log, (const bf16_t*)(ws + WS_STATES), (const float*)(ws + WS_CDEC), bh >> 3, c, bh & 7); }
    }
}
__device__ __forceinline__ void ph_mixers_c(unsigned char* lds, unsigned char* ws0, const float* btab, const float* ssm_norm_w, int l) {
    const int tid = ltid();
    for (;;) {
        unsigned u; QUEUE_NEXT(u, 3 * l + 2);
        if (u >= 512u) break;
        const int qb = 31 - ((int)u >> 4), bh = (int)u & 15, h = bh & 7; unsigned char* ws = MIX_WS;
        att::attn_unit<att::MODE_MOWN>(lds, P_PROJ(ws), (const float*)(ws + WS_SEL), btab, h, 0.f, bh >> 3, h, h, qb, PC_MQ, PC_MK, PC_MV, false, (const void*)(ws + WS_PO2), (const void*)(ws + WS_PL));
    }
    { unsigned char* ws = MIX_WS; ph_mamba_norm(P_PROJ(ws), P_XC(ws), ssm_norm_w); }
}
#define XB_TMO      128
#define XB_XCNT(j)  (256  + 64 * (j))
#define XB_XSUB(j)  (1280 + 64 * (j))
#define XB_XGEN(j)  (2304 + 64 * (j))
#define XB_TOP      3328
#define XB_TOPGEN   3392
#define XCD_BAR_WORDS 3456
#define XB_SPIN_CAP (1u << 18)

__device__ __forceinline__ unsigned xb_ld(unsigned* p)              { return __hip_atomic_load(p, __ATOMIC_RELAXED, __HIP_MEMORY_SCOPE_AGENT); }
__device__ __forceinline__ unsigned xb_add(unsigned* p, unsigned v) { return __hip_atomic_fetch_add(p, v, __ATOMIC_RELAXED, __HIP_MEMORY_SCOPE_AGENT); }
__device__ __forceinline__ unsigned xb_xcc_id() { return (unsigned)__builtin_amdgcn_s_getreg((3 << 11) | 20) & 0xFu; }
#define XB_SPIN(cond, bar) do { unsigned _sp = 0; while (cond) { __builtin_amdgcn_s_sleep(1); \
    if ((++_sp & 255u) == 0u) { if (xb_ld(&(bar)[XB_TMO])) break; if (_sp > XB_SPIN_CAP) { atomicAdd(&(bar)[XB_TMO], 1u); break; } } } } while (0)

struct XcdBarrier {
    unsigned* bar; unsigned x;
    volatile LAS unsigned* st;
};

__device__ __forceinline__ XcdBarrier xcd_barrier_post(unsigned* bar, volatile LAS unsigned* st) {
    XcdBarrier b; b.bar = bar; b.x = xb_xcc_id(); b.st = st;
    if (threadIdx.x == 0) (void)xb_add(&bar[XB_XCNT(b.x)], 1u);
    return b;
}
__device__ __forceinline__ void xcd_barrier_complete(unsigned* bar, unsigned x, unsigned& nloc, unsigned& nx) {
    const unsigned G = gridDim.x * gridDim.y * gridDim.z;
    unsigned sum, cnt, mine, sp = 0u;
    for (;;) {
        sum = 0u; cnt = 0u; mine = 0u;
#pragma unroll
        for (unsigned j = 0; j < 16; ++j) { const unsigned c = xb_ld(&bar[XB_XCNT(j)]); sum += c; cnt += (c > 0u) ? 1u : 0u; mine = (j == x) ? c : mine; }
        if (sum == G) break;
        __builtin_amdgcn_s_sleep(1);
        if ((++sp & 255u) == 0u) { if (xb_ld(&bar[XB_TMO])) break; if (sp > XB_SPIN_CAP) { atomicAdd(&bar[XB_TMO], 1u); break; } }
    }
    nloc = mine > 0u ? mine : 1u; nx = cnt > 0u ? cnt : 1u;
}

__device__ __forceinline__ void xcd_barrier(const XcdBarrier& b) {
    asm volatile("s_waitcnt vmcnt(0)" ::: "memory");
    __syncthreads();
    if (threadIdx.x == 0) {
        unsigned* bar = b.bar;
        __builtin_amdgcn_s_waitcnt(0);
        unsigned nloc = b.st[0], nx = b.st[1];
        if (nloc == 0u) { xcd_barrier_complete(bar, b.x, nloc, nx); b.st[0] = nloc; b.st[1] = nx; }
        const unsigned old = xb_add(&bar[XB_XSUB(b.x)], 1u);
        const unsigned gen = old / nloc;
        if (old + 1u == (gen + 1u) * nloc) {
            __builtin_amdgcn_fence(__ATOMIC_RELEASE, "agent");
            asm volatile("s_waitcnt vmcnt(0)" ::: "memory");
            const unsigned og = xb_add(&bar[XB_TOP], 1u);
            const unsigned tg = og / nx;
            if (og + 1u == (tg + 1u) * nx) xb_add(&bar[XB_TOPGEN], 1u);
            else XB_SPIN(xb_ld(&bar[XB_TOPGEN]) == tg, bar);
            __builtin_amdgcn_fence(__ATOMIC_ACQUIRE, "agent");
            xb_add(&bar[XB_XGEN(b.x)], 1u);
            asm volatile("s_waitcnt vmcnt(0)" ::: "memory");
        } else {
            XB_SPIN(xb_ld(&bar[XB_XGEN(b.x)]) == gen, bar);
            __builtin_amdgcn_fence(__ATOMIC_ACQUIRE, "agent");
            asm volatile("s_waitcnt vmcnt(0)" ::: "memory");
        }
    }
    __syncthreads();
}

constexpr int MISC_OFF = 131072 + 320;
constexpr int LDS_BYTES = 147456;
constexpr int HROW_OFF = 69632;
#define GRID_SYNC() xcd_barrier(bar)
#define WSL ({ unsigned char* p_ = a.ws; asm volatile("" : "+s"(p_)); p_; })
__global__ void __launch_bounds__(NT, 2) fwd(Args a) {
    extern __shared__ __attribute__((aligned(16))) unsigned char lds[];
    LAS unsigned char* L = (LAS unsigned char*)lds;
    volatile LAS unsigned* MISC = (volatile LAS unsigned*)(L + MISC_OFF);
    if (threadIdx.x < 32) MISC[threadIdx.x] = 0u;
    __syncthreads();
    XcdBarrier bar = xcd_barrier_post((unsigned*)(a.ws + WS_CTL) + 4096, MISC + 8);
#pragma unroll 1
    for (int l = 0; l < 2; ++l) {
        {
            unsigned char* ws = WSL; const float* w_in = a.in[1] + (size_t)l * D * DIN;
            ph_wconv(ws, w_in, a.in[11] + (size_t)l * 4 * 512 * 1024, a.in[12] + (size_t)l * D * D, a.in[15] + (size_t)l * D * DFF, a.in[16] + (size_t)l * D * DFF, a.in[17] + (size_t)l * DFF * D, (LAS float*)L, 0, WCV_IN, blockIdx.x, gridDim.x);
            __syncthreads();
            if (l == 0) ph_norm<false>((float*)lds, a.in[0], a.in[13] + l * D, P_XN(ws), true, w_in, a.in[4] + l * 8, a.in[8] + l * 8, (float*)(ws + WS_DT), (float*)(ws + WS_LF), (bf16_t*)a.out);
            else ph_norm<true>((float*)lds, a.out, a.in[13] + l * D, P_XN(ws), true, w_in, a.in[4] + l * 8, a.in[8] + l * 8, (float*)(ws + WS_DT), (float*)(ws + WS_LF), nullptr);
        }
        GRID_SYNC();
        {
            unsigned char* ws = WSL;
            pg8::PlainSched S; S.T.init(M / 256, INP_TILES, gridDim.x, blockIdx.x); S.A = (const char*)P_XN(ws); S.B = (const char*)(ws + WS_WIN); S.lda2 = D * 2; S.ldb2 = D * 2; S.nt = D / 64;
            pg8::EpiStoreBf16 E{P_PROJ(ws), NPROJ}; pg8::gemm_phase<pg8::EpiStoreBf16, pg8::PlainSched, true>(L, S, E);
        }
        GRID_SYNC();
        { unsigned char* ws = WSL; ph_pre(lds, P_PROJ(ws), a.in[2] + (size_t)l * 4 * 1024, a.in[3] + l * 1024, P_XC(ws), (float*)(ws + WS_KMEAN), (float*)(ws + WS_CUM)); }
        GRID_SYNC();
        ph_mixers(lds, a.ws, a.in[5] + l * 8, a.in[6] + l * 8, a.in[9] + l * 8, a.in[10], l);
        GRID_SYNC();
        ph_mixers_b(lds, a.ws, a.in[5] + l * 8, a.in[10], l, a.in);
        GRID_SYNC();
        ph_mixers_c(lds, a.ws, a.in[10], a.in[7] + l * 512, l);
        GRID_SYNC();
        {
            unsigned char* ws = WSL;
            pg8::GBSched S; S.T.init(M / 256, D / 256, gridDim.x, blockIdx.x); S.XN = (const char*)P_XN(ws); S.WG = (const char*)(ws + WS_WG); S.PROJ = (const char*)P_PROJ(ws); S.WBR = (const char*)(ws + WS_WBR);
            pg8::EpiGB E{P_PROJ(ws), P_XC(ws), (bf16_t*)a.out + (size_t)M * D}; pg8::gemm_phase<pg8::EpiGB, pg8::GBSched, true>(L, S, E);
        }
        GRID_SYNC();
        {
            unsigned char* ws = WSL;
            pg8::PlainSched S; S.T.init(M / 256, D / 256, gridDim.x, blockIdx.x); S.A = (const char*)((const bf16_t*)a.out + (size_t)M * D); S.B = (const char*)(ws + WS_WOUT); S.lda2 = D * 2; S.ldb2 = D * 2; S.nt = D / 64;
            pg8::EpiRes E{(const bf16_t*)a.out, (void*)P_XC(ws), false}; pg8::gemm_phase<pg8::EpiRes, pg8::PlainSched, false>(L, S, E);
        }
        GRID_SYNC();
        { unsigned char* ws = WSL; ph_norm<true>(nullptr, P_XC(ws), a.in[14] + l * D, P_XN(ws), false, nullptr, nullptr, nullptr, nullptr, nullptr, nullptr); }
        GRID_SYNC();
        {
            unsigned char* ws = WSL;
            pg8::PlainSched S; S.T.init(M / 256, 2 * DFF / 256, gridDim.x, blockIdx.x); S.A = (const char*)P_XN(ws); S.B = (const char*)(ws + WS_WGU); S.lda2 = D * 2; S.ldb2 = D * 2; S.nt = D / 64;
            pg8::EpiSwiglu E{P_PROJ(ws)}; pg8::gemm_phase<pg8::EpiSwiglu, pg8::PlainSched, true>(L, S, E);
        }
        GRID_SYNC();
        {
            unsigned char* ws = WSL;
            pg8::PlainSched S; S.T.init(M / 256, D / 256, gridDim.x, blockIdx.x); S.A = (const char*)P_PROJ(ws); S.B = (const char*)(ws + WS_WDN); S.lda2 = DFF * 2; S.ldb2 = DFF * 2; S.nt = DFF / 64;
            pg8::EpiRes E{P_XC(ws), (void*)a.out, l == 1}; pg8::gemm_phase<pg8::EpiRes, pg8::PlainSched, false>(L, S, E);
        }
        GRID_SYNC();
    }
    ph_final(a.out, a.in[18]);
}

extern "C" void kernel_launch(void* const* d_in, const int* in_sizes, int n_in, void* d_out, int out_size, void* d_ws, size_t ws_size, hipStream_t stream) {
    static int grid = 0;
    if (grid == 0) {
        if (n_in != 19 || out_size != M * D || ws_size < WS_TOTAL) { fprintf(stderr, "kernel_launch: unexpected shapes (n_in %d out %d ws %zu)\n", n_in, out_size, ws_size); grid = -1; return; }
        int dev = 0, cus = 0, per_cu = 0;
        (void)hipGetDevice(&dev); (void)hipDeviceGetAttribute(&cus, hipDeviceAttributeMultiprocessorCount, dev);
        if (hipFuncSetAttribute((const void*)fwd, hipFuncAttributeMaxDynamicSharedMemorySize, LDS_BYTES) != hipSuccess) { fprintf(stderr, "kernel_launch: hipFuncSetAttribute failed\n"); grid = -1; return; }
        (void)hipOccupancyMaxActiveBlocksPerMultiprocessor(&per_cu, (const void*)fwd, NT, LDS_BYTES);
        if (per_cu < 1) { fprintf(stderr, "kernel_launch: occupancy query says 0 blocks per CU\n"); grid = -1; return; }
        grid = cus < 256 ? cus : 256;
    }
    if (grid < 0) return;
    if (hipMemsetAsync((char*)d_ws + WS_CTL, 0, CTL_ZERO_BYTES, stream) != hipSuccess) { fprintf(stderr, "kernel_launch: memset of the control words failed\n"); return; }
    Args a{};
    for (int i = 0; i < 19; ++i) a.in[i] = (const float*)d_in[i];
    a.out = (float*)d_out; a.ws = (unsigned char*)d_ws;
    hipLaunchKernelGGL(fwd, dim3(grid), dim3(NT), LDS_BYTES, stream, a);
}
```

```cpp
#include <hip/hip_runtime.h>
#include <hip/hip_cooperative_groups.h>
#include <cstdio>
#include <cstdint>
namespace cg = cooperative_groups;

#ifndef SINGLE_LAUNCH
#define SINGLE_LAUNCH 0
#endif

typedef unsigned short bf16_t;
constexpr int M = 16384, SEQ = 8192, D = 1024, DIN = 9488, NPROJ = 5376, DFF = 2816;
constexpr int NT = 512;
constexpr int INP_TILES = 20;
constexpr int PC_Z = 0, PC_XBC = 512, PC_MQ = 1536, PC_MK = 2048, PC_MV = 2560, PC_FQ = 3072, PC_FK = 3584, PC_FV = 4096, PC_SQ = 4608, PC_SK = 5120, PC_SV = 5248;
constexpr int WC_DT = 1536, WC_F = 4616, WC_GATE = 5392;
constexpr size_t MiB = 1u << 20;
constexpr size_t WS_XN = 0, WS_PROJ = 32 * MiB, WS_XC = 200 * MiB, WS_DT = 232 * MiB, WS_LF = WS_DT + MiB / 2, WS_CUM = 233 * MiB, WS_KMEAN = WS_CUM + MiB / 2;
constexpr size_t WS_WIN = 234 * MiB;
constexpr size_t WS_WG = WS_WIN + (size_t)NPROJ * D * 2;
constexpr size_t WS_WBR = WS_WG + (size_t)4096 * D * 2;
constexpr size_t WS_WOUT = WS_WBR + (size_t)4 * D * 512 * 2;
constexpr size_t WS_WGU = WS_WOUT + (size_t)D * D * 2;
constexpr size_t WS_WDN = WS_WGU + (size_t)2 * DFF * D * 2;
constexpr size_t WS_END = WS_WDN + (size_t)D * DFF * 2;
static_assert(WS_END <= 276 * MiB, "workspace map");

constexpr size_t WS_CTL = 276 * MiB, CTL_ZERO_BYTES = 65536, WS_CDEC = WS_CTL + 131072, WS_TOTAL = 294 * MiB;
constexpr size_t WS_STATES = 234 * MiB, WS_PL = WS_STATES + 8 * MiB;
constexpr size_t WS_PO2 = 277 * MiB, WS_SEL = 293 * MiB;
#define P_XN(w) ((bf16_t*)((w) + WS_XN))
#define P_PROJ(w) ((bf16_t*)((w) + WS_PROJ))
#define P_XC(w) ((bf16_t*)((w) + WS_XC))
struct Args { const float* in[19]; float* out; unsigned char* ws; int ph_lo, ph_hi, coop, pad; };

__device__ __forceinline__ float bf2f(unsigned v) { return __uint_as_float(v << 16); }
__device__ __forceinline__ float bflo(unsigned v) { return __uint_as_float(v << 16); }
__device__ __forceinline__ float bfhi(unsigned v) { return __uint_as_float(v & 0xffff0000u); }
__device__ __forceinline__ unsigned f2bf(float f) { unsigned u = __float_as_uint(f); return (u + 0x7fffu + ((u >> 16) & 1u)) >> 16; }
__device__ __forceinline__ unsigned pk2(float lo, float hi) { return f2bf(lo) | (f2bf(hi) << 16); }
__device__ __forceinline__ float wave_sum(float v) {
#pragma unroll
    for (int o = 1; o < 64; o <<= 1) v += __shfl_xor(v, o);
    return v;
}
__device__ __forceinline__ unsigned q_ld(unsigned* p)              { return __hip_atomic_load(p, __ATOMIC_RELAXED, __HIP_MEMORY_SCOPE_AGENT); }
__device__ __forceinline__ unsigned q_add(unsigned* p, unsigned v) { return __hip_atomic_fetch_add(p, v, __ATOMIC_RELAXED, __HIP_MEMORY_SCOPE_AGENT); }
__device__ __forceinline__ int ltid() { int t = threadIdx.x; asm volatile("" : "+v"(t)); return t; }
__device__ __forceinline__ float log1p_pos(float e) {
    const float small = e * (1.f + e * (-0.5f + e * (0.33333333f + e * (-0.25f + e * 0.2f))));
    return e < 0.02f ? small : logf(1.f + e);
}
__device__ __forceinline__ float softplus_f(float x) { return fmaxf(x, 0.f) + log1p_pos(expf(-fabsf(x))); }
__device__ __forceinline__ float silu_f(float x) { return x / (1.f + expf(-x)); }
__device__ __forceinline__ float sigmoid_f(float x) { return 1.f / (1.f + expf(-x)); }
__device__ __forceinline__ int rel_bucket(int d) {
    if (d < 16) return d;
    int b = 16;
    b += (d >= 21); b += (d >= 27); b += (d >= 35); b += (d >= 46); b += (d >= 59); b += (d >= 77); b += (d >= 99); b += (d >= 128);
    b += (d >= 166); b += (d >= 216); b += (d >= 280); b += (d >= 363); b += (d >= 470); b += (d >= 609); b += (d >= 790);
    return b;
}

template <bool IN_BF16>
__device__ __forceinline__ void ph_norm(float* wd, const void* xin, const float* nw, bf16_t* XN, bool dots, const float* w_in, const float* dt_bias, const float* fbias, float* DT, float* LF, bf16_t* R0) {
    const int tx_ = ltid();
    const int lane = tx_ & 63, wave = tx_ >> 6;
    const int gw = blockIdx.x * 8 + wave, NGW = gridDim.x * 8;
    if (dots) {
        for (int i = tx_; i < 1024 * 4; i += NT) { const int k = i >> 2, part = i & 3;
            *(float4*)((char*)wd + (k >> 2) * 272 + (k & 3) * 64 + part * 16) = *(const float4*)(w_in + (size_t)k * DIN + (part < 2 ? WC_DT + part * 4 : WC_F + (part - 2) * 4)); }
        __syncthreads();
    }
    float4 nwv[4];
#pragma unroll
    for (int j = 0; j < 4; ++j) nwv[j] = ((const float4*)nw)[lane + 64 * j];
    for (int row0 = gw; row0 < M; row0 += 4 * NGW) {
    float4 vb[IN_BF16 ? 1 : 4][4]; uint2 ub[IN_BF16 ? 4 : 1][4];
#pragma unroll
    for (int k = 0; k < 4; ++k) { const int rk = row0 + k * NGW; if (rk < M) {
        if constexpr (IN_BF16) { const uint2* xr = (const uint2*)((const bf16_t*)xin + (size_t)rk * D);
#pragma unroll
            for (int j = 0; j < 4; ++j) ub[k][j] = xr[lane + 64 * j]; }
        else { const float4* xr = (const float4*)((const float*)xin + (size_t)rk * D);
#pragma unroll
            for (int j = 0; j < 4; ++j) vb[k][j] = xr[lane + 64 * j]; } } }
#pragma unroll
    for (int k = 0; k < 4; ++k) {
        const int row = row0 + k * NGW; if (row >= M) break;
        float4 v[4]; float ss = 0.f;
#pragma unroll
        for (int j = 0; j < 4; ++j) {
            if constexpr (IN_BF16) v[j] = make_float4(bflo(ub[k][j].x), bfhi(ub[k][j].x), bflo(ub[k][j].y), bfhi(ub[k][j].y)); else v[j] = vb[k][j];
            ss += v[j].x * v[j].x + v[j].y * v[j].y + v[j].z * v[j].z + v[j].w * v[j].w; }
        if constexpr (!IN_BF16) { if (R0) { uint2* rp = (uint2*)(R0 + (size_t)row * D);
#pragma unroll
            for (int j = 0; j < 4; ++j) rp[lane + 64 * j] = make_uint2(pk2(v[j].x, v[j].y), pk2(v[j].z, v[j].w)); } }
        ss = wave_sum(ss);
        const float rstd = 1.0f / sqrtf(ss * (1.0f / D) + 1e-6f);
#pragma unroll
        for (int j = 0; j < 4; ++j) { const float4 w4 = nwv[j]; v[j].x *= rstd * w4.x; v[j].y *= rstd * w4.y; v[j].z *= rstd * w4.z; v[j].w *= rstd * w4.w; }
        uint2* o = (uint2*)(XN + (size_t)row * D);
#pragma unroll
        for (int j = 0; j < 4; ++j) o[lane + 64 * j] = make_uint2(pk2(v[j].x, v[j].y), pk2(v[j].z, v[j].w));
        if (dots) {
            float d[16];
#pragma unroll
            for (int c = 0; c < 16; ++c) d[c] = 0.f;
#pragma unroll
            for (int j = 0; j < 4; ++j) { const float hv[4] = {v[j].x, v[j].y, v[j].z, v[j].w};
#pragma unroll
                for (int e = 0; e < 4; ++e) { const float* wr = (const float*)((const char*)wd + (lane + 64 * j) * 272 + e * 64); const float h = hv[e];
                    const float4 a0 = *(const float4*)(wr), a1 = *(const float4*)(wr + 4), b0 = *(const float4*)(wr + 8), b1 = *(const float4*)(wr + 12);
                    d[0] += h * a0.x; d[1] += h * a0.y; d[2] += h * a0.z; d[3] += h * a0.w; d[4] += h * a1.x; d[5] += h * a1.y; d[6] += h * a1.z; d[7] += h * a1.w;
                    d[8] += h * b0.x; d[9] += h * b0.y; d[10] += h * b0.z; d[11] += h * b0.w; d[12] += h * b1.x; d[13] += h * b1.y; d[14] += h * b1.z; d[15] += h * b1.w; }
                asm volatile("" ::: "memory"); }
            float r8[8], r4[4], r2[2];
            { const bool up = (lane & 32) != 0;
#pragma unroll
              for (int i = 0; i < 8; ++i) { const float keep = up ? d[i + 8] : d[i], send = up ? d[i] : d[i + 8]; r8[i] = keep + __shfl_xor(send, 32); } }
            { const bool up = (lane & 16) != 0;
#pragma unroll
              for (int i = 0; i < 4; ++i) { const float keep = up ? r8[i + 4] : r8[i], send = up ? r8[i] : r8[i + 4]; r4[i] = keep + __shfl_xor(send, 16); } }
            { const bool up = (lane & 8) != 0;
#pragma unroll
              for (int i = 0; i < 2; ++i) { const float keep = up ? r4[i + 2] : r4[i], send = up ? r4[i] : r4[i + 2]; r2[i] = keep + __shfl_xor(send, 8); } }
            float mine; { const bool up = (lane & 4) != 0; const float keep = up ? r2[1] : r2[0], send = up ? r2[0] : r2[1]; mine = keep + __shfl_xor(send, 4); }
            mine += __shfl_xor(mine, 2); mine += __shfl_xor(mine, 1);
            const int col = ((lane >> 5) & 1) * 8 + ((lane >> 4) & 1) * 4 + ((lane >> 3) & 1) * 2 + ((lane >> 2) & 1);
            if ((lane & 3) == 0) { if (col < 8) DT[(size_t)row * 8 + col] = softplus_f(mine + dt_bias[col]); else LF[(size_t)row * 8 + (col - 8)] = -softplus_f(-(mine + fbias[col - 8])); }
        }
    }    }
}

namespace pg8 {
#define PG8_LAS __attribute__((address_space(3)))
typedef short bf16x8 __attribute__((ext_vector_type(8)));
typedef float f32x4 __attribute__((ext_vector_type(4)));
typedef unsigned u32x4 __attribute__((ext_vector_type(4)));
constexpr int BM = 256, BK = 64, HALF = 128, HTB = HALF * BK * 2, STAGE_BYTES = 8 * HTB, NXCD = 8, WGM = 8;
__host__ __device__ __forceinline__ int lds_byte(int r, int c) { const int st = (r >> 4) * 2 + (c >> 5), rr = r & 15, cc = c & 31, ob = rr * 64 + cc * 2; return st * 1024 + (ob ^ (((ob >> 9) & 1) << 5)); }
__host__ __device__ __forceinline__ void stage_rc(int b, int& R, int& C) { const int st = b / 1024, sb = b % 1024, swz = sb ^ (((sb >> 9) & 1) << 5); R = (st >> 1) * 16 + swz / 64; C = (st & 1) * 32 + (swz % 64) / 2; }
__host__ __device__ __forceinline__ int perm32(int rho) { const int n = rho >> 4, i = rho & 15; return 8 * (i >> 2) + 4 * n + (i & 3); }
struct Unit { const char* A; const char* B; unsigned lda2, ldb2; int nt, pm, pn, aux; };
struct TileOrder {
    int nM, nN, nwg, G, c;
    __device__ void init(int nM_, int nN_, int G_, int c_) { nM = nM_; nN = nN_; nwg = nM * nN; G = G_; c = c_; }
    __device__ bool tile(int i, int& pm, int& pn) const {
        const long L = (long)i * G + c; if (L >= nwg) return false;
        int wgid = (int)L; { const int q = nwg / NXCD, r = nwg % NXCD, xcd = wgid % NXCD, off = wgid / NXCD; wgid = (xcd < r ? xcd * (q + 1) : r * (q + 1) + (xcd - r) * q) + off; }
        const int nig = WGM * nN, gid = wgid / nig, fm = gid * WGM, gsz = (nM - fm) < WGM ? (nM - fm) : WGM;
        pm = fm + ((wgid % nig) % gsz); pn = (wgid % nig) / gsz; return true;
    }
};
typedef float f32x2_t __attribute__((ext_vector_type(2))); typedef __bf16 bf16x2_t __attribute__((ext_vector_type(2)));
__device__ __forceinline__ unsigned cvt_pk_bf16(float lo, float hi) { f32x2_t v = {lo, hi}; bf16x2_t b = __builtin_convertvector(v, bf16x2_t); return __builtin_bit_cast(unsigned, b); }

template <class Epi, class Sched, bool ALIGN_EPI>
__device__ __forceinline__ void gemm_phase(PG8_LAS unsigned char* lds, const Sched& S, const Epi& E) {
    int tid = threadIdx.x; asm volatile("" : "+v"(tid));
    const int wid = __builtin_amdgcn_readfirstlane(tid >> 6), lane = tid & 63, wr = wid >> 2, wc = wid & 3, fr = lane & 15, fq = lane >> 4;
    unsigned RA[2], RB[2], C2[2];
#pragma unroll
    for (int i = 0; i < 2; ++i) { int R, C; stage_rc(tid * 16 + i * 8192, R, C); RA[i] = (unsigned)R; RB[i] = (unsigned)(Epi::PERM ? ((R & ~31) + perm32(R & 31)) : R); C2[i] = (unsigned)(C * 2); }
    const unsigned ldsw = (unsigned)wid * 1024u;
    const int aoff = lds_byte(wr * 64 + fr, fq * 8), boff = lds_byte(wc * 32 + fr, fq * 8);
#define PG8_SA(b, h) (((b) * 2 + (h)) * HTB)
#define PG8_SB(b, h) ((4 + (b) * 2 + (h)) * HTB)
#define PG8_STAGE(bufoff, gbase, RR, pitch) do { _Pragma("unroll") for (int _i = 0; _i < 2; ++_i) \
        __builtin_amdgcn_global_load_lds((const unsigned*)((const char*)(gbase) + (RR[_i] * (pitch) + C2[_i])), (PG8_LAS unsigned*)(lds + (bufoff) + ldsw + _i * 8192), 16, 0, 0); } while (0)
#define PG8_LDA(dst, b, h) do { _Pragma("unroll") for (int m = 0; m < 4; ++m) _Pragma("unroll") for (int k = 0; k < 2; ++k) dst[m][k] = *(const PG8_LAS bf16x8*)(lds + PG8_SA(b, h) + aoff + m * 2048 + k * 1024); } while (0)
#define PG8_LDB(dst, b, h) do { _Pragma("unroll") for (int n = 0; n < 2; ++n) _Pragma("unroll") for (int k = 0; k < 2; ++k) dst[n][k] = *(const PG8_LAS bf16x8*)(lds + PG8_SB(b, h) + boff + n * 2048 + k * 1024); } while (0)
#define PG8_MMA(ai, bj, At, Bt) do { __builtin_amdgcn_s_setprio(1); _Pragma("unroll") for (int m = 0; m < 4; ++m) _Pragma("unroll") for (int n = 0; n < 2; ++n) _Pragma("unroll") for (int k = 0; k < 2; ++k) \
        acc[ai][bj][m][n] = __builtin_amdgcn_mfma_f32_16x16x32_bf16(Bt[n][k], At[m][k], acc[ai][bj][m][n], 0, 0, 0); __builtin_amdgcn_s_setprio(0); } while (0)
#define PG8_WAIT_V(n) asm volatile("s_waitcnt vmcnt(" #n ")" ::: "memory")
#define PG8_WAIT_L(n) asm volatile("s_waitcnt lgkmcnt(" #n ")" ::: "memory")
#define PG8_BAR __builtin_amdgcn_s_barrier()
#define PG8_SCHED __builtin_amdgcn_sched_barrier(0)
#define PG8_ZERO() do { _Pragma("unroll") for (int a_ = 0; a_ < 2; ++a_) _Pragma("unroll") for (int b_ = 0; b_ < 2; ++b_) _Pragma("unroll") for (int m_ = 0; m_ < 4; ++m_) _Pragma("unroll") for (int n_ = 0; n_ < 2; ++n_) acc[a_][b_][m_][n_] = (f32x4){0.f, 0.f, 0.f, 0.f}; } while (0)
    Unit cur, nxt; int ui = 0;
    if (!S.next(0, cur)) return;
    f32x4 acc[2][2][4][2];
    PG8_ZERO();
    bf16x8 At[4][2], B0[2][2], B1[2][2];
    const char* cA = cur.A; const char* cB = cur.B; unsigned pAc = cur.lda2, pBc = cur.ldb2; int ntc = cur.nt;
    const unsigned kstep = BK * 2;
    {
        const size_t hA = (size_t)HALF * pAc, hB = (size_t)HALF * pBc;
        PG8_STAGE(PG8_SB(0, 0), cB, RB, pBc); PG8_STAGE(PG8_SB(0, 1), cB + hB, RB, pBc); PG8_STAGE(PG8_SA(0, 0), cA, RA, pAc); PG8_STAGE(PG8_SA(0, 1), cA + hA, RA, pAc);
        if (wr == 1) PG8_BAR;
        PG8_WAIT_V(2); PG8_BAR;
        PG8_STAGE(PG8_SB(1, 0), cB + kstep, RB, pBc); PG8_STAGE(PG8_SA(1, 0), cA + kstep, RA, pAc); PG8_STAGE(PG8_SB(1, 1), cB + hB + kstep, RB, pBc);
        PG8_WAIT_V(6); PG8_BAR;
    }
    for (;;) {
        const bool has_next = S.next(ui + 1, nxt);
        const char* nA = has_next ? nxt.A : cA; const char* nB = has_next ? nxt.B : cB;
        const unsigned pAn = has_next ? nxt.lda2 : pAc, pBn = has_next ? nxt.ldb2 : pBc;
        const size_t hAc = (size_t)HALF * pAc;
        for (int t = 0; t < ntc; t += 2) {
            const bool last = (t == ntc - 2);
            const char* a1 = cA + (size_t)(t + 1) * kstep;
            const char* a2 = last ? nA : cA + (size_t)(t + 2) * kstep; const char* b2 = last ? nB : cB + (size_t)(t + 2) * kstep;
            const char* a3 = a2 + kstep; const char* b3 = b2 + kstep;
            const unsigned pA2 = last ? pAn : pAc, pB2 = last ? pBn : pBc;
            const size_t hA2 = (size_t)HALF * pA2, hB2 = (size_t)HALF * pB2;
            PG8_LDB(B0, 0, 0); PG8_LDB(B1, 0, 1); PG8_SCHED; PG8_LDA(At, 0, 0); PG8_STAGE(PG8_SA(1, 1), a1 + hAc, RA, pAc);
            PG8_WAIT_V(8); PG8_WAIT_L(0); PG8_BAR; PG8_MMA(0, 0, At, B0); PG8_MMA(0, 1, At, B1); PG8_BAR; PG8_SCHED;
            PG8_LDA(At, 0, 1); PG8_STAGE(PG8_SB(0, 0), b2, RB, pB2); PG8_STAGE(PG8_SB(0, 1), b2 + hB2, RB, pB2); PG8_STAGE(PG8_SA(0, 0), a2, RA, pA2);
            PG8_WAIT_V(8); PG8_WAIT_L(0); PG8_BAR; PG8_MMA(1, 0, At, B0); PG8_MMA(1, 1, At, B1); PG8_BAR; PG8_SCHED;
            PG8_LDB(B0, 1, 0); PG8_LDB(B1, 1, 1); PG8_SCHED; PG8_LDA(At, 1, 0); PG8_STAGE(PG8_SA(0, 1), a2 + hA2, RA, pA2);
            PG8_WAIT_V(8); PG8_WAIT_L(0); PG8_BAR; PG8_MMA(0, 0, At, B0); PG8_MMA(0, 1, At, B1); PG8_BAR; PG8_SCHED;
            PG8_LDA(At, 1, 1); PG8_STAGE(PG8_SB(1, 0), b3, RB, pB2); PG8_STAGE(PG8_SB(1, 1), b3 + hB2, RB, pB2); PG8_STAGE(PG8_SA(1, 0), a3, RA, pA2);
            PG8_WAIT_V(8); PG8_WAIT_L(0); PG8_BAR; PG8_MMA(1, 0, At, B0); PG8_MMA(1, 1, At, B1); PG8_BAR; PG8_SCHED;
        }
        if constexpr (ALIGN_EPI) { if (wr == 0) PG8_BAR; }
        { int fr_ = fr, fq_ = fq; asm volatile("" : "+v"(fr_), "+v"(fq_)); E(acc, cur, wr, wc, fr_, fq_); }
        if (!has_next) break;
        PG8_ZERO();
        cur = nxt; cA = nA; cB = nB; pAc = pAn; pBc = pBn; ntc = nxt.nt; ++ui;
        if constexpr (ALIGN_EPI) { if (wr == 1) PG8_BAR; }
    }
    PG8_WAIT_V(0);
    if constexpr (!ALIGN_EPI) { if (wr == 0) PG8_BAR; }
    PG8_BAR;
#undef PG8_SA
#undef PG8_SB
#undef PG8_STAGE
#undef PG8_LDA
#undef PG8_LDB
#undef PG8_MMA
#undef PG8_WAIT_V
#undef PG8_WAIT_L
#undef PG8_BAR
#undef PG8_SCHED
#undef PG8_ZERO
}

struct PlainSched {
    TileOrder T; const char* A; const char* B; unsigned lda2, ldb2; int nt;
    __device__ bool next(int i, Unit& u) const { int pm, pn; if (!T.tile(i, pm, pn)) return false;
        u.A = A + (size_t)pm * 256 * lda2; u.B = B + (size_t)pn * 256 * ldb2; u.lda2 = lda2; u.ldb2 = ldb2; u.nt = nt; u.pm = pm; u.pn = pn; u.aux = 0; return true; }
};
struct OneSched { Unit u0; __device__ bool next(int i, Unit& u) const { if (i != 0) return false; u = u0; return true; } };
struct EpiStoreBf16 {
    static constexpr bool PERM = true;
    bf16_t* O; int ldc;
    __device__ __forceinline__ void operator()(const f32x4 (&acc)[2][2][4][2], const Unit& u, int wr, int wc, int fr, int fq) const {
        const int row0 = u.pm * BM + wr * 64 + fr, col0 = u.pn * BM + wc * 32 + 8 * fq;
#pragma unroll
        for (int ai = 0; ai < 2; ++ai)
#pragma unroll
            for (int m = 0; m < 4; ++m) { bf16_t* rowp = O + (size_t)(row0 + ai * HALF + m * 16) * ldc + col0;
#pragma unroll
                for (int bj = 0; bj < 2; ++bj) { const f32x4 v0 = acc[ai][bj][m][0], v1 = acc[ai][bj][m][1];
                    u32x4 w; w.x = cvt_pk_bf16(v0[0], v0[1]); w.y = cvt_pk_bf16(v0[2], v0[3]); w.z = cvt_pk_bf16(v1[0], v1[1]); w.w = cvt_pk_bf16(v1[2], v1[3]);
                    *(u32x4*)(rowp + bj * HALF) = w; } }
    }
};
__device__ __forceinline__ float fast_sigmoid(float x) { return __builtin_amdgcn_rcpf(1.f + __expf(-x)); }
struct EpiSwiglu {
    static constexpr bool PERM = true;
    bf16_t* H;
    __device__ __forceinline__ void operator()(const f32x4 (&acc)[2][2][4][2], const Unit& u, int wr, int wc, int fr, int fq) const {
        const int row0 = u.pm * BM + wr * 64 + fr, col0 = u.pn * HALF + wc * 32 + 8 * fq;
#pragma unroll
        for (int ai = 0; ai < 2; ++ai)
#pragma unroll
            for (int m = 0; m < 4; ++m) { float v[8];
#pragma unroll
                for (int n = 0; n < 2; ++n)
#pragma unroll
                    for (int e = 0; e < 4; ++e) { const float g = acc[ai][0][m][n][e], up = acc[ai][1][m][n][e]; v[n * 4 + e] = g * fast_sigmoid(g) * up; }
                u32x4 w; w.x = cvt_pk_bf16(v[0], v[1]); w.y = cvt_pk_bf16(v[2], v[3]); w.z = cvt_pk_bf16(v[4], v[5]); w.w = cvt_pk_bf16(v[6], v[7]);
                *(u32x4*)(H + (size_t)(row0 + ai * HALF + m * 16) * DFF + col0) = w; }
    }
};
struct EpiRes {
    static constexpr bool PERM = true;
    const bf16_t* res; void* out; bool out_f32;
    __device__ __forceinline__ void operator()(const f32x4 (&acc)[2][2][4][2], const Unit& u, int wr, int wc, int fr, int fq) const {
        const int row0 = u.pm * BM + wr * 64 + fr, col0 = u.pn * BM + wc * 32 + 8 * fq;
#pragma unroll
        for (int gb = 0; gb < 16; gb += 8) {
            u32x4 r[8];
#pragma unroll
            for (int k = 0; k < 8; ++k) { const int i = gb + k, ai = i >> 3, m = (i >> 1) & 3, bj = i & 1; r[k] = *(const u32x4*)(res + (size_t)(row0 + ai * HALF + m * 16) * D + col0 + bj * HALF); }
#pragma unroll
            for (int k = 0; k < 8; ++k) { const int i = gb + k, ai = i >> 3, m = (i >> 1) & 3, bj = i & 1; const size_t off = (size_t)(row0 + ai * HALF + m * 16) * D + col0 + bj * HALF;
                f32x4 p0 = acc[ai][bj][m][0], p1 = acc[ai][bj][m][1];
                p0[0] += bflo(r[k].x); p0[1] += bfhi(r[k].x); p0[2] += bflo(r[k].y); p0[3] += bfhi(r[k].y); p1[0] += bflo(r[k].z); p1[1] += bfhi(r[k].z); p1[2] += bflo(r[k].w); p1[3] += bfhi(r[k].w);
                if (out_f32) { *(f32x4*)((float*)out + off) = p0; *(f32x4*)((float*)out + off + 4) = p1; }
                else { u32x4 w; w.x = cvt_pk_bf16(p0[0], p0[1]); w.y = cvt_pk_bf16(p0[2], p0[3]); w.z = cvt_pk_bf16(p1[0], p1[1]); w.w = cvt_pk_bf16(p1[2], p1[3]); *(u32x4*)((bf16_t*)out + off) = w; } }
            asm volatile("" ::: "memory");
        }
    }
};
struct EpiGate {
    static constexpr bool PERM = true;
    bf16_t* PROJ; bf16_t* XC;
    __device__ __forceinline__ void operator()(const f32x4 (&acc)[2][2][4][2], const Unit& u, int wr, int wc, int fr, int fq) const {
        const int br = u.pn >> 2, row0 = u.pm * BM + wr * 64 + fr, col0 = (u.pn & 3) * BM + wc * 32 + 8 * fq;
        bf16_t* base = br < 3 ? PROJ + 512 + 1536 * br : XC;
        const int ld = br < 3 ? NPROJ : 1024;
#pragma unroll
        for (int ai = 0; ai < 2; ++ai)
#pragma unroll
            for (int m = 0; m < 4; ++m) { bf16_t* rowp = base + (size_t)(row0 + ai * HALF + m * 16) * ld + col0;
#pragma unroll
                for (int bj = 0; bj < 2; ++bj) { const f32x4 v0 = acc[ai][bj][m][0], v1 = acc[ai][bj][m][1];
                    u32x4 w; w.x = cvt_pk_bf16(fast_sigmoid(v0[0]), fast_sigmoid(v0[1])); w.y = cvt_pk_bf16(fast_sigmoid(v0[2]), fast_sigmoid(v0[3]));
                    w.z = cvt_pk_bf16(fast_sigmoid(v1[0]), fast_sigmoid(v1[1])); w.w = cvt_pk_bf16(fast_sigmoid(v1[2]), fast_sigmoid(v1[3]));
                    *(u32x4*)(rowp + bj * HALF) = w; } }
    }
};
struct BranchSched {
    TileOrder T; const char* PROJ; const char* WBR;
    __device__ bool next(int i, Unit& u) const { int pm, pn; if (!T.tile(i >> 2, pm, pn)) return false;
        const int br = i & 3; u.pm = pm; u.pn = pn; u.aux = br;
        u.A = PROJ + (size_t)pm * 256 * (NPROJ * 2) + 1536 * 2 * br; u.lda2 = NPROJ * 2; u.B = WBR + ((size_t)br * 1024 + pn * 256) * (512 * 2); u.ldb2 = 512 * 2; u.nt = 512 / 64; return true; }
};
struct EpiBranch {
    static constexpr bool PERM = true;
    const bf16_t* PROJ; const bf16_t* XC; bf16_t* MIX;
    __device__ __forceinline__ void operator()(const f32x4 (&acc)[2][2][4][2], const Unit& u, int wr, int wc, int fr, int fq) const {
        const int br = u.aux, row0 = u.pm * BM + wr * 64 + fr, col0 = u.pn * BM + wc * 32 + 8 * fq;
        const bf16_t* G = br < 3 ? PROJ + 512 + 1536 * br : XC; const int ldg = br < 3 ? NPROJ : 1024;
        if (br == 0) run<true>(acc, G, ldg, row0, col0); else run<false>(acc, G, ldg, row0, col0);
    }
    template <bool FIRST>
    __device__ __forceinline__ void run(const f32x4 (&acc)[2][2][4][2], const bf16_t* G, int ldg, int row0, int col0) const {
#pragma unroll
        for (int gb = 0; gb < 16; gb += 4) {
            u32x4 g[4], o[4];
#pragma unroll
            for (int k = 0; k < 4; ++k) { const int i = gb + k, ai = i >> 3, m = (i >> 1) & 3, bj = i & 1; const size_t row = (size_t)(row0 + ai * HALF + m * 16);
                g[k] = *(const u32x4*)(G + row * ldg + col0 + bj * HALF); if (!FIRST) o[k] = *(const u32x4*)(MIX + row * D + col0 + bj * HALF); }
#pragma unroll
            for (int k = 0; k < 4; ++k) { const int i = gb + k, ai = i >> 3, m = (i >> 1) & 3, bj = i & 1; const size_t row = (size_t)(row0 + ai * HALF + m * 16);
                f32x4 p0 = acc[ai][bj][m][0], p1 = acc[ai][bj][m][1];
                p0[0] *= bflo(g[k].x); p0[1] *= bfhi(g[k].x); p0[2] *= bflo(g[k].y); p0[3] *= bfhi(g[k].y); p1[0] *= bflo(g[k].z); p1[1] *= bfhi(g[k].z); p1[2] *= bflo(g[k].w); p1[3] *= bfhi(g[k].w);
                if (!FIRST) { p0[0] += bflo(o[k].x); p0[1] += bfhi(o[k].x); p0[2] += bflo(o[k].y); p0[3] += bfhi(o[k].y); p1[0] += bflo(o[k].z); p1[1] += bfhi(o[k].z); p1[2] += bflo(o[k].w); p1[3] += bfhi(o[k].w); }
                u32x4 w; w.x = cvt_pk_bf16(p0[0], p0[1]); w.y = cvt_pk_bf16(p0[2], p0[3]); w.z = cvt_pk_bf16(p1[0], p1[1]); w.w = cvt_pk_bf16(p1[2], p1[3]);
                *(u32x4*)(MIX + row * D + col0 + bj * HALF) = w; }
            asm volatile("" ::: "memory");
        }
    }
};
struct GBSched {
    TileOrder T; const char* XN; const char* WG; const char* PROJ; const char* WBR;
    __device__ bool next(int i, Unit& u) const { int pm, pn; if (!T.tile(i >> 3, pm, pn)) return false;
        const int sub = i & 7, br = sub >> 1; u.pm = pm; u.pn = pn; u.aux = sub;
        if ((sub & 1) == 0) { u.A = XN + (size_t)pm * 256 * (D * 2); u.lda2 = D * 2; u.B = WG + ((size_t)br * 1024 + pn * 256) * (D * 2); u.ldb2 = D * 2; u.nt = D / 64; }
        else { u.A = PROJ + (size_t)pm * 256 * (NPROJ * 2) + 1536 * 2 * br; u.lda2 = NPROJ * 2; u.B = WBR + ((size_t)br * 1024 + pn * 256) * (512 * 2); u.ldb2 = 512 * 2; u.nt = 512 / 64; }
        return true; }
};
struct EpiGB {
    static constexpr bool PERM = true;
    bf16_t* PROJ; bf16_t* XC; bf16_t* MIX;
    __device__ __forceinline__ void operator()(const f32x4 (&acc)[2][2][4][2], const Unit& u, int wr, int wc, int fr, int fq) const {
        const int br = u.aux >> 1, row0 = u.pm * BM + wr * 64 + fr, col0 = u.pn * BM + wc * 32 + 8 * fq;
        bf16_t* G = br < 3 ? PROJ + 512 + 1536 * br : XC; const int ldg = br < 3 ? NPROJ : 1024;
        if ((u.aux & 1) == 0) {
#pragma unroll
            for (int ai = 0; ai < 2; ++ai)
#pragma unroll
                for (int m = 0; m < 4; ++m) { bf16_t* rowp = G + (size_t)(row0 + ai * HALF + m * 16) * ldg + col0;
#pragma unroll
                    for (int bj = 0; bj < 2; ++bj) { const f32x4 v0 = acc[ai][bj][m][0], v1 = acc[ai][bj][m][1];
                        u32x4 w; w.x = cvt_pk_bf16(fast_sigmoid(v0[0]), fast_sigmoid(v0[1])); w.y = cvt_pk_bf16(fast_sigmoid(v0[2]), fast_sigmoid(v0[3]));
                        w.z = cvt_pk_bf16(fast_sigmoid(v1[0]), fast_sigmoid(v1[1])); w.w = cvt_pk_bf16(fast_sigmoid(v1[2]), fast_sigmoid(v1[3]));
                        *(u32x4*)(rowp + bj * HALF) = w; } }
        } else { EpiBranch B{PROJ, XC, MIX}; if (br == 0) B.run<true>(acc, G, ldg, row0, col0); else B.run<false>(acc, G, ldg, row0, col0); }
    }
};
}

#define LAS __attribute__((address_space(3)))
__device__ __forceinline__ void wt_item(const float* W, int ldw, int src_col0, int k0, bf16_t* WT, int ldwt, int dst_row0, LAS float* scr, int lane) {
#pragma unroll
    for (int i = 0; i < 8; ++i) { const int k = 4 * i + (lane >> 4), n4 = (lane & 15) * 4;
        const float4 v = *(const float4*)(W + (size_t)(k0 + k) * ldw + src_col0 + n4);
        LAS float* d = scr + k * 65 + n4; d[0] = v.x; d[1] = v.y; d[2] = v.z; d[3] = v.w; }
    asm volatile("s_waitcnt lgkmcnt(0)" ::: "memory");
    unsigned w[16];
#pragma unroll
    for (int j = 0; j < 16; ++j) w[j] = pk2(scr[(2 * j) * 65 + lane], scr[(2 * j + 1) * 65 + lane]);
    uint4* o = (uint4*)(WT + (size_t)(dst_row0 + lane) * ldwt + k0);
#pragma unroll
    for (int j = 0; j < 4; ++j) o[j] = make_uint4(w[4 * j], w[4 * j + 1], w[4 * j + 2], w[4 * j + 3]);
    asm volatile("s_waitcnt lgkmcnt(0)" ::: "memory");
}
constexpr int WCV_IN = 32 * (NPROJ / 64), WCV_ALL = WCV_IN + 32 * 64 + 4 * 16 * 16 + 32 * 16 + 32 * (2 * DFF / 64) + (DFF / 32) * 16, WCV_CHUNK = 16;
__device__ __forceinline__ void ph_wconv(unsigned char* ws, const float* w_in, const float* w_branch, const float* w_out, const float* w_gate, const float* w_up, const float* w_down, LAS float* scr_base,
                                         int lo, int hi, int first, int stride) {
    const int tx_ = ltid();
    const int lane = tx_ & 63, wave = tx_ >> 6;
    LAS float* scr = scr_base + wave * (32 * 65);
    constexpr int I_IN = 32 * (NPROJ / 64), I_G = 32 * 64, I_BR = 4 * 16 * 16, I_OUT = 32 * 16, I_GU = 32 * (2 * DFF / 64), I_DN = (DFF / 32) * 16;
    static_assert(I_IN + I_G + I_BR + I_OUT + I_GU + I_DN == WCV_ALL && (WCV_ALL - WCV_IN) % WCV_CHUNK == 0, "conversion list");
    for (int it = lo + first * 8 + wave; it < hi; it += stride * 8) {
        int r = it;
        if (r < I_IN) { const int nb = r % (NPROJ / 64), kb = r / (NPROJ / 64), c0 = nb * 64;
            wt_item(w_in, DIN, c0 + (c0 >= 1536 ? 8 : 0) + (c0 >= 4608 ? 8 : 0), kb * 32, (bf16_t*)(ws + WS_WIN), D, c0, scr, lane); continue; } r -= I_IN;
        if (r < I_G) { const int nb = r % 64, kb = r / 64; wt_item(w_in, DIN, WC_GATE + nb * 64, kb * 32, (bf16_t*)(ws + WS_WG), D, nb * 64, scr, lane); continue; } r -= I_G;
        if (r < I_BR) { const int br = r / 256, q = r % 256, nb = q % 16, kb = q / 16;
            wt_item(w_branch + (size_t)br * 512 * 1024, D, nb * 64, kb * 32, (bf16_t*)(ws + WS_WBR) + (size_t)br * 1024 * 512, 512, nb * 64, scr, lane); continue; } r -= I_BR;
        if (r < I_OUT) { const int nb = r % 16, kb = r / 16; wt_item(w_out, D, nb * 64, kb * 32, (bf16_t*)(ws + WS_WOUT), D, nb * 64, scr, lane); continue; } r -= I_OUT;
        if (r < I_GU) { const int nb = r % (2 * DFF / 64), kb = r / (2 * DFF / 64), r0 = nb * 64, t = r0 >> 8, j = r0 & 255;
            wt_item(j < 128 ? w_gate : w_up, DFF, t * 128 + (j & 127), kb * 32, (bf16_t*)(ws + WS_WGU), D, r0, scr, lane); continue; } r -= I_GU;
        { const int nb = r % 16, kb = r / 16; wt_item(w_down, D, nb * 64, kb * 32, (bf16_t*)(ws + WS_WDN), DFF, nb * 64, scr, lane); }
    }
}

__device__ __forceinline__ float silu_fast(float x) { return x * __builtin_amdgcn_rcpf(1.f + __expf(-x)); }
__device__ __forceinline__ void ph_pre(unsigned char* lds, const bf16_t* PROJ, const float* conv_w, const float* conv_b, bf16_t* XC, float* KMEAN, float* KMAXP) {
    const int tx_ = ltid();
    const int lane = tx_ & 63, gw = blockIdx.x * 8 + (tx_ >> 6), NGW = gridDim.x * 8;
    int* smax = (int*)lds;
    if (tx_ < 16) smax[tx_] = 0;
    for (int it = gw; it < (M / 16) * 2; it += NGW) {
        const int r0 = (it >> 1) * 16, c8 = (it & 1) * 512 + lane * 8;
        const bool head = (r0 & (SEQ - 1)) == 0;
        uint4 xr[19];
        const bf16_t* src = PROJ + (size_t)r0 * NPROJ + PC_XBC + c8;
#pragma unroll
        for (int j = 0; j < 3; ++j) xr[j] = head ? make_uint4(0u, 0u, 0u, 0u) : *(const uint4*)(src + (ptrdiff_t)(j - 3) * NPROJ);
#pragma unroll
        for (int j = 3; j < 19; ++j) xr[j] = *(const uint4*)(src + (size_t)(j - 3) * NPROJ);
        float w[4][8], b[8];
#pragma unroll
        for (int i = 0; i < 4; ++i) { const float4 w0 = *(const float4*)(conv_w + i * 1024 + c8), w1 = *(const float4*)(conv_w + i * 1024 + c8 + 4);
            w[i][0] = w0.x; w[i][1] = w0.y; w[i][2] = w0.z; w[i][3] = w0.w; w[i][4] = w1.x; w[i][5] = w1.y; w[i][6] = w1.z; w[i][7] = w1.w; }
        { const float4 b0 = *(const float4*)(conv_b + c8), b1 = *(const float4*)(conv_b + c8 + 4); b[0] = b0.x; b[1] = b0.y; b[2] = b0.z; b[3] = b0.w; b[4] = b1.x; b[5] = b1.y; b[6] = b1.z; b[7] = b1.w; }
        bf16_t* dst = XC + (size_t)r0 * 1024 + c8;
#pragma unroll
        for (int j = 0; j < 16; ++j) {
            float acc[8];
#pragma unroll
            for (int c = 0; c < 8; ++c) acc[c] = b[c];
#pragma unroll
            for (int i = 0; i < 4; ++i) { const uint4 u = xr[j + i];
                acc[0] += w[i][0] * bflo(u.x); acc[1] += w[i][1] * bfhi(u.x); acc[2] += w[i][2] * bflo(u.y); acc[3] += w[i][3] * bfhi(u.y);
                acc[4] += w[i][4] * bflo(u.z); acc[5] += w[i][5] * bfhi(u.z); acc[6] += w[i][6] * bflo(u.w); acc[7] += w[i][7] * bfhi(u.w); }
            uint4 o; o.x = pk2(silu_fast(acc[0]), silu_fast(acc[1])); o.y = pk2(silu_fast(acc[2]), silu_fast(acc[3])); o.z = pk2(silu_fast(acc[4]), silu_fast(acc[5])); o.w = pk2(silu_fast(acc[6]), silu_fast(acc[7]));
            *(uint4*)(dst + (size_t)j * 1024) = o;
        }
    }
    for (int it = gw; it < 64 * 16; it += NGW) {
        const int bb = it >> 4, cg = it & 15, rr = lane >> 2, c8 = cg * 32 + (lane & 3) * 8;
        uint4 u[16];
#pragma unroll
        for (int st = 0; st < 16; ++st) u[st] = *(const uint4*)(PROJ + ((size_t)bb * 256 + st * 16 + rr) * NPROJ + PC_MK + c8);
        float sm[8];
#pragma unroll
        for (int j = 0; j < 8; ++j) sm[j] = 0.f;
#pragma unroll
        for (int st = 0; st < 16; ++st) { sm[0] += bflo(u[st].x); sm[1] += bfhi(u[st].x); sm[2] += bflo(u[st].y); sm[3] += bfhi(u[st].y); sm[4] += bflo(u[st].z); sm[5] += bfhi(u[st].z); sm[6] += bflo(u[st].w); sm[7] += bfhi(u[st].w); }
#pragma unroll
        for (int j = 0; j < 8; ++j) { sm[j] += __shfl_xor(sm[j], 4); sm[j] += __shfl_xor(sm[j], 8); sm[j] += __shfl_xor(sm[j], 16); sm[j] += __shfl_xor(sm[j], 32); }
        if (lane < 4) { float* kp = KMEAN + (size_t)bb * 512 + c8;
            *(float4*)kp = make_float4(sm[0] * (1.0f / 256.0f), sm[1] * (1.0f / 256.0f), sm[2] * (1.0f / 256.0f), sm[3] * (1.0f / 256.0f));
            *(float4*)(kp + 4) = make_float4(sm[4] * (1.0f / 256.0f), sm[5] * (1.0f / 256.0f), sm[6] * (1.0f / 256.0f), sm[7] * (1.0f / 256.0f)); }
    }
    {
        const size_t gt = (size_t)blockIdx.x * NT + tx_, tot = (size_t)gridDim.x * NT;
        __syncthreads();
        for (size_t e = gt; e < (size_t)M * 8; e += tot) { const int row = (int)(e >> 3), h = (int)(e & 7);
            const bf16_t* kp = PROJ + (size_t)row * NPROJ + PC_FK + h * 64; float n2 = 0.f;
#pragma unroll
            for (int c = 0; c < 8; ++c) { const uint4 u = *(const uint4*)(kp + c * 8);
                n2 += bflo(u.x) * bflo(u.x) + bfhi(u.x) * bfhi(u.x) + bflo(u.y) * bflo(u.y) + bfhi(u.y) * bfhi(u.y) + bflo(u.z) * bflo(u.z) + bfhi(u.z) * bfhi(u.z) + bflo(u.w) * bflo(u.w) + bfhi(u.w) * bfhi(u.w); }
            atomicMax(&smax[(row >> 13) * 8 + h], __float_as_int(n2)); }
        __syncthreads();
        if (tx_ < 16) KMAXP[blockIdx.x * 16 + tx_] = sqrtf(__int_as_float(smax[tx_]));
    }
}

__device__ __forceinline__ void ph_mamba_norm(bf16_t* PROJ, const bf16_t* XC, const float* nw) {
    const int tx_ = ltid();
    const int lane = tx_ & 63, gw = blockIdx.x * 8 + (tx_ >> 6), NGW = gridDim.x * 8;
    const float4 w0 = *(const float4*)(nw + lane * 8), w1 = *(const float4*)(nw + lane * 8 + 4);
    for (int row0 = gw; row0 < M; row0 += 8 * NGW) {
        uint4 yb[8], zb[8];
#pragma unroll
        for (int k = 0; k < 8; ++k) { const int rk = row0 + k * NGW; if (rk < M) { yb[k] = *(const uint4*)(XC + (size_t)rk * 1024 + lane * 8); zb[k] = *(const uint4*)(PROJ + (size_t)rk * NPROJ + PC_Z + lane * 8); } }
#pragma unroll
        for (int k = 0; k < 8; ++k) {
            const int row = row0 + k * NGW; if (row >= M) break;
            const uint4 yv = yb[k], zv = zb[k];
            float y[8] = {bflo(yv.x), bfhi(yv.x), bflo(yv.y), bfhi(yv.y), bflo(yv.z), bfhi(yv.z), bflo(yv.w), bfhi(yv.w)};
            const float z[8] = {bflo(zv.x), bfhi(zv.x), bflo(zv.y), bfhi(zv.y), bflo(zv.z), bfhi(zv.z), bflo(zv.w), bfhi(zv.w)};
            float ss = 0.f;
#pragma unroll
            for (int i = 0; i < 8; ++i) { y[i] *= silu_fast(z[i]); ss += y[i] * y[i]; }
            ss = wave_sum(ss); const float rstd = 1.0f / sqrtf(ss * (1.0f / 512.0f) + 1e-6f);
            uint4 o; o.x = pk2(y[0] * rstd * w0.x, y[1] * rstd * w0.y); o.y = pk2(y[2] * rstd * w0.z, y[3] * rstd * w0.w); o.z = pk2(y[4] * rstd * w1.x, y[5] * rstd * w1.y); o.w = pk2(y[6] * rstd * w1.z, y[7] * rstd * w1.w);
            *(uint4*)(PROJ + (size_t)row * NPROJ + PC_Z + lane * 8) = o;
        }
    }
}
__device__ __forceinline__ void ph_final(float* out, const float* nw) {
    const int tx_ = ltid();
    const int lane = tx_ & 63, gw = blockIdx.x * 8 + (tx_ >> 6), NGW = gridDim.x * 8;
    float4 nwv[4];
#pragma unroll
    for (int j = 0; j < 4; ++j) nwv[j] = ((const float4*)nw)[lane + 64 * j];
    for (int row0 = gw; row0 < M; row0 += 4 * NGW) {
        float4 vb[4][4];
#pragma unroll
        for (int k = 0; k < 4; ++k) { const int rk = row0 + k * NGW; if (rk < M) { const float4* xr = (const float4*)(out + (size_t)rk * D);
#pragma unroll
            for (int j = 0; j < 4; ++j) vb[k][j] = xr[lane + 64 * j]; } }
#pragma unroll
        for (int k = 0; k < 4; ++k) {
            const int row = row0 + k * NGW; if (row >= M) break;
            float4* xr = (float4*)(out + (size_t)row * D);
            float ss = 0.f;
#pragma unroll
            for (int j = 0; j < 4; ++j) { const float4 v = vb[k][j]; ss += v.x * v.x + v.y * v.y + v.z * v.z + v.w * v.w; }
            ss = wave_sum(ss); const float rstd = 1.0f / sqrtf(ss * (1.0f / D) + 1e-6f);
#pragma unroll
            for (int j = 0; j < 4; ++j) { const float4 v = vb[k][j], w4 = nwv[j]; xr[lane + 64 * j] = make_float4(v.x * rstd * w4.x, v.y * rstd * w4.y, v.z * rstd * w4.z, v.w * rstd * w4.w); }
        }
    }
}

namespace att {
typedef short bf16x8 __attribute__((ext_vector_type(8)));
typedef short s16x4 __attribute__((ext_vector_type(4)));
typedef float f32x16 __attribute__((ext_vector_type(16)));
typedef float f32x2_t __attribute__((ext_vector_type(2))); typedef __bf16 bf16x2_t __attribute__((ext_vector_type(2)));
__device__ __forceinline__ unsigned cvtpk(float lo, float hi) { f32x2_t v = {lo, hi}; bf16x2_t b = __builtin_convertvector(v, bf16x2_t); return __builtin_bit_cast(unsigned, b); }
constexpr float LOG2E = 1.4426950408889634f, C2 = 0.125f * LOG2E;
constexpr int ST_BYTES = 16384, OFF_BIAS = 65536, OFF_EB = OFF_BIAS + 1024, OFF_KMAX = OFF_EB + 32, OFF_TAB = OFF_BIAS + 2048, TAB_N = 1280, OFF_END = OFF_TAB + TAB_N * 4;
constexpr float FOX_THR = 25.f;
enum { MODE_FOX = 0, MODE_SWA = 1, MODE_MOBA = 2, MODE_MOWN = 3 };
#define LASC __attribute__((address_space(3)))
typedef short v4i16_t __attribute__((ext_vector_type(4)));

template <int MODE>
__device__ __forceinline__ void attn_unit(unsigned char* lds, bf16_t* PROJ, const float* AUX, const float* btab, int bcol, float sink, int b, int hq, int hk, int qb, int qcol, int kcol, int vcol, bool dry = false, const void* ex0 = nullptr, const void* ex1 = nullptr) {
    const int tid = ltid(), lane = tid & 63, wave = __builtin_amdgcn_readfirstlane(tid >> 6), r32 = lane & 31, hi = lane >> 5;
    const int q0 = qb * 256, qw = q0 + wave * 32, q = qw + r32;
    const size_t rowbase = (size_t)b * SEQ;
    float* tab = (float*)(lds + OFF_TAB);
    float tv0 = 0.f, tv1 = 0.f;
    if constexpr (MODE == MODE_SWA) { const int d = tid - 128; if (d >= 0 && d < 128) tv0 = btab[rel_bucket(d) * 16 + bcol]; }
    if constexpr (MODE == MODE_MOBA || MODE == MODE_MOWN) { tv0 = btab[rel_bucket(tid) * 16 + bcol]; tv1 = btab[rel_bucket(tid + 512) * 16 + bcol]; }
    const bf16_t* qp = PROJ + (rowbase + q) * NPROJ + qcol + hq * 64 + 8 * hi;
    const uint4 qu0 = *(const uint4*)(qp), qu1 = *(const uint4*)(qp + 16), qu2 = *(const uint4*)(qp + 32), qu3 = *(const uint4*)(qp + 48);
    float km0 = 0.f, km1 = 0.f, km2 = 0.f, km3 = 0.f;
    if constexpr (MODE == MODE_FOX) { if (tid < 64) { const float* kmp = btab + (tid * 4) * 16 + b * 8 + hq; km0 = kmp[0]; km1 = kmp[16]; km2 = kmp[32]; km3 = kmp[48]; } }
    unsigned msel = 0u; float4 mpl = make_float4(0.f, 0.f, 0.f, 0.f);
    if constexpr (MODE == MODE_MOWN) { msel = ((const unsigned*)AUX)[(size_t)(b * 8 + hq) * SEQ + q]; mpl = *(const float4*)((const float*)ex1 + ((rowbase + q) * 8 + hq) * 4); }
    const int t_beg = (MODE == MODE_SWA) ? (qb > 0 ? 4 * qb - 2 : 0) : (MODE == MODE_MOWN ? 4 * qb : 0), t_end = 4 * (qb + 1);
    const int skey = tid >> 3, sch = tid & 7;
    const bf16_t* kg = PROJ + (rowbase + skey) * NPROJ + kcol + hk * 64 + sch * 8;
    const bf16_t* vg = PROJ + (rowbase + skey) * NPROJ + vcol + hk * 64 + sch * 8;
    const int kdst = skey * 128 + ((sch ^ ((skey >> 1) & 7)) * 16);
    uint4 kreg0, kreg1, vreg0, vreg1; float breg0 = 0.f, breg1 = 0.f;
#define ATT_LOAD1(t_, KR, VR, BR) do { KR = *(const uint4*)(kg + (size_t)(t_) * 64 * NPROJ); VR = *(const uint4*)(vg + (size_t)(t_) * 64 * NPROJ); \
        if (MODE == MODE_FOX) { if (tid < 64) BR = AUX[(rowbase + (t_) * 64 + tid) * 8 + hq]; } } while (0)
#define ATT_LOAD(s_) do { ATT_LOAD1(ATT_TI(2 * (s_)), kreg0, vreg0, breg0); ATT_LOAD1(ATT_TI(2 * (s_) + 1), kreg1, vreg1, breg1); } while (0)
#define ATT_STORE1(ts_, KR, VR, BR) do { unsigned char* sb_ = lds + (ts_) * ST_BYTES; \
        *(uint4*)(sb_ + kdst) = KR; *(uint4*)(sb_ + 8192 + skey * 128 + ((sch ^ (((skey >> 1) & 1) << 2)) * 16)) = VR; \
        if (MODE == MODE_FOX) { if (tid < 64) { float inc_ = BR; \
            _Pragma("unroll") for (int o_ = 1; o_ < 64; o_ <<= 1) { const float v_ = __shfl_up(inc_, o_); if (lane >= o_) inc_ += v_; } \
            const float tot_ = __shfl(inc_, 63); \
            ((float*)(lds + OFF_BIAS))[(ts_) * 64 + tid] = (carry + tot_ - inc_) * LOG2E;        \
            carry += tot_; if (tid == 0) ((float*)(lds + OFF_EB))[(ts_)] = carry * LOG2E; } } } while (0)
#define ATT_STORE(st) do { ATT_STORE1((st) * 2, kreg0, vreg0, breg0); ATT_STORE1((st) * 2 + 1, kreg1, vreg1, breg1); } while (0)
    const int ntile = t_end - t_beg;
#define ATT_TI(i) ((MODE == MODE_FOX) ? (t_end - 1 - (i)) : (t_beg + (i)))
    const int nstep = ntile >> 1;
    ATT_LOAD(0);
    if constexpr (MODE == MODE_SWA) tab[tid] = tv0 * LOG2E;
    if constexpr (MODE == MODE_MOBA || MODE == MODE_MOWN) { tab[tid] = tv0 * LOG2E; tab[tid + 512] = tv1 * LOG2E; }
    bf16x8 qr[4]; float gq[32]; float qn2 = 0.f;
    {
#pragma unroll
      for (int d0 = 0; d0 < 4; ++d0) { const uint4 u = d0 == 0 ? qu0 : d0 == 1 ? qu1 : d0 == 2 ? qu2 : qu3;
          const float f[8] = {bflo(u.x), bfhi(u.x), bflo(u.y), bfhi(u.y), bflo(u.z), bfhi(u.z), bflo(u.w), bfhi(u.w)};
          if constexpr (MODE == MODE_MOBA) {
#pragma unroll
              for (int e = 0; e < 8; ++e) gq[d0 * 8 + e] = f[e]; }
          if constexpr (MODE == MODE_FOX) {
#pragma unroll
              for (int e = 0; e < 8; ++e) qn2 += f[e] * f[e]; }
          uint4 w; w.x = cvtpk(f[0] * C2, f[1] * C2); w.y = cvtpk(f[2] * C2, f[3] * C2); w.z = cvtpk(f[4] * C2, f[5] * C2); w.w = cvtpk(f[6] * C2, f[7] * C2);
          qr[d0] = __builtin_bit_cast(bf16x8, w); } }
    unsigned selmask = 0u;
    if constexpr (MODE == MODE_MOBA) {
        float g0 = -INFINITY, g1 = -INFINITY, g2 = -INFINITY; int i0 = -1, i1 = -1, i2 = -1;
        for (int n = 0; n < qb; ++n) {
            const float* km = AUX + ((size_t)(b * 32 + n)) * 512 + hk * 64 + 8 * hi; float g = 0.f;
#pragma unroll
            for (int d0 = 0; d0 < 4; ++d0) { const float4 k0 = *(const float4*)(km + 16 * d0), k1 = *(const float4*)(km + 16 * d0 + 4);
                g += gq[d0 * 8] * k0.x + gq[d0 * 8 + 1] * k0.y + gq[d0 * 8 + 2] * k0.z + gq[d0 * 8 + 3] * k0.w + gq[d0 * 8 + 4] * k1.x + gq[d0 * 8 + 5] * k1.y + gq[d0 * 8 + 6] * k1.z + gq[d0 * 8 + 7] * k1.w; }
            g += __shfl_xor(g, 32);
            if (g > g0) { g2 = g1; i2 = i1; g1 = g0; i1 = i0; g0 = g; i0 = n; }
            else if (g > g1) { g2 = g1; i2 = i1; g1 = g; i1 = n; }
            else if (g > g2) { g2 = g; i2 = n; }
        }
        if (i0 >= 0) selmask |= 1u << i0; if (i1 >= 0) selmask |= 1u << i1; if (i2 >= 0) selmask |= 1u << i2;
    }
    float carry = 0.f;
    f32x16 o0, o1;
#pragma unroll
    for (int r = 0; r < 16; ++r) { o0[r] = 0.f; o1[r] = 0.f; }
    float m = -1e30f, l = 0.f;
    if constexpr (MODE == MODE_SWA) { m = sink * LOG2E; l = hi == 0 ? 1.f : 0.f; }
    float qkb = 0.f;
    if constexpr (MODE == MODE_FOX) {
        if (tid < 64) { float km = fmaxf(fmaxf(km0, km1), fmaxf(km2, km3));
#pragma unroll
            for (int o = 1; o < 64; o <<= 1) km = fmaxf(km, __shfl_xor(km, o));
            if (tid == 0) *(float*)(lds + OFF_KMAX) = km; }
    }
    ATT_STORE(0);
    if (1 < nstep) ATT_LOAD(1);
    __syncthreads();
    if constexpr (MODE == MODE_FOX) { qn2 += __shfl_xor(qn2, 32); qkb = sqrtf(qn2) * C2 * 1.01f * *(const float*)(lds + OFF_KMAX); }
    const int vtr_off = ((lane & 15) >> 2) * 128 + (16 * ((lane >> 4) & 1) + 4 * (lane & 3)) * 2 + 4 * hi * 128;
    bool started = false;
    for (int i = 0; i < nstep; ++i) {
        const int st = i & 1;
        if (i + 1 < nstep) ATT_STORE(st ^ 1);
        if (i + 2 < nstep) ATT_LOAD(i + 2);
#pragma unroll 1
        for (int sub = 0; sub < 2; ++sub) {
        const int t = ATT_TI(2 * i + sub), ts = st * 2 + sub;
        bool act = (64 * t <= qw + 31);
        if constexpr (MODE == MODE_SWA) act = act && (64 * t + 63 >= qw - 127);
        if constexpr (MODE == MODE_MOBA) { if (t < 4 * qb) act = __builtin_amdgcn_ballot_w64(((selmask >> (t >> 2)) & 1u) != 0u) != 0ull; }
        if (act) {
            const unsigned char* Ks = lds + ts * ST_BYTES; const unsigned char* Vt = Ks + 8192;
            f32x16 p0, p1;
            if constexpr (MODE == MODE_FOX) { const float* bt = (const float*)(lds + OFF_BIAS) + ts * 64;
#pragma unroll
                for (int g = 0; g < 4; ++g) { const float4 b0 = *(const float4*)(bt + 8 * g + 4 * hi), b1 = *(const float4*)(bt + 32 + 8 * g + 4 * hi);
                    p0[4 * g] = b0.x; p0[4 * g + 1] = b0.y; p0[4 * g + 2] = b0.z; p0[4 * g + 3] = b0.w; p1[4 * g] = b1.x; p1[4 * g + 1] = b1.y; p1[4 * g + 2] = b1.z; p1[4 * g + 3] = b1.w; }
            } else if constexpr (MODE == MODE_SWA) { const float* tp = tab + 128 + (q - 64 * t - 4 * hi);
#pragma unroll
                for (int r = 0; r < 16; ++r) { const int kofs = (r & 3) + 8 * (r >> 2); p0[r] = tp[-kofs]; p1[r] = tp[-kofs - 32]; }
            } else { const int dq = q - 64 * t - 4 * hi;
                if (64 * t + 63 + 790 <= qw) { const float c31 = tab[1023];
#pragma unroll
                    for (int r = 0; r < 16; ++r) { p0[r] = c31; p1[r] = c31; } }
                else {
#pragma unroll
                    for (int r = 0; r < 16; ++r) { const int kofs = (r & 3) + 8 * (r >> 2); const int d0_ = dq - kofs, d1_ = dq - kofs - 32;
                        p0[r] = tab[d0_ < 0 ? 0 : (d0_ > 1023 ? 1023 : d0_)]; p1[r] = tab[d1_ < 0 ? 0 : (d1_ > 1023 ? 1023 : d1_)]; } }
            }
#pragma unroll
            for (int d0 = 0; d0 < 4; ++d0) {
                const bf16x8 a0 = *(const bf16x8*)(Ks + r32 * 128 + (((2 * d0 + hi) ^ ((r32 >> 1) & 7)) * 16));
                const bf16x8 a1 = *(const bf16x8*)(Ks + (32 + r32) * 128 + (((2 * d0 + hi) ^ ((r32 >> 1) & 7)) * 16));
                p0 = __builtin_amdgcn_mfma_f32_32x32x16_bf16(a0, qr[d0], p0, 0, 0, 0);
                p1 = __builtin_amdgcn_mfma_f32_32x32x16_bf16(a1, qr[d0], p1, 0, 0, 0);
            }
            const int kb = 64 * t + 4 * hi;
            if constexpr (MODE == MODE_SWA) {
#pragma unroll
                for (int r = 0; r < 16; ++r) { const int kv = kb + (r & 3) + 8 * (r >> 2); if (kv > q || kv < q - 127) p0[r] = -INFINITY; if (kv + 32 > q || kv + 32 < q - 127) p1[r] = -INFINITY; }
            } else {
                if (64 * t + 63 > qw) {
#pragma unroll
                    for (int r = 0; r < 16; ++r) { const int kv = kb + (r & 3) + 8 * (r >> 2); if (kv > q) p0[r] = -INFINITY; if (kv + 32 > q) p1[r] = -INFINITY; }
                }
                if constexpr (MODE == MODE_MOBA) { if (t < 4 * qb && ((selmask >> (t >> 2)) & 1u) == 0u) {
#pragma unroll
                    for (int r = 0; r < 16; ++r) { p0[r] = -INFINITY; p1[r] = -INFINITY; } } }
            }
            float mx = fmaxf(p0[0], p1[0]);
#pragma unroll
            for (int r = 1; r < 16; ++r) mx = fmaxf(mx, fmaxf(p0[r], p1[r]));
            mx = fmaxf(mx, __shfl_xor(mx, 32));
            const float mn = fmaxf(m, mx);
            if (__builtin_amdgcn_ballot_w64(mn > m) != 0ull) {
                const float alpha = __builtin_amdgcn_exp2f(m - mn); l *= alpha;
#pragma unroll
                for (int r = 0; r < 16; ++r) { o0[r] *= alpha; o1[r] *= alpha; }
            }
            m = mn;
            float sum = 0.f;
#pragma unroll
            for (int r = 0; r < 16; ++r) { p0[r] = __builtin_amdgcn_exp2f(p0[r] - mn); p1[r] = __builtin_amdgcn_exp2f(p1[r] - mn); sum += p0[r] + p1[r]; }
            l += sum;
            bf16x8 pa[4];
#pragma unroll
            for (int ks = 0; ks < 4; ++ks) { uint4 w;
                if (ks < 2) { w.x = cvtpk(p0[8 * ks], p0[8 * ks + 1]); w.y = cvtpk(p0[8 * ks + 2], p0[8 * ks + 3]); w.z = cvtpk(p0[8 * ks + 4], p0[8 * ks + 5]); w.w = cvtpk(p0[8 * ks + 6], p0[8 * ks + 7]); }
                else { const int k2 = ks - 2; w.x = cvtpk(p1[8 * k2], p1[8 * k2 + 1]); w.y = cvtpk(p1[8 * k2 + 2], p1[8 * k2 + 3]); w.z = cvtpk(p1[8 * k2 + 4], p1[8 * k2 + 5]); w.w = cvtpk(p1[8 * k2 + 6], p1[8 * k2 + 7]); }
                pa[ks] = __builtin_bit_cast(bf16x8, w); }
#pragma unroll
            for (int ks = 0; ks < 4; ++ks) {
#pragma unroll
                for (int db = 0; db < 2; ++db) {
                    const LASC unsigned char* vp = (const LASC unsigned char*)(Vt + vtr_off + ks * 16 * 128 + ((db ^ ((lane >> 3) & 1)) * 64));
                    const s16x4 lo = __builtin_bit_cast(s16x4, __builtin_amdgcn_ds_read_tr16_b64_v4i16((LASC v4i16_t*)vp));
                    const s16x4 hh = __builtin_bit_cast(s16x4, __builtin_amdgcn_ds_read_tr16_b64_v4i16((LASC v4i16_t*)(vp + 8 * 128)));
                    const bf16x8 vf = {lo[0], lo[1], lo[2], lo[3], hh[0], hh[1], hh[2], hh[3]};
                    if (db == 0) o0 = __builtin_amdgcn_mfma_f32_32x32x16_bf16(vf, pa[ks], o0, 0, 0, 0);
                    else o1 = __builtin_amdgcn_mfma_f32_32x32x16_bf16(vf, pa[ks], o1, 0, 0, 0); }
            }
            started = true;
        }
        }
        if constexpr (MODE == MODE_FOX) {
            const float eb = ((const float*)(lds + OFF_EB))[st * 2 + 1];
            if (__syncthreads_and((started && (qkb + eb - m < -FOX_THR)) ? 1 : 0)) break;
        } else __syncthreads();
    }
    if constexpr (MODE == MODE_FOX) __syncthreads();
#undef ATT_LOAD
#undef ATT_STORE
#undef ATT_LOAD1
#undef ATT_STORE1
#undef ATT_TI
    l += __shfl_xor(l, 32);
    float inv = 1.0f / l;
    bf16_t* op = PROJ + (rowbase + q) * NPROJ + qcol + hq * 64 + 4 * hi;
    if (dry && inv != 123.4567f) return;
    if constexpr (MODE == MODE_MOWN) {
        const int cnt = (int)((msel >> 15) & 3u);
        const float pls[3] = {mpl.x, mpl.y, mpl.z};
        float R = m + __builtin_amdgcn_logf(l), wsum = 1.f;
#pragma unroll
        for (int r = 0; r < 16; ++r) { o0[r] *= inv; o1[r] *= inv; }
        uint2 pa0[3][4], pa1[3][4];
#pragma unroll
        for (int sl = 0; sl < 3; ++sl) { if (sl < cnt) {
            const bf16_t* pp = (sl < 2) ? PROJ + (rowbase + q) * NPROJ + PC_XBC + (hq * 2 + sl) * 64 + 4 * hi : (const bf16_t*)ex0 + ((rowbase + q) * 8 + hq) * 64 + 4 * hi;
#pragma unroll
            for (int g = 0; g < 4; ++g) { pa0[sl][g] = *(const uint2*)(pp + 8 * g); pa1[sl][g] = *(const uint2*)(pp + 32 + 8 * g); } } }
#pragma unroll
        for (int sl = 0; sl < 3; ++sl) { if (sl >= cnt) break;
            const float ls = pls[sl]; const float Rn = fmaxf(R, ls), sc = __builtin_amdgcn_exp2f(R - Rn), ws_ = __builtin_amdgcn_exp2f(ls - Rn);
#pragma unroll
            for (int g = 0; g < 4; ++g) { const uint2 a0 = pa0[sl][g], a1 = pa1[sl][g];
                o0[4 * g] = o0[4 * g] * sc + ws_ * bflo(a0.x); o0[4 * g + 1] = o0[4 * g + 1] * sc + ws_ * bfhi(a0.x); o0[4 * g + 2] = o0[4 * g + 2] * sc + ws_ * bflo(a0.y); o0[4 * g + 3] = o0[4 * g + 3] * sc + ws_ * bfhi(a0.y);
                o1[4 * g] = o1[4 * g] * sc + ws_ * bflo(a1.x); o1[4 * g + 1] = o1[4 * g + 1] * sc + ws_ * bfhi(a1.x); o1[4 * g + 2] = o1[4 * g + 2] * sc + ws_ * bflo(a1.y); o1[4 * g + 3] = o1[4 * g + 3] * sc + ws_ * bfhi(a1.y); }
            wsum = wsum * sc + ws_; R = Rn;
        }
        inv = 1.0f / wsum;
    }
#pragma unroll
    for (int g = 0; g < 4; ++g) {
        *(uint2*)(op + 8 * g) = make_uint2(cvtpk(o0[4 * g] * inv, o0[4 * g + 1] * inv), cvtpk(o0[4 * g + 2] * inv, o0[4 * g + 3] * inv));
        *(uint2*)(op + 32 + 8 * g) = make_uint2(cvtpk(o1[4 * g] * inv, o1[4 * g + 1] * inv), cvtpk(o1[4 * g + 2] * inv, o1[4 * g + 3] * inv));
    }
}
}
namespace ssd {
using att::bf16x8; using att::s16x4; using att::f32x16; using att::cvtpk; using att::LOG2E;
#define LASC __attribute__((address_space(3)))
constexpr int STB = 40960;
constexpr int OFF_AL2 = 2 * STB, OFF_DTV = OFF_AL2 + 1024, OFF_E = OFF_DTV + 1024, OFF_HIN = 0;
__device__ __forceinline__ float chunk_scan(unsigned char* lds, const float* DT, size_t row0, int h, float A, int tid) {
    float* al = (float*)(lds + OFF_AL2); float* dtv = (float*)(lds + OFF_DTV);
    if (tid < 256) { const float d = DT[(row0 + tid) * 8 + h]; dtv[tid] = d; al[tid] = d * A; }
    __syncthreads();
    if (tid < 64) { const float4 a4 = *(const float4*)(al + 4 * tid); const float s = (a4.x + a4.y) + (a4.z + a4.w); float incl = s;
#pragma unroll
        for (int o = 1; o < 64; o <<= 1) { const float v = __shfl_up(incl, o); if (tid >= o) incl += v; }
        const float base = incl - s; float4 c4; c4.x = base + a4.x; c4.y = c4.x + a4.y; c4.z = c4.y + a4.z; c4.w = c4.z + a4.w; *(float4*)(al + 4 * tid) = c4; }
    __syncthreads();
    return al[255];
}
__device__ __forceinline__ void m1_unit(unsigned char* lds, bf16_t* XC, const float* DT, const float* a_log, const float* d_skip, bf16_t* STATES, float* CDEC, int b, int c, int h) {
    const int tid = ltid(), lane = tid & 63, wave = __builtin_amdgcn_readfirstlane(tid >> 6), r32 = lane & 31, hi = lane >> 5, g = h >> 2;
    const size_t row0 = (size_t)b * SEQ + c * 256; const int l = wave * 32 + r32;
    const float A = -expf(a_log[h]);
    float* al = (float*)(lds + OFF_AL2); float* dtv = (float*)(lds + OFF_DTV); float* ev = (float*)(lds + OFF_E);
    const float alast = chunk_scan(lds, DT, row0, h, A, tid);
    float myac = 0.f; if (tid < 256) myac = al[tid];
    __syncthreads();
    if (tid < 256) { ev[tid] = expf(alast - myac); al[tid] = myac * LOG2E; }
    if (tid == 0) CDEC[(b * 32 + c) * 8 + h] = expf(alast);
    __syncthreads();
    const float al_l = al[l];
    bf16x8 cfr[8];
    { const bf16_t* cp = XC + (row0 + l) * 1024 + 768 + g * 128 + 8 * hi;
#pragma unroll
      for (int k0 = 0; k0 < 8; ++k0) cfr[k0] = *(const bf16x8*)(cp + 16 * k0); }
    f32x16 o0, o1, sacc;
#pragma unroll
    for (int r = 0; r < 16; ++r) { o0[r] = 0.f; o1[r] = 0.f; sacc[r] = 0.f; }
    const int ss = tid >> 3, pc = tid & 7;
    const bf16_t* bg = XC + (row0 + ss) * 1024 + 512 + g * 128 + 16 * pc;
    const bf16_t* xg = XC + (row0 + ss) * 1024 + h * 64 + 8 * pc;
    uint4 b0r, b1r, xr;
#define SSD_LOAD(t) do { b0r = *(const uint4*)(bg + (size_t)(t) * 64 * 1024); b1r = *(const uint4*)(bg + (size_t)(t) * 64 * 1024 + 8); xr = *(const uint4*)(xg + (size_t)(t) * 64 * 1024); } while (0)
#define SSD_SC2(w, f) cvtpk(bflo(w) * (f), bfhi(w) * (f))
#define SSD_STORE(st, t) do { unsigned char* sb_ = lds + (st) * STB; \
        *(uint4*)(sb_ + ss * 256 + (((2 * pc) ^ (ss & 15)) * 16)) = b0r; *(uint4*)(sb_ + ss * 256 + (((2 * pc + 1) ^ (ss & 15)) * 16)) = b1r; \
        const float es_ = ev[(t) * 64 + ss], ds_ = dtv[(t) * 64 + ss]; \
        *(uint4*)(sb_ + 16384 + ss * 256 + pc * 32) = make_uint4(SSD_SC2(b0r.x, es_), SSD_SC2(b0r.y, es_), SSD_SC2(b0r.z, es_), SSD_SC2(b0r.w, es_));         \
        *(uint4*)(sb_ + 16384 + ss * 256 + pc * 32 + 16) = make_uint4(SSD_SC2(b1r.x, es_), SSD_SC2(b1r.y, es_), SSD_SC2(b1r.z, es_), SSD_SC2(b1r.w, es_)); \
        *(uint4*)(sb_ + 32768 + ss * 128 + pc * 16) = make_uint4(SSD_SC2(xr.x, ds_), SSD_SC2(xr.y, ds_), SSD_SC2(xr.z, ds_), SSD_SC2(xr.w, ds_)); } while (0)
    SSD_LOAD(0); SSD_STORE(0, 0);
    __syncthreads();
    const int nb = wave >> 1, pb = wave & 1;
    const int trx = ((lane & 15) >> 2) * 128 + (16 * ((lane >> 4) & 1) + 4 * (lane & 3)) * 2, trb = ((lane & 15) >> 2) * 256 + (16 * ((lane >> 4) & 1) + 4 * (lane & 3)) * 2;
#pragma unroll 1
    for (int t = 0; t < 4; ++t) {
        const int st = t & 1;
        if (t + 1 < 4) SSD_LOAD(t + 1);
        const unsigned char* Bs = lds + st * STB; const unsigned char* Bt = Bs + 16384; const unsigned char* Xt = Bs + 32768;
        if (64 * t <= wave * 32 + 31) {
            f32x16 p0, p1;
#pragma unroll
            for (int r = 0; r < 16; ++r) { p0[r] = 0.f; p1[r] = 0.f; }
#pragma unroll
            for (int k0 = 0; k0 < 8; ++k0) {
                const bf16x8 a0 = *(const bf16x8*)(Bs + r32 * 256 + (((2 * k0 + hi) ^ (r32 & 15)) * 16));
                const bf16x8 a1 = *(const bf16x8*)(Bs + (32 + r32) * 256 + (((2 * k0 + hi) ^ (r32 & 15)) * 16));
                p0 = __builtin_amdgcn_mfma_f32_32x32x16_bf16(a0, cfr[k0], p0, 0, 0, 0);
                p1 = __builtin_amdgcn_mfma_f32_32x32x16_bf16(a1, cfr[k0], p1, 0, 0, 0);
            }
#pragma unroll
            for (int gq = 0; gq < 4; ++gq) { const int sb0 = 64 * t + 8 * gq + 4 * hi;
                const float4 s0 = *(const float4*)(al + sb0), s1 = *(const float4*)(al + sb0 + 32);
                const float a0[4] = {s0.x, s0.y, s0.z, s0.w}, a1[4] = {s1.x, s1.y, s1.z, s1.w};
#pragma unroll
                for (int e = 0; e < 4; ++e) { const int r = 4 * gq + e;
                    p0[r] = (sb0 + e <= l) ? p0[r] * __builtin_amdgcn_exp2f(al_l - a0[e]) : 0.f;
                    p1[r] = (sb0 + 32 + e <= l) ? p1[r] * __builtin_amdgcn_exp2f(al_l - a1[e]) : 0.f; } }
            bf16x8 pa[4];
#pragma unroll
            for (int ks = 0; ks < 4; ++ks) { uint4 w;
                if (ks < 2) { w.x = cvtpk(p0[8 * ks], p0[8 * ks + 1]); w.y = cvtpk(p0[8 * ks + 2], p0[8 * ks + 3]); w.z = cvtpk(p0[8 * ks + 4], p0[8 * ks + 5]); w.w = cvtpk(p0[8 * ks + 6], p0[8 * ks + 7]); }
                else { const int k2 = ks - 2; w.x = cvtpk(p1[8 * k2], p1[8 * k2 + 1]); w.y = cvtpk(p1[8 * k2 + 2], p1[8 * k2 + 3]); w.z = cvtpk(p1[8 * k2 + 4], p1[8 * k2 + 5]); w.w = cvtpk(p1[8 * k2 + 6], p1[8 * k2 + 7]); }
                pa[ks] = __builtin_bit_cast(bf16x8, w); }
#pragma unroll
            for (int ks = 0; ks < 4; ++ks) {
#pragma unroll
                for (int db = 0; db < 2; ++db) {
                    const LASC unsigned char* vp = (const LASC unsigned char*)(Xt + trx + 4 * hi * 128 + ks * 16 * 128 + db * 64);
                    const s16x4 lo = __builtin_bit_cast(s16x4, __builtin_amdgcn_ds_read_tr16_b64_v4i16((LASC att::v4i16_t*)vp));
                    const s16x4 hh = __builtin_bit_cast(s16x4, __builtin_amdgcn_ds_read_tr16_b64_v4i16((LASC att::v4i16_t*)(vp + 8 * 128)));
                    const bf16x8 vf = {lo[0], lo[1], lo[2], lo[3], hh[0], hh[1], hh[2], hh[3]};
                    if (db == 0) o0 = __builtin_amdgcn_mfma_f32_32x32x16_bf16(vf, pa[ks], o0, 0, 0, 0);
                    else o1 = __builtin_amdgcn_mfma_f32_32x32x16_bf16(vf, pa[ks], o1, 0, 0, 0); } }
        }
        {
#pragma unroll
            for (int ks = 0; ks < 4; ++ks) {
                const LASC unsigned char* bp = (const LASC unsigned char*)(Bt + trb + (16 * ks + 8 * hi) * 256 + nb * 64);
                const s16x4 a_lo = __builtin_bit_cast(s16x4, __builtin_amdgcn_ds_read_tr16_b64_v4i16((LASC att::v4i16_t*)bp));
                const s16x4 a_hi = __builtin_bit_cast(s16x4, __builtin_amdgcn_ds_read_tr16_b64_v4i16((LASC att::v4i16_t*)(bp + 4 * 256)));
                const LASC unsigned char* xp = (const LASC unsigned char*)(Xt + trx + (16 * ks + 8 * hi) * 128 + pb * 64);
                const s16x4 x_lo = __builtin_bit_cast(s16x4, __builtin_amdgcn_ds_read_tr16_b64_v4i16((LASC att::v4i16_t*)xp));
                const s16x4 x_hi = __builtin_bit_cast(s16x4, __builtin_amdgcn_ds_read_tr16_b64_v4i16((LASC att::v4i16_t*)(xp + 4 * 128)));
                const bf16x8 af = {a_lo[0], a_lo[1], a_lo[2], a_lo[3], a_hi[0], a_hi[1], a_hi[2], a_hi[3]};
                const bf16x8 xf = {x_lo[0], x_lo[1], x_lo[2], x_lo[3], x_hi[0], x_hi[1], x_hi[2], x_hi[3]};
                sacc = __builtin_amdgcn_mfma_f32_32x32x16_bf16(af, xf, sacc, 0, 0, 0);
            }
        }
        if (t + 1 < 4) SSD_STORE(st ^ 1, t + 1);
        __syncthreads();
    }
#undef SSD_LOAD
#undef SSD_STORE
    { const float Dh = d_skip[h]; bf16_t* yp = XC + (row0 + l) * 1024 + h * 64 + 4 * hi;
#pragma unroll
      for (int gq = 0; gq < 4; ++gq) {
          const uint2 x0 = *(const uint2*)(yp + 8 * gq), x1 = *(const uint2*)(yp + 32 + 8 * gq);
          *(uint2*)(yp + 8 * gq) = make_uint2(cvtpk(o0[4 * gq] + Dh * bflo(x0.x), o0[4 * gq + 1] + Dh * bfhi(x0.x)), cvtpk(o0[4 * gq + 2] + Dh * bflo(x0.y), o0[4 * gq + 3] + Dh * bfhi(x0.y)));
          *(uint2*)(yp + 32 + 8 * gq) = make_uint2(cvtpk(o1[4 * gq] + Dh * bflo(x1.x), o1[4 * gq + 1] + Dh * bfhi(x1.x)), cvtpk(o1[4 * gq + 2] + Dh * bflo(x1.y), o1[4 * gq + 3] + Dh * bfhi(x1.y))); } }
    { bf16_t* sp = STATES + ((size_t)((b * 32 + c) * 8 + h)) * 8192 + (size_t)(r32 + 32 * pb) * 128 + 32 * nb + 4 * hi;
#pragma unroll
      for (int gq = 0; gq < 4; ++gq) *(uint2*)(sp + 8 * gq) = make_uint2(cvtpk(sacc[4 * gq], sacc[4 * gq + 1]), cvtpk(sacc[4 * gq + 2], sacc[4 * gq + 3])); }
    __syncthreads();
}
__device__ __forceinline__ void m2_unit(unsigned char* lds, bf16_t* XC, const float* DT, const float* a_log, const bf16_t* STATES, const float* CDEC, int b, int c, int h) {
    if (c == 0) return;
    const int tid = ltid(), lane = tid & 63, wave = __builtin_amdgcn_readfirstlane(tid >> 6), r32 = lane & 31, hi = lane >> 5, g = h >> 2;
    const size_t row0 = (size_t)b * SEQ + c * 256; const int l = wave * 32 + r32;
    const float A = -expf(a_log[h]);
    float* al = (float*)(lds + OFF_AL2);
    (void)chunk_scan(lds, DT, row0, h, A, tid);
    const float ea = expf(al[l]);
    float4 hin[4];
#pragma unroll
    for (int j = 0; j < 4; ++j) hin[j] = make_float4(0.f, 0.f, 0.f, 0.f);
    const bf16_t* sbase = STATES + ((size_t)((b * 32) * 8 + h)) * 8192 + 4 * tid;
    for (int c0 = 0; c0 < c; c0 += 4) {
        uint2 sv[4][4]; float dec[4];
#pragma unroll
        for (int k = 0; k < 4; ++k) { const int cc = (c0 + k < c) ? c0 + k : c - 1; dec[k] = CDEC[(b * 32 + cc) * 8 + h];
#pragma unroll
            for (int j = 0; j < 4; ++j) sv[k][j] = *(const uint2*)(sbase + (size_t)cc * 8 * 8192 + 2048 * j); }
#pragma unroll
        for (int k = 0; k < 4; ++k) if (c0 + k < c) {
#pragma unroll
            for (int j = 0; j < 4; ++j) { hin[j].x = hin[j].x * dec[k] + bflo(sv[k][j].x); hin[j].y = hin[j].y * dec[k] + bfhi(sv[k][j].x); hin[j].z = hin[j].z * dec[k] + bflo(sv[k][j].y); hin[j].w = hin[j].w * dec[k] + bfhi(sv[k][j].y); } } }
#pragma unroll
    for (int j = 0; j < 4; ++j) { const int idx = 4 * tid + 2048 * j, p = idx >> 7, n = idx & 127;
        *(uint2*)(lds + OFF_HIN + p * 256 + (((n >> 3) ^ (p & 15)) * 16) + (n & 7) * 2) = make_uint2(cvtpk(hin[j].x, hin[j].y), cvtpk(hin[j].z, hin[j].w)); }
    __syncthreads();
    bf16x8 cfr[8];
    { const bf16_t* cp = XC + (row0 + l) * 1024 + 768 + g * 128 + 8 * hi;
#pragma unroll
      for (int k0 = 0; k0 < 8; ++k0) cfr[k0] = *(const bf16x8*)(cp + 16 * k0); }
    f32x16 o0, o1;
#pragma unroll
    for (int r = 0; r < 16; ++r) { o0[r] = 0.f; o1[r] = 0.f; }
#pragma unroll
    for (int k0 = 0; k0 < 8; ++k0) {
        const bf16x8 h0 = *(const bf16x8*)(lds + OFF_HIN + r32 * 256 + (((2 * k0 + hi) ^ (r32 & 15)) * 16));
        const bf16x8 h1 = *(const bf16x8*)(lds + OFF_HIN + (32 + r32) * 256 + (((2 * k0 + hi) ^ (r32 & 15)) * 16));
        o0 = __builtin_amdgcn_mfma_f32_32x32x16_bf16(h0, cfr[k0], o0, 0, 0, 0);
        o1 = __builtin_amdgcn_mfma_f32_32x32x16_bf16(h1, cfr[k0], o1, 0, 0, 0);
    }
    { bf16_t* yp = XC + (row0 + l) * 1024 + h * 64 + 4 * hi;
#pragma unroll
      for (int gq = 0; gq < 4; ++gq) {
          const uint2 y0 = *(const uint2*)(yp + 8 * gq), y1 = *(const uint2*)(yp + 32 + 8 * gq);
          *(uint2*)(yp + 8 * gq) = make_uint2(cvtpk(bflo(y0.x) + ea * o0[4 * gq], bfhi(y0.x) + ea * o0[4 * gq + 1]), cvtpk(bflo(y0.y) + ea * o0[4 * gq + 2], bfhi(y0.y) + ea * o0[4 * gq + 3]));
          *(uint2*)(yp + 32 + 8 * gq) = make_uint2(cvtpk(bflo(y1.x) + ea * o1[4 * gq], bfhi(y1.x) + ea * o1[4 * gq + 1]), cvtpk(bflo(y1.y) + ea * o1[4 * gq + 2], bfhi(y1.y) + ea * o1[4 * gq + 3])); } }
    __syncthreads();
}
}

__device__ __forceinline__ void moba_select_unit(unsigned char* lds, const bf16_t* PROJ, const float* KMEAN, unsigned* SEL, int b, int h, int qb) {
    const int tid = ltid(), lane = tid & 63, hf = lane & 1;
    const int q = qb * 256 + (tid >> 1);
    float* km_s = (float*)lds;
    { const int n = tid >> 4, c4 = (tid & 15) * 4; *(float4*)(km_s + n * 64 + c4) = *(const float4*)(KMEAN + ((size_t)(b * 32 + n)) * 512 + h * 64 + c4); }
    __syncthreads();
    const bf16_t* qp = PROJ + ((size_t)b * SEQ + q) * NPROJ + PC_MQ + h * 64 + hf * 32;
    float qv[32];
#pragma unroll
    for (int c = 0; c < 4; ++c) { const uint4 u = *(const uint4*)(qp + c * 8);
        qv[c * 8 + 0] = bflo(u.x); qv[c * 8 + 1] = bfhi(u.x); qv[c * 8 + 2] = bflo(u.y); qv[c * 8 + 3] = bfhi(u.y); qv[c * 8 + 4] = bflo(u.z); qv[c * 8 + 5] = bfhi(u.z); qv[c * 8 + 6] = bflo(u.w); qv[c * 8 + 7] = bfhi(u.w); }
    float g0 = -INFINITY, g1 = -INFINITY, g2 = -INFINITY; int i0 = 31, i1 = 31, i2 = 31;
    for (int n = 0; n < qb; ++n) {
        const float* km = km_s + n * 64 + hf * 32; float g = 0.f;
#pragma unroll
        for (int c = 0; c < 8; ++c) { const float4 k4 = *(const float4*)(km + 4 * c); g += qv[4 * c] * k4.x + qv[4 * c + 1] * k4.y + qv[4 * c + 2] * k4.z + qv[4 * c + 3] * k4.w; }
        g += __shfl_xor(g, 1);
        if (g > g0) { g2 = g1; i2 = i1; g1 = g0; i1 = i0; g0 = g; i0 = n; }
        else if (g > g1) { g2 = g1; i2 = i1; g1 = g; i1 = n; }
        else if (g > g2) { g2 = g; i2 = n; }
    }
    const int cnt = qb < 3 ? qb : 3;
    if (hf == 0) SEL[(size_t)(b * 8 + h) * SEQ + q] = (unsigned)i0 | ((unsigned)i1 << 5) | ((unsigned)i2 << 10) | ((unsigned)cnt << 15);
    __syncthreads();
}
namespace gat { constexpr int OFF_LIST = 65536, OFF_TABG = 98304, OFF_CNT = 102400; }
__device__ __forceinline__ void moba_gather_unit(unsigned char* lds, bf16_t* PROJ, const unsigned* SEL, const float* btab, bf16_t* PO2, float* PL, int b, int h, int j, int qc) {
    using namespace att;
    const int tid = ltid(), lane = tid & 63, wave = __builtin_amdgcn_readfirstlane(tid >> 6), r32 = lane & 31, hi = lane >> 5;
    const size_t rowbase = (size_t)b * SEQ;
    float* tab = (float*)(lds + gat::OFF_TABG); unsigned* list = (unsigned*)(lds + gat::OFF_LIST); unsigned* cntp = (unsigned*)(lds + gat::OFF_CNT);
    for (int d = tid; d < 1024; d += NT) tab[d] = btab[rel_bucket(d) * 16 + h] * LOG2E;
    if (tid == 0) *cntp = 0u;
    const uint4 selv0 = *(const uint4*)(SEL + (size_t)(b * 8 + h) * SEQ + 4096 * qc + 4 * tid), selv1 = *(const uint4*)(SEL + (size_t)(b * 8 + h) * SEQ + 4096 * qc + 2048 + 4 * tid);
    { const int skey = tid >> 3, sch = tid & 7;
      const bf16_t* kp = PROJ + (rowbase + j * 256 + skey) * NPROJ + h * 64 + sch * 8;
      const uint4 k0 = *(const uint4*)(kp + PC_MK), v0 = *(const uint4*)(kp + PC_MV), k1 = *(const uint4*)(kp + (size_t)64 * NPROJ + PC_MK), v1 = *(const uint4*)(kp + (size_t)64 * NPROJ + PC_MV);
      const uint4 k2 = *(const uint4*)(kp + (size_t)128 * NPROJ + PC_MK), v2 = *(const uint4*)(kp + (size_t)128 * NPROJ + PC_MV), k3 = *(const uint4*)(kp + (size_t)192 * NPROJ + PC_MK), v3 = *(const uint4*)(kp + (size_t)192 * NPROJ + PC_MV);
      unsigned char* kd = lds + skey * 128 + ((sch ^ ((skey >> 1) & 7)) * 16); unsigned char* vd = lds + 8192 + skey * 128 + ((sch ^ (((skey >> 1) & 1) << 2)) * 16);
      *(uint4*)(kd) = k0; *(uint4*)(vd) = v0; *(uint4*)(kd + ST_BYTES) = k1; *(uint4*)(vd + ST_BYTES) = v1;
      *(uint4*)(kd + 2 * ST_BYTES) = k2; *(uint4*)(vd + 2 * ST_BYTES) = v2; *(uint4*)(kd + 3 * ST_BYTES) = k3; *(uint4*)(vd + 3 * ST_BYTES) = v3; }
    __syncthreads();
#pragma unroll
    for (int half = 0; half < 2; ++half) {
        const int qf = 4096 * qc + 2048 * half + 4 * tid, qmin = 256 * (j + 1);
        const uint4 sv4 = half ? selv1 : selv0; const unsigned sv[4] = {sv4.x, sv4.y, sv4.z, sv4.w};
#pragma unroll
        for (int e = 0; e < 4; ++e) { int slot = -1; const int cnt = (int)((sv[e] >> 15) & 3u);
            if (qf + e >= qmin) { if ((int)(sv[e] & 31u) == j && cnt > 0) slot = 0; else if ((int)((sv[e] >> 5) & 31u) == j && cnt > 1) slot = 1; else if ((int)((sv[e] >> 10) & 31u) == j && cnt > 2) slot = 2; }
            const unsigned long long bal = __builtin_amdgcn_ballot_w64(slot >= 0);
            unsigned pos = 0u;
            if (lane == 0 && bal) pos = atomicAdd(cntp, (unsigned)__builtin_popcountll(bal));
            pos = __shfl(pos, 0);
            if (slot >= 0) list[pos + __builtin_popcountll(bal & ((1ull << lane) - 1ull))] = (unsigned)(qf + e) | ((unsigned)slot << 13); }
    }
    __syncthreads();
    const int n = (int)*cntp, ngroups = (n + 31) >> 5;
    const int vtr_off = ((lane & 15) >> 2) * 128 + (16 * ((lane >> 4) & 1) + 4 * (lane & 3)) * 2 + 4 * hi * 128;
    uint4 qraw[4]; unsigned entn = 0u;
    if (wave < ngroups) { const int ei = 32 * wave + r32; entn = list[ei < n ? ei : n - 1];
        const bf16_t* qp = PROJ + (rowbase + (int)(entn & 8191u)) * NPROJ + PC_MQ + h * 64 + 8 * hi;
#pragma unroll
        for (int d0 = 0; d0 < 4; ++d0) qraw[d0] = *(const uint4*)(qp + 16 * d0); }
    for (int grp = wave; grp < ngroups; grp += 8) {
        const int ei = 32 * grp + r32; const bool valid = ei < n; const unsigned ent = entn;
        const int q = (int)(ent & 8191u), slot = (int)(ent >> 13);
        bf16x8 qr[4];
        {
#pragma unroll
          for (int d0 = 0; d0 < 4; ++d0) { const uint4 u = qraw[d0];
              uint4 w; w.x = cvtpk(bflo(u.x) * C2, bfhi(u.x) * C2); w.y = cvtpk(bflo(u.y) * C2, bfhi(u.y) * C2); w.z = cvtpk(bflo(u.z) * C2, bfhi(u.z) * C2); w.w = cvtpk(bflo(u.w) * C2, bfhi(u.w) * C2);
              qr[d0] = __builtin_bit_cast(bf16x8, w); } }
        if (grp + 8 < ngroups) { const int ein = 32 * (grp + 8) + r32; entn = list[ein < n ? ein : n - 1];
            const bf16_t* qp = PROJ + (rowbase + (int)(entn & 8191u)) * NPROJ + PC_MQ + h * 64 + 8 * hi;
#pragma unroll
            for (int d0 = 0; d0 < 4; ++d0) qraw[d0] = *(const uint4*)(qp + 16 * d0); }
        f32x16 o0, o1;
#pragma unroll
        for (int r = 0; r < 16; ++r) { o0[r] = 0.f; o1[r] = 0.f; }
        float m = -1e30f, l = 0.f;
#pragma unroll 1
        for (int t = 0; t < 4; ++t) {
            const unsigned char* Ks = lds + t * ST_BYTES; const unsigned char* Vt = Ks + 8192;
            const int key0 = j * 256 + t * 64; f32x16 p0, p1;
            { const int dq = q - key0 - 4 * hi;
              if (__builtin_amdgcn_ballot_w64(q - (key0 + 63) >= 790) == ~0ull) { const float c31 = tab[1023];
#pragma unroll
                  for (int r = 0; r < 16; ++r) { p0[r] = c31; p1[r] = c31; } }
              else {
#pragma unroll
                  for (int r = 0; r < 16; ++r) { const int kofs = (r & 3) + 8 * (r >> 2); const int d0_ = dq - kofs, d1_ = dq - kofs - 32;
                      p0[r] = tab[d0_ > 1023 ? 1023 : d0_]; p1[r] = tab[d1_ > 1023 ? 1023 : d1_]; } } }
#pragma unroll
            for (int d0 = 0; d0 < 4; ++d0) {
                const bf16x8 a0 = *(const bf16x8*)(Ks + r32 * 128 + (((2 * d0 + hi) ^ ((r32 >> 1) & 7)) * 16));
                const bf16x8 a1 = *(const bf16x8*)(Ks + (32 + r32) * 128 + (((2 * d0 + hi) ^ ((r32 >> 1) & 7)) * 16));
                p0 = __builtin_amdgcn_mfma_f32_32x32x16_bf16(a0, qr[d0], p0, 0, 0, 0);
                p1 = __builtin_amdgcn_mfma_f32_32x32x16_bf16(a1, qr[d0], p1, 0, 0, 0);
            }
            float mx = fmaxf(p0[0], p1[0]);
#pragma unroll
            for (int r = 1; r < 16; ++r) mx = fmaxf(mx, fmaxf(p0[r], p1[r]));
            mx = fmaxf(mx, __shfl_xor(mx, 32));
            const float mn = fmaxf(m, mx);
            if (__builtin_amdgcn_ballot_w64(mn > m) != 0ull) {
                const float alpha = __builtin_amdgcn_exp2f(m - mn); l *= alpha;
#pragma unroll
                for (int r = 0; r < 16; ++r) { o0[r] *= alpha; o1[r] *= alpha; }
            }
            m = mn;
            float sum = 0.f;
#pragma unroll
            for (int r = 0; r < 16; ++r) { p0[r] = __builtin_amdgcn_exp2f(p0[r] - mn); p1[r] = __builtin_amdgcn_exp2f(p1[r] - mn); sum += p0[r] + p1[r]; }
            l += sum;
            bf16x8 pa[4];
#pragma unroll
            for (int ks = 0; ks < 4; ++ks) { uint4 w;
                if (ks < 2) { w.x = cvtpk(p0[8 * ks], p0[8 * ks + 1]); w.y = cvtpk(p0[8 * ks + 2], p0[8 * ks + 3]); w.z = cvtpk(p0[8 * ks + 4], p0[8 * ks + 5]); w.w = cvtpk(p0[8 * ks + 6], p0[8 * ks + 7]); }
                else { const int k2 = ks - 2; w.x = cvtpk(p1[8 * k2], p1[8 * k2 + 1]); w.y = cvtpk(p1[8 * k2 + 2], p1[8 * k2 + 3]); w.z = cvtpk(p1[8 * k2 + 4], p1[8 * k2 + 5]); w.w = cvtpk(p1[8 * k2 + 6], p1[8 * k2 + 7]); }
                pa[ks] = __builtin_bit_cast(bf16x8, w); }
#pragma unroll
            for (int ks = 0; ks < 4; ++ks) {
#pragma unroll
                for (int db = 0; db < 2; ++db) {
                    const LASC unsigned char* vp = (const LASC unsigned char*)(Vt + vtr_off + ks * 16 * 128 + ((db ^ ((lane >> 3) & 1)) * 64));
                    const s16x4 lo = __builtin_bit_cast(s16x4, __builtin_amdgcn_ds_read_tr16_b64_v4i16((LASC v4i16_t*)vp));
                    const s16x4 hh = __builtin_bit_cast(s16x4, __builtin_amdgcn_ds_read_tr16_b64_v4i16((LASC v4i16_t*)(vp + 8 * 128)));
                    const bf16x8 vf = {lo[0], lo[1], lo[2], lo[3], hh[0], hh[1], hh[2], hh[3]};
                    if (db == 0) o0 = __builtin_amdgcn_mfma_f32_32x32x16_bf16(vf, pa[ks], o0, 0, 0, 0);
                    else o1 = __builtin_amdgcn_mfma_f32_32x32x16_bf16(vf, pa[ks], o1, 0, 0, 0); }
            }
        }
        l += __shfl_xor(l, 32);
        const float inv = 1.0f / l;
        if (valid) {
            bf16_t* pp = (slot < 2) ? PROJ + (rowbase + q) * NPROJ + PC_XBC + (h * 2 + slot) * 64 + 4 * hi : PO2 + ((rowbase + q) * 8 + h) * 64 + 4 * hi;
#pragma unroll
            for (int g = 0; g < 4; ++g) {
                *(uint2*)(pp + 8 * g) = make_uint2(cvtpk(o0[4 * g] * inv, o0[4 * g + 1] * inv), cvtpk(o0[4 * g + 2] * inv, o0[4 * g + 3] * inv));
                *(uint2*)(pp + 32 + 8 * g) = make_uint2(cvtpk(o1[4 * g] * inv, o1[4 * g + 1] * inv), cvtpk(o1[4 * g + 2] * inv, o1[4 * g + 3] * inv)); }
            if (hi == 0) PL[((rowbase + q) * 8 + h) * 4 + slot] = m + __builtin_amdgcn_logf(l);
        }
    }
    __syncthreads();
}
#define MIX_WS ({ unsigned char* p_ = ws0; asm volatile("" : "+s"(p_)); p_; })
#define QUEUE_NEXT(u, word) do { if (tid == 0) *(volatile unsigned*)(lds + 131072 + 64) = atomicAdd((unsigned*)(MIX_WS + WS_CTL + 32768) + 64 * (word), 1u); \
        __syncthreads(); u = *(volatile unsigned*)(lds + 131072 + 64); __syncthreads(); } while (0)
__device__ __forceinline__ void ph_mixers(unsigned char* lds, unsigned char* ws0, const float* a_log, const float* d_skip, const float* sinks, const float* btab, int l) {
    const int tid = ltid();
    bool swa_ok = false;
    for (;;) {
        unsigned u; QUEUE_NEXT(u, 3 * l);
        if (u >= 2048u + 64u) break;
        if (u < 64u) {
            unsigned char* ws = MIX_WS;
            pg8::OneSched S; S.u0.A = (const char*)P_XN(ws) + (size_t)u * 256 * (D * 2); S.u0.B = (const char*)(ws + WS_WIN) + (size_t)INP_TILES * 256 * (D * 2);
            S.u0.lda2 = D * 2; S.u0.ldb2 = D * 2; S.u0.nt = D / 64; S.u0.pm = (int)u; S.u0.pn = INP_TILES; S.u0.aux = 0;
            pg8::EpiStoreBf16 E{P_PROJ(ws), NPROJ}; pg8::gemm_phase<pg8::EpiStoreBf16, pg8::OneSched, true>((LAS unsigned char*)lds, S, E);
            if (tid == 0) { __builtin_amdgcn_fence(__ATOMIC_RELEASE, "agent"); asm volatile("s_waitcnt vmcnt(0)" ::: "memory"); (void)q_add((unsigned*)(ws + WS_CTL + 32768) + 64 * (6 + l), 1u); }
            continue;
        }
        u -= 64u;
        const int k = (int)(u & 511u);
        if (u < 512u) { const int qb = 31 - (k >> 4), bh = k & 15; unsigned char* ws = MIX_WS;
            att::attn_unit<att::MODE_FOX>(lds, P_PROJ(ws), (const float*)(ws + WS_LF), (const float*)(ws + WS_CUM), 0, 0.f, bh >> 3, bh & 7, bh & 7, qb, PC_FQ, PC_FK, PC_FV); }
        else if (u < 1024u) { unsigned char* ws = MIX_WS; ssd::m1_unit(lds, P_XC(ws), (const float*)(ws + WS_DT), a_log, d_skip, (bf16_t*)(ws + WS_STATES), (float*)(ws + WS_CDEC), k >> 8, (k >> 3) & 31, k & 7); }
        else if (u < 1536u) { const int bh = k >> 5, qb = k & 31, hq = bh & 7; unsigned char* ws = MIX_WS;
            if (!swa_ok) {
                if (tid == 0) { unsigned sp = 0; while (q_ld((unsigned*)(ws + WS_CTL + 32768) + 64 * (6 + l)) < 64u) { __builtin_amdgcn_s_sleep(2); if (++sp > (1u << 22)) break; } }
                __syncthreads();
                __builtin_amdgcn_fence(__ATOMIC_ACQUIRE, "agent"); asm volatile("s_waitcnt vmcnt(0)" ::: "memory");
                __syncthreads();
                swa_ok = true; }
            att::attn_unit<att::MODE_SWA>(lds, P_PROJ(ws), nullptr, btab, 8 + hq, sinks[hq], bh >> 3, hq, hq >> 2, qb, PC_SQ, PC_SK, PC_SV); }
        else { const int qb = 31 - (k >> 4), bh = k & 15; unsigned char* ws = MIX_WS;
            moba_select_unit(lds, P_PROJ(ws), (const float*)(ws + WS_KMEAN), (unsigned*)(ws + WS_SEL), bh >> 3, bh & 7, qb); }
    }
}
__device__ __forceinline__ void ph_mixers_b(unsigned char* lds, unsigned char* ws0, const float* a_log, const float* btab, int l, const float* const* in) {
    const int tid = ltid();
    for (;;) {
        unsigned u; QUEUE_NEXT(u, 3 * l + 1);
        if (u >= 736u + 512u + (unsigned)((WCV_ALL - WCV_IN) / WCV_CHUNK)) break;
        if (u >= 736u + 512u) {
            const int lo = WCV_IN + (int)(u - (736u + 512u)) * WCV_CHUNK; unsigned char* ws = MIX_WS;
            ph_wconv(ws, in[1] + (size_t)l * D * DIN, in[11] + (size_t)l * 4 * 512 * 1024, in[12] + (size_t)l * D * D, in[15] + (size_t)l * D * DFF, in[16] + (size_t)l * D * DFF, in[17] + (size_t)l * DFF * D,
                     (LAS float*)lds, lo, lo + WCV_CHUNK, 0, 1);
            continue; }
        if (u < 736u) { const int bh = (int)u & 15, idx = (int)u >> 4;
            const int qc = idx < 15 ? 0 : 1, j = idx - (qc == 0 ? 0 : 15); unsigned char* ws = MIX_WS;
            moba_gather_unit(lds, P_PROJ(ws), (const unsigned*)(ws + WS_SEL), btab, (bf16_t*)(ws + WS_PO2), (float*)(ws + WS_PL), bh >> 3, bh & 7, j, qc); }
        else { const int k = (int)u - 736, c = 31 - (k >> 4), bh = k & 15; unsigned char* ws = MIX_WS;
            ssd::m2_unit(lds, P_XC(ws), (const float*)(ws + WS_DT), a_log, (const bf16_t*)(ws + WS_STATES), (const float*)(ws + WS_CDEC), bh >> 3, c, bh & 7); }
    }
}
__device__ __forceinline__ void ph_mixers_c(unsigned char* lds, unsigned char* ws0, const float* btab, const float* ssm_norm_w, int l) {
    const int tid = ltid();
    for (;;) {
        unsigned u; QUEUE_NEXT(u, 3 * l + 2);
        if (u >= 512u) break;
        const int qb = 31 - ((int)u >> 4), bh = (int)u & 15, h = bh & 7; unsigned char* ws = MIX_WS;
        att::attn_unit<att::MODE_MOWN>(lds, P_PROJ(ws), (const float*)(ws + WS_SEL), btab, h, 0.f, bh >> 3, h, h, qb, PC_MQ, PC_MK, PC_MV, false, (const void*)(ws + WS_PO2), (const void*)(ws + WS_PL));
    }
    { unsigned char* ws = MIX_WS; ph_mamba_norm(P_PROJ(ws), P_XC(ws), ssm_norm_w); }
}
#define XB_TMO      128
#define XB_XCNT(j)  (256  + 64 * (j))
#define XB_XSUB(j)  (1280 + 64 * (j))
#define XB_XGEN(j)  (2304 + 64 * (j))
#define XB_TOP      3328
#define XB_TOPGEN   3392
#define XCD_BAR_WORDS 3456
#define XB_SPIN_CAP (1u << 18)

__device__ __forceinline__ unsigned xb_ld(unsigned* p)              { return __hip_atomic_load(p, __ATOMIC_RELAXED, __HIP_MEMORY_SCOPE_AGENT); }
__device__ __forceinline__ unsigned xb_add(unsigned* p, unsigned v) { return __hip_atomic_fetch_add(p, v, __ATOMIC_RELAXED, __HIP_MEMORY_SCOPE_AGENT); }
__device__ __forceinline__ unsigned xb_xcc_id() { return (unsigned)__builtin_amdgcn_s_getreg((3 << 11) | 20) & 0xFu; }
#define XB_SPIN(cond, bar) do { unsigned _sp = 0; while (cond) { __builtin_amdgcn_s_sleep(1); \
    if ((++_sp & 255u) == 0u) { if (xb_ld(&(bar)[XB_TMO])) break; if (_sp > XB_SPIN_CAP) { atomicAdd(&(bar)[XB_TMO], 1u); break; } } } } while (0)

struct XcdBarrier {
    unsigned* bar; unsigned x;
    volatile LAS unsigned* st;
};

__device__ __forceinline__ XcdBarrier xcd_barrier_post(unsigned* bar, volatile LAS unsigned* st) {
    XcdBarrier b; b.bar = bar; b.x = xb_xcc_id(); b.st = st;
    if (threadIdx.x == 0) (void)xb_add(&bar[XB_XCNT(b.x)], 1u);
    return b;
}
__device__ __forceinline__ void xcd_barrier_complete(unsigned* bar, unsigned x, unsigned& nloc, unsigned& nx) {
    const unsigned G = gridDim.x * gridDim.y * gridDim.z;
    unsigned sum, cnt, mine, sp = 0u;
    for (;;) {
        sum = 0u; cnt = 0u; mine = 0u;
#pragma unroll
        for (unsigned j = 0; j < 16; ++j) { const unsigned c = xb_ld(&bar[XB_XCNT(j)]); sum += c; cnt += (c > 0u) ? 1u : 0u; mine = (j == x) ? c : mine; }
        if (sum == G) break;
        __builtin_amdgcn_s_sleep(1);
        if ((++sp & 255u) == 0u) { if (xb_ld(&bar[XB_TMO])) break; if (sp > XB_SPIN_CAP) { atomicAdd(&bar[XB_TMO], 1u); break; } }
    }
    nloc = mine > 0u ? mine : 1u; nx = cnt > 0u ? cnt : 1u;
}

__device__ __forceinline__ void xcd_barrier(const XcdBarrier& b) {
    asm volatile("s_waitcnt vmcnt(0)" ::: "memory");
    __syncthreads();
    if (threadIdx.x == 0) {
        unsigned* bar = b.bar;
        __builtin_amdgcn_s_waitcnt(0);
        unsigned nloc = b.st[0], nx = b.st[1];
        if (nloc == 0u) { xcd_barrier_complete(bar, b.x, nloc, nx); b.st[0] = nloc; b.st[1] = nx; }
        const unsigned old = xb_add(&bar[XB_XSUB(b.x)], 1u);
        const unsigned gen = old / nloc;
        if (old + 1u == (gen + 1u) * nloc) {
            __builtin_amdgcn_fence(__ATOMIC_RELEASE, "agent");
            asm volatile("s_waitcnt vmcnt(0)" ::: "memory");
            const unsigned og = xb_add(&bar[XB_TOP], 1u);
            const unsigned tg = og / nx;
            __builtin_amdgcn_fence(__ATOMIC_ACQUIRE, "agent");
            if (og + 1u == (tg + 1u) * nx) xb_add(&bar[XB_TOPGEN], 1u);
            else XB_SPIN(xb_ld(&bar[XB_TOPGEN]) == tg, bar);
            xb_add(&bar[XB_XGEN(b.x)], 1u);
            asm volatile("s_waitcnt vmcnt(0)" ::: "memory");
        } else {
            __builtin_amdgcn_fence(__ATOMIC_ACQUIRE, "agent");
            XB_SPIN(xb_ld(&bar[XB_XGEN(b.x)]) == gen, bar);
            asm volatile("s_waitcnt vmcnt(0)" ::: "memory");
        }
    }
    __syncthreads();
}

constexpr int MISC_OFF = 131072 + 320;
constexpr int LDS_BYTES = 147456;
constexpr int HROW_OFF = 69632;
#define GRID_SYNC() xcd_barrier(bar)
#define WSL ({ unsigned char* p_ = a.ws; asm volatile("" : "+s"(p_)); p_; })
__global__ void __launch_bounds__(NT, 2) fwd(Args a) {
    extern __shared__ __attribute__((aligned(16))) unsigned char lds[];
    LAS unsigned char* L = (LAS unsigned char*)lds;
    volatile LAS unsigned* MISC = (volatile LAS unsigned*)(L + MISC_OFF);
    if (threadIdx.x < 32) MISC[threadIdx.x] = 0u;
    __syncthreads();
    XcdBarrier bar = xcd_barrier_post((unsigned*)(a.ws + WS_CTL) + 4096, MISC + 8);
#pragma unroll 1
    for (int l = 0; l < 2; ++l) {
        {
            unsigned char* ws = WSL; const float* w_in = a.in[1] + (size_t)l * D * DIN;
            ph_wconv(ws, w_in, a.in[11] + (size_t)l * 4 * 512 * 1024, a.in[12] + (size_t)l * D * D, a.in[15] + (size_t)l * D * DFF, a.in[16] + (size_t)l * D * DFF, a.in[17] + (size_t)l * DFF * D, (LAS float*)L, 0, WCV_IN, blockIdx.x, gridDim.x);
            __syncthreads();
            if (l == 0) ph_norm<false>((float*)lds, a.in[0], a.in[13] + l * D, P_XN(ws), true, w_in, a.in[4] + l * 8, a.in[8] + l * 8, (float*)(ws + WS_DT), (float*)(ws + WS_LF), (bf16_t*)a.out);
            else ph_norm<true>((float*)lds, a.out, a.in[13] + l * D, P_XN(ws), true, w_in, a.in[4] + l * 8, a.in[8] + l * 8, (float*)(ws + WS_DT), (float*)(ws + WS_LF), nullptr);
        }
        GRID_SYNC();
        {
            unsigned char* ws = WSL;
            pg8::PlainSched S; S.T.init(M / 256, INP_TILES, gridDim.x, blockIdx.x); S.A = (const char*)P_XN(ws); S.B = (const char*)(ws + WS_WIN); S.lda2 = D * 2; S.ldb2 = D * 2; S.nt = D / 64;
            pg8::EpiStoreBf16 E{P_PROJ(ws), NPROJ}; pg8::gemm_phase<pg8::EpiStoreBf16, pg8::PlainSched, true>(L, S, E);
        }
        GRID_SYNC();
        { unsigned char* ws = WSL; ph_pre(lds, P_PROJ(ws), a.in[2] + (size_t)l * 4 * 1024, a.in[3] + l * 1024, P_XC(ws), (float*)(ws + WS_KMEAN), (float*)(ws + WS_CUM)); }
        GRID_SYNC();
        ph_mixers(lds, a.ws, a.in[5] + l * 8, a.in[6] + l * 8, a.in[9] + l * 8, a.in[10], l);
        GRID_SYNC();
        ph_mixers_b(lds, a.ws, a.in[5] + l * 8, a.in[10], l, a.in);
        GRID_SYNC();
        ph_mixers_c(lds, a.ws, a.in[10], a.in[7] + l * 512, l);
        GRID_SYNC();
        {
            unsigned char* ws = WSL;
            pg8::GBSched S; S.T.init(M / 256, D / 256, gridDim.x, blockIdx.x); S.XN = (const char*)P_XN(ws); S.WG = (const char*)(ws + WS_WG); S.PROJ = (const char*)P_PROJ(ws); S.WBR = (const char*)(ws + WS_WBR);
            pg8::EpiGB E{P_PROJ(ws), P_XC(ws), (bf16_t*)a.out + (size_t)M * D}; pg8::gemm_phase<pg8::EpiGB, pg8::GBSched, true>(L, S, E);
        }
        GRID_SYNC();
        {
            unsigned char* ws = WSL;
            pg8::PlainSched S; S.T.init(M / 256, D / 256, gridDim.x, blockIdx.x); S.A = (const char*)((const bf16_t*)a.out + (size_t)M * D); S.B = (const char*)(ws + WS_WOUT); S.lda2 = D * 2; S.ldb2 = D * 2; S.nt = D / 64;
            pg8::EpiRes E{(const bf16_t*)a.out, (void*)P_XC(ws), false}; pg8::gemm_phase<pg8::EpiRes, pg8::PlainSched, false>(L, S, E);
        }
        GRID_SYNC();
        { unsigned char* ws = WSL; ph_norm<true>(nullptr, P_XC(ws), a.in[14] + l * D, P_XN(ws), false, nullptr, nullptr, nullptr, nullptr, nullptr, nullptr); }
        GRID_SYNC();
        {
            unsigned char* ws = WSL;
            pg8::PlainSched S; S.T.init(M / 256, 2 * DFF / 256, gridDim.x, blockIdx.x); S.A = (const char*)P_XN(ws); S.B = (const char*)(ws + WS_WGU); S.lda2 = D * 2; S.ldb2 = D * 2; S.nt = D / 64;
            pg8::EpiSwiglu E{P_PROJ(ws)}; pg8::gemm_phase<pg8::EpiSwiglu, pg8::PlainSched, true>(L, S, E);
        }
        GRID_SYNC();
        {
            unsigned char* ws = WSL;
            pg8::PlainSched S; S.T.init(M / 256, D / 256, gridDim.x, blockIdx.x); S.A = (const char*)P_PROJ(ws); S.B = (const char*)(ws + WS_WDN); S.lda2 = DFF * 2; S.ldb2 = DFF * 2; S.nt = DFF / 64;
            pg8::EpiRes E{P_XC(ws), (void*)a.out, l == 1}; pg8::gemm_phase<pg8::EpiRes, pg8::PlainSched, false>(L, S, E);
        }
        GRID_SYNC();
    }
    ph_final(a.out, a.in[18]);
}

extern "C" void kernel_launch(void* const* d_in, const int* in_sizes, int n_in, void* d_out, int out_size, void* d_ws, size_t ws_size, hipStream_t stream) {
    static int grid = 0;
    if (grid == 0) {
        if (n_in != 19 || out_size != M * D || ws_size < WS_TOTAL) { fprintf(stderr, "kernel_launch: unexpected shapes (n_in %d out %d ws %zu)\n", n_in, out_size, ws_size); grid = -1; return; }
        int dev = 0, cus = 0, per_cu = 0;
        (void)hipGetDevice(&dev); (void)hipDeviceGetAttribute(&cus, hipDeviceAttributeMultiprocessorCount, dev);
        if (hipFuncSetAttribute((const void*)fwd, hipFuncAttributeMaxDynamicSharedMemorySize, LDS_BYTES) != hipSuccess) { fprintf(stderr, "kernel_launch: hipFuncSetAttribute failed\n"); grid = -1; return; }
        (void)hipOccupancyMaxActiveBlocksPerMultiprocessor(&per_cu, (const void*)fwd, NT, LDS_BYTES);
        if (per_cu < 1) { fprintf(stderr, "kernel_launch: occupancy query says 0 blocks per CU\n"); grid = -1; return; }
        grid = cus < 256 ? cus : 256;
    }
    if (grid < 0) return;
    if (hipMemsetAsync((char*)d_ws + WS_CTL, 0, CTL_ZERO_BYTES, stream) != hipSuccess) { fprintf(stderr, "kernel_launch: memset of the control words failed\n"); return; }
    Args a{};
    for (int i = 0; i < 19; ++i) a.in[i] = (const float*)d_in[i];
    a.out = (float*)d_out; a.ws = (unsigned char*)d_ws;
    hipLaunchKernelGGL(fwd, dim3(grid), dim3(NT), LDS_BYTES, stream, a);
}
```

```cpp
#include <hip/hip_runtime.h>
#include <hip/hip_cooperative_groups.h>
#include <cstdio>
#include <cstdint>
namespace cg = cooperative_groups;

#ifndef SINGLE_LAUNCH
#define SINGLE_LAUNCH 0
#endif

typedef unsigned short bf16_t;
constexpr int M = 16384, SEQ = 8192, D = 1024, DIN = 9488, NPROJ = 5376, DFF = 2816;
constexpr int NT = 512;
constexpr int INP_TILES = 20;
constexpr int PC_Z = 0, PC_XBC = 512, PC_MQ = 1536, PC_MK = 2048, PC_MV = 2560, PC_FQ = 3072, PC_FK = 3584, PC_FV = 4096, PC_SQ = 4608, PC_SK = 5120, PC_SV = 5248;
constexpr int WC_DT = 1536, WC_F = 4616, WC_GATE = 5392;
constexpr size_t MiB = 1u << 20;
constexpr size_t WS_XN = 0, WS_PROJ = 32 * MiB, WS_XC = 200 * MiB, WS_DT = 232 * MiB, WS_LF = WS_DT + MiB / 2, WS_CUM = 233 * MiB, WS_KMEAN = WS_CUM + MiB / 2;
constexpr size_t WS_WIN = 234 * MiB;
constexpr size_t WS_WG = WS_WIN + (size_t)NPROJ * D * 2;
constexpr size_t WS_WBR = WS_WG + (size_t)4096 * D * 2;
constexpr size_t WS_WOUT = WS_WBR + (size_t)4 * D * 512 * 2;
constexpr size_t WS_WGU = WS_WOUT + (size_t)D * D * 2;
constexpr size_t WS_WDN = WS_WGU + (size_t)2 * DFF * D * 2;
constexpr size_t WS_END = WS_WDN + (size_t)D * DFF * 2;
static_assert(WS_END <= 276 * MiB, "workspace map");

constexpr size_t WS_CTL = 276 * MiB, CTL_ZERO_BYTES = 65536, WS_CDEC = WS_CTL + 131072, WS_TOTAL = 294 * MiB;
constexpr size_t WS_STATES = 234 * MiB, WS_PL = WS_STATES + 8 * MiB;
constexpr size_t WS_WDTF = WS_KMEAN + 256 * 1024;
constexpr size_t WS_PO2 = 277 * MiB, WS_SEL = 293 * MiB;
#define P_XN(w) ((bf16_t*)((w) + WS_XN))
#define P_PROJ(w) ((bf16_t*)((w) + WS_PROJ))
#define P_XC(w) ((bf16_t*)((w) + WS_XC))
struct Args { const float* in[19]; float* out; unsigned char* ws; int ph_lo, ph_hi, coop, pad; };

__device__ __forceinline__ float bf2f(unsigned v) { return __uint_as_float(v << 16); }
__device__ __forceinline__ float bflo(unsigned v) { return __uint_as_float(v << 16); }
__device__ __forceinline__ float bfhi(unsigned v) { return __uint_as_float(v & 0xffff0000u); }
__device__ __forceinline__ unsigned f2bf(float f) { unsigned u = __float_as_uint(f); return (u + 0x7fffu + ((u >> 16) & 1u)) >> 16; }
__device__ __forceinline__ unsigned pk2(float lo, float hi) { return f2bf(lo) | (f2bf(hi) << 16); }
__device__ __forceinline__ float wave_sum(float v) {
#pragma unroll
    for (int o = 1; o < 64; o <<= 1) v += __shfl_xor(v, o);
    return v;
}
__device__ __forceinline__ unsigned q_ld(unsigned* p)              { return __hip_atomic_load(p, __ATOMIC_RELAXED, __HIP_MEMORY_SCOPE_AGENT); }
__device__ __forceinline__ unsigned q_add(unsigned* p, unsigned v) { return __hip_atomic_fetch_add(p, v, __ATOMIC_RELAXED, __HIP_MEMORY_SCOPE_AGENT); }
__device__ __forceinline__ int ltid() { int t = threadIdx.x; asm volatile("" : "+v"(t)); return t; }
__device__ __forceinline__ float log1p_pos(float e) {
    const float small = e * (1.f + e * (-0.5f + e * (0.33333333f + e * (-0.25f + e * 0.2f))));
    return e < 0.02f ? small : logf(1.f + e);
}
__device__ __forceinline__ float softplus_f(float x) { return fmaxf(x, 0.f) + log1p_pos(expf(-fabsf(x))); }
__device__ __forceinline__ float silu_f(float x) { return x / (1.f + expf(-x)); }
__device__ __forceinline__ float sigmoid_f(float x) { return 1.f / (1.f + expf(-x)); }
__device__ __forceinline__ int rel_bucket(int d) {
    if (d < 16) return d;
    int b = 16;
    b += (d >= 21); b += (d >= 27); b += (d >= 35); b += (d >= 46); b += (d >= 59); b += (d >= 77); b += (d >= 99); b += (d >= 128);
    b += (d >= 166); b += (d >= 216); b += (d >= 280); b += (d >= 363); b += (d >= 470); b += (d >= 609); b += (d >= 790);
    return b;
}

template <bool IN_BF16>
__device__ __forceinline__ void ph_norm(float* wd, const void* xin, const float* nw, bf16_t* XN, bool dots, const float* w_in, const float* dt_bias, const float* fbias, float* DT, float* LF, bf16_t* R0, bool grouped) {
    const int tx_ = ltid();
    const int lane = tx_ & 63, wave = tx_ >> 6;
    const int gw = blockIdx.x * 8 + wave, NGW = gridDim.x * 8;
    if (dots) {
        for (int i = tx_; i < 1024 * 4; i += NT) { const int k = i >> 2, part = i & 3;
            *(float4*)((char*)wd + (k >> 2) * 272 + (k & 3) * 64 + part * 16) = *(const float4*)(w_in + (size_t)k * DIN + (part < 2 ? WC_DT + part * 4 : WC_F + (part - 2) * 4)); }
        __syncthreads();
    }
    float4 nwv[4];
#pragma unroll
    for (int j = 0; j < 4; ++j) nwv[j] = ((const float4*)nw)[lane + 64 * j];
    const int rstart = grouped ? 2048 * (int)(blockIdx.x & 7) + 64 * (int)(blockIdx.x >> 3) + 8 * wave : gw, rstride = grouped ? 1 : NGW, rcnt = grouped ? 8 : (M - gw + NGW - 1) / NGW;
#pragma unroll 1
    for (int i0 = 0; i0 < rcnt; i0 += 4) {
    float4 vb[IN_BF16 ? 1 : 4][4]; uint2 ub[IN_BF16 ? 4 : 1][4];
#pragma unroll
    for (int k = 0; k < 4; ++k) { const int rk = rstart + (i0 + k) * rstride; if (i0 + k < rcnt) {
        if constexpr (IN_BF16) { const uint2* xr = (const uint2*)((const bf16_t*)xin + (size_t)rk * D);
#pragma unroll
            for (int j = 0; j < 4; ++j) ub[k][j] = xr[lane + 64 * j]; }
        else { const float4* xr = (const float4*)((const float*)xin + (size_t)rk * D);
#pragma unroll
            for (int j = 0; j < 4; ++j) vb[k][j] = xr[lane + 64 * j]; } } }
#pragma unroll
    for (int k = 0; k < 4; ++k) {
        const int row = rstart + (i0 + k) * rstride; if (i0 + k >= rcnt) break;
        float4 v[4]; float ss = 0.f;
#pragma unroll
        for (int j = 0; j < 4; ++j) {
            if constexpr (IN_BF16) v[j] = make_float4(bflo(ub[k][j].x), bfhi(ub[k][j].x), bflo(ub[k][j].y), bfhi(ub[k][j].y)); else v[j] = vb[k][j];
            ss += v[j].x * v[j].x + v[j].y * v[j].y + v[j].z * v[j].z + v[j].w * v[j].w; }
        if constexpr (!IN_BF16) { if (R0) { uint2* rp = (uint2*)(R0 + (size_t)row * D);
#pragma unroll
            for (int j = 0; j < 4; ++j) rp[lane + 64 * j] = make_uint2(pk2(v[j].x, v[j].y), pk2(v[j].z, v[j].w)); } }
        ss = wave_sum(ss);
        const float rstd = 1.0f / sqrtf(ss * (1.0f / D) + 1e-6f);
#pragma unroll
        for (int j = 0; j < 4; ++j) { const float4 w4 = nwv[j]; v[j].x *= rstd * w4.x; v[j].y *= rstd * w4.y; v[j].z *= rstd * w4.z; v[j].w *= rstd * w4.w; }
        uint2* o = (uint2*)(XN + (size_t)row * D);
#pragma unroll
        for (int j = 0; j < 4; ++j) o[lane + 64 * j] = make_uint2(pk2(v[j].x, v[j].y), pk2(v[j].z, v[j].w));
        if (dots) {
            float d[16];
#pragma unroll
            for (int c = 0; c < 16; ++c) d[c] = 0.f;
#pragma unroll
            for (int j = 0; j < 4; ++j) { const float hv[4] = {v[j].x, v[j].y, v[j].z, v[j].w};
#pragma unroll
                for (int e = 0; e < 4; ++e) { const float* wr = (const float*)((const char*)wd + (lane + 64 * j) * 272 + e * 64); const float h = hv[e];
                    const float4 a0 = *(const float4*)(wr), a1 = *(const float4*)(wr + 4), b0 = *(const float4*)(wr + 8), b1 = *(const float4*)(wr + 12);
                    d[0] += h * a0.x; d[1] += h * a0.y; d[2] += h * a0.z; d[3] += h * a0.w; d[4] += h * a1.x; d[5] += h * a1.y; d[6] += h * a1.z; d[7] += h * a1.w;
                    d[8] += h * b0.x; d[9] += h * b0.y; d[10] += h * b0.z; d[11] += h * b0.w; d[12] += h * b1.x; d[13] += h * b1.y; d[14] += h * b1.z; d[15] += h * b1.w; }
                asm volatile("" ::: "memory"); }
            float r8[8], r4[4], r2[2];
            { const bool up = (lane & 32) != 0;
#pragma unroll
              for (int i = 0; i < 8; ++i) { const float keep = up ? d[i + 8] : d[i], send = up ? d[i] : d[i + 8]; r8[i] = keep + __shfl_xor(send, 32); } }
            { const bool up = (lane & 16) != 0;
#pragma unroll
              for (int i = 0; i < 4; ++i) { const float keep = up ? r8[i + 4] : r8[i], send = up ? r8[i] : r8[i + 4]; r4[i] = keep + __shfl_xor(send, 16); } }
            { const bool up = (lane & 8) != 0;
#pragma unroll
              for (int i = 0; i < 2; ++i) { const float keep = up ? r4[i + 2] : r4[i], send = up ? r4[i] : r4[i + 2]; r2[i] = keep + __shfl_xor(send, 8); } }
            float mine; { const bool up = (lane & 4) != 0; const float keep = up ? r2[1] : r2[0], send = up ? r2[0] : r2[1]; mine = keep + __shfl_xor(send, 4); }
            mine += __shfl_xor(mine, 2); mine += __shfl_xor(mine, 1);
            const int col = ((lane >> 5) & 1) * 8 + ((lane >> 4) & 1) * 4 + ((lane >> 3) & 1) * 2 + ((lane >> 2) & 1);
            if ((lane & 3) == 0) { if (col < 8) DT[(size_t)row * 8 + col] = softplus_f(mine + dt_bias[col]); else LF[(size_t)row * 8 + (col - 8)] = -softplus_f(-(mine + fbias[col - 8])); }
        }
    }    }
}

namespace pg8 {
#define PG8_LAS __attribute__((address_space(3)))
typedef short bf16x8 __attribute__((ext_vector_type(8)));
typedef float f32x4 __attribute__((ext_vector_type(4)));
typedef unsigned u32x4 __attribute__((ext_vector_type(4)));
constexpr int BM = 256, BK = 64, HALF = 128, HTB = HALF * BK * 2, STAGE_BYTES = 8 * HTB, NXCD = 8, WGM = 8;
__host__ __device__ __forceinline__ int lds_byte(int r, int c) { const int st = (r >> 4) * 2 + (c >> 5), rr = r & 15, cc = c & 31, ob = rr * 64 + cc * 2; return st * 1024 + (ob ^ (((ob >> 9) & 1) << 5)); }
__host__ __device__ __forceinline__ void stage_rc(int b, int& R, int& C) { const int st = b / 1024, sb = b % 1024, swz = sb ^ (((sb >> 9) & 1) << 5); R = (st >> 1) * 16 + swz / 64; C = (st & 1) * 32 + (swz % 64) / 2; }
__host__ __device__ __forceinline__ int perm32(int rho) { const int n = rho >> 4, i = rho & 15; return 8 * (i >> 2) + 4 * n + (i & 3); }
struct Unit { const char* A; const char* B; unsigned lda2, ldb2; int nt, pm, pn, aux; };
struct TileOrder {
    int nM, nN, nwg, G, c;
    __device__ void init(int nM_, int nN_, int G_, int c_) { nM = nM_; nN = nN_; nwg = nM * nN; G = G_; c = c_; }
    __device__ bool tile(int i, int& pm, int& pn) const {
        const long L = (long)i * G + c; if (L >= nwg) return false;
        int wgid = (int)L; { const int q = nwg / NXCD, r = nwg % NXCD, xcd = wgid % NXCD, off = wgid / NXCD; wgid = (xcd < r ? xcd * (q + 1) : r * (q + 1) + (xcd - r) * q) + off; }
        const int nig = WGM * nN, gid = wgid / nig, fm = gid * WGM, gsz = (nM - fm) < WGM ? (nM - fm) : WGM;
        pm = fm + ((wgid % nig) % gsz); pn = (wgid % nig) / gsz; return true;
    }
};
typedef float f32x2_t __attribute__((ext_vector_type(2))); typedef __bf16 bf16x2_t __attribute__((ext_vector_type(2)));
__device__ __forceinline__ unsigned cvt_pk_bf16(float lo, float hi) { f32x2_t v = {lo, hi}; bf16x2_t b = __builtin_convertvector(v, bf16x2_t); return __builtin_bit_cast(unsigned, b); }

template <class Epi, class Sched, bool ALIGN_EPI>
__device__ __forceinline__ void gemm_phase(PG8_LAS unsigned char* lds, const Sched& S, const Epi& E) {
    int tid = threadIdx.x; asm volatile("" : "+v"(tid));
    const int wid = __builtin_amdgcn_readfirstlane(tid >> 6), lane = tid & 63, wr = wid >> 2, wc = wid & 3, fr = lane & 15, fq = lane >> 4;
    unsigned RA[2], RB[2], C2[2];
#pragma unroll
    for (int i = 0; i < 2; ++i) { int R, C; stage_rc(tid * 16 + i * 8192, R, C); RA[i] = (unsigned)R; RB[i] = (unsigned)(Epi::PERM ? ((R & ~31) + perm32(R & 31)) : R); C2[i] = (unsigned)(C * 2); }
    const unsigned ldsw = (unsigned)wid * 1024u;
    const int aoff = lds_byte(wr * 64 + fr, fq * 8), boff = lds_byte(wc * 32 + fr, fq * 8);
#define PG8_SA(b, h) (((b) * 2 + (h)) * HTB)
#define PG8_SB(b, h) ((4 + (b) * 2 + (h)) * HTB)
#define PG8_STAGE(bufoff, gbase, RR, pitch) do { _Pragma("unroll") for (int _i = 0; _i < 2; ++_i) \
        __builtin_amdgcn_global_load_lds((const unsigned*)((const char*)(gbase) + (RR[_i] * (pitch) + C2[_i])), (PG8_LAS unsigned*)(lds + (bufoff) + ldsw + _i * 8192), 16, 0, 0); } while (0)
#define PG8_LDA(dst, b, h) do { _Pragma("unroll") for (int m = 0; m < 4; ++m) _Pragma("unroll") for (int k = 0; k < 2; ++k) dst[m][k] = *(const PG8_LAS bf16x8*)(lds + PG8_SA(b, h) + aoff + m * 2048 + k * 1024); } while (0)
#define PG8_LDB(dst, b, h) do { _Pragma("unroll") for (int n = 0; n < 2; ++n) _Pragma("unroll") for (int k = 0; k < 2; ++k) dst[n][k] = *(const PG8_LAS bf16x8*)(lds + PG8_SB(b, h) + boff + n * 2048 + k * 1024); } while (0)
#define PG8_MMA(ai, bj, At, Bt) do { __builtin_amdgcn_s_setprio(1); _Pragma("unroll") for (int m = 0; m < 4; ++m) _Pragma("unroll") for (int n = 0; n < 2; ++n) _Pragma("unroll") for (int k = 0; k < 2; ++k) \
        acc[ai][bj][m][n] = __builtin_amdgcn_mfma_f32_16x16x32_bf16(Bt[n][k], At[m][k], acc[ai][bj][m][n], 0, 0, 0); __builtin_amdgcn_s_setprio(0); } while (0)
#define PG8_WAIT_V(n) asm volatile("s_waitcnt vmcnt(" #n ")" ::: "memory")
#define PG8_WAIT_L(n) asm volatile("s_waitcnt lgkmcnt(" #n ")" ::: "memory")
#define PG8_BAR __builtin_amdgcn_s_barrier()
#define PG8_SCHED __builtin_amdgcn_sched_barrier(0)
#define PG8_ZERO() do { _Pragma("unroll") for (int a_ = 0; a_ < 2; ++a_) _Pragma("unroll") for (int b_ = 0; b_ < 2; ++b_) _Pragma("unroll") for (int m_ = 0; m_ < 4; ++m_) _Pragma("unroll") for (int n_ = 0; n_ < 2; ++n_) acc[a_][b_][m_][n_] = (f32x4){0.f, 0.f, 0.f, 0.f}; } while (0)
    Unit cur, nxt; int ui = 0;
    if (!S.next(0, cur)) return;
    f32x4 acc[2][2][4][2];
    PG8_ZERO();
    bf16x8 At[4][2], B0[2][2], B1[2][2];
    const char* cA = cur.A; const char* cB = cur.B; unsigned pAc = cur.lda2, pBc = cur.ldb2; int ntc = cur.nt;
    const unsigned kstep = BK * 2;
    {
        const size_t hA = (size_t)HALF * pAc, hB = (size_t)HALF * pBc;
        PG8_STAGE(PG8_SB(0, 0), cB, RB, pBc); PG8_STAGE(PG8_SB(0, 1), cB + hB, RB, pBc); PG8_STAGE(PG8_SA(0, 0), cA, RA, pAc); PG8_STAGE(PG8_SA(0, 1), cA + hA, RA, pAc);
        if (wr == 1) PG8_BAR;
        PG8_WAIT_V(2); PG8_BAR;
        PG8_STAGE(PG8_SB(1, 0), cB + kstep, RB, pBc); PG8_STAGE(PG8_SA(1, 0), cA + kstep, RA, pAc); PG8_STAGE(PG8_SB(1, 1), cB + hB + kstep, RB, pBc);
        PG8_WAIT_V(6); PG8_BAR;
    }
    for (;;) {
        const bool has_next = S.next(ui + 1, nxt);
        const char* nA = has_next ? nxt.A : cA; const char* nB = has_next ? nxt.B : cB;
        const unsigned pAn = has_next ? nxt.lda2 : pAc, pBn = has_next ? nxt.ldb2 : pBc;
        const size_t hAc = (size_t)HALF * pAc;
        for (int t = 0; t < ntc; t += 2) {
            const bool last = (t == ntc - 2);
            const char* a1 = cA + (size_t)(t + 1) * kstep;
            const char* a2 = last ? nA : cA + (size_t)(t + 2) * kstep; const char* b2 = last ? nB : cB + (size_t)(t + 2) * kstep;
            const char* a3 = a2 + kstep; const char* b3 = b2 + kstep;
            const unsigned pA2 = last ? pAn : pAc, pB2 = last ? pBn : pBc;
            const size_t hA2 = (size_t)HALF * pA2, hB2 = (size_t)HALF * pB2;
            PG8_LDB(B0, 0, 0); PG8_LDB(B1, 0, 1); PG8_SCHED; PG8_LDA(At, 0, 0); PG8_STAGE(PG8_SA(1, 1), a1 + hAc, RA, pAc);
            PG8_WAIT_V(8); PG8_WAIT_L(0); PG8_BAR; PG8_MMA(0, 0, At, B0); PG8_MMA(0, 1, At, B1); PG8_BAR; PG8_SCHED;
            PG8_LDA(At, 0, 1); PG8_STAGE(PG8_SB(0, 0), b2, RB, pB2); PG8_STAGE(PG8_SB(0, 1), b2 + hB2, RB, pB2); PG8_STAGE(PG8_SA(0, 0), a2, RA, pA2);
            PG8_WAIT_V(8); PG8_WAIT_L(0); PG8_BAR; PG8_MMA(1, 0, At, B0); PG8_MMA(1, 1, At, B1); PG8_BAR; PG8_SCHED;
            PG8_LDB(B0, 1, 0); PG8_LDB(B1, 1, 1); PG8_SCHED; PG8_LDA(At, 1, 0); PG8_STAGE(PG8_SA(0, 1), a2 + hA2, RA, pA2);
            PG8_WAIT_V(8); PG8_WAIT_L(0); PG8_BAR; PG8_MMA(0, 0, At, B0); PG8_MMA(0, 1, At, B1); PG8_BAR; PG8_SCHED;
            PG8_LDA(At, 1, 1); PG8_STAGE(PG8_SB(1, 0), b3, RB, pB2); PG8_STAGE(PG8_SB(1, 1), b3 + hB2, RB, pB2); PG8_STAGE(PG8_SA(1, 0), a3, RA, pA2);
            PG8_WAIT_V(8); PG8_WAIT_L(0); PG8_BAR; PG8_MMA(1, 0, At, B0); PG8_MMA(1, 1, At, B1); PG8_BAR; PG8_SCHED;
        }
        if constexpr (ALIGN_EPI) { if (wr == 0) PG8_BAR; }
        { int fr_ = fr, fq_ = fq; asm volatile("" : "+v"(fr_), "+v"(fq_)); E(acc, cur, wr, wc, fr_, fq_); }
        if (!has_next) break;
        PG8_ZERO();
        cur = nxt; cA = nA; cB = nB; pAc = pAn; pBc = pBn; ntc = nxt.nt; ++ui;
        if constexpr (ALIGN_EPI) { if (wr == 1) PG8_BAR; }
    }
    PG8_WAIT_V(0);
    if constexpr (!ALIGN_EPI) { if (wr == 0) PG8_BAR; }
    PG8_BAR;
#undef PG8_SA
#undef PG8_SB
#undef PG8_STAGE
#undef PG8_LDA
#undef PG8_LDB
#undef PG8_MMA
#undef PG8_WAIT_V
#undef PG8_WAIT_L
#undef PG8_BAR
#undef PG8_SCHED
#undef PG8_ZERO
}

struct PlainSched {
    TileOrder T; const char* A; const char* B; unsigned lda2, ldb2; int nt;
    __device__ bool next(int i, Unit& u) const { int pm, pn; if (!T.tile(i, pm, pn)) return false;
        u.A = A + (size_t)pm * 256 * lda2; u.B = B + (size_t)pn * 256 * ldb2; u.lda2 = lda2; u.ldb2 = ldb2; u.nt = nt; u.pm = pm; u.pn = pn; u.aux = 0; return true; }
};
struct OneSched { Unit u0; __device__ bool next(int i, Unit& u) const { if (i != 0) return false; u = u0; return true; } };
struct EpiStoreBf16 {
    static constexpr bool PERM = true;
    bf16_t* O; int ldc;
    __device__ __forceinline__ void operator()(const f32x4 (&acc)[2][2][4][2], const Unit& u, int wr, int wc, int fr, int fq) const {
        const int row0 = u.pm * BM + wr * 64 + fr, col0 = u.pn * BM + wc * 32 + 8 * fq;
#pragma unroll
        for (int ai = 0; ai < 2; ++ai)
#pragma unroll
            for (int m = 0; m < 4; ++m) { bf16_t* rowp = O + (size_t)(row0 + ai * HALF + m * 16) * ldc + col0;
#pragma unroll
                for (int bj = 0; bj < 2; ++bj) { const f32x4 v0 = acc[ai][bj][m][0], v1 = acc[ai][bj][m][1];
                    u32x4 w; w.x = cvt_pk_bf16(v0[0], v0[1]); w.y = cvt_pk_bf16(v0[2], v0[3]); w.z = cvt_pk_bf16(v1[0], v1[1]); w.w = cvt_pk_bf16(v1[2], v1[3]);
                    *(u32x4*)(rowp + bj * HALF) = w; } }
    }
};
__device__ __forceinline__ float fast_sigmoid(float x) { return __builtin_amdgcn_rcpf(1.f + __expf(-x)); }
struct EpiSwiglu {
    static constexpr bool PERM = true;
    bf16_t* H; int ldh;
    __device__ __forceinline__ void operator()(const f32x4 (&acc)[2][2][4][2], const Unit& u, int wr, int wc, int fr, int fq) const {
        const int row0 = u.pm * BM + wr * 64 + fr, col0 = u.pn * HALF + wc * 32 + 8 * fq;
#pragma unroll
        for (int ai = 0; ai < 2; ++ai)
#pragma unroll
            for (int m = 0; m < 4; ++m) { float v[8];
#pragma unroll
                for (int n = 0; n < 2; ++n)
#pragma unroll
                    for (int e = 0; e < 4; ++e) { const float g = acc[ai][0][m][n][e], up = acc[ai][1][m][n][e]; v[n * 4 + e] = g * fast_sigmoid(g) * up; }
                u32x4 w; w.x = cvt_pk_bf16(v[0], v[1]); w.y = cvt_pk_bf16(v[2], v[3]); w.z = cvt_pk_bf16(v[4], v[5]); w.w = cvt_pk_bf16(v[6], v[7]);
                *(u32x4*)(H + (size_t)(row0 + ai * HALF + m * 16) * ldh + col0) = w; }
    }
};
struct EpiRes {
    static constexpr bool PERM = true;
    const bf16_t* res; void* out; bool out_f32;
    __device__ __forceinline__ void operator()(const f32x4 (&acc)[2][2][4][2], const Unit& u, int wr, int wc, int fr, int fq) const {
        const int row0 = u.pm * BM + wr * 64 + fr, col0 = u.pn * BM + wc * 32 + 8 * fq;
#pragma unroll
        for (int gb = 0; gb < 16; gb += 8) {
            u32x4 r[8];
#pragma unroll
            for (int k = 0; k < 8; ++k) { const int i = gb + k, ai = i >> 3, m = (i >> 1) & 3, bj = i & 1; r[k] = *(const u32x4*)(res + (size_t)(row0 + ai * HALF + m * 16) * D + col0 + bj * HALF); }
#pragma unroll
            for (int k = 0; k < 8; ++k) { const int i = gb + k, ai = i >> 3, m = (i >> 1) & 3, bj = i & 1; const size_t off = (size_t)(row0 + ai * HALF + m * 16) * D + col0 + bj * HALF;
                f32x4 p0 = acc[ai][bj][m][0], p1 = acc[ai][bj][m][1];
                p0[0] += bflo(r[k].x); p0[1] += bfhi(r[k].x); p0[2] += bflo(r[k].y); p0[3] += bfhi(r[k].y); p1[0] += bflo(r[k].z); p1[1] += bfhi(r[k].z); p1[2] += bflo(r[k].w); p1[3] += bfhi(r[k].w);
                if (out_f32) { *(f32x4*)((float*)out + off) = p0; *(f32x4*)((float*)out + off + 4) = p1; }
                else { u32x4 w; w.x = cvt_pk_bf16(p0[0], p0[1]); w.y = cvt_pk_bf16(p0[2], p0[3]); w.z = cvt_pk_bf16(p1[0], p1[1]); w.w = cvt_pk_bf16(p1[2], p1[3]); *(u32x4*)((bf16_t*)out + off) = w; } }
            asm volatile("" ::: "memory");
        }
    }
};
struct EpiGate {
    static constexpr bool PERM = true;
    bf16_t* PROJ; bf16_t* XC;
    __device__ __forceinline__ void operator()(const f32x4 (&acc)[2][2][4][2], const Unit& u, int wr, int wc, int fr, int fq) const {
        const int br = u.pn >> 2, row0 = u.pm * BM + wr * 64 + fr, col0 = (u.pn & 3) * BM + wc * 32 + 8 * fq;
        bf16_t* base = br < 3 ? PROJ + 512 + 1536 * br : XC;
        const int ld = br < 3 ? NPROJ : 1024;
#pragma unroll
        for (int ai = 0; ai < 2; ++ai)
#pragma unroll
            for (int m = 0; m < 4; ++m) { bf16_t* rowp = base + (size_t)(row0 + ai * HALF + m * 16) * ld + col0;
#pragma unroll
                for (int bj = 0; bj < 2; ++bj) { const f32x4 v0 = acc[ai][bj][m][0], v1 = acc[ai][bj][m][1];
                    u32x4 w; w.x = cvt_pk_bf16(fast_sigmoid(v0[0]), fast_sigmoid(v0[1])); w.y = cvt_pk_bf16(fast_sigmoid(v0[2]), fast_sigmoid(v0[3]));
                    w.z = cvt_pk_bf16(fast_sigmoid(v1[0]), fast_sigmoid(v1[1])); w.w = cvt_pk_bf16(fast_sigmoid(v1[2]), fast_sigmoid(v1[3]));
                    *(u32x4*)(rowp + bj * HALF) = w; } }
    }
};
struct BranchSched {
    TileOrder T; const char* PROJ; const char* WBR;
    __device__ bool next(int i, Unit& u) const { int pm, pn; if (!T.tile(i >> 2, pm, pn)) return false;
        const int br = i & 3; u.pm = pm; u.pn = pn; u.aux = br;
        u.A = PROJ + (size_t)pm * 256 * (NPROJ * 2) + 1536 * 2 * br; u.lda2 = NPROJ * 2; u.B = WBR + ((size_t)br * 1024 + pn * 256) * (512 * 2); u.ldb2 = 512 * 2; u.nt = 512 / 64; return true; }
};
struct EpiBranch {
    static constexpr bool PERM = true;
    const bf16_t* PROJ; const bf16_t* XC; bf16_t* MIX;
    __device__ __forceinline__ void operator()(const f32x4 (&acc)[2][2][4][2], const Unit& u, int wr, int wc, int fr, int fq) const {
        const int br = u.aux, row0 = u.pm * BM + wr * 64 + fr, col0 = u.pn * BM + wc * 32 + 8 * fq;
        const bf16_t* G = br < 3 ? PROJ + 512 + 1536 * br : XC; const int ldg = br < 3 ? NPROJ : 1024;
        if (br == 0) run<true>(acc, G, ldg, row0, col0); else run<false>(acc, G, ldg, row0, col0);
    }
    template <bool FIRST>
    __device__ __forceinline__ void run(const f32x4 (&acc)[2][2][4][2], const bf16_t* G, int ldg, int row0, int col0) const {
#pragma unroll
        for (int gb = 0; gb < 16; gb += 4) {
            u32x4 g[4], o[4];
#pragma unroll
            for (int k = 0; k < 4; ++k) { const int i = gb + k, ai = i >> 3, m = (i >> 1) & 3, bj = i & 1; const size_t row = (size_t)(row0 + ai * HALF + m * 16);
                g[k] = *(const u32x4*)(G + row * ldg + col0 + bj * HALF); if (!FIRST) o[k] = *(const u32x4*)(MIX + row * D + col0 + bj * HALF); }
#pragma unroll
            for (int k = 0; k < 4; ++k) { const int i = gb + k, ai = i >> 3, m = (i >> 1) & 3, bj = i & 1; const size_t row = (size_t)(row0 + ai * HALF + m * 16);
                f32x4 p0 = acc[ai][bj][m][0], p1 = acc[ai][bj][m][1];
                p0[0] *= bflo(g[k].x); p0[1] *= bfhi(g[k].x); p0[2] *= bflo(g[k].y); p0[3] *= bfhi(g[k].y); p1[0] *= bflo(g[k].z); p1[1] *= bfhi(g[k].z); p1[2] *= bflo(g[k].w); p1[3] *= bfhi(g[k].w);
                if (!FIRST) { p0[0] += bflo(o[k].x); p0[1] += bfhi(o[k].x); p0[2] += bflo(o[k].y); p0[3] += bfhi(o[k].y); p1[0] += bflo(o[k].z); p1[1] += bfhi(o[k].z); p1[2] += bflo(o[k].w); p1[3] += bfhi(o[k].w); }
                u32x4 w; w.x = cvt_pk_bf16(p0[0], p0[1]); w.y = cvt_pk_bf16(p0[2], p0[3]); w.z = cvt_pk_bf16(p1[0], p1[1]); w.w = cvt_pk_bf16(p1[2], p1[3]);
                *(u32x4*)(MIX + row * D + col0 + bj * HALF) = w; }
            asm volatile("" ::: "memory");
        }
    }
};
struct GBSched {
    TileOrder T; const char* XN; const char* WG; const char* PROJ; const char* WBR;
    __device__ bool next(int i, Unit& u) const { int pm, pn; if (!T.tile(i >> 3, pm, pn)) return false;
        const int sub = i & 7, br = sub >> 1; u.pm = pm; u.pn = pn; u.aux = sub;
        if ((sub & 1) == 0) { u.A = XN + (size_t)pm * 256 * (D * 2); u.lda2 = D * 2; u.B = WG + ((size_t)br * 1024 + pn * 256) * (D * 2); u.ldb2 = D * 2; u.nt = D / 64; }
        else { u.A = PROJ + (size_t)pm * 256 * (NPROJ * 2) + 1536 * 2 * br; u.lda2 = NPROJ * 2; u.B = WBR + ((size_t)br * 1024 + pn * 256) * (512 * 2); u.ldb2 = 512 * 2; u.nt = 512 / 64; }
        return true; }
};
struct EpiGB {
    static constexpr bool PERM = true;
    bf16_t* PROJ; bf16_t* XC; bf16_t* MIX;
    __device__ __forceinline__ void operator()(const f32x4 (&acc)[2][2][4][2], const Unit& u, int wr, int wc, int fr, int fq) const {
        const int br = u.aux >> 1, row0 = u.pm * BM + wr * 64 + fr, col0 = u.pn * BM + wc * 32 + 8 * fq;
        bf16_t* G = br < 3 ? PROJ + 512 + 1536 * br : XC; const int ldg = br < 3 ? NPROJ : 1024;
        if ((u.aux & 1) == 0) {
#pragma unroll
            for (int ai = 0; ai < 2; ++ai)
#pragma unroll
                for (int m = 0; m < 4; ++m) { bf16_t* rowp = G + (size_t)(row0 + ai * HALF + m * 16) * ldg + col0;
#pragma unroll
                    for (int bj = 0; bj < 2; ++bj) { const f32x4 v0 = acc[ai][bj][m][0], v1 = acc[ai][bj][m][1];
                        u32x4 w; w.x = cvt_pk_bf16(fast_sigmoid(v0[0]), fast_sigmoid(v0[1])); w.y = cvt_pk_bf16(fast_sigmoid(v0[2]), fast_sigmoid(v0[3]));
                        w.z = cvt_pk_bf16(fast_sigmoid(v1[0]), fast_sigmoid(v1[1])); w.w = cvt_pk_bf16(fast_sigmoid(v1[2]), fast_sigmoid(v1[3]));
                        *(u32x4*)(rowp + bj * HALF) = w; } }
        } else { EpiBranch B{PROJ, XC, MIX}; if (br == 0) B.run<true>(acc, G, ldg, row0, col0); else B.run<false>(acc, G, ldg, row0, col0); }
    }
};
}

#define LAS __attribute__((address_space(3)))
struct WtDesc { const float* src; bf16_t* dst; int ldw, ldwt; };
struct WtRegs { float4 v[8]; };
__device__ __forceinline__ void wt_load(const WtDesc& d, WtRegs& r, int lane) {
#pragma unroll
    for (int i = 0; i < 8; ++i) r.v[i] = *(const float4*)(d.src + (size_t)(4 * i + (lane >> 4)) * d.ldw + (lane & 15) * 4);
}
__device__ __forceinline__ void wt_finish(const WtDesc& d, const WtRegs& r, LAS float* scr, int lane) {
#pragma unroll
    for (int i = 0; i < 8; ++i) { const int k = 4 * i + (lane >> 4), n4 = (lane & 15) * 4;
        LAS float* p = scr + k * 65 + n4; p[0] = r.v[i].x; p[1] = r.v[i].y; p[2] = r.v[i].z; p[3] = r.v[i].w; }
    asm volatile("s_waitcnt lgkmcnt(0)" ::: "memory");
    unsigned w[16];
#pragma unroll
    for (int j = 0; j < 16; ++j) w[j] = pg8::cvt_pk_bf16(scr[(2 * j) * 65 + lane], scr[(2 * j + 1) * 65 + lane]);
    uint4* o = (uint4*)(d.dst + (size_t)lane * d.ldwt);
#pragma unroll
    for (int j = 0; j < 4; ++j) o[j] = make_uint4(w[4 * j], w[4 * j + 1], w[4 * j + 2], w[4 * j + 3]);
    asm volatile("s_waitcnt lgkmcnt(0)" ::: "memory");
}
constexpr int WCV_IN = 32 * (NPROJ / 64), WCV_ALL = WCV_IN + 32 * 64 + 4 * 16 * 16 + 32 * 16 + 32 * (2 * DFF / 64) + (DFF / 32) * 16, WCV_CHUNK = 16;
__device__ __forceinline__ WtDesc wt_decode(int r, unsigned char* ws, const float* w_in, const float* w_branch, const float* w_out, const float* w_gate, const float* w_up, const float* w_down) {
    constexpr int I_IN = 32 * (NPROJ / 64), I_G = 32 * 64, I_BR = 4 * 16 * 16, I_OUT = 32 * 16, I_GU = 32 * (2 * DFF / 64), I_DN = (DFF / 32) * 16;
    static_assert(I_IN + I_G + I_BR + I_OUT + I_GU + I_DN == WCV_ALL && (WCV_ALL - WCV_IN) % WCV_CHUNK == 0, "conversion list");
    WtDesc d;
    if (r < I_IN) { const int nb = r % (NPROJ / 64), kb = r / (NPROJ / 64), c0 = nb * 64;
        d.src = w_in + (size_t)(kb * 32) * DIN + c0 + (c0 >= 1536 ? 8 : 0) + (c0 >= 4608 ? 8 : 0); d.ldw = DIN; d.dst = (bf16_t*)(ws + WS_WIN) + (size_t)c0 * D + kb * 32; d.ldwt = D; return d; } r -= I_IN;
    if (r < I_G) { const int nb = r % 64, kb = r / 64; d.src = w_in + (size_t)(kb * 32) * DIN + WC_GATE + nb * 64; d.ldw = DIN; d.dst = (bf16_t*)(ws + WS_WG) + (size_t)(nb * 64) * D + kb * 32; d.ldwt = D; return d; } r -= I_G;
    if (r < I_BR) { const int br = r / 256, q = r % 256, nb = q % 16, kb = q / 16;
        d.src = w_branch + (size_t)br * 512 * 1024 + (size_t)(kb * 32) * D + nb * 64; d.ldw = D; d.dst = (bf16_t*)(ws + WS_WBR) + (size_t)br * 1024 * 512 + (size_t)(nb * 64) * 512 + kb * 32; d.ldwt = 512; return d; } r -= I_BR;
    if (r < I_OUT) { const int nb = r % 16, kb = r / 16; d.src = w_out + (size_t)(kb * 32) * D + nb * 64; d.ldw = D; d.dst = (bf16_t*)(ws + WS_WOUT) + (size_t)(nb * 64) * D + kb * 32; d.ldwt = D; return d; } r -= I_OUT;
    if (r < I_GU) { const int nb = r % (2 * DFF / 64), kb = r / (2 * DFF / 64), r0 = nb * 64, t = r0 >> 8, j = r0 & 255;
        d.src = (j < 128 ? w_gate : w_up) + (size_t)(kb * 32) * DFF + t * 128 + (j & 127); d.ldw = DFF; d.dst = (bf16_t*)(ws + WS_WGU) + (size_t)r0 * D + kb * 32; d.ldwt = D; return d; } r -= I_GU;
    { const int nb = r % 16, kb = r / 16; d.src = w_down + (size_t)(kb * 32) * D + nb * 64; d.ldw = D; d.dst = (bf16_t*)(ws + WS_WDN) + (size_t)(nb * 64) * DFF + kb * 32; d.ldwt = DFF; return d; }
}
__device__ __forceinline__ void ph_wconv(unsigned char* ws, const float* w_in, const float* w_branch, const float* w_out, const float* w_gate, const float* w_up, const float* w_down, LAS float* scr_base,
                                         int lo, int hi, int first, int stride) {
    const int tx_ = ltid();
    const int lane = tx_ & 63, wave = tx_ >> 6;
    LAS float* scr = scr_base + wave * (32 * 65);
    int it = lo + first * 8 + wave;
    if (it >= hi) return;
    WtDesc dc = wt_decode(it, ws, w_in, w_branch, w_out, w_gate, w_up, w_down); WtRegs rc; wt_load(dc, rc, lane);
    for (;;) {
        const int itn = it + stride * 8; const bool more = itn < hi;
        WtDesc dn = dc; WtRegs rn;
        if (more) { dn = wt_decode(itn, ws, w_in, w_branch, w_out, w_gate, w_up, w_down); wt_load(dn, rn, lane); }
        wt_finish(dc, rc, scr, lane);
        if (!more) break;
        dc = dn; rc = rn; it = itn;
    }
}

__device__ __forceinline__ float silu_fast(float x) { return x * __builtin_amdgcn_rcpf(1.f + __expf(-x)); }
__device__ __forceinline__ void ph_pre(unsigned char* lds, const bf16_t* PROJ, const float* conv_w, const float* conv_b, bf16_t* XC, float* KMEAN, float* KMAXP,
                                       const bf16_t* XN, const bf16_t* WDTF, const float* dt_bias, const float* fbias, float* DT, float* LF) {
    const int tx_ = ltid();
    const int lane = tx_ & 63, gw = blockIdx.x * 8 + (tx_ >> 6), NGW = gridDim.x * 8;
    int* smax = (int*)lds;
    if (tx_ < 16) smax[tx_] = 0;
    for (int it = gw; it < (M / 16) * 2; it += NGW) {
        const int r0 = (it >> 1) * 16, c8 = (it & 1) * 512 + lane * 8;
        const bool head = (r0 & (SEQ - 1)) == 0;
        uint4 xr[19];
        const bf16_t* src = PROJ + (size_t)r0 * NPROJ + PC_XBC + c8;
#pragma unroll
        for (int j = 0; j < 3; ++j) xr[j] = head ? make_uint4(0u, 0u, 0u, 0u) : *(const uint4*)(src + (ptrdiff_t)(j - 3) * NPROJ);
#pragma unroll
        for (int j = 3; j < 19; ++j) xr[j] = *(const uint4*)(src + (size_t)(j - 3) * NPROJ);
        float w[4][8], b[8];
#pragma unroll
        for (int i = 0; i < 4; ++i) { const float4 w0 = *(const float4*)(conv_w + i * 1024 + c8), w1 = *(const float4*)(conv_w + i * 1024 + c8 + 4);
            w[i][0] = w0.x; w[i][1] = w0.y; w[i][2] = w0.z; w[i][3] = w0.w; w[i][4] = w1.x; w[i][5] = w1.y; w[i][6] = w1.z; w[i][7] = w1.w; }
        { const float4 b0 = *(const float4*)(conv_b + c8), b1 = *(const float4*)(conv_b + c8 + 4); b[0] = b0.x; b[1] = b0.y; b[2] = b0.z; b[3] = b0.w; b[4] = b1.x; b[5] = b1.y; b[6] = b1.z; b[7] = b1.w; }
        bf16_t* dst = XC + (size_t)r0 * 1024 + c8;
#pragma unroll
        for (int j = 0; j < 16; ++j) {
            float acc[8];
#pragma unroll
            for (int c = 0; c < 8; ++c) acc[c] = b[c];
#pragma unroll
            for (int i = 0; i < 4; ++i) { const uint4 u = xr[j + i];
                acc[0] += w[i][0] * bflo(u.x); acc[1] += w[i][1] * bfhi(u.x); acc[2] += w[i][2] * bflo(u.y); acc[3] += w[i][3] * bfhi(u.y);
                acc[4] += w[i][4] * bflo(u.z); acc[5] += w[i][5] * bfhi(u.z); acc[6] += w[i][6] * bflo(u.w); acc[7] += w[i][7] * bfhi(u.w); }
            uint4 o; o.x = pk2(silu_fast(acc[0]), silu_fast(acc[1])); o.y = pk2(silu_fast(acc[2]), silu_fast(acc[3])); o.z = pk2(silu_fast(acc[4]), silu_fast(acc[5])); o.w = pk2(silu_fast(acc[6]), silu_fast(acc[7]));
            *(uint4*)(dst + (size_t)j * 1024) = o;
        }
    }
    for (int it = gw >> 1; (gw & 1) == 0 && it < M / 16; it += NGW >> 1) {
        const int rl = lane & 15, kq = lane >> 4;
        const bf16_t* xp = XN + (size_t)(it * 16 + rl) * D + 8 * kq; const bf16_t* wp = WDTF + (size_t)rl * D + 8 * kq;
        pg8::f32x4 acc = {0.f, 0.f, 0.f, 0.f};
        pg8::bf16x8 xa[32];
#pragma unroll
        for (int i = 0; i < 32; ++i) xa[i] = *(const pg8::bf16x8*)(xp + 32 * i);
#pragma unroll
        for (int s0 = 0; s0 < 32; s0 += 8) {
            pg8::bf16x8 wa[8];
#pragma unroll
            for (int i = 0; i < 8; ++i) wa[i] = *(const pg8::bf16x8*)(wp + 32 * (s0 + i));
#pragma unroll
            for (int i = 0; i < 8; ++i) acc = __builtin_amdgcn_mfma_f32_16x16x32_bf16(wa[i], xa[s0 + i], acc, 0, 0, 0);
        }
        const int row = it * 16 + rl;
        if (kq < 2) { const float4 bb = *(const float4*)(dt_bias + 4 * kq);
            *(float4*)(DT + (size_t)row * 8 + 4 * kq) = make_float4(softplus_f(acc[0] + bb.x), softplus_f(acc[1] + bb.y), softplus_f(acc[2] + bb.z), softplus_f(acc[3] + bb.w)); }
        else { const float4 bb = *(const float4*)(fbias + 4 * (kq - 2));
            *(float4*)(LF + (size_t)row * 8 + 4 * (kq - 2)) = make_float4(-softplus_f(-(acc[0] + bb.x)), -softplus_f(-(acc[1] + bb.y)), -softplus_f(-(acc[2] + bb.z)), -softplus_f(-(acc[3] + bb.w))); }
    }
    for (int it = gw >> 1; (gw & 1) == 1 && it < 64 * 16; it += NGW >> 1) {
        const int bb = it >> 4, cg = it & 15, rr = lane >> 2, c8 = cg * 32 + (lane & 3) * 8;
        uint4 u[16];
#pragma unroll
        for (int st = 0; st < 16; ++st) u[st] = *(const uint4*)(PROJ + ((size_t)bb * 256 + st * 16 + rr) * NPROJ + PC_MK + c8);
        float sm[8];
#pragma unroll
        for (int j = 0; j < 8; ++j) sm[j] = 0.f;
#pragma unroll
        for (int st = 0; st < 16; ++st) { sm[0] += bflo(u[st].x); sm[1] += bfhi(u[st].x); sm[2] += bflo(u[st].y); sm[3] += bfhi(u[st].y); sm[4] += bflo(u[st].z); sm[5] += bfhi(u[st].z); sm[6] += bflo(u[st].w); sm[7] += bfhi(u[st].w); }
#pragma unroll
        for (int j = 0; j < 8; ++j) { sm[j] += __shfl_xor(sm[j], 4); sm[j] += __shfl_xor(sm[j], 8); sm[j] += __shfl_xor(sm[j], 16); sm[j] += __shfl_xor(sm[j], 32); }
        if (lane < 4) { float* kp = KMEAN + (size_t)bb * 512 + c8;
            *(float4*)kp = make_float4(sm[0] * (1.0f / 256.0f), sm[1] * (1.0f / 256.0f), sm[2] * (1.0f / 256.0f), sm[3] * (1.0f / 256.0f));
            *(float4*)(kp + 4) = make_float4(sm[4] * (1.0f / 256.0f), sm[5] * (1.0f / 256.0f), sm[6] * (1.0f / 256.0f), sm[7] * (1.0f / 256.0f)); }
    }
    {
        const size_t gt = (size_t)blockIdx.x * NT + tx_, tot = (size_t)gridDim.x * NT;
        __syncthreads();
        for (size_t e = gt; e < (size_t)M * 8; e += tot) { const int row = (int)(e >> 3), h = (int)(e & 7);
            const bf16_t* kp = PROJ + (size_t)row * NPROJ + PC_FK + h * 64; float n2 = 0.f;
#pragma unroll
            for (int c = 0; c < 8; ++c) { const uint4 u = *(const uint4*)(kp + c * 8);
                n2 += bflo(u.x) * bflo(u.x) + bfhi(u.x) * bfhi(u.x) + bflo(u.y) * bflo(u.y) + bfhi(u.y) * bfhi(u.y) + bflo(u.z) * bflo(u.z) + bfhi(u.z) * bfhi(u.z) + bflo(u.w) * bflo(u.w) + bfhi(u.w) * bfhi(u.w); }
            atomicMax(&smax[(row >> 13) * 8 + h], __float_as_int(n2)); }
        __syncthreads();
        if (tx_ < 16) KMAXP[blockIdx.x * 16 + tx_] = sqrtf(__int_as_float(smax[tx_]));
    }
}

__device__ __forceinline__ void ph_mamba_norm(bf16_t* PROJ, const bf16_t* XC, const float* nw, int gw, int NGW, int rend) {
    const int tx_ = ltid();
    const int lane = tx_ & 63;
    const float4 w0 = *(const float4*)(nw + lane * 8), w1 = *(const float4*)(nw + lane * 8 + 4);
    for (int row0 = gw; row0 < rend; row0 += 8 * NGW) {
        uint4 yb[8], zb[8];
#pragma unroll
        for (int k = 0; k < 8; ++k) { const int rk = row0 + k * NGW; if (rk < rend) { yb[k] = *(const uint4*)(XC + (size_t)rk * 1024 + lane * 8); zb[k] = *(const uint4*)(PROJ + (size_t)rk * NPROJ + PC_Z + lane * 8); } }
#pragma unroll
        for (int k = 0; k < 8; ++k) {
            const int row = row0 + k * NGW; if (row >= rend) break;
            const uint4 yv = yb[k], zv = zb[k];
            float y[8] = {bflo(yv.x), bfhi(yv.x), bflo(yv.y), bfhi(yv.y), bflo(yv.z), bfhi(yv.z), bflo(yv.w), bfhi(yv.w)};
            const float z[8] = {bflo(zv.x), bfhi(zv.x), bflo(zv.y), bfhi(zv.y), bflo(zv.z), bfhi(zv.z), bflo(zv.w), bfhi(zv.w)};
            float ss = 0.f;
#pragma unroll
            for (int i = 0; i < 8; ++i) { y[i] *= silu_fast(z[i]); ss += y[i] * y[i]; }
            ss = wave_sum(ss); const float rstd = 1.0f / sqrtf(ss * (1.0f / 512.0f) + 1e-6f);
            uint4 o; o.x = pk2(y[0] * rstd * w0.x, y[1] * rstd * w0.y); o.y = pk2(y[2] * rstd * w0.z, y[3] * rstd * w0.w); o.z = pk2(y[4] * rstd * w1.x, y[5] * rstd * w1.y); o.w = pk2(y[6] * rstd * w1.z, y[7] * rstd * w1.w);
            *(uint4*)(PROJ + (size_t)row * NPROJ + PC_Z + lane * 8) = o;
        }
    }
}
__device__ __forceinline__ void ph_final(const bf16_t* xin, float* out, const float* nw) {
    const int tx_ = ltid();
    const int lane = tx_ & 63, gw = blockIdx.x * 8 + (tx_ >> 6), NGW = gridDim.x * 8;
    float4 nwv[4];
#pragma unroll
    for (int j = 0; j < 4; ++j) nwv[j] = ((const float4*)nw)[lane + 64 * j];
    for (int row0 = gw; row0 < M; row0 += 4 * NGW) {
        uint2 ub[4][4];
#pragma unroll
        for (int k = 0; k < 4; ++k) { const int rk = row0 + k * NGW; if (rk < M) { const uint2* xr = (const uint2*)(xin + (size_t)rk * D);
#pragma unroll
            for (int j = 0; j < 4; ++j) ub[k][j] = xr[lane + 64 * j]; } }
#pragma unroll
        for (int k = 0; k < 4; ++k) {
            const int row = row0 + k * NGW; if (row >= M) break;
            float4* xr = (float4*)(out + (size_t)row * D);
            float4 v[4]; float ss = 0.f;
#pragma unroll
            for (int j = 0; j < 4; ++j) { v[j] = make_float4(bflo(ub[k][j].x), bfhi(ub[k][j].x), bflo(ub[k][j].y), bfhi(ub[k][j].y)); ss += v[j].x * v[j].x + v[j].y * v[j].y + v[j].z * v[j].z + v[j].w * v[j].w; }
            ss = wave_sum(ss); const float rstd = 1.0f / sqrtf(ss * (1.0f / D) + 1e-6f);
#pragma unroll
            for (int j = 0; j < 4; ++j) { const float4 w4 = nwv[j]; xr[lane + 64 * j] = make_float4(v[j].x * rstd * w4.x, v[j].y * rstd * w4.y, v[j].z * rstd * w4.z, v[j].w * rstd * w4.w); }
        }
    }
}

namespace att {
typedef short bf16x8 __attribute__((ext_vector_type(8)));
typedef short s16x4 __attribute__((ext_vector_type(4)));
typedef float f32x16 __attribute__((ext_vector_type(16)));
typedef float f32x2_t __attribute__((ext_vector_type(2))); typedef __bf16 bf16x2_t __attribute__((ext_vector_type(2)));
__device__ __forceinline__ unsigned cvtpk(float lo, float hi) { f32x2_t v = {lo, hi}; bf16x2_t b = __builtin_convertvector(v, bf16x2_t); return __builtin_bit_cast(unsigned, b); }
constexpr float LOG2E = 1.4426950408889634f, C2 = 0.125f * LOG2E;
__device__ __forceinline__ void st_pair16(bf16_t* rowk, int hi, uint2 a, uint2 b) {
    const auto rx = __builtin_amdgcn_permlane32_swap(a.x, b.x, false, false); const auto ry = __builtin_amdgcn_permlane32_swap(a.y, b.y, false, false);
    *(uint4*)(rowk + 8 * hi) = make_uint4(rx[0], ry[0], rx[1], ry[1]);
}
__device__ __forceinline__ float rowmax32(const f32x16& p0, const f32x16& p1) {
    float mx = __builtin_amdgcn_fmed3f(p0[0], p1[0], INFINITY);
#pragma unroll
    for (int r = 1; r < 16; ++r) asm("v_max3_f32 %0, %0, %1, %2" : "+v"(mx) : "v"(p0[r]), "v"(p1[r]));
    return mx;
}
__device__ __forceinline__ void ld_pair16(const bf16_t* rowk, int hi, uint2& a, uint2& b) {
    const uint4 v = *(const uint4*)(rowk + 8 * hi);
    const auto rx = __builtin_amdgcn_permlane32_swap(v.x, v.z, false, false); const auto ry = __builtin_amdgcn_permlane32_swap(v.y, v.w, false, false);
    a = make_uint2(rx[0], ry[0]); b = make_uint2(rx[1], ry[1]);
}
constexpr int ST_BYTES = 16384, OFF_BIAS = 65536, OFF_EB = OFF_BIAS + 1024, OFF_KMAX = OFF_EB + 32, OFF_TAB = OFF_BIAS + 2048, TAB_N = 1280, OFF_END = OFF_TAB + TAB_N * 4;
constexpr float FOX_THR = 25.f;
enum { MODE_FOX = 0, MODE_SWA = 1, MODE_MOBA = 2, MODE_MOWN = 3 };
#define LASC __attribute__((address_space(3)))
typedef short v4i16_t __attribute__((ext_vector_type(4)));

template <int MODE>
__device__ __forceinline__ void attn_unit(unsigned char* lds, bf16_t* PROJ, const float* AUX, const float* btab, int bcol, float sink, int b, int hq, int hk, int qb, int qcol, int kcol, int vcol, bool dry = false, const void* ex0 = nullptr, const void* ex1 = nullptr) {
    const int tid = ltid(), lane = tid & 63, wave = __builtin_amdgcn_readfirstlane(tid >> 6), r32 = lane & 31, hi = lane >> 5;
    const int q0 = qb * 256, qw = q0 + wave * 32, q = qw + r32;
    const size_t rowbase = (size_t)b * SEQ;
    float* tab = (float*)(lds + (MODE == MODE_SWA ? 98304 : OFF_TAB));
    float tv0 = 0.f, tv1 = 0.f;
    if constexpr (MODE == MODE_SWA) { const int d = 383 - tid; if (d >= 0 && d < 128) tv0 = btab[rel_bucket(d) * 16 + bcol]; }
    if constexpr (MODE == MODE_MOBA) { tv0 = btab[rel_bucket(tid) * 16 + bcol]; tv1 = btab[rel_bucket(tid + 512) * 16 + bcol]; }
    if constexpr (MODE == MODE_MOWN) { const int d = 383 - tid; tv0 = btab[rel_bucket(d < 0 ? 0 : d) * 16 + bcol]; }
    const bf16_t* qp = PROJ + (rowbase + q) * NPROJ + qcol + hq * 64 + 8 * hi;
    const uint4 qu0 = *(const uint4*)(qp), qu1 = *(const uint4*)(qp + 16), qu2 = *(const uint4*)(qp + 32), qu3 = *(const uint4*)(qp + 48);
    float km0 = 0.f, km1 = 0.f, km2 = 0.f, km3 = 0.f;
    if constexpr (MODE == MODE_FOX) { if (tid < 64) { const float* kmp = btab + (tid * 4) * 16 + b * 8 + hq; km0 = kmp[0]; km1 = kmp[16]; km2 = kmp[32]; km3 = kmp[48]; } }
    unsigned msel = 0u; float4 mpl = make_float4(0.f, 0.f, 0.f, 0.f);
    if constexpr (MODE == MODE_MOWN) { msel = ((const unsigned*)AUX)[(size_t)(b * 8 + hq) * SEQ + q]; mpl = *(const float4*)((const float*)ex1 + ((rowbase + q) * 8 + hq) * 4); }
    const int t_beg = (MODE == MODE_SWA) ? (qb > 0 ? 4 * qb - 2 : 0) : (MODE == MODE_MOWN ? 4 * qb : 0), t_end = 4 * (qb + 1);
    const int skey = tid >> 3, sch = tid & 7;
    const bf16_t* kg = PROJ + (rowbase + skey) * NPROJ + kcol + hk * 64 + sch * 8;
    const bf16_t* vg = PROJ + (rowbase + skey) * NPROJ + vcol + hk * 64 + sch * 8;
    const int kdst = skey * 128 + ((sch ^ ((skey >> 1) & 7)) * 16);
    uint4 kreg0, kreg1, vreg0, vreg1; float breg0 = 0.f, breg1 = 0.f;
#define ATT_LOAD1(t_, KR, VR, BR) do { KR = *(const uint4*)(kg + (size_t)(t_) * 64 * NPROJ); VR = *(const uint4*)(vg + (size_t)(t_) * 64 * NPROJ); \
        if (MODE == MODE_FOX) { if (tid < 64) BR = AUX[(rowbase + (t_) * 64 + tid) * 8 + hq]; } } while (0)
#define ATT_LOAD(s_) do { ATT_LOAD1(ATT_TI(2 * (s_)), kreg0, vreg0, breg0); ATT_LOAD1(ATT_TI(2 * (s_) + 1), kreg1, vreg1, breg1); } while (0)
#define ATT_STORE1(ts_, KR, VR, BR) do { unsigned char* sb_ = lds + (ts_) * ST_BYTES; \
        *(uint4*)(sb_ + kdst) = KR; *(uint4*)(sb_ + 8192 + skey * 128 + ((sch ^ (((skey >> 1) & 1) << 2)) * 16)) = VR; \
        if (MODE == MODE_FOX) { if (tid < 64) { float inc_ = BR; \
            _Pragma("unroll") for (int o_ = 1; o_ < 64; o_ <<= 1) { const float v_ = __shfl_up(inc_, o_); if (lane >= o_) inc_ += v_; } \
            const float tot_ = __shfl(inc_, 63); \
            ((float*)(lds + OFF_BIAS))[(ts_) * 64 + tid] = (carry + tot_ - inc_) * LOG2E;        \
            carry += tot_; if (tid == 0) ((float*)(lds + OFF_EB))[(ts_)] = carry * LOG2E; } } } while (0)
#define ATT_STORE(st) do { ATT_STORE1((st) * 2, kreg0, vreg0, breg0); ATT_STORE1((st) * 2 + 1, kreg1, vreg1, breg1); } while (0)
    const int ntile = t_end - t_beg;
#define ATT_TI(i) ((MODE == MODE_FOX) ? (t_end - 1 - (i)) : (t_beg + (i)))
    const int nstep = ntile >> 1;
    uint4 sk0, sk1, sk2, sk3, sk4, sk5, sv0, sv1, sv2, sv3, sv4, sv5;
    if constexpr (MODE == MODE_SWA) {
#define SWA_LD(i, KR, VR) do { if ((i) < ntile) { KR = *(const uint4*)(kg + (size_t)(t_beg + (i)) * 64 * NPROJ); VR = *(const uint4*)(vg + (size_t)(t_beg + (i)) * 64 * NPROJ); } } while (0)
        SWA_LD(0, sk0, sv0); SWA_LD(1, sk1, sv1); SWA_LD(2, sk2, sv2); SWA_LD(3, sk3, sv3); SWA_LD(4, sk4, sv4); SWA_LD(5, sk5, sv5);
#undef SWA_LD
    } else { ATT_LOAD(0); }
    if constexpr (MODE == MODE_FOX) { if (ex0 != nullptr) {
        const float* KMEAN = (const float*)ex0; unsigned* SEL = (unsigned*)const_cast<void*>(ex1); unsigned char* sl = lds + 98304;
        const bf16_t* mq = PROJ + (rowbase + q) * NPROJ + PC_MQ + hq * 64 + 8 * hi;
        const uint4 mu0 = *(const uint4*)(mq), mu1 = *(const uint4*)(mq + 16), mu2 = *(const uint4*)(mq + 32), mu3 = *(const uint4*)(mq + 48);
        { const int n = tid >> 4, c4 = (tid & 15) * 4; const float4 k = *(const float4*)(KMEAN + ((size_t)(b * 32 + n)) * 512 + hq * 64 + c4);
          const unsigned h01 = cvtpk(k.x, k.y), h23 = cvtpk(k.z, k.w);
          const unsigned l01 = cvtpk(k.x - bflo(h01), k.y - bfhi(h01)), l23 = cvtpk(k.z - bflo(h23), k.w - bfhi(h23));
          const int addr = n * 128 + (((((tid & 15) >> 1)) ^ ((n >> 1) & 7)) * 16) + (tid & 1) * 8;
          *(uint2*)(sl + addr) = make_uint2(h01, h23); *(uint2*)(sl + 4096 + addr) = make_uint2(l01, l23); }
        __syncthreads();
        f32x16 gp;
#pragma unroll
        for (int r = 0; r < 16; ++r) gp[r] = 0.f;
#pragma unroll
        for (int d0 = 0; d0 < 4; ++d0) {
            const int off = r32 * 128 + (((2 * d0 + hi) ^ ((r32 >> 1) & 7)) * 16);
            const bf16x8 ah = *(const bf16x8*)(sl + off), al = *(const bf16x8*)(sl + 4096 + off);
            const uint4 mu = d0 == 0 ? mu0 : d0 == 1 ? mu1 : d0 == 2 ? mu2 : mu3;
            const bf16x8 qf = __builtin_bit_cast(bf16x8, mu);
            gp = __builtin_amdgcn_mfma_f32_32x32x16_bf16(ah, qf, gp, 0, 0, 0);
            gp = __builtin_amdgcn_mfma_f32_32x32x16_bf16(al, qf, gp, 0, 0, 0);
        }
        float g0 = -INFINITY, g1 = -INFINITY, g2 = -INFINITY; int i0 = 31, i1 = 31, i2 = 31;
#pragma unroll
        for (int r = 0; r < 16; ++r) {
            const int n = (r & 3) + 8 * (r >> 2) + 4 * hi; const float g = n < qb ? gp[r] : -INFINITY;
            if (g > g0) { g2 = g1; i2 = i1; g1 = g0; i1 = i0; g0 = g; i0 = n; }
            else if (g > g1) { g2 = g1; i2 = i1; g1 = g; i1 = n; }
            else if (g > g2) { g2 = g; i2 = n; }
        }
        {
            const float pg[3] = {__shfl_xor(g0, 32), __shfl_xor(g1, 32), __shfl_xor(g2, 32)}; const int pi[3] = {__shfl_xor(i0, 32), __shfl_xor(i1, 32), __shfl_xor(i2, 32)};
#pragma unroll
            for (int c = 0; c < 3; ++c) { const float g = pg[c]; const int n = pi[c];
                if (g > g0 || (g == g0 && n < i0)) { g2 = g1; i2 = i1; g1 = g0; i1 = i0; g0 = g; i0 = n; }
                else if (g > g1 || (g == g1 && n < i1)) { g2 = g1; i2 = i1; g1 = g; i1 = n; }
                else if (g > g2 || (g == g2 && n < i2)) { g2 = g; i2 = n; } }
        }
        const int cnt = qb < 3 ? qb : 3;
        if (hi == 0) SEL[(size_t)(b * 8 + hq) * SEQ + q] = (unsigned)i0 | ((unsigned)i1 << 5) | ((unsigned)i2 << 10) | ((unsigned)cnt << 15);
    } }
    if constexpr (MODE == MODE_SWA) tab[tid] = tv0 * LOG2E;
    if constexpr (MODE == MODE_MOBA) { tab[tid] = tv0 * LOG2E; tab[tid + 512] = tv1 * LOG2E; }
    if constexpr (MODE == MODE_MOWN) tab[tid] = tv0 * LOG2E;
    bf16x8 qr[4]; float gq[32]; float qn2 = 0.f;
    {
#pragma unroll
      for (int d0 = 0; d0 < 4; ++d0) { const uint4 u = d0 == 0 ? qu0 : d0 == 1 ? qu1 : d0 == 2 ? qu2 : qu3;
          const float f[8] = {bflo(u.x), bfhi(u.x), bflo(u.y), bfhi(u.y), bflo(u.z), bfhi(u.z), bflo(u.w), bfhi(u.w)};
          if constexpr (MODE == MODE_MOBA) {
#pragma unroll
              for (int e = 0; e < 8; ++e) gq[d0 * 8 + e] = f[e]; }
          if constexpr (MODE == MODE_FOX) {
#pragma unroll
              for (int e = 0; e < 8; ++e) qn2 += f[e] * f[e]; }
          uint4 w; w.x = cvtpk(f[0] * C2, f[1] * C2); w.y = cvtpk(f[2] * C2, f[3] * C2); w.z = cvtpk(f[4] * C2, f[5] * C2); w.w = cvtpk(f[6] * C2, f[7] * C2);
          qr[d0] = __builtin_bit_cast(bf16x8, w); } }
    unsigned selmask = 0u;
    if constexpr (MODE == MODE_MOBA) {
        float g0 = -INFINITY, g1 = -INFINITY, g2 = -INFINITY; int i0 = -1, i1 = -1, i2 = -1;
        for (int n = 0; n < qb; ++n) {
            const float* km = AUX + ((size_t)(b * 32 + n)) * 512 + hk * 64 + 8 * hi; float g = 0.f;
#pragma unroll
            for (int d0 = 0; d0 < 4; ++d0) { const float4 k0 = *(const float4*)(km + 16 * d0), k1 = *(const float4*)(km + 16 * d0 + 4);
                g += gq[d0 * 8] * k0.x + gq[d0 * 8 + 1] * k0.y + gq[d0 * 8 + 2] * k0.z + gq[d0 * 8 + 3] * k0.w + gq[d0 * 8 + 4] * k1.x + gq[d0 * 8 + 5] * k1.y + gq[d0 * 8 + 6] * k1.z + gq[d0 * 8 + 7] * k1.w; }
            g += __shfl_xor(g, 32);
            if (g > g0) { g2 = g1; i2 = i1; g1 = g0; i1 = i0; g0 = g; i0 = n; }
            else if (g > g1) { g2 = g1; i2 = i1; g1 = g; i1 = n; }
            else if (g > g2) { g2 = g; i2 = n; }
        }
        if (i0 >= 0) selmask |= 1u << i0; if (i1 >= 0) selmask |= 1u << i1; if (i2 >= 0) selmask |= 1u << i2;
    }
    float carry = 0.f;
    f32x16 o0, o1;
#pragma unroll
    for (int r = 0; r < 16; ++r) { o0[r] = 0.f; o1[r] = 0.f; }
    float m = -1e30f, l = 0.f;
    if constexpr (MODE == MODE_SWA) { m = sink * LOG2E; l = hi == 0 ? 1.f : 0.f; }
    float qkb = 0.f;
    if constexpr (MODE == MODE_FOX) {
        if (tid < 64) { float km = fmaxf(fmaxf(km0, km1), fmaxf(km2, km3));
#pragma unroll
            for (int o = 1; o < 64; o <<= 1) km = fmaxf(km, __shfl_xor(km, o));
            if (tid == 0) *(float*)(lds + OFF_KMAX) = km; }
    }
    if constexpr (MODE == MODE_SWA) {
#define SWA_ST(i, KR, VR) do { if ((i) < ntile) { unsigned char* sb_ = lds + (i) * ST_BYTES; *(uint4*)(sb_ + kdst) = KR; *(uint4*)(sb_ + 8192 + skey * 128 + ((sch ^ (((skey >> 1) & 1) << 2)) * 16)) = VR; } } while (0)
        SWA_ST(0, sk0, sv0); SWA_ST(1, sk1, sv1); SWA_ST(2, sk2, sv2); SWA_ST(3, sk3, sv3); SWA_ST(4, sk4, sv4); SWA_ST(5, sk5, sv5);
#undef SWA_ST
    } else { ATT_STORE(0); if (1 < nstep) ATT_LOAD(1); }
    __syncthreads();
    if constexpr (MODE == MODE_FOX) { qn2 += __shfl_xor(qn2, 32); qkb = sqrtf(qn2) * C2 * 1.01f * *(const float*)(lds + OFF_KMAX); }
    const int vtr_off = ((lane & 15) >> 2) * 128 + (16 * ((lane >> 4) & 1) + 4 * (lane & 3)) * 2 + 4 * hi * 128;
    bool started = false;
    for (int i = 0; i < nstep; ++i) {
        const int st = i & 1;
        if constexpr (MODE != MODE_SWA) {
        if (i + 1 < nstep) ATT_STORE(st ^ 1);
        if (i + 2 < nstep) ATT_LOAD(i + 2); }
#pragma unroll 1
        for (int sub = 0; sub < 2; ++sub) {
        const int t = ATT_TI(2 * i + sub), ts = (MODE == MODE_SWA) ? 2 * i + sub : st * 2 + sub;
        bool act = (64 * t <= qw + 31);
        if constexpr (MODE == MODE_SWA) act = act && (64 * t + 63 >= qw - 127);
        if constexpr (MODE == MODE_MOBA) { if (t < 4 * qb) act = __builtin_amdgcn_ballot_w64(((selmask >> (t >> 2)) & 1u) != 0u) != 0ull; }
        if (act) {
            const unsigned char* Ks = lds + ts * ST_BYTES; const unsigned char* Vt = Ks + 8192;
            f32x16 p0, p1;
            if constexpr (MODE == MODE_FOX) { const float* bt = (const float*)(lds + OFF_BIAS) + ts * 64;
#pragma unroll
                for (int g = 0; g < 4; ++g) { const float4 b0 = *(const float4*)(bt + 8 * g + 4 * hi), b1 = *(const float4*)(bt + 32 + 8 * g + 4 * hi);
                    p0[4 * g] = b0.x; p0[4 * g + 1] = b0.y; p0[4 * g + 2] = b0.z; p0[4 * g + 3] = b0.w; p1[4 * g] = b1.x; p1[4 * g + 1] = b1.y; p1[4 * g + 2] = b1.z; p1[4 * g + 3] = b1.w; }
            } else if constexpr (MODE == MODE_SWA || MODE == MODE_MOWN) { const float* tp = tab + 383 - (q - 64 * t - 4 * hi);
#pragma unroll
                for (int r = 0; r < 16; ++r) { const int kofs = (r & 3) + 8 * (r >> 2); p0[r] = tp[kofs]; p1[r] = tp[kofs + 32]; }
            } else { const int dq = q - 64 * t - 4 * hi;
                if (MODE != MODE_MOWN && 64 * t + 63 + 790 <= qw) { const float c31 = tab[1023];
#pragma unroll
                    for (int r = 0; r < 16; ++r) { p0[r] = c31; p1[r] = c31; } }
                else {
#pragma unroll
                    for (int r = 0; r < 16; ++r) { const int kofs = (r & 3) + 8 * (r >> 2); const int d0_ = dq - kofs, d1_ = dq - kofs - 32;
                        if constexpr (MODE == MODE_MOWN) { p0[r] = tab[d0_ < 0 ? 0 : d0_]; p1[r] = tab[d1_ < 0 ? 0 : d1_]; }
                        else { p0[r] = tab[d0_ < 0 ? 0 : (d0_ > 1023 ? 1023 : d0_)]; p1[r] = tab[d1_ < 0 ? 0 : (d1_ > 1023 ? 1023 : d1_)]; } } }
            }
#pragma unroll
            for (int d0 = 0; d0 < 4; ++d0) {
                const bf16x8 a0 = *(const bf16x8*)(Ks + r32 * 128 + (((2 * d0 + hi) ^ ((r32 >> 1) & 7)) * 16));
                const bf16x8 a1 = *(const bf16x8*)(Ks + (32 + r32) * 128 + (((2 * d0 + hi) ^ ((r32 >> 1) & 7)) * 16));
                p0 = __builtin_amdgcn_mfma_f32_32x32x16_bf16(a0, qr[d0], p0, 0, 0, 0);
                p1 = __builtin_amdgcn_mfma_f32_32x32x16_bf16(a1, qr[d0], p1, 0, 0, 0);
            }
            const int kb = 64 * t + 4 * hi;
            if constexpr (MODE == MODE_SWA) {
                if (64 * t + 63 > qw) {
#pragma unroll
                    for (int r = 0; r < 16; ++r) { const int kv = kb + (r & 3) + 8 * (r >> 2); if (kv > q) p0[r] = -INFINITY; if (kv + 32 > q) p1[r] = -INFINITY; }
                } else if (64 * t < qw + 31 - 127) {
#pragma unroll
                    for (int r = 0; r < 16; ++r) { const int kv = kb + (r & 3) + 8 * (r >> 2); if (kv < q - 127) p0[r] = -INFINITY; if (kv + 32 < q - 127) p1[r] = -INFINITY; }
                }
            } else {
                if (64 * t + 63 > qw) {
#pragma unroll
                    for (int r = 0; r < 16; ++r) { const int kv = kb + (r & 3) + 8 * (r >> 2); if (kv > q) p0[r] = -INFINITY; if (kv + 32 > q) p1[r] = -INFINITY; }
                }
                if constexpr (MODE == MODE_MOBA) { if (t < 4 * qb && ((selmask >> (t >> 2)) & 1u) == 0u) {
#pragma unroll
                    for (int r = 0; r < 16; ++r) { p0[r] = -INFINITY; p1[r] = -INFINITY; } } }
            }
            float mx = rowmax32(p0, p1);
            mx = fmaxf(mx, __shfl_xor(mx, 32));
            const float mn = fmaxf(m, mx);
            if (__builtin_amdgcn_ballot_w64(mn > m) != 0ull) {
                const float alpha = __builtin_amdgcn_exp2f(m - mn); l *= alpha;
#pragma unroll
                for (int r = 0; r < 16; ++r) { o0[r] *= alpha; o1[r] *= alpha; }
            }
            m = mn;
            float sum = 0.f;
#pragma unroll
            for (int r = 0; r < 16; ++r) { p0[r] = __builtin_amdgcn_exp2f(p0[r] - mn); p1[r] = __builtin_amdgcn_exp2f(p1[r] - mn); sum += p0[r] + p1[r]; }
            l += sum;
            bf16x8 pa[4];
#pragma unroll
            for (int ks = 0; ks < 4; ++ks) { uint4 w;
                if (ks < 2) { w.x = cvtpk(p0[8 * ks], p0[8 * ks + 1]); w.y = cvtpk(p0[8 * ks + 2], p0[8 * ks + 3]); w.z = cvtpk(p0[8 * ks + 4], p0[8 * ks + 5]); w.w = cvtpk(p0[8 * ks + 6], p0[8 * ks + 7]); }
                else { const int k2 = ks - 2; w.x = cvtpk(p1[8 * k2], p1[8 * k2 + 1]); w.y = cvtpk(p1[8 * k2 + 2], p1[8 * k2 + 3]); w.z = cvtpk(p1[8 * k2 + 4], p1[8 * k2 + 5]); w.w = cvtpk(p1[8 * k2 + 6], p1[8 * k2 + 7]); }
                pa[ks] = __builtin_bit_cast(bf16x8, w); }
#pragma unroll
            for (int ks = 0; ks < 4; ++ks) {
#pragma unroll
                for (int db = 0; db < 2; ++db) {
                    const LASC unsigned char* vp = (const LASC unsigned char*)(Vt + vtr_off + ks * 16 * 128 + ((db ^ ((lane >> 3) & 1)) * 64));
                    const s16x4 lo = __builtin_bit_cast(s16x4, __builtin_amdgcn_ds_read_tr16_b64_v4i16((LASC v4i16_t*)vp));
                    const s16x4 hh = __builtin_bit_cast(s16x4, __builtin_amdgcn_ds_read_tr16_b64_v4i16((LASC v4i16_t*)(vp + 8 * 128)));
                    const bf16x8 vf = {lo[0], lo[1], lo[2], lo[3], hh[0], hh[1], hh[2], hh[3]};
                    if (db == 0) o0 = __builtin_amdgcn_mfma_f32_32x32x16_bf16(vf, pa[ks], o0, 0, 0, 0);
                    else o1 = __builtin_amdgcn_mfma_f32_32x32x16_bf16(vf, pa[ks], o1, 0, 0, 0); }
            }
            started = true;
        }
        }
        if constexpr (MODE == MODE_FOX) {
            const float eb = ((const float*)(lds + OFF_EB))[st * 2 + 1];
            if (__syncthreads_and((started && (qkb + eb - m < -FOX_THR)) ? 1 : 0)) break;
        } else if constexpr (MODE != MODE_SWA) __syncthreads();
    }
    if constexpr (MODE == MODE_FOX) __syncthreads();
#undef ATT_LOAD
#undef ATT_STORE
#undef ATT_LOAD1
#undef ATT_STORE1
#undef ATT_TI
    l += __shfl_xor(l, 32);
    float inv = 1.0f / l;
    bf16_t* op = PROJ + (rowbase + q) * NPROJ + qcol + hq * 64 + 4 * hi;
    if (dry && inv != 123.4567f) return;
    if constexpr (MODE == MODE_MOWN) {
        const int cnt = (int)((msel >> 15) & 3u);
        const float pls[3] = {mpl.x, mpl.y, mpl.z};
        float R = m + __builtin_amdgcn_logf(l), wsum = 1.f;
#pragma unroll
        for (int r = 0; r < 16; ++r) { o0[r] *= inv; o1[r] *= inv; }
        uint2 pa0[3][4], pa1[3][4];
#pragma unroll
        for (int sl = 0; sl < 3; ++sl) { if (sl < cnt) {
            const bf16_t* pp = (sl < 2) ? PROJ + (rowbase + q) * NPROJ + PC_XBC + (hq * 2 + sl) * 64 + 4 * hi : (const bf16_t*)ex0 + ((rowbase + q) * 8 + hq) * 64 + 4 * hi;
#pragma unroll
            for (int g = 0; g < 4; ++g) { pa0[sl][g] = *(const uint2*)(pp + 8 * g); pa1[sl][g] = *(const uint2*)(pp + 32 + 8 * g); } } }
#pragma unroll
        for (int sl = 0; sl < 3; ++sl) { if (sl >= cnt) break;
            const float ls = pls[sl]; const float Rn = fmaxf(R, ls), sc = __builtin_amdgcn_exp2f(R - Rn), ws_ = __builtin_amdgcn_exp2f(ls - Rn);
#pragma unroll
            for (int g = 0; g < 4; ++g) { const uint2 a0 = pa0[sl][g], a1 = pa1[sl][g];
                o0[4 * g] = o0[4 * g] * sc + ws_ * bflo(a0.x); o0[4 * g + 1] = o0[4 * g + 1] * sc + ws_ * bfhi(a0.x); o0[4 * g + 2] = o0[4 * g + 2] * sc + ws_ * bflo(a0.y); o0[4 * g + 3] = o0[4 * g + 3] * sc + ws_ * bfhi(a0.y);
                o1[4 * g] = o1[4 * g] * sc + ws_ * bflo(a1.x); o1[4 * g + 1] = o1[4 * g + 1] * sc + ws_ * bfhi(a1.x); o1[4 * g + 2] = o1[4 * g + 2] * sc + ws_ * bflo(a1.y); o1[4 * g + 3] = o1[4 * g + 3] * sc + ws_ * bfhi(a1.y); }
            wsum = wsum * sc + ws_; R = Rn;
        }
        inv = 1.0f / wsum;
    }
    bf16_t* orow = op - 4 * hi;
#pragma unroll
    for (int g = 0; g < 4; g += 2) {
        st_pair16(orow + 8 * g, hi, make_uint2(cvtpk(o0[4 * g] * inv, o0[4 * g + 1] * inv), cvtpk(o0[4 * g + 2] * inv, o0[4 * g + 3] * inv)),
                                    make_uint2(cvtpk(o0[4 * g + 4] * inv, o0[4 * g + 5] * inv), cvtpk(o0[4 * g + 6] * inv, o0[4 * g + 7] * inv)));
        st_pair16(orow + 32 + 8 * g, hi, make_uint2(cvtpk(o1[4 * g] * inv, o1[4 * g + 1] * inv), cvtpk(o1[4 * g + 2] * inv, o1[4 * g + 3] * inv)),
                                         make_uint2(cvtpk(o1[4 * g + 4] * inv, o1[4 * g + 5] * inv), cvtpk(o1[4 * g + 6] * inv, o1[4 * g + 7] * inv)));
    }
}
}
namespace ssd {
using att::bf16x8; using att::s16x4; using att::f32x16; using att::cvtpk; using att::LOG2E;
#define LASC __attribute__((address_space(3)))
constexpr int STB = 40960;
constexpr int OFF_AL2 = 2 * STB, OFF_DTV = OFF_AL2 + 1024, OFF_E = OFF_DTV + 1024, OFF_HIN = 0;
__device__ __forceinline__ float chunk_scan(unsigned char* lds, const float* DT, size_t row0, int h, float A, int tid) {
    float* al = (float*)(lds + OFF_AL2); float* dtv = (float*)(lds + OFF_DTV);
    if (tid < 256) { const float d = DT[(row0 + tid) * 8 + h]; dtv[tid] = d; al[tid] = d * A; }
    __syncthreads();
    if (tid < 64) { const float4 a4 = *(const float4*)(al + 4 * tid); const float s = (a4.x + a4.y) + (a4.z + a4.w); float incl = s;
#pragma unroll
        for (int o = 1; o < 64; o <<= 1) { const float v = __shfl_up(incl, o); if (tid >= o) incl += v; }
        const float base = incl - s; float4 c4; c4.x = base + a4.x; c4.y = c4.x + a4.y; c4.z = c4.y + a4.z; c4.w = c4.z + a4.w; *(float4*)(al + 4 * tid) = c4; }
    __syncthreads();
    return al[255];
}
__device__ __forceinline__ void m1_unit(unsigned char* lds, bf16_t* XC, const float* DT, const float* a_log, const float* d_skip, bf16_t* STATES, float* CDEC, int b, int c, int h) {
    const int tid = ltid(), lane = tid & 63, wave = __builtin_amdgcn_readfirstlane(tid >> 6), r32 = lane & 31, hi = lane >> 5, g = h >> 2;
    const size_t row0 = (size_t)b * SEQ + c * 256; const int l = wave * 32 + r32;
    const float A = -expf(a_log[h]);
    float* al = (float*)(lds + OFF_AL2); float* dtv = (float*)(lds + OFF_DTV); float* ev = (float*)(lds + OFF_E);
    const float alast = chunk_scan(lds, DT, row0, h, A, tid);
    float myac = 0.f; if (tid < 256) myac = al[tid];
    __syncthreads();
    if (tid < 256) { ev[tid] = expf(alast - myac); al[tid] = myac * LOG2E; }
    if (tid == 0) CDEC[(b * 32 + c) * 8 + h] = expf(alast);
    __syncthreads();
    const float al_l = al[l];
    bf16x8 cfr[8];
    { const bf16_t* cp = XC + (row0 + l) * 1024 + 768 + g * 128 + 8 * hi;
#pragma unroll
      for (int k0 = 0; k0 < 8; ++k0) cfr[k0] = *(const bf16x8*)(cp + 16 * k0); }
    f32x16 o0, o1, sacc;
#pragma unroll
    for (int r = 0; r < 16; ++r) { o0[r] = 0.f; o1[r] = 0.f; sacc[r] = 0.f; }
    const int ss = tid >> 3, pc = tid & 7;
    const bf16_t* bg = XC + (row0 + ss) * 1024 + 512 + g * 128 + 16 * pc;
    const bf16_t* xg = XC + (row0 + ss) * 1024 + h * 64 + 8 * pc;
    uint4 b0r, b1r, xr;
#define SSD_LOAD(t) do { b0r = *(const uint4*)(bg + (size_t)(t) * 64 * 1024); b1r = *(const uint4*)(bg + (size_t)(t) * 64 * 1024 + 8); xr = *(const uint4*)(xg + (size_t)(t) * 64 * 1024); } while (0)
#define SSD_SC2(w, f) cvtpk(bflo(w) * (f), bfhi(w) * (f))
#define SSD_STORE(st, t) do { unsigned char* sb_ = lds + (st) * STB; \
        *(uint4*)(sb_ + ss * 256 + (((2 * pc) ^ (ss & 15)) * 16)) = b0r; *(uint4*)(sb_ + ss * 256 + (((2 * pc + 1) ^ (ss & 15)) * 16)) = b1r; \
        const float es_ = ev[(t) * 64 + ss], ds_ = dtv[(t) * 64 + ss]; \
        *(uint4*)(sb_ + 16384 + ss * 256 + pc * 32) = make_uint4(SSD_SC2(b0r.x, es_), SSD_SC2(b0r.y, es_), SSD_SC2(b0r.z, es_), SSD_SC2(b0r.w, es_));         \
        *(uint4*)(sb_ + 16384 + ss * 256 + pc * 32 + 16) = make_uint4(SSD_SC2(b1r.x, es_), SSD_SC2(b1r.y, es_), SSD_SC2(b1r.z, es_), SSD_SC2(b1r.w, es_)); \
        *(uint4*)(sb_ + 32768 + ss * 128 + pc * 16) = make_uint4(SSD_SC2(xr.x, ds_), SSD_SC2(xr.y, ds_), SSD_SC2(xr.z, ds_), SSD_SC2(xr.w, ds_)); } while (0)
    SSD_LOAD(0); SSD_STORE(0, 0);
    __syncthreads();
    const int nb = wave >> 1, pb = wave & 1;
    const int trx = ((lane & 15) >> 2) * 128 + (16 * ((lane >> 4) & 1) + 4 * (lane & 3)) * 2, trb = ((lane & 15) >> 2) * 256 + (16 * ((lane >> 4) & 1) + 4 * (lane & 3)) * 2;
#pragma unroll 1
    for (int t = 0; t < 4; ++t) {
        const int st = t & 1;
        if (t + 1 < 4) SSD_LOAD(t + 1);
        const unsigned char* Bs = lds + st * STB; const unsigned char* Bt = Bs + 16384; const unsigned char* Xt = Bs + 32768;
        if (64 * t <= wave * 32 + 31) {
            f32x16 p0, p1;
#pragma unroll
            for (int r = 0; r < 16; ++r) { p0[r] = 0.f; p1[r] = 0.f; }
#pragma unroll
            for (int k0 = 0; k0 < 8; ++k0) {
                const bf16x8 a0 = *(const bf16x8*)(Bs + r32 * 256 + (((2 * k0 + hi) ^ (r32 & 15)) * 16));
                const bf16x8 a1 = *(const bf16x8*)(Bs + (32 + r32) * 256 + (((2 * k0 + hi) ^ (r32 & 15)) * 16));
                p0 = __builtin_amdgcn_mfma_f32_32x32x16_bf16(a0, cfr[k0], p0, 0, 0, 0);
                p1 = __builtin_amdgcn_mfma_f32_32x32x16_bf16(a1, cfr[k0], p1, 0, 0, 0);
            }
#pragma unroll
            for (int gq = 0; gq < 4; ++gq) { const int sb0 = 64 * t + 8 * gq + 4 * hi;
                const float4 s0 = *(const float4*)(al + sb0), s1 = *(const float4*)(al + sb0 + 32);
                const float a0[4] = {s0.x, s0.y, s0.z, s0.w}, a1[4] = {s1.x, s1.y, s1.z, s1.w};
#pragma unroll
                for (int e = 0; e < 4; ++e) { const int r = 4 * gq + e;
                    p0[r] = (sb0 + e <= l) ? p0[r] * __builtin_amdgcn_exp2f(al_l - a0[e]) : 0.f;
                    p1[r] = (sb0 + 32 + e <= l) ? p1[r] * __builtin_amdgcn_exp2f(al_l - a1[e]) : 0.f; } }
            bf16x8 pa[4];
#pragma unroll
            for (int ks = 0; ks < 4; ++ks) { uint4 w;
                if (ks < 2) { w.x = cvtpk(p0[8 * ks], p0[8 * ks + 1]); w.y = cvtpk(p0[8 * ks + 2], p0[8 * ks + 3]); w.z = cvtpk(p0[8 * ks + 4], p0[8 * ks + 5]); w.w = cvtpk(p0[8 * ks + 6], p0[8 * ks + 7]); }
                else { const int k2 = ks - 2; w.x = cvtpk(p1[8 * k2], p1[8 * k2 + 1]); w.y = cvtpk(p1[8 * k2 + 2], p1[8 * k2 + 3]); w.z = cvtpk(p1[8 * k2 + 4], p1[8 * k2 + 5]); w.w = cvtpk(p1[8 * k2 + 6], p1[8 * k2 + 7]); }
                pa[ks] = __builtin_bit_cast(bf16x8, w); }
#pragma unroll
            for (int ks = 0; ks < 4; ++ks) {
#pragma unroll
                for (int db = 0; db < 2; ++db) {
                    const LASC unsigned char* vp = (const LASC unsigned char*)(Xt + trx + 4 * hi * 128 + ks * 16 * 128 + db * 64);
                    const s16x4 lo = __builtin_bit_cast(s16x4, __builtin_amdgcn_ds_read_tr16_b64_v4i16((LASC att::v4i16_t*)vp));
                    const s16x4 hh = __builtin_bit_cast(s16x4, __builtin_amdgcn_ds_read_tr16_b64_v4i16((LASC att::v4i16_t*)(vp + 8 * 128)));
                    const bf16x8 vf = {lo[0], lo[1], lo[2], lo[3], hh[0], hh[1], hh[2], hh[3]};
                    if (db == 0) o0 = __builtin_amdgcn_mfma_f32_32x32x16_bf16(vf, pa[ks], o0, 0, 0, 0);
                    else o1 = __builtin_amdgcn_mfma_f32_32x32x16_bf16(vf, pa[ks], o1, 0, 0, 0); } }
        }
        {
#pragma unroll
            for (int ks = 0; ks < 4; ++ks) {
                const LASC unsigned char* bp = (const LASC unsigned char*)(Bt + trb + (16 * ks + 8 * hi) * 256 + nb * 64);
                const s16x4 a_lo = __builtin_bit_cast(s16x4, __builtin_amdgcn_ds_read_tr16_b64_v4i16((LASC att::v4i16_t*)bp));
                const s16x4 a_hi = __builtin_bit_cast(s16x4, __builtin_amdgcn_ds_read_tr16_b64_v4i16((LASC att::v4i16_t*)(bp + 4 * 256)));
                const LASC unsigned char* xp = (const LASC unsigned char*)(Xt + trx + (16 * ks + 8 * hi) * 128 + pb * 64);
                const s16x4 x_lo = __builtin_bit_cast(s16x4, __builtin_amdgcn_ds_read_tr16_b64_v4i16((LASC att::v4i16_t*)xp));
                const s16x4 x_hi = __builtin_bit_cast(s16x4, __builtin_amdgcn_ds_read_tr16_b64_v4i16((LASC att::v4i16_t*)(xp + 4 * 128)));
                const bf16x8 af = {a_lo[0], a_lo[1], a_lo[2], a_lo[3], a_hi[0], a_hi[1], a_hi[2], a_hi[3]};
                const bf16x8 xf = {x_lo[0], x_lo[1], x_lo[2], x_lo[3], x_hi[0], x_hi[1], x_hi[2], x_hi[3]};
                sacc = __builtin_amdgcn_mfma_f32_32x32x16_bf16(af, xf, sacc, 0, 0, 0);
            }
        }
        if (t + 1 < 4) SSD_STORE(st ^ 1, t + 1);
        __syncthreads();
    }
#undef SSD_LOAD
#undef SSD_STORE
    { const float Dh = d_skip[h]; bf16_t* yr = XC + (row0 + l) * 1024 + h * 64;
      uint2 xa[4], xb[4];
#pragma unroll
      for (int gq = 0; gq < 4; gq += 2) { att::ld_pair16(yr + 8 * gq, hi, xa[gq], xa[gq + 1]); att::ld_pair16(yr + 32 + 8 * gq, hi, xb[gq], xb[gq + 1]); }
      uint2 ya[4], yb[4];
#pragma unroll
      for (int gq = 0; gq < 4; ++gq) { const uint2 x0 = xa[gq], x1 = xb[gq];
          ya[gq] = make_uint2(cvtpk(o0[4 * gq] + Dh * bflo(x0.x), o0[4 * gq + 1] + Dh * bfhi(x0.x)), cvtpk(o0[4 * gq + 2] + Dh * bflo(x0.y), o0[4 * gq + 3] + Dh * bfhi(x0.y)));
          yb[gq] = make_uint2(cvtpk(o1[4 * gq] + Dh * bflo(x1.x), o1[4 * gq + 1] + Dh * bfhi(x1.x)), cvtpk(o1[4 * gq + 2] + Dh * bflo(x1.y), o1[4 * gq + 3] + Dh * bfhi(x1.y))); }
#pragma unroll
      for (int gq = 0; gq < 4; gq += 2) { att::st_pair16(yr + 8 * gq, hi, ya[gq], ya[gq + 1]); att::st_pair16(yr + 32 + 8 * gq, hi, yb[gq], yb[gq + 1]); } }
    { bf16_t* sp = STATES + ((size_t)((b * 32 + c) * 8 + h)) * 8192 + (size_t)(r32 + 32 * pb) * 128 + 32 * nb;
#pragma unroll
      for (int gq = 0; gq < 4; gq += 2) att::st_pair16(sp + 8 * gq, hi, make_uint2(cvtpk(sacc[4 * gq], sacc[4 * gq + 1]), cvtpk(sacc[4 * gq + 2], sacc[4 * gq + 3])),
                                                       make_uint2(cvtpk(sacc[4 * gq + 4], sacc[4 * gq + 5]), cvtpk(sacc[4 * gq + 6], sacc[4 * gq + 7]))); }
    __syncthreads();
}
__device__ __forceinline__ void m2_unit(unsigned char* lds, bf16_t* XC, const float* DT, const float* a_log, const bf16_t* STATES, const float* CDEC, int b, int c, int h) {
    if (c == 0) return;
    const int tid = ltid(), lane = tid & 63, wave = __builtin_amdgcn_readfirstlane(tid >> 6), r32 = lane & 31, hi = lane >> 5, g = h >> 2;
    const size_t row0 = (size_t)b * SEQ + c * 256; const int l = wave * 32 + r32;
    const float A = -expf(a_log[h]);
    float* al = (float*)(lds + OFF_AL2);
    (void)chunk_scan(lds, DT, row0, h, A, tid);
    const float ea = expf(al[l]);
    float4 hin[4];
#pragma unroll
    for (int j = 0; j < 4; ++j) hin[j] = make_float4(0.f, 0.f, 0.f, 0.f);
    const bf16_t* sbase = STATES + ((size_t)((b * 32) * 8 + h)) * 8192 + 4 * tid;
    for (int c0 = 0; c0 < c; c0 += 4) {
        uint2 sv[4][4]; float dec[4];
#pragma unroll
        for (int k = 0; k < 4; ++k) { const int cc = (c0 + k < c) ? c0 + k : c - 1; dec[k] = CDEC[(b * 32 + cc) * 8 + h];
#pragma unroll
            for (int j = 0; j < 4; ++j) sv[k][j] = *(const uint2*)(sbase + (size_t)cc * 8 * 8192 + 2048 * j); }
#pragma unroll
        for (int k = 0; k < 4; ++k) if (c0 + k < c) {
#pragma unroll
            for (int j = 0; j < 4; ++j) { hin[j].x = hin[j].x * dec[k] + bflo(sv[k][j].x); hin[j].y = hin[j].y * dec[k] + bfhi(sv[k][j].x); hin[j].z = hin[j].z * dec[k] + bflo(sv[k][j].y); hin[j].w = hin[j].w * dec[k] + bfhi(sv[k][j].y); } } }
#pragma unroll
    for (int j = 0; j < 4; ++j) { const int idx = 4 * tid + 2048 * j, p = idx >> 7, n = idx & 127;
        *(uint2*)(lds + OFF_HIN + p * 256 + (((n >> 3) ^ (p & 15)) * 16) + (n & 7) * 2) = make_uint2(cvtpk(hin[j].x, hin[j].y), cvtpk(hin[j].z, hin[j].w)); }
    __syncthreads();
    bf16x8 cfr[8];
    { const bf16_t* cp = XC + (row0 + l) * 1024 + 768 + g * 128 + 8 * hi;
#pragma unroll
      for (int k0 = 0; k0 < 8; ++k0) cfr[k0] = *(const bf16x8*)(cp + 16 * k0); }
    f32x16 o0, o1;
#pragma unroll
    for (int r = 0; r < 16; ++r) { o0[r] = 0.f; o1[r] = 0.f; }
#pragma unroll
    for (int k0 = 0; k0 < 8; ++k0) {
        const bf16x8 h0 = *(const bf16x8*)(lds + OFF_HIN + r32 * 256 + (((2 * k0 + hi) ^ (r32 & 15)) * 16));
        const bf16x8 h1 = *(const bf16x8*)(lds + OFF_HIN + (32 + r32) * 256 + (((2 * k0 + hi) ^ (r32 & 15)) * 16));
        o0 = __builtin_amdgcn_mfma_f32_32x32x16_bf16(h0, cfr[k0], o0, 0, 0, 0);
        o1 = __builtin_amdgcn_mfma_f32_32x32x16_bf16(h1, cfr[k0], o1, 0, 0, 0);
    }
    { bf16_t* yr = XC + (row0 + l) * 1024 + h * 64;
      uint2 xa[4], xb[4];
#pragma unroll
      for (int gq = 0; gq < 4; gq += 2) { att::ld_pair16(yr + 8 * gq, hi, xa[gq], xa[gq + 1]); att::ld_pair16(yr + 32 + 8 * gq, hi, xb[gq], xb[gq + 1]); }
      uint2 ya[4], yb[4];
#pragma unroll
      for (int gq = 0; gq < 4; ++gq) { const uint2 y0 = xa[gq], y1 = xb[gq];
          ya[gq] = make_uint2(cvtpk(bflo(y0.x) + ea * o0[4 * gq], bfhi(y0.x) + ea * o0[4 * gq + 1]), cvtpk(bflo(y0.y) + ea * o0[4 * gq + 2], bfhi(y0.y) + ea * o0[4 * gq + 3]));
          yb[gq] = make_uint2(cvtpk(bflo(y1.x) + ea * o1[4 * gq], bfhi(y1.x) + ea * o1[4 * gq + 1]), cvtpk(bflo(y1.y) + ea * o1[4 * gq + 2], bfhi(y1.y) + ea * o1[4 * gq + 3])); }
#pragma unroll
      for (int gq = 0; gq < 4; gq += 2) { att::st_pair16(yr + 8 * gq, hi, ya[gq], ya[gq + 1]); att::st_pair16(yr + 32 + 8 * gq, hi, yb[gq], yb[gq + 1]); } }
    __syncthreads();
}
}

__device__ __forceinline__ void moba_select_unit(unsigned char* lds, const bf16_t* PROJ, const float* KMEAN, unsigned* SEL, int b, int h, int qb) {
    const int tid = ltid(), lane = tid & 63, hf = lane & 1;
    const int q = qb * 256 + (tid >> 1);
    float* km_s = (float*)lds;
    { const int n = tid >> 4, c4 = (tid & 15) * 4; *(float4*)(km_s + n * 64 + c4) = *(const float4*)(KMEAN + ((size_t)(b * 32 + n)) * 512 + h * 64 + c4); }
    __syncthreads();
    const bf16_t* qp = PROJ + ((size_t)b * SEQ + q) * NPROJ + PC_MQ + h * 64 + hf * 32;
    float qv[32];
#pragma unroll
    for (int c = 0; c < 4; ++c) { const uint4 u = *(const uint4*)(qp + c * 8);
        qv[c * 8 + 0] = bflo(u.x); qv[c * 8 + 1] = bfhi(u.x); qv[c * 8 + 2] = bflo(u.y); qv[c * 8 + 3] = bfhi(u.y); qv[c * 8 + 4] = bflo(u.z); qv[c * 8 + 5] = bfhi(u.z); qv[c * 8 + 6] = bflo(u.w); qv[c * 8 + 7] = bfhi(u.w); }
    float g0 = -INFINITY, g1 = -INFINITY, g2 = -INFINITY; int i0 = 31, i1 = 31, i2 = 31;
    for (int n = 0; n < qb; ++n) {
        const float* km = km_s + n * 64 + hf * 32; float g = 0.f;
#pragma unroll
        for (int c = 0; c < 8; ++c) { const float4 k4 = *(const float4*)(km + 4 * c); g += qv[4 * c] * k4.x + qv[4 * c + 1] * k4.y + qv[4 * c + 2] * k4.z + qv[4 * c + 3] * k4.w; }
        g += __shfl_xor(g, 1);
        if (g > g0) { g2 = g1; i2 = i1; g1 = g0; i1 = i0; g0 = g; i0 = n; }
        else if (g > g1) { g2 = g1; i2 = i1; g1 = g; i1 = n; }
        else if (g > g2) { g2 = g; i2 = n; }
    }
    const int cnt = qb < 3 ? qb : 3;
    if (hf == 0) SEL[(size_t)(b * 8 + h) * SEQ + q] = (unsigned)i0 | ((unsigned)i1 << 5) | ((unsigned)i2 << 10) | ((unsigned)cnt << 15);
    __syncthreads();
}
namespace gat { constexpr int OFF_LIST = 65536, OFF_TABG = 98304, OFF_CNT = 102400; }
__device__ __forceinline__ void moba_gather_unit(unsigned char* lds, bf16_t* PROJ, const unsigned* SEL, const float* btab, bf16_t* PO2, float* PL, int b, int h, int j, int qc) {
    using namespace att;
    const int tid = ltid(), lane = tid & 63, wave = __builtin_amdgcn_readfirstlane(tid >> 6), r32 = lane & 31, hi = lane >> 5;
    const size_t rowbase = (size_t)b * SEQ;
    float* tab = (float*)(lds + gat::OFF_TABG); unsigned* list = (unsigned*)(lds + gat::OFF_LIST); unsigned* cntp = (unsigned*)(lds + gat::OFF_CNT);
    for (int d = tid; d < 1024; d += NT) tab[d] = btab[rel_bucket(d) * 16 + h] * LOG2E;
    if (tid == 0) *cntp = 0u;
    const uint4 selv0 = *(const uint4*)(SEL + (size_t)(b * 8 + h) * SEQ + 4096 * qc + 4 * tid), selv1 = *(const uint4*)(SEL + (size_t)(b * 8 + h) * SEQ + 4096 * qc + 2048 + 4 * tid);
    { const int skey = tid >> 3, sch = tid & 7;
      const bf16_t* kp = PROJ + (rowbase + j * 256 + skey) * NPROJ + h * 64 + sch * 8;
      const uint4 k0 = *(const uint4*)(kp + PC_MK), v0 = *(const uint4*)(kp + PC_MV), k1 = *(const uint4*)(kp + (size_t)64 * NPROJ + PC_MK), v1 = *(const uint4*)(kp + (size_t)64 * NPROJ + PC_MV);
      const uint4 k2 = *(const uint4*)(kp + (size_t)128 * NPROJ + PC_MK), v2 = *(const uint4*)(kp + (size_t)128 * NPROJ + PC_MV), k3 = *(const uint4*)(kp + (size_t)192 * NPROJ + PC_MK), v3 = *(const uint4*)(kp + (size_t)192 * NPROJ + PC_MV);
      unsigned char* kd = lds + skey * 128 + ((sch ^ ((skey >> 1) & 7)) * 16); unsigned char* vd = lds + 8192 + skey * 128 + ((sch ^ (((skey >> 1) & 1) << 2)) * 16);
      *(uint4*)(kd) = k0; *(uint4*)(vd) = v0; *(uint4*)(kd + ST_BYTES) = k1; *(uint4*)(vd + ST_BYTES) = v1;
      *(uint4*)(kd + 2 * ST_BYTES) = k2; *(uint4*)(vd + 2 * ST_BYTES) = v2; *(uint4*)(kd + 3 * ST_BYTES) = k3; *(uint4*)(vd + 3 * ST_BYTES) = v3; }
    __syncthreads();
#pragma unroll
    for (int half = 0; half < 2; ++half) {
        const int qf = 4096 * qc + 2048 * half + 4 * tid, qmin = 256 * (j + 1);
        const uint4 sv4 = half ? selv1 : selv0; const unsigned sv[4] = {sv4.x, sv4.y, sv4.z, sv4.w};
#pragma unroll
        for (int e = 0; e < 4; ++e) { int slot = -1; const int cnt = (int)((sv[e] >> 15) & 3u);
            if (qf + e >= qmin) { if ((int)(sv[e] & 31u) == j && cnt > 0) slot = 0; else if ((int)((sv[e] >> 5) & 31u) == j && cnt > 1) slot = 1; else if ((int)((sv[e] >> 10) & 31u) == j && cnt > 2) slot = 2; }
            const unsigned long long bal = __builtin_amdgcn_ballot_w64(slot >= 0);
            unsigned pos = 0u;
            if (lane == 0 && bal) pos = atomicAdd(cntp, (unsigned)__builtin_popcountll(bal));
            pos = __shfl(pos, 0);
            if (slot >= 0) list[pos + __builtin_popcountll(bal & ((1ull << lane) - 1ull))] = (unsigned)(qf + e) | ((unsigned)slot << 13); }
    }
    __syncthreads();
    const int n = (int)*cntp, ngroups = (n + 31) >> 5;
    const int vtr_off = ((lane & 15) >> 2) * 128 + (16 * ((lane >> 4) & 1) + 4 * (lane & 3)) * 2 + 4 * hi * 128;
    uint4 qraw[4]; unsigned entn = 0u;
    if (wave < ngroups) { const int ei = 32 * wave + r32; entn = list[ei < n ? ei : n - 1];
        const bf16_t* qp = PROJ + (rowbase + (int)(entn & 8191u)) * NPROJ + PC_MQ + h * 64 + 8 * hi;
#pragma unroll
        for (int d0 = 0; d0 < 4; ++d0) qraw[d0] = *(const uint4*)(qp + 16 * d0); }
    for (int grp = wave; grp < ngroups; grp += 8) {
        const int ei = 32 * grp + r32; const bool valid = ei < n; const unsigned ent = entn;
        const int q = (int)(ent & 8191u), slot = (int)(ent >> 13);
        bf16x8 qr[4];
        {
#pragma unroll
          for (int d0 = 0; d0 < 4; ++d0) { const uint4 u = qraw[d0];
              uint4 w; w.x = cvtpk(bflo(u.x) * C2, bfhi(u.x) * C2); w.y = cvtpk(bflo(u.y) * C2, bfhi(u.y) * C2); w.z = cvtpk(bflo(u.z) * C2, bfhi(u.z) * C2); w.w = cvtpk(bflo(u.w) * C2, bfhi(u.w) * C2);
              qr[d0] = __builtin_bit_cast(bf16x8, w); } }
        if (grp + 8 < ngroups) { const int ein = 32 * (grp + 8) + r32; entn = list[ein < n ? ein : n - 1];
            const bf16_t* qp = PROJ + (rowbase + (int)(entn & 8191u)) * NPROJ + PC_MQ + h * 64 + 8 * hi;
#pragma unroll
            for (int d0 = 0; d0 < 4; ++d0) qraw[d0] = *(const uint4*)(qp + 16 * d0); }
        f32x16 o0, o1;
#pragma unroll
        for (int r = 0; r < 16; ++r) { o0[r] = 0.f; o1[r] = 0.f; }
        float m = -1e30f, l = 0.f;
#pragma unroll 1
        for (int t = 0; t < 4; ++t) {
            const unsigned char* Ks = lds + t * ST_BYTES; const unsigned char* Vt = Ks + 8192;
            const int key0 = j * 256 + t * 64; f32x16 p0, p1;
            { const int dq = q - key0 - 4 * hi;
              if (__builtin_amdgcn_ballot_w64(q - (key0 + 63) >= 790) == ~0ull) { const float c31 = tab[1023];
#pragma unroll
                  for (int r = 0; r < 16; ++r) { p0[r] = c31; p1[r] = c31; } }
              else {
#pragma unroll
                  for (int r = 0; r < 16; ++r) { const int kofs = (r & 3) + 8 * (r >> 2); const int d0_ = dq - kofs, d1_ = dq - kofs - 32;
                      p0[r] = tab[d0_ > 1023 ? 1023 : d0_]; p1[r] = tab[d1_ > 1023 ? 1023 : d1_]; } } }
#pragma unroll
            for (int d0 = 0; d0 < 4; ++d0) {
                const bf16x8 a0 = *(const bf16x8*)(Ks + r32 * 128 + (((2 * d0 + hi) ^ ((r32 >> 1) & 7)) * 16));
                const bf16x8 a1 = *(const bf16x8*)(Ks + (32 + r32) * 128 + (((2 * d0 + hi) ^ ((r32 >> 1) & 7)) * 16));
                p0 = __builtin_amdgcn_mfma_f32_32x32x16_bf16(a0, qr[d0], p0, 0, 0, 0);
                p1 = __builtin_amdgcn_mfma_f32_32x32x16_bf16(a1, qr[d0], p1, 0, 0, 0);
            }
            float mx = rowmax32(p0, p1);
            mx = fmaxf(mx, __shfl_xor(mx, 32));
            const float mn = fmaxf(m, mx);
            if (__builtin_amdgcn_ballot_w64(mn > m) != 0ull) {
                const float alpha = __builtin_amdgcn_exp2f(m - mn); l *= alpha;
#pragma unroll
                for (int r = 0; r < 16; ++r) { o0[r] *= alpha; o1[r] *= alpha; }
            }
            m = mn;
            float sum = 0.f;
#pragma unroll
            for (int r = 0; r < 16; ++r) { p0[r] = __builtin_amdgcn_exp2f(p0[r] - mn); p1[r] = __builtin_amdgcn_exp2f(p1[r] - mn); sum += p0[r] + p1[r]; }
            l += sum;
            bf16x8 pa[4];
#pragma unroll
            for (int ks = 0; ks < 4; ++ks) { uint4 w;
                if (ks < 2) { w.x = cvtpk(p0[8 * ks], p0[8 * ks + 1]); w.y = cvtpk(p0[8 * ks + 2], p0[8 * ks + 3]); w.z = cvtpk(p0[8 * ks + 4], p0[8 * ks + 5]); w.w = cvtpk(p0[8 * ks + 6], p0[8 * ks + 7]); }
                else { const int k2 = ks - 2; w.x = cvtpk(p1[8 * k2], p1[8 * k2 + 1]); w.y = cvtpk(p1[8 * k2 + 2], p1[8 * k2 + 3]); w.z = cvtpk(p1[8 * k2 + 4], p1[8 * k2 + 5]); w.w = cvtpk(p1[8 * k2 + 6], p1[8 * k2 + 7]); }
                pa[ks] = __builtin_bit_cast(bf16x8, w); }
#pragma unroll
            for (int ks = 0; ks < 4; ++ks) {
#pragma unroll
                for (int db = 0; db < 2; ++db) {
                    const LASC unsigned char* vp = (const LASC unsigned char*)(Vt + vtr_off + ks * 16 * 128 + ((db ^ ((lane >> 3) & 1)) * 64));
                    const s16x4 lo = __builtin_bit_cast(s16x4, __builtin_amdgcn_ds_read_tr16_b64_v4i16((LASC v4i16_t*)vp));
                    const s16x4 hh = __builtin_bit_cast(s16x4, __builtin_amdgcn_ds_read_tr16_b64_v4i16((LASC v4i16_t*)(vp + 8 * 128)));
                    const bf16x8 vf = {lo[0], lo[1], lo[2], lo[3], hh[0], hh[1], hh[2], hh[3]};
                    if (db == 0) o0 = __builtin_amdgcn_mfma_f32_32x32x16_bf16(vf, pa[ks], o0, 0, 0, 0);
                    else o1 = __builtin_amdgcn_mfma_f32_32x32x16_bf16(vf, pa[ks], o1, 0, 0, 0); }
            }
        }
        l += __shfl_xor(l, 32);
        const float inv = 1.0f / l;
        {
            bf16_t* pp = (slot < 2) ? PROJ + (rowbase + q) * NPROJ + PC_XBC + (h * 2 + slot) * 64 + 8 * hi : PO2 + ((rowbase + q) * 8 + h) * 64 + 8 * hi;
#pragma unroll
            for (int g = 0; g < 4; g += 2) {
                const unsigned a0x = cvtpk(o0[4 * g] * inv, o0[4 * g + 1] * inv), a0y = cvtpk(o0[4 * g + 2] * inv, o0[4 * g + 3] * inv), b0x = cvtpk(o0[4 * g + 4] * inv, o0[4 * g + 5] * inv), b0y = cvtpk(o0[4 * g + 6] * inv, o0[4 * g + 7] * inv);
                const unsigned a1x = cvtpk(o1[4 * g] * inv, o1[4 * g + 1] * inv), a1y = cvtpk(o1[4 * g + 2] * inv, o1[4 * g + 3] * inv), b1x = cvtpk(o1[4 * g + 4] * inv, o1[4 * g + 5] * inv), b1y = cvtpk(o1[4 * g + 6] * inv, o1[4 * g + 7] * inv);
                const auto r0x = __builtin_amdgcn_permlane32_swap(a0x, b0x, false, false), r0y = __builtin_amdgcn_permlane32_swap(a0y, b0y, false, false);
                const auto r1x = __builtin_amdgcn_permlane32_swap(a1x, b1x, false, false), r1y = __builtin_amdgcn_permlane32_swap(a1y, b1y, false, false);
                if (valid) { *(uint4*)(pp + 8 * g) = make_uint4(r0x[0], r0y[0], r0x[1], r0y[1]); *(uint4*)(pp + 32 + 8 * g) = make_uint4(r1x[0], r1y[0], r1x[1], r1y[1]); } }
            if (valid && hi == 0) PL[((rowbase + q) * 8 + h) * 4 + slot] = m + __builtin_amdgcn_logf(l);
        }
    }
    __syncthreads();
}
#define MIX_WS ({ unsigned char* p_ = ws0; asm volatile("" : "+s"(p_)); p_; })
#define QUEUE_NEXT(u, word) do { if (tid == 0) *(volatile unsigned*)(lds + 131072 + 64) = atomicAdd((unsigned*)(MIX_WS + WS_CTL + 32768) + 64 * (word), 1u); \
        __syncthreads(); u = *(volatile unsigned*)(lds + 131072 + 64); __syncthreads(); } while (0)
__device__ __forceinline__ void ph_mixers(unsigned char* lds, unsigned char* ws0, const float* a_log, const float* d_skip, const float* sinks, const float* btab, int l, const float* const* in) {
    const int tid = ltid();
    bool swa_ok = false;
    for (;;) {
        unsigned u; QUEUE_NEXT(u, 3 * l);
        if (u >= 1536u + 64u + (unsigned)((WCV_ALL - WCV_IN) / WCV_CHUNK)) break;
        if (u >= 1536u + 64u) {
            const int lo = WCV_IN + (int)(u - (1536u + 64u)) * WCV_CHUNK; unsigned char* ws = MIX_WS;
            ph_wconv(ws, in[1] + (size_t)l * D * DIN, in[11] + (size_t)l * 4 * 512 * 1024, in[12] + (size_t)l * D * D, in[15] + (size_t)l * D * DFF, in[16] + (size_t)l * D * DFF, in[17] + (size_t)l * DFF * D,
                     (LAS float*)lds, lo, lo + WCV_CHUNK, 0, 1);
            continue; }
        if (u < 64u) {
            unsigned char* ws = MIX_WS;
            pg8::OneSched S; S.u0.A = (const char*)P_XN(ws) + (size_t)u * 256 * (D * 2); S.u0.B = (const char*)(ws + WS_WIN) + (size_t)INP_TILES * 256 * (D * 2);
            S.u0.lda2 = D * 2; S.u0.ldb2 = D * 2; S.u0.nt = D / 64; S.u0.pm = (int)u; S.u0.pn = INP_TILES; S.u0.aux = 0;
            pg8::EpiStoreBf16 E{P_PROJ(ws), NPROJ}; pg8::gemm_phase<pg8::EpiStoreBf16, pg8::OneSched, true>((LAS unsigned char*)lds, S, E);
            if (tid == 0) { __builtin_amdgcn_fence(__ATOMIC_RELEASE, "agent"); asm volatile("s_waitcnt vmcnt(0)" ::: "memory"); (void)q_add((unsigned*)(ws + WS_CTL + 32768) + 64 * (6 + l), 1u); }
            continue;
        }
        u -= 64u;
        const int k = (int)(u & 511u);
        if (u < 512u) { const int qb = 31 - (k >> 4), bh = k & 15; unsigned char* ws = MIX_WS;
            att::attn_unit<att::MODE_FOX>(lds, P_PROJ(ws), (const float*)(ws + WS_LF), (const float*)(ws + WS_CUM), 0, 0.f, bh >> 3, bh & 7, bh & 7, qb, PC_FQ, PC_FK, PC_FV, false, (const void*)(ws + WS_KMEAN), (const void*)(ws + WS_SEL)); }
        else if (u < 1024u) { unsigned char* ws = MIX_WS; ssd::m1_unit(lds, P_XC(ws), (const float*)(ws + WS_DT), a_log, d_skip, (bf16_t*)(ws + WS_STATES), (float*)(ws + WS_CDEC), k >> 8, (k >> 3) & 31, k & 7); }
        else if (u < 1536u) { const int bh = k >> 5, qb = k & 31, hq = bh & 7; unsigned char* ws = MIX_WS;
            if (!swa_ok) {
                if (tid == 0) { unsigned sp = 0; while (q_ld((unsigned*)(ws + WS_CTL + 32768) + 64 * (6 + l)) < 64u) { __builtin_amdgcn_s_sleep(2); if (++sp > (1u << 22)) break; } }
                __syncthreads();
                __builtin_amdgcn_fence(__ATOMIC_ACQUIRE, "agent"); asm volatile("s_waitcnt vmcnt(0)" ::: "memory");
                __syncthreads();
                swa_ok = true; }
            att::attn_unit<att::MODE_SWA>(lds, P_PROJ(ws), nullptr, btab, 8 + hq, sinks[hq], bh >> 3, hq, hq >> 2, qb, PC_SQ, PC_SK, PC_SV); }
    }
}
__device__ __forceinline__ void ph_mixers_b(unsigned char* lds, unsigned char* ws0, const float* a_log, const float* btab, int l) {
    const int tid = ltid();
    for (;;) {
        unsigned u; QUEUE_NEXT(u, 3 * l + 1);
        if (u >= 736u + 512u) break;
        if (u < 736u) { const int bh = (int)u & 15, idx = (int)u >> 4;
            const int qc = idx < 15 ? 0 : 1, j = idx - (qc == 0 ? 0 : 15); unsigned char* ws = MIX_WS;
            moba_gather_unit(lds, P_PROJ(ws), (const unsigned*)(ws + WS_SEL), btab, (bf16_t*)(ws + WS_PO2), (float*)(ws + WS_PL), bh >> 3, bh & 7, j, qc); }
        else { const int k = (int)u - 736, c = 31 - (k >> 4), bh = k & 15; unsigned char* ws = MIX_WS;
            ssd::m2_unit(lds, P_XC(ws), (const float*)(ws + WS_DT), a_log, (const bf16_t*)(ws + WS_STATES), (const float*)(ws + WS_CDEC), bh >> 3, c, bh & 7); }
    }
}
__device__ __forceinline__ void ph_mixers_c(unsigned char* lds, unsigned char* ws0, const float* btab, const float* ssm_norm_w, int l) {
    const int tid = ltid();
    for (;;) {
        unsigned u; QUEUE_NEXT(u, 3 * l + 2);
        if (u >= 512u + 512u) break;
        if (u >= 512u) {
            const int r0 = ((int)u - 512) * 32; unsigned char* ws = MIX_WS;
            ph_mamba_norm(P_PROJ(ws), P_XC(ws), ssm_norm_w, r0 + (tid >> 6) * 4, 1, r0 + (tid >> 6) * 4 + 4);
            continue; }
        const int qb = 31 - ((int)u >> 4), bh = (int)u & 15, h = bh & 7; unsigned char* ws = MIX_WS;
        att::attn_unit<att::MODE_MOWN>(lds, P_PROJ(ws), (const float*)(ws + WS_SEL), btab, h, 0.f, bh >> 3, h, h, qb, PC_MQ, PC_MK, PC_MV, false, (const void*)(ws + WS_PO2), (const void*)(ws + WS_PL));
    }
}
#define XB_TMO      128
#define XB_XCNT(j)  (256  + 64 * (j))
#define XB_XSUB(j)  (1280 + 64 * (j))
#define XB_XGEN(j)  (2304 + 64 * (j))
#define XB_TOP      3328
#define XB_TOPGEN   3392
#define XCD_BAR_WORDS 3456
#define XB_SPIN_CAP (1u << 18)

__device__ __forceinline__ unsigned xb_ld(unsigned* p)              { return __hip_atomic_load(p, __ATOMIC_RELAXED, __HIP_MEMORY_SCOPE_AGENT); }
__device__ __forceinline__ unsigned xb_add(unsigned* p, unsigned v) { return __hip_atomic_fetch_add(p, v, __ATOMIC_RELAXED, __HIP_MEMORY_SCOPE_AGENT); }
__device__ __forceinline__ unsigned xb_xcc_id() { return (unsigned)__builtin_amdgcn_s_getreg((3 << 11) | 20) & 0xFu; }
#define XB_SPIN(cond, bar) do { unsigned _sp = 0; while (cond) { __builtin_amdgcn_s_sleep(1); \
    if ((++_sp & 255u) == 0u) { if (xb_ld(&(bar)[XB_TMO])) break; if (_sp > XB_SPIN_CAP) { atomicAdd(&(bar)[XB_TMO], 1u); break; } } } } while (0)

struct XcdBarrier {
    unsigned* bar; unsigned x;
    volatile LAS unsigned* st;
};

__device__ __forceinline__ XcdBarrier xcd_barrier_post(unsigned* bar, volatile LAS unsigned* st) {
    XcdBarrier b; b.bar = bar; b.x = xb_xcc_id(); b.st = st;
    if (threadIdx.x == 0) (void)xb_add(&bar[XB_XCNT(b.x)], 1u);
    return b;
}
__device__ __forceinline__ void xcd_barrier_complete(unsigned* bar, unsigned x, unsigned& nloc, unsigned& nx) {
    const unsigned G = gridDim.x * gridDim.y * gridDim.z;
    unsigned sum, cnt, mine, sp = 0u;
    for (;;) {
        sum = 0u; cnt = 0u; mine = 0u;
#pragma unroll
        for (unsigned j = 0; j < 16; ++j) { const unsigned c = xb_ld(&bar[XB_XCNT(j)]); sum += c; cnt += (c > 0u) ? 1u : 0u; mine = (j == x) ? c : mine; }
        if (sum == G) break;
        __builtin_amdgcn_s_sleep(1);
        if ((++sp & 255u) == 0u) { if (xb_ld(&bar[XB_TMO])) break; if (sp > XB_SPIN_CAP) { atomicAdd(&bar[XB_TMO], 1u); break; } }
    }
    nloc = mine > 0u ? mine : 1u; nx = cnt > 0u ? cnt : 1u;
}

__device__ __forceinline__ void xcd_barrier(const XcdBarrier& b) {
    asm volatile("s_waitcnt vmcnt(0)" ::: "memory");
    __syncthreads();
    if (threadIdx.x == 0) {
        unsigned* bar = b.bar;
        __builtin_amdgcn_s_waitcnt(0);
        unsigned nloc = b.st[0], nx = b.st[1];
        if (nloc == 0u) { xcd_barrier_complete(bar, b.x, nloc, nx); b.st[0] = nloc; b.st[1] = nx;
            { unsigned xx_ = b.x; asm volatile("" : "+s"(xx_)); atomicOr(bar + 6144 + 64 * (8 + (blockIdx.x & 7)), 1u << xx_); } }
        const unsigned old = xb_add(&bar[XB_XSUB(b.x)], 1u);
        const unsigned gen = old / nloc;
        if (old + 1u == (gen + 1u) * nloc) {
            __builtin_amdgcn_fence(__ATOMIC_RELEASE, "agent");
            asm volatile("s_waitcnt vmcnt(0)" ::: "memory");
            const unsigned og = xb_add(&bar[XB_TOP], 1u);
            const unsigned tg = og / nx;
            __builtin_amdgcn_fence(__ATOMIC_ACQUIRE, "agent");
            if (og + 1u == (tg + 1u) * nx) xb_add(&bar[XB_TOPGEN], 1u);
            else XB_SPIN(xb_ld(&bar[XB_TOPGEN]) == tg, bar);
            xb_add(&bar[XB_XGEN(b.x)], 1u);
            asm volatile("s_waitcnt vmcnt(0)" ::: "memory");
        } else {
            __builtin_amdgcn_fence(__ATOMIC_ACQUIRE, "agent");
            XB_SPIN(xb_ld(&bar[XB_XGEN(b.x)]) == gen, bar);
            asm volatile("s_waitcnt vmcnt(0)" ::: "memory");
        }
    }
    __syncthreads();
}

__device__ __forceinline__ void grp_barrier(unsigned* bar, volatile LAS unsigned* st) {
    asm volatile("s_waitcnt vmcnt(0)" ::: "memory");
    __syncthreads();
    if (threadIdx.x == 0) {
        unsigned* cnt = bar + 6144 + 64 * (blockIdx.x & 7); unsigned* mask = cnt + 512; unsigned* tmo = bar + XB_TMO; const unsigned nper = gridDim.x >> 3;
        unsigned sx = st[0];
        if (sx == 0u) { const unsigned m_ = xb_ld(mask); sx = (m_ != 0u && (m_ & (m_ - 1u)) == 0u) ? 1u : 2u; st[0] = sx; }
        if (sx != 1u) { __builtin_amdgcn_fence(__ATOMIC_RELEASE, "agent"); asm volatile("s_waitcnt vmcnt(0)" ::: "memory"); }
        const unsigned old = xb_add(cnt, 1u), target = (old / nper + 1u) * nper;
        __builtin_amdgcn_fence(__ATOMIC_ACQUIRE, "agent");
        unsigned sp = 0u; while (xb_ld(cnt) < target) { __builtin_amdgcn_s_sleep(1); if ((++sp & 255u) == 0u) { if (xb_ld(tmo)) break; if (sp > XB_SPIN_CAP) { atomicAdd(tmo, 1u); break; } } }
        asm volatile("s_waitcnt vmcnt(0)" ::: "memory");
    }
    __syncthreads();
}

constexpr int MISC_OFF = 131072 + 320;
constexpr int LDS_BYTES = 147456;
constexpr int HROW_OFF = 69632;
#define GRID_SYNC() xcd_barrier(bar)
#define WSL ({ unsigned char* p_ = a.ws; asm volatile("" : "+s"(p_)); p_; })
__global__ void __launch_bounds__(NT, 2) fwd(Args a) {
    extern __shared__ __attribute__((aligned(16))) unsigned char lds[];
    LAS unsigned char* L = (LAS unsigned char*)lds;
    volatile LAS unsigned* MISC = (volatile LAS unsigned*)(L + MISC_OFF);
    if (threadIdx.x < 32) MISC[threadIdx.x] = 0u;
    __syncthreads();
    XcdBarrier bar = xcd_barrier_post((unsigned*)(a.ws + WS_CTL) + 4096, MISC + 8);
#define GROUPED true
#define GCTL ((unsigned*)(WSL + WS_CTL + 32768) + 64 * 32)
#define GROUP_SYNC() grp_barrier(bar.bar, MISC + 13)
#pragma unroll 1
    for (int l = 0; l < 2; ++l) {
        {
            unsigned char* ws = WSL; const float* w_in = a.in[1] + (size_t)l * D * DIN;
            ph_wconv(ws, w_in, a.in[11] + (size_t)l * 4 * 512 * 1024, a.in[12] + (size_t)l * D * D, a.in[15] + (size_t)l * D * DFF, a.in[16] + (size_t)l * D * DFF, a.in[17] + (size_t)l * DFF * D, (LAS float*)L, 0, WCV_IN, blockIdx.x, gridDim.x);
            __syncthreads();
            for (int e = blockIdx.x * NT + ltid(); e < 16 * D; e += gridDim.x * NT) { const int c = e >> 10, k = e & (D - 1);
                ((bf16_t*)(ws + WS_WDTF))[e] = (bf16_t)f2bf(w_in[(size_t)k * DIN + (c < 8 ? WC_DT + c : WC_F + (c - 8))]); }
            if (l == 0) ph_norm<false>((float*)lds, a.in[0], a.in[13] + l * D, P_XN(ws), false, w_in, a.in[4] + l * 8, a.in[8] + l * 8, (float*)(ws + WS_DT), (float*)(ws + WS_LF), (bf16_t*)a.out, GROUPED);
            else ph_norm<true>((float*)lds, a.out, a.in[13] + l * D, P_XN(ws), false, w_in, a.in[4] + l * 8, a.in[8] + l * 8, (float*)(ws + WS_DT), (float*)(ws + WS_LF), nullptr, GROUPED);
        }
        GRID_SYNC();
        {
            unsigned char* ws = WSL;
            pg8::PlainSched S; S.T.init(M / 256, INP_TILES, gridDim.x, blockIdx.x); S.A = (const char*)P_XN(ws); S.B = (const char*)(ws + WS_WIN); S.lda2 = D * 2; S.ldb2 = D * 2; S.nt = D / 64;
            pg8::EpiStoreBf16 E{P_PROJ(ws), NPROJ}; pg8::gemm_phase<pg8::EpiStoreBf16, pg8::PlainSched, true>(L, S, E);
        }
        GRID_SYNC();
        { unsigned char* ws = WSL; ph_pre(lds, P_PROJ(ws), a.in[2] + (size_t)l * 4 * 1024, a.in[3] + l * 1024, P_XC(ws), (float*)(ws + WS_KMEAN), (float*)(ws + WS_CUM),
                                          P_XN(ws), (const bf16_t*)(ws + WS_WDTF), a.in[4] + l * 8, a.in[8] + l * 8, (float*)(ws + WS_DT), (float*)(ws + WS_LF)); }
        GRID_SYNC();
        ph_mixers(lds, a.ws, a.in[5] + l * 8, a.in[6] + l * 8, a.in[9] + l * 8, a.in[10], l, a.in);
        GRID_SYNC();
        ph_mixers_b(lds, a.ws, a.in[5] + l * 8, a.in[10], l);
        GRID_SYNC();
        ph_mixers_c(lds, a.ws, a.in[10], a.in[7] + l * 512, l);
        GRID_SYNC();
        {
            unsigned char* ws = WSL;
            pg8::GBSched S; S.T.init(M / 256, D / 256, gridDim.x, blockIdx.x); S.XN = (const char*)P_XN(ws); S.WG = (const char*)(ws + WS_WG); S.PROJ = (const char*)P_PROJ(ws); S.WBR = (const char*)(ws + WS_WBR);
            pg8::EpiGB E{P_PROJ(ws), P_XC(ws), (bf16_t*)a.out + (size_t)M * D}; pg8::gemm_phase<pg8::EpiGB, pg8::GBSched, true>(L, S, E);
        }
        GROUP_SYNC();
        {
            unsigned char* ws = WSL;
            pg8::PlainSched S; S.T.init(M / 256, D / 256, gridDim.x, blockIdx.x); S.A = (const char*)((const bf16_t*)a.out + (size_t)M * D); S.B = (const char*)(ws + WS_WOUT); S.lda2 = D * 2; S.ldb2 = D * 2; S.nt = D / 64;
            pg8::EpiRes E{(const bf16_t*)a.out, (void*)P_XC(ws), false}; pg8::gemm_phase<pg8::EpiRes, pg8::PlainSched, false>(L, S, E);
        }
        GROUP_SYNC();
        { unsigned char* ws = WSL; ph_norm<true>(nullptr, P_XC(ws), a.in[14] + l * D, P_XN(ws), false, nullptr, nullptr, nullptr, nullptr, nullptr, nullptr, GROUPED); }
        GROUP_SYNC();
        {
            unsigned char* ws = WSL;
            pg8::PlainSched S; S.T.init(M / 256, 2 * DFF / 256, gridDim.x, blockIdx.x); S.A = (const char*)P_XN(ws); S.B = (const char*)(ws + WS_WGU); S.lda2 = D * 2; S.ldb2 = D * 2; S.nt = D / 64;
            pg8::EpiSwiglu E{P_PROJ(ws), NPROJ}; pg8::gemm_phase<pg8::EpiSwiglu, pg8::PlainSched, true>(L, S, E);
        }
        GROUP_SYNC();
        {
            unsigned char* ws = WSL;
            pg8::PlainSched S; S.T.init(M / 256, D / 256, gridDim.x, blockIdx.x); S.A = (const char*)P_PROJ(ws); S.B = (const char*)(ws + WS_WDN); S.lda2 = NPROJ * 2; S.ldb2 = DFF * 2; S.nt = DFF / 64;
            pg8::EpiRes E{P_XC(ws), l == 0 ? (void*)a.out : (void*)P_XN(ws), false}; pg8::gemm_phase<pg8::EpiRes, pg8::PlainSched, false>(L, S, E);
        }
        if (l == 0) GROUP_SYNC(); else GRID_SYNC();
    }
    { unsigned char* ws = WSL; ph_final(P_XN(ws), a.out, a.in[18]); }
}

extern "C" void kernel_launch(void* const* d_in, const int* in_sizes, int n_in, void* d_out, int out_size, void* d_ws, size_t ws_size, hipStream_t stream) {
    static int grid = 0;
    if (grid == 0) {
        if (n_in != 19 || out_size != M * D || ws_size < WS_TOTAL) { fprintf(stderr, "kernel_launch: unexpected shapes (n_in %d out %d ws %zu)\n", n_in, out_size, ws_size); grid = -1; return; }
        int dev = 0, cus = 0, per_cu = 0;
        (void)hipGetDevice(&dev); (void)hipDeviceGetAttribute(&cus, hipDeviceAttributeMultiprocessorCount, dev);
        if (hipFuncSetAttribute((const void*)fwd, hipFuncAttributeMaxDynamicSharedMemorySize, LDS_BYTES) != hipSuccess) { fprintf(stderr, "kernel_launch: hipFuncSetAttribute failed\n"); grid = -1; return; }
        (void)hipOccupancyMaxActiveBlocksPerMultiprocessor(&per_cu, (const void*)fwd, NT, LDS_BYTES);
        if (per_cu < 1) { fprintf(stderr, "kernel_launch: occupancy query says 0 blocks per CU\n"); grid = -1; return; }
        if (cus < 256) { fprintf(stderr, "kernel_launch: %d CUs, the phase program (group barriers, tile rounds) is laid out for 256 workgroups\n", cus); grid = -1; return; }
        grid = 256;
    }
    if (grid < 0) return;
    if (hipMemsetAsync((char*)d_ws + WS_CTL, 0, CTL_ZERO_BYTES, stream) != hipSuccess) { fprintf(stderr, "kernel_launch: memset of the control words failed\n"); return; }
    Args a{};
    for (int i = 0; i < 19; ++i) a.in[i] = (const float*)d_in[i];
    a.out = (float*)d_out; a.ws = (unsigned char*)d_ws;
    hipLaunchKernelGGL(fwd, dim3(grid), dim3(NT), LDS_BYTES, stream, a);
}
```
